# Optimizing an MI355X kernel written in HIP

```python
import jax
import jax.numpy as jnp
from jax import lax
import numpy as np

D_MODEL = 2048
BATCH = 2
SEQ = 4096
DEPTH = 2

CTX_LEN = 256
GRID_W = 64

BRANCH_W = D_MODEL // 2
N_BRANCH = 3
ML_HEADS = 4
ML_DV = BRANCH_W // ML_HEADS
ML_DQK = ML_DV // 2
ML_CHUNK = 64
RW_DH = 64
RW_HEADS = BRANCH_W // RW_DH
RW_W = RW_HEADS * RW_DH
RW_DECAY_LORA = 96
RW_ICLR_LORA = 96
RW_GATE_LORA = 256
RW_GN_EPS = 64e-5
NA_DH = 128
NA_HEADS = BRANCH_W // NA_DH
NA_WIN_R = 8
NA_WIN_C = 16
D_FF = 4 * D_MODEL
ROPE_BASE = 10000.0
EPS = 1e-6

ML_SIZES = (ML_HEADS * ML_DQK, ML_HEADS * ML_DQK, ML_HEADS * ML_DV, ML_HEADS * ML_DV, 4 * ML_HEADS)
RW_SIZES = (RW_W, RW_W, RW_W, RW_DECAY_LORA, RW_DECAY_LORA, RW_ICLR_LORA, RW_ICLR_LORA, RW_GATE_LORA)
NA_SIZES = (NA_HEADS * NA_DH, NA_HEADS * NA_DH, NA_HEADS * NA_DH)
GROUP_SIZES = (sum(ML_SIZES), sum(RW_SIZES), sum(NA_SIZES), N_BRANCH * D_MODEL)
D_IN = sum(GROUP_SIZES)

kernel_name = 'hybrid_mlstm_rwkv7_natten_dit'


def split_last(t, sizes):
    out, o = [], 0
    for s in sizes:
        out.append(t[..., o:o + s])
        o += s
    return out


def rms_norm(x, g):
    xf = x.astype(jnp.float32)
    y = xf * lax.rsqrt(jnp.mean(xf * xf, axis=-1, keepdims=True) + EPS)
    return (y * g).astype(x.dtype)


def modulate(h, shift, scale):
    return (h * (1 + scale) + shift).astype(h.dtype)


def sq_relu_mlp(h, w1, w2):
    return jnp.square(jax.nn.relu(h @ w1)) @ w2


def rope_1d(x, pos):
    nf = x.shape[-1] // 2
    freqs = ROPE_BASE ** (-jnp.arange(nf, dtype=jnp.float32) / nf)
    ang = pos.astype(jnp.float32)[:, None] * freqs[None, :]
    cos, sin = jnp.cos(ang)[:, None, :], jnp.sin(ang)[:, None, :]
    x1, x2 = x[..., :nf].astype(jnp.float32), x[..., nf:].astype(jnp.float32)
    return jnp.concatenate([x1 * cos - x2 * sin, x1 * sin + x2 * cos], axis=-1).astype(x.dtype)


def axial_rope(x):
    t = jnp.arange(x.shape[1])
    half = x.shape[-1] // 2
    return jnp.concatenate([rope_1d(x[..., :half], t // GRID_W), rope_1d(x[..., half:], t % GRID_W)], axis=-1)


def centred_shift(p, mu):
    prev = jnp.pad(p[:, :-1], ((0, 0), (1, 0), (0, 0)))
    nxt = jnp.pad(p[:, 1:], ((0, 0), (0, 1), (0, 0)))
    return p + mu * (0.5 * (prev + nxt) - p)


def mlstm_chunkwise(q, k, v, ig, lf, state, with_output):
    B, H, T, dk = k.shape
    dv = v.shape[-1]
    L = ML_CHUNK
    nc = T // L
    kc = k.astype(jnp.float32).reshape(B, H, nc, L, dk)
    vc = v.astype(jnp.float32).reshape(B, H, nc, L, dv)
    igc = ig.reshape(B, H, nc, L)
    b = jnp.cumsum(lf.reshape(B, H, nc, L), axis=-1)
    b_end = b[..., -1]
    a = b_end[..., None] - b + igc
    a_max = jnp.max(a, axis=-1)
    wgt = jnp.exp(a - a_max[..., None])
    C_loc = jnp.einsum('bhclv,bhclk->bhcvk', vc * wgt[..., None], kc)
    n_loc = jnp.einsum('bhcl,bhclk->bhck', wgt, kc)

    def step(carry, inp):
        C, n, m = carry
        Cl, nl, ge, am = inp
        m_new = jnp.maximum(ge + m, am)
        so, sl = jnp.exp(ge + m - m_new), jnp.exp(am - m_new)
        new = (so[..., None, None] * C + sl[..., None, None] * Cl, so[..., None] * n + sl[..., None] * nl, m_new)
        return new, (C, n, m)

    xs = tuple(jnp.moveaxis(t, 2, 0) for t in (C_loc, n_loc, b_end, a_max))
    final, inits = lax.scan(step, state, xs)
    if not with_output:
        return None, final
    C0, n0, m0 = (jnp.moveaxis(t, 0, 2) for t in inits)
    qc = q.astype(jnp.float32).reshape(B, H, nc, L, dk)
    lower = jnp.tril(jnp.ones((L, L), dtype=bool))
    log_intra = jnp.where(lower, b[..., :, None] - b[..., None, :] + igc[..., None, :], -jnp.inf)
    log_inter = b + m0[..., None]
    m_j = jnp.maximum(log_inter, jnp.max(log_intra, axis=-1))
    s = jnp.einsum('bhcjd,bhcsd->bhcjs', qc, kc) * jnp.exp(log_intra - m_j[..., None])
    w_inter = jnp.exp(log_inter - m_j)
    num = jnp.einsum('bhcjs,bhcsv->bhcjv', s, vc) + w_inter[..., None] * jnp.einsum('bhcvd,bhcjd->bhcjv', C0, qc)
    den = jnp.sum(s, axis=-1) + w_inter * jnp.einsum('bhcd,bhcjd->bhcj', n0, qc)
    h = num / jnp.maximum(jnp.abs(den), jnp.exp(-m_j))[..., None]
    return h.reshape(B, H, T, dv), final


def mlstm_branch(pc, pl, gate_b, norm_g, with_ctx):
    qc, kc, vc, oc, gc = split_last(pc, ML_SIZES)
    ql, kl, vl, ol, gl = split_last(pl, ML_SIZES)
    B = pl.shape[0]
    scale = ML_DQK ** -0.5

    def heads(t, d, rope):
        t = t.reshape(t.shape[0], t.shape[1], ML_HEADS, d)
        if rope:
            t = axial_rope(t)
        return jnp.swapaxes(t, 1, 2)

    def gates(g):
        g = (g + gate_b).astype(jnp.float32).reshape(g.shape[0], g.shape[1], 4, ML_HEADS)
        g = jnp.moveaxis(g, 1, 3)
        return (g[:, 0], jax.nn.log_sigmoid(g[:, 1])), (g[:, 2], jax.nn.log_sigmoid(g[:, 3]))

    fl = lambda t: jnp.flip(t, axis=2)
    q_c = heads(qc * scale, ML_DQK, False) if with_ctx else None
    k_c, v_c = heads(kc, ML_DQK, False), heads(vc, ML_DV, False)
    q_l, k_l, v_l = heads(ql * scale, ML_DQK, True), heads(kl, ML_DQK, True), heads(vl, ML_DV, False)
    (ic_f, lc_f), (ic_b, lc_b) = gates(gc)
    (il_f, ll_f), (il_b, ll_b) = gates(gl)
    zero = (jnp.zeros((B, ML_HEADS, ML_DV, ML_DQK), jnp.float32),
            jnp.zeros((B, ML_HEADS, ML_DQK), jnp.float32),
            jnp.zeros((B, ML_HEADS), jnp.float32))
    h_cf, s_f = mlstm_chunkwise(q_c, k_c, v_c, ic_f, lc_f, zero, with_ctx)
    h_lf, _ = mlstm_chunkwise(q_l, k_l, v_l, il_f, ll_f, s_f, True)
    h_cb, s_b = mlstm_chunkwise(fl(q_c) if with_ctx else None, fl(k_c), fl(v_c), fl(ic_b), fl(lc_b), zero, with_ctx)
    h_lb, _ = mlstm_chunkwise(fl(q_l), fl(k_l), fl(v_l), fl(il_b), fl(ll_b), s_b, True)

    def post(h, o):
        Bh, _, T, _ = h.shape
        h = h * lax.rsqrt(jnp.mean(h * h, axis=-1, keepdims=True) + EPS)
        h = jnp.swapaxes(h, 1, 2).reshape(Bh, T, BRANCH_W) * norm_g
        return (h * jax.nn.sigmoid(o.astype(jnp.float32))).astype(o.dtype)

    y_l = post(h_lf + fl(h_lb), ol)
    y_c = post(h_cf + fl(h_cb), oc) if with_ctx else None
    return y_c, y_l


def rwkv7_scan(r, dec, k, v, a, b, S0):
    def step(S, inp):
        r_t, d_t, k_t, v_t, a_t, b_t = inp
        sa = jnp.einsum('bhvk,bhk->bhv', S, a_t)
        S = S * d_t[:, :, None, :] + sa[..., :, None] * b_t[..., None, :] + v_t[..., :, None] * k_t[..., None, :]
        return S, jnp.einsum('bhvk,bhk->bhv', S, r_t)
    xs = tuple(jnp.moveaxis(t.astype(jnp.float32), 1, 0) for t in (r, dec, k, v, a, b))
    S, ys = lax.scan(step, S0, xs)
    return jnp.moveaxis(ys, 0, 1), S


def rwkv_prep(p, prm):
    p = centred_shift(p, prm['rw_mu'])
    r, k, v, wfd, wbd, afd, abd, gd = split_last(p, RW_SIZES)
    B, T = p.shape[:2]
    hs = lambda t: t.reshape(B, T, RW_HEADS, RW_DH)
    dirs = []
    for i, (wd, ad) in enumerate(((wfd, afd), (wbd, abd))):
        w = -jax.nn.softplus(-(prm['rw_w0'][i] + jnp.tanh(wd) @ prm['rw_w_up'][i])) - 0.5
        dec = jnp.exp(-jnp.exp(w.astype(jnp.float32)))
        a = jax.nn.sigmoid((prm['rw_a0'][i] + ad @ prm['rw_a_up'][i]).astype(jnp.float32))
        k_dir = k * (1 + (a - 1) * prm['rw_k_a'])
        dirs.append((hs(dec), hs(k_dir), hs(a)))
    kk = hs((k * prm['rw_k_k']).astype(jnp.float32))
    kk = kk / jnp.maximum(jnp.sqrt(jnp.sum(kk * kk, axis=-1, keepdims=True)), 1e-12)
    bonus = jnp.sum(hs(r * k * prm['rw_r_k']), axis=-1, keepdims=True) * hs(v)
    g = jax.nn.sigmoid(gd) @ prm['rw_g_up']
    return {'r': hs(r), 'v': hs(v), 'kk': kk, 'dirs': dirs, 'bonus': bonus, 'g': g}


def rwkv_post(y, s, prm):
    B, T = y.shape[:2]
    mu = jnp.mean(y, axis=-1, keepdims=True)
    var = jnp.mean(jnp.square(y - mu), axis=-1, keepdims=True)
    y = ((y - mu) * lax.rsqrt(var + RW_GN_EPS)).reshape(B, T, RW_W)
    y = y * prm['rw_ln_w'] + prm['rw_ln_b'] + s['bonus'].reshape(B, T, RW_W)
    return (y * s['g']).astype(s['g'].dtype)


def rwkv_branch(pc, pl, prm, with_ctx):
    s_c, s_l = rwkv_prep(pc, prm), rwkv_prep(pl, prm)
    B = pl.shape[0]
    S0 = jnp.zeros((B, RW_HEADS, RW_DH, RW_DH), jnp.float32)
    ys_c, ys_l = [], []
    for d in range(2):
        f = (lambda t: t) if d == 0 else (lambda t: jnp.flip(t, axis=1))

        def run(s, state):
            dec, kd, a = s['dirs'][d]
            y, S = rwkv7_scan(f(s['r']), f(dec), f(kd), f(s['v']), f(-s['kk']), f(s['kk'] * a), state)
            return f(y), S

        y_c, S_ctx = run(s_c, S0)
        y_l, _ = run(s_l, S_ctx)
        ys_c.append(y_c)
        ys_l.append(y_l)
    out_l = rwkv_post(ys_l[0] + ys_l[1], s_l, prm)
    out_c = rwkv_post(ys_c[0] + ys_c[1], s_c, prm) if with_ctx else None
    return out_c, out_l


def na_latent(q, k, v, k_ctx, v_ctx, rpb):
    B, T, H, dh = q.shape
    rows = T // GRID_W
    kr = min(NA_WIN_R, rows)
    r_ix = jnp.arange(rows)
    row_idx = jnp.clip(r_ix - kr // 2, 0, rows - kr)[:, None] + jnp.arange(kr)[None, :]
    c_ix = jnp.arange(GRID_W)
    c_start = jnp.clip(c_ix - NA_WIN_C // 2, 0, GRID_W - NA_WIN_C)
    col_ok = (c_ix[None, :] >= c_start[:, None]) & (c_ix[None, :] < c_start[:, None] + NA_WIN_C)
    row_off = row_idx - r_ix[:, None] + (NA_WIN_R - 1)
    col_off = jnp.clip(c_ix[None, :] - c_ix[:, None], 1 - NA_WIN_C, NA_WIN_C - 1) + (NA_WIN_C - 1)
    bias = rpb[:, row_off[:, None, :, None], col_off[None, :, None, :]]
    qg = q.reshape(B, rows, GRID_W, H, dh)
    kg = k.reshape(B, rows, GRID_W, H, dh)[:, row_idx]
    vg = v.reshape(B, rows, GRID_W, H, dh)[:, row_idx]
    s_win = jnp.einsum('brqhd,brjkhd->bhrqjk', qg, kg).astype(jnp.float32) + bias[None].astype(jnp.float32)
    s_win = jnp.where(col_ok[:, None, :], s_win, -jnp.inf)
    s_ctx = jnp.einsum('brqhd,bmhd->bhrqm', qg, k_ctx).astype(jnp.float32)
    n_win = kr * GRID_W
    p = jax.nn.softmax(jnp.concatenate([s_win.reshape(B, H, rows, GRID_W, n_win), s_ctx], axis=-1), axis=-1)
    p_win = p[..., :n_win].reshape(B, H, rows, GRID_W, kr, GRID_W).astype(v.dtype)
    p_ctx = p[..., n_win:].astype(v.dtype)
    y = jnp.einsum('bhrqjk,brjkhd->brqhd', p_win, vg) + jnp.einsum('bhrqm,bmhd->brqhd', p_ctx, v_ctx)
    return y.reshape(B, T, H * dh)


def na_branch(pc, pl, rpb, with_ctx):
    B = pl.shape[0]
    qc, kc, vc = [t.reshape(B, t.shape[1], NA_HEADS, NA_DH) for t in split_last(pc, NA_SIZES)]
    ql, kl, vl = [t.reshape(B, t.shape[1], NA_HEADS, NA_DH) for t in split_last(pl, NA_SIZES)]
    scale = NA_DH ** -0.5
    y_l = na_latent(ql * scale, kl, vl, kc, vc, rpb).astype(pl.dtype)
    y_c = None
    if with_ctx:
        p = jax.nn.softmax(jnp.einsum('bqhd,bkhd->bhqk', qc * scale, kc).astype(jnp.float32), axis=-1)
        y_c = jnp.einsum('bhqk,bkhd->bqhd', p.astype(vc.dtype), vc).reshape(B, pc.shape[1], BRANCH_W).astype(pc.dtype)
    return y_c, y_l


def merge_branches(ys, gate_pre, w_branch, w_out):
    Y = jnp.stack(ys, axis=-2)
    proj = jnp.einsum('btnw,nwd->btnd', Y, w_branch)
    g = jax.nn.sigmoid(gate_pre).reshape(*gate_pre.shape[:-1], N_BRANCH, D_MODEL)
    return (jnp.sum(g * proj, axis=-2) @ w_out).astype(gate_pre.dtype)


def token_mixer(hc, hl, prm, with_ctx):
    pc = hc @ prm['w_in']
    pl = hl @ prm['w_in']
    ml_c, rw_c, na_c, gt_c = split_last(pc, GROUP_SIZES)
    ml_l, rw_l, na_l, gt_l = split_last(pl, GROUP_SIZES)
    m_c, m_l = mlstm_branch(ml_c, ml_l, prm['ml_gate_b'], prm['ml_norm_g'], with_ctx)
    r_c, r_l = rwkv_branch(rw_c, rw_l, prm, with_ctx)
    n_c, n_l = na_branch(na_c, na_l, prm['na_rpb'], with_ctx)
    y_l = merge_branches([m_l.astype(hl.dtype), r_l.astype(hl.dtype), n_l], gt_l, prm['w_branch'], prm['w_out'])
    y_c = None
    if with_ctx:
        y_c = merge_branches([m_c.astype(hc.dtype), r_c.astype(hc.dtype), n_c], gt_c, prm['w_branch'], prm['w_out'])
    return y_c, y_l


def setup_inputs(seed: int = 0) -> dict:
    key = jax.random.key(seed)
    ks = jax.random.split(key, 32)
    D = D_MODEL

    def nrm(i, shape, s):
        return jax.random.normal(ks[i], shape, jnp.float32) * s

    def uni(i, shape, lo, hi):
        return jax.random.uniform(ks[i], shape, jnp.float32, lo, hi)

    ml_gate_b = jnp.concatenate([nrm(8, (DEPTH, 2, 1, ML_HEADS), 0.1),
                                 uni(9, (DEPTH, 2, 1, ML_HEADS), 3.0, 6.0)], axis=2).reshape(DEPTH, 4 * ML_HEADS)
    return {
        'x': nrm(0, (BATCH, SEQ, D), 1.0),
        'c': nrm(1, (BATCH, D), 1.0),
        'ctx': nrm(2, (BATCH, CTX_LEN, D), 1.0),
        'c_ctx': nrm(3, (D,), 1.0),
        'w_mod': nrm(4, (DEPTH, D, 6 * D), 0.5 * D ** -0.5),
        'b_mod': nrm(5, (DEPTH, 6 * D), 0.02),
        'norm1_g': 1.0 + nrm(6, (DEPTH, D), 0.02),
        'w_in': nrm(7, (DEPTH, D, D_IN), D ** -0.5),
        'ml_gate_b': ml_gate_b,
        'ml_norm_g': 1.0 + nrm(10, (DEPTH, BRANCH_W), 0.02),
        'rw_mu': uni(11, (DEPTH, sum(RW_SIZES)), 0.0, 1.0),
        'rw_w0': uni(12, (DEPTH, 2, RW_W), -5.0, 0.0),
        'rw_w_up': nrm(13, (DEPTH, 2, RW_DECAY_LORA, RW_W), 0.5 * RW_DECAY_LORA ** -0.5),
        'rw_a0': nrm(14, (DEPTH, 2, RW_W), 0.1),
        'rw_a_up': nrm(15, (DEPTH, 2, RW_ICLR_LORA, RW_W), RW_ICLR_LORA ** -0.5),
        'rw_g_up': nrm(16, (DEPTH, RW_GATE_LORA, RW_W), RW_GATE_LORA ** -0.5),
        'rw_k_k': 1.0 + nrm(17, (DEPTH, RW_W), 0.1),
        'rw_k_a': 1.0 + nrm(18, (DEPTH, RW_W), 0.1),
        'rw_r_k': nrm(19, (DEPTH, RW_W), 0.1),
        'rw_ln_w': 1.0 + nrm(20, (DEPTH, RW_W), 0.02),
        'rw_ln_b': nrm(21, (DEPTH, RW_W), 0.02),
        'na_rpb': nrm(22, (DEPTH, NA_HEADS, 2 * NA_WIN_R - 1, 2 * NA_WIN_C - 1), 0.1),
        'w_branch': nrm(23, (DEPTH, N_BRANCH, BRANCH_W, D), BRANCH_W ** -0.5),
        'w_out': nrm(24, (DEPTH, D, D), D ** -0.5),
        'norm2_g': 1.0 + nrm(25, (DEPTH, D), 0.02),
        'w_ff1': nrm(26, (DEPTH, D, D_FF), D ** -0.5),
        'w_ff2': nrm(27, (DEPTH, D_FF, D), D_FF ** -0.5),
        'final_g': 1.0 + nrm(28, (D,), 0.02),
    }


def reference(x, c, ctx, c_ctx, w_mod, b_mod, norm1_g, w_in, ml_gate_b, ml_norm_g, rw_mu, rw_w0, rw_w_up,
              rw_a0, rw_a_up, rw_g_up, rw_k_k, rw_k_a, rw_r_k, rw_ln_w, rw_ln_b, na_rpb, w_branch, w_out,
              norm2_g, w_ff1, w_ff2, final_g):
    xl, xc = x, ctx
    s_lat, s_ctx = jax.nn.silu(c), jax.nn.silu(c_ctx)
    for l in range(DEPTH):
        with_ctx = l < DEPTH - 1
        mod_l = jnp.split((s_lat @ w_mod[l] + b_mod[l])[:, None, :], 6, axis=-1)
        mod_c = jnp.split((s_ctx @ w_mod[l] + b_mod[l])[None, None, :], 6, axis=-1)
        prm = {'w_in': w_in[l], 'ml_gate_b': ml_gate_b[l], 'ml_norm_g': ml_norm_g[l], 'rw_mu': rw_mu[l],
               'rw_w0': rw_w0[l], 'rw_w_up': rw_w_up[l], 'rw_a0': rw_a0[l], 'rw_a_up': rw_a_up[l],
               'rw_g_up': rw_g_up[l], 'rw_k_k': rw_k_k[l], 'rw_k_a': rw_k_a[l], 'rw_r_k': rw_r_k[l],
               'rw_ln_w': rw_ln_w[l], 'rw_ln_b': rw_ln_b[l], 'na_rpb': na_rpb[l],
               'w_branch': w_branch[l], 'w_out': w_out[l]}
        hl = modulate(rms_norm(xl, norm1_g[l]), mod_l[0], mod_l[1])
        hc = modulate(rms_norm(xc, norm1_g[l]), mod_c[0], mod_c[1])
        y_c, y_l = token_mixer(hc, hl, prm, with_ctx)
        xl = (xl + mod_l[2] * y_l).astype(x.dtype)
        hl = modulate(rms_norm(xl, norm2_g[l]), mod_l[3], mod_l[4])
        xl = (xl + mod_l[5] * sq_relu_mlp(hl, w_ff1[l], w_ff2[l])).astype(x.dtype)
        if with_ctx:
            xc = (xc + mod_c[2] * y_c).astype(ctx.dtype)
            hc = modulate(rms_norm(xc, norm2_g[l]), mod_c[3], mod_c[4])
            xc = (xc + mod_c[5] * sq_relu_mlp(hc, w_ff1[l], w_ff2[l])).astype(ctx.dtype)
    return rms_norm(xl, final_g)
```

```cpp
#include <hip/hip_runtime.h>
#include <hip/hip_cooperative_groups.h>
#include <cstdio>
namespace cg = cooperative_groups;

#ifndef ONE_LAUNCH
#define ONE_LAUNCH 1
#endif

#define DEVI __device__ __forceinline__
#define LAS __attribute__((address_space(3)))
typedef unsigned short bf16_t;
typedef short bf16x8 __attribute__((ext_vector_type(8)));
typedef short bf16x4 __attribute__((ext_vector_type(4)));
typedef float f32x4 __attribute__((ext_vector_type(4)));
typedef float f32x2 __attribute__((ext_vector_type(2)));
typedef unsigned u32x4 __attribute__((ext_vector_type(4)));
typedef unsigned u32x2 __attribute__((ext_vector_type(2)));

constexpr int D = 2048, NTOK = 8704, NLAT = 8192, NP = 16128, DIN = 16016, DFF = 8192;
constexpr int RWB = 3088, NAB = 6800, GTB = 9872;
constexpr int LDS_BYTES = 131072;
constexpr int NPHASE = 24;

constexpr size_t OFF_CTL = 0;
constexpr size_t OFF_MOD = 4096;
constexpr size_t OFF_ROPE = OFF_MOD + 2ull * 3 * 12288 * 4;
constexpr size_t OFF_WIN = OFF_ROPE + 16384;
constexpr size_t OFF_WBR = OFF_WIN + 16128ull * 2048 * 2;
constexpr size_t OFF_WOUT = OFF_WBR + 3ull * 2048 * 1024 * 2;
constexpr size_t OFF_WFF1 = OFF_WOUT + 2048ull * 2048 * 2;
constexpr size_t OFF_WFF2 = OFF_WFF1 + 8192ull * 2048 * 2;
constexpr size_t OFF_WLORA = OFF_WFF2 + 8192ull * 2048 * 2;
constexpr size_t OFF_XL = OFF_WLORA + 5120ull * 640 * 2;
constexpr size_t OFF_H = OFF_XL + 8704ull * 2048 * 4;
constexpr size_t OFF_P = OFF_H + 8704ull * 2048 * 2;
constexpr size_t OFF_LA = OFF_P + 8704ull * 16128 * 2;
constexpr size_t OFF_LO = OFF_LA + 8704ull * 640 * 2;
constexpr size_t OFF_YRWF = OFF_LO + 8704ull * 5120 * 2;
constexpr size_t OFF_MLNUM = OFF_YRWF + 2ull * 8704 * 1024 * 4;
constexpr size_t OFF_VT = OFF_MLNUM + 2ull * 8704 * 4 * 272 * 4;
constexpr size_t OFF_Y3 = OFF_VT + 2ull * 8 * 128 * 4352 * 2;
constexpr size_t WS_END = OFF_Y3 + 3ull * 8704 * 1024 * 2;

struct Params {
    const float* in[28];
    float* out;
    unsigned char* ws;
    int ph_lo, ph_hi;
};
enum { I_X = 0, I_C, I_CTX, I_CCTX, I_WMOD, I_BMOD, I_N1G, I_WIN, I_MLGB, I_MLNG, I_RWMU, I_RWW0, I_RWWUP, I_RWA0, I_RWAUP, I_RWGUP,
       I_RWKK, I_RWKA, I_RWRK, I_RWLNW, I_RWLNB, I_RPB, I_WBR, I_WOUT, I_N2G, I_WFF1, I_WFF2, I_FING };

DEVI int otid() { int t; asm volatile("v_mov_b32 %0, %1" : "=v"(t) : "v"((int)threadIdx.x)); return t; }
DEVI float bf2f(bf16_t b) { return __uint_as_float(((unsigned)b) << 16); }
DEVI float bflo(unsigned u) { return __uint_as_float(u << 16); }
DEVI float bfhi(unsigned u) { return __uint_as_float(u & 0xffff0000u); }
DEVI bf16_t f2bf(float f) { unsigned u = __float_as_uint(f); u += 0x7FFFu + ((u >> 16) & 1u); return (bf16_t)(u >> 16); }
DEVI unsigned pack2(float lo, float hi) { return (unsigned)f2bf(lo) | ((unsigned)f2bf(hi) << 16); }
DEVI float sigmoidf(float x) { return 1.0f / (1.0f + __expf(-x)); }
DEVI float wsum(float x) {
#pragma unroll
    for (int o = 32; o; o >>= 1) x += __shfl_xor(x, o);
    return x;
}
DEVI float dppf(float x, const int ctrl) { return x; }
#define DPP_ADD(x, CTRL) ((x) + __int_as_float(__builtin_amdgcn_update_dpp(0, __float_as_int(x), CTRL, 0xF, 0xF, true)))
DEVI float red8(float x) {
    x = DPP_ADD(x, 0xB1);
    x = DPP_ADD(x, 0x4E);
    x = DPP_ADD(x, 0x141);
    return x;
}

namespace pg8 {
constexpr int BM = 256, BK = 64, HALF = 128, HTB = HALF * BK * 2, STAGE_BYTES = 8 * HTB, NXCD = 8, WGM = 8;
__host__ __device__ __forceinline__ int lds_byte(int r, int c) { const int st = (r >> 4) * 2 + (c >> 5), rr = r & 15, cc = c & 31, ob = rr * 64 + cc * 2; return st * 1024 + (ob ^ (((ob >> 9) & 1) << 5)); }
__host__ __device__ __forceinline__ void stage_rc(int b, int& R, int& C) { const int st = b / 1024, sb = b % 1024, swz = sb ^ (((sb >> 9) & 1) << 5); R = (st >> 1) * 16 + swz / 64; C = (st & 1) * 32 + (swz % 64) / 2; }
__host__ __device__ __forceinline__ int perm32(int rho) { const int n = rho >> 4, i = rho & 15; return 8 * (i >> 2) + 4 * n + (i & 3); }
struct Unit { int pm, pn; };
struct Gemm { const bf16_t* A; const bf16_t* Bt; int M, N, K; };
struct StaticOrder {
    int nM, nN, nwg, G, c;
    __device__ void init(int M, int N, int G_, int c_) { nM = M / BM; nN = N / BM; nwg = nM * nN; G = G_; c = c_; }
    __device__ bool next(int i, Unit& u) const {
        const long L = (long)i * G + c; if (L >= nwg) return false;
        int wgid = (int)L; { const int q = nwg / NXCD, r = nwg % NXCD, xcd = wgid % NXCD, off = wgid / NXCD; wgid = (xcd < r ? xcd * (q + 1) : r * (q + 1) + (xcd - r) * q) + off; }
        const int nig = WGM * nN, gid = wgid / nig, fm = gid * WGM, gsz = (nM - fm) < WGM ? (nM - fm) : WGM;
        u.pm = fm + ((wgid % nig) % gsz); u.pn = (wgid % nig) / gsz; return true;
    }
    __device__ __forceinline__ void a_ready(const Unit&) const {}
    __device__ __forceinline__ void done(const Unit&) const {}
};
struct MergeOrder {
    int ntiles, G, c;
    __device__ void init(int nM, int G_, int c_) { ntiles = nM * 8; G = G_; c = c_; }
    __device__ bool next(int i, Unit& u) const {
        const int ti = i / 3, br = i - ti * 3; const long L = (long)ti * G + c; if (L >= ntiles) return false;
        const int pm = (int)L >> 3, pn = (int)L & 7; u.pm = br * 34 + pm; u.pn = br * 8 + pn; return true;
    }
    __device__ __forceinline__ void a_ready(const Unit&) const {}
    __device__ __forceinline__ void done(const Unit&) const {}
};
DEVI unsigned cvt_pk_bf16(float lo, float hi) { unsigned r; asm volatile("v_cvt_pk_bf16_f32 %0, %1, %2" : "=v"(r) : "v"(lo), "v"(hi)); return r; }


struct SchedG {
    int mode;
    StaticOrder so; MergeOrder mo;
    __device__ __forceinline__ bool next(int i, Unit& u) const { return mode == 0 ? so.next(i, u) : mo.next(i, u); }
    __device__ __forceinline__ void a_ready(const Unit&) const {}
    __device__ __forceinline__ void done(const Unit&) const {}
};
struct EpiG {
    static constexpr bool PERM = true, AFTER_DRAIN = false;
    int kind;
    bf16_t* O; int ldc;
    const bf16_t* P; float* ACC;
    const float* xin_lat; const float* xin_ctx; float* XL; const float* gate;
    __device__ __forceinline__ void operator()(const f32x4 (&acc)[2][2][4][2], const Unit& u, int wr, int wc, int fr, int fq) const {
        if (kind <= 1) {
            const int row0 = u.pm * BM + wr * 64 + fr, col0 = u.pn * BM + wc * 32 + 8 * fq;
#pragma unroll
            for (int ai = 0; ai < 2; ++ai)
#pragma unroll
                for (int m = 0; m < 4; ++m) { bf16_t* rowp = O + (size_t)(row0 + ai * HALF + m * 16) * ldc + col0;
#pragma unroll
                    for (int bj = 0; bj < 2; ++bj) { f32x4 v0 = acc[ai][bj][m][0], v1 = acc[ai][bj][m][1];
                        if (kind == 1) {
#pragma unroll
                            for (int i = 0; i < 4; ++i) { float a = fmaxf(v0[i], 0.f), b = fmaxf(v1[i], 0.f); v0[i] = a * a; v1[i] = b * b; } }
                        u32x4 o; o[0] = cvt_pk_bf16(v0[0], v0[1]); o[1] = cvt_pk_bf16(v0[2], v0[3]); o[2] = cvt_pk_bf16(v1[0], v1[1]); o[3] = cvt_pk_bf16(v1[2], v1[3]);
                        *(u32x4*)(rowp + bj * HALF) = o; } }
        } else if (kind == 2) {
            const int br = u.pn >> 3, pn = u.pn & 7, pm = u.pm - br * 34;
            const int row0 = pm * BM + wr * 64 + fr, col0 = pn * BM + wc * 32 + 8 * fq;
#pragma unroll
            for (int ai = 0; ai < 2; ++ai)
#pragma unroll
                for (int m = 0; m < 4; ++m) { const size_t row = (size_t)(row0 + ai * HALF + m * 16);
#pragma unroll
                    for (int bj = 0; bj < 2; ++bj) { const int col = col0 + bj * HALF;
                        const u32x4 gv = *(const u32x4*)(P + row * NP + GTB + br * 2048 + col);
                        f32x4 v0 = acc[ai][bj][m][0], v1 = acc[ai][bj][m][1];
                        v0[0] *= sigmoidf(bflo(gv[0])); v0[1] *= sigmoidf(bfhi(gv[0])); v0[2] *= sigmoidf(bflo(gv[1])); v0[3] *= sigmoidf(bfhi(gv[1]));
                        v1[0] *= sigmoidf(bflo(gv[2])); v1[1] *= sigmoidf(bfhi(gv[2])); v1[2] *= sigmoidf(bflo(gv[3])); v1[3] *= sigmoidf(bfhi(gv[3]));
                        float* ap = ACC + row * 2048 + col;
                        if (br == 0) { *(f32x4*)ap = v0; *(f32x4*)(ap + 4) = v1; }
                        else { v0 += *(const f32x4*)ap; v1 += *(const f32x4*)(ap + 4);
                            if (br == 1) { *(f32x4*)ap = v0; *(f32x4*)(ap + 4) = v1; }
                            else { u32x4 o; o[0] = cvt_pk_bf16(v0[0], v0[1]); o[1] = cvt_pk_bf16(v0[2], v0[3]); o[2] = cvt_pk_bf16(v1[0], v1[1]); o[3] = cvt_pk_bf16(v1[2], v1[3]);
                                *(u32x4*)(O + row * 2048 + col) = o; } } } }
        } else {
            const int row0 = u.pm * BM + wr * 64 + fr, col0 = u.pn * BM + wc * 32 + 8 * fq;
#pragma unroll
            for (int ai = 0; ai < 2; ++ai)
#pragma unroll
                for (int m = 0; m < 4; ++m) { const int row = row0 + ai * HALF + m * 16;
                    const int mrow = row < NLAT ? (row >> 12) : 2;
                    const float* xr = row < NLAT ? xin_lat + (size_t)row * 2048 : xin_ctx + (size_t)(row - NLAT) * 2048;
                    const float* gr = gate + (size_t)mrow * 12288; float* orow = XL + (size_t)row * 2048;
#pragma unroll
                    for (int bj = 0; bj < 2; ++bj)
#pragma unroll
                        for (int n = 0; n < 2; ++n) { const int col = col0 + bj * HALF + n * 4;
                            const f32x4 g = *(const f32x4*)(gr + col), x = *(const f32x4*)(xr + col);
                            *(f32x4*)(orow + col) = x + g * acc[ai][bj][m][n]; } }
        }
    }
};
template <class Epi, class Sched>
__device__ __forceinline__ void gemm_phase(LAS unsigned char* lds, const Gemm g, const Sched& S, const Epi& E) {
    const int tid = otid(), wid = __builtin_amdgcn_readfirstlane(tid >> 6), lane = tid & 63, wr = wid >> 2, wc = wid & 3, fr = lane & 15, fq = lane >> 4;
    const int K = g.K, nt = K / BK;
    unsigned voffA[2], voffB[2];
#pragma unroll
    for (int i = 0; i < 2; ++i) { int R, C; stage_rc(tid * 16 + i * 8192, R, C); const int Rb = Epi::PERM ? ((R & ~31) + perm32(R & 31)) : R;
        voffA[i] = (unsigned)(R * K + C) * 2u; voffB[i] = (unsigned)(Rb * K + C) * 2u; }
    const size_t kstep = (size_t)(BK * 2);
    const size_t hstep = (size_t)HALF * K * 2;
    const size_t tstep = 2 * hstep;
    const unsigned ldsw = (unsigned)wid * 1024u;
    const int aoff = lds_byte(wr * 64 + fr, fq * 8), boff = lds_byte(wc * 32 + fr, fq * 8);
#define PG8_SA(b, h) (((b) * 2 + (h)) * HTB)
#define PG8_SB(b, h) ((4 + (b) * 2 + (h)) * HTB)
#define PG8_STAGE(bufoff, gbase, voff) do { _Pragma("unroll") for (int _i = 0; _i < 2; ++_i) \
        __builtin_amdgcn_global_load_lds((const unsigned*)((const char*)(gbase) + (voff)[_i]), (LAS unsigned*)(lds + (bufoff) + ldsw + _i * 8192), 16, 0, 0); } while (0)
#define PG8_LDA(dst, b, h) do { _Pragma("unroll") for (int m = 0; m < 4; ++m) _Pragma("unroll") for (int k = 0; k < 2; ++k) dst[m][k] = *(const LAS bf16x8*)(lds + PG8_SA(b, h) + aoff + m * 2048 + k * 1024); } while (0)
#define PG8_LDB(dst, b, h) do { _Pragma("unroll") for (int n = 0; n < 2; ++n) _Pragma("unroll") for (int k = 0; k < 2; ++k) dst[n][k] = *(const LAS bf16x8*)(lds + PG8_SB(b, h) + boff + n * 2048 + k * 1024); } while (0)
#define PG8_MMA(ai, bj, At, Bt) do { __builtin_amdgcn_s_setprio(1); _Pragma("unroll") for (int m = 0; m < 4; ++m) _Pragma("unroll") for (int n = 0; n < 2; ++n) _Pragma("unroll") for (int k = 0; k < 2; ++k) \
        acc[ai][bj][m][n] = __builtin_amdgcn_mfma_f32_16x16x32_bf16(Bt[n][k], At[m][k], acc[ai][bj][m][n], 0, 0, 0); __builtin_amdgcn_s_setprio(0); } while (0)
#define PG8_WAIT_V(n) asm volatile("s_waitcnt vmcnt(" #n ")" ::: "memory")
#define PG8_WAIT_L(n) asm volatile("s_waitcnt lgkmcnt(" #n ")" ::: "memory")
#define PG8_BAR __builtin_amdgcn_s_barrier()
#define PG8_SCHED __builtin_amdgcn_sched_barrier(0)
    Unit cur, nxt; int ui = 0;
    if (!S.next(0, cur)) return;
    f32x4 acc[2][2][4][2];
#pragma unroll
    for (int a = 0; a < 2; ++a)
#pragma unroll
        for (int b = 0; b < 2; ++b)
#pragma unroll
            for (int m = 0; m < 4; ++m)
#pragma unroll
                for (int n = 0; n < 2; ++n) acc[a][b][m][n] = (f32x4){0.f, 0.f, 0.f, 0.f};
    bf16x8 At[4][2], B0[2][2], B1[2][2];
    const char* cA = (const char*)g.A + (size_t)cur.pm * tstep; const char* cB = (const char*)g.Bt + (size_t)cur.pn * tstep;
    S.a_ready(cur);
    PG8_STAGE(PG8_SB(0, 0), cB, voffB); PG8_STAGE(PG8_SA(0, 0), cA, voffA); PG8_STAGE(PG8_SB(0, 1), cB + hstep, voffB); PG8_STAGE(PG8_SA(0, 1), cA + hstep, voffA);
    if (wr == 1) PG8_BAR;
    PG8_WAIT_V(4); PG8_BAR;
    PG8_STAGE(PG8_SB(1, 0), cB + kstep, voffB); PG8_STAGE(PG8_SA(1, 0), cA + kstep, voffA); PG8_STAGE(PG8_SB(1, 1), cB + hstep + kstep, voffB);
    PG8_WAIT_V(6); PG8_BAR;
    for (;;) {
        const bool has_next = S.next(ui + 1, nxt);
        const char* nA = has_next ? (const char*)g.A + (size_t)nxt.pm * tstep : cA; const char* nB = has_next ? (const char*)g.Bt + (size_t)nxt.pn * tstep : cB;
        for (int t = 0; t < nt; t += 2) {
            const bool last = (t == nt - 2);
            const char* a1 = cA + (size_t)(t + 1) * kstep;
            const char* a2 = last ? nA : cA + (size_t)(t + 2) * kstep; const char* b2 = last ? nB : cB + (size_t)(t + 2) * kstep;
            const char* a3 = a2 + kstep; const char* b3 = b2 + kstep;
            if (last && has_next) S.a_ready(nxt);
            PG8_LDB(B0, 0, 0); PG8_SCHED; PG8_LDA(At, 0, 0); PG8_STAGE(PG8_SA(1, 1), a1 + hstep, voffA);
            PG8_WAIT_L(8); PG8_BAR; PG8_WAIT_L(0); PG8_MMA(0, 0, At, B0); PG8_BAR; PG8_SCHED;
            PG8_LDB(B1, 0, 1); PG8_STAGE(PG8_SB(0, 0), b2, voffB);
            PG8_BAR; PG8_WAIT_L(0); PG8_MMA(0, 1, At, B1); PG8_BAR;
            PG8_LDA(At, 0, 1); PG8_STAGE(PG8_SA(0, 0), a2, voffA);
            PG8_BAR; PG8_WAIT_L(0); PG8_MMA(1, 0, At, B0); PG8_BAR; PG8_SCHED;
            PG8_STAGE(PG8_SB(0, 1), b2 + hstep, voffB);
            PG8_WAIT_V(6); PG8_BAR; PG8_MMA(1, 1, At, B1); PG8_BAR;
            PG8_LDB(B0, 1, 0); PG8_SCHED; PG8_LDA(At, 1, 0); PG8_STAGE(PG8_SA(0, 1), a2 + hstep, voffA);
            PG8_WAIT_L(8); PG8_BAR; PG8_WAIT_L(0); PG8_MMA(0, 0, At, B0); PG8_BAR; PG8_SCHED;
            PG8_LDB(B1, 1, 1); PG8_STAGE(PG8_SB(1, 0), b3, voffB);
            PG8_BAR; PG8_WAIT_L(0); PG8_MMA(0, 1, At, B1); PG8_BAR;
            PG8_LDA(At, 1, 1); PG8_STAGE(PG8_SA(1, 0), a3, voffA);
            PG8_BAR; PG8_WAIT_L(0); PG8_MMA(1, 0, At, B0); PG8_BAR; PG8_SCHED;
            PG8_STAGE(PG8_SB(1, 1), b3 + hstep, voffB);
            PG8_WAIT_V(6); PG8_BAR; PG8_MMA(1, 1, At, B1); PG8_BAR;
        }
        if constexpr (!Epi::AFTER_DRAIN) { E(acc, cur, wr, wc, fr, fq); S.done(cur); }
        if (!has_next) break;
#pragma unroll
        for (int a = 0; a < 2; ++a)
#pragma unroll
            for (int b = 0; b < 2; ++b)
#pragma unroll
                for (int m = 0; m < 4; ++m)
#pragma unroll
                    for (int n = 0; n < 2; ++n) acc[a][b][m][n] = (f32x4){0.f, 0.f, 0.f, 0.f};
        cur = nxt; cA = nA; cB = nB; ++ui;
    }
    PG8_WAIT_V(0);
    if (wr == 0) PG8_BAR;
    PG8_BAR;
    if constexpr (Epi::AFTER_DRAIN) { E.fused(acc, cur, wr, wc, fr, fq, lds, wid, lane); S.done(cur); }
#undef PG8_SA
#undef PG8_SB
#undef PG8_STAGE
#undef PG8_LDA
#undef PG8_LDB
#undef PG8_MMA
#undef PG8_WAIT_V
#undef PG8_WAIT_L
#undef PG8_BAR
#undef PG8_SCHED
}
}

__device__ void phase_mod(const Params& p, float* lds) {
    const int TIDX = otid();
    const int tid = TIDX;
    float* s = lds;
    float* red = lds + 3 * 2048;
    float* MOD = (float*)(p.ws + OFF_MOD);
    for (int i = tid; i < 3 * 2048; i += 512) { const int r = i >> 11, k = i & 2047; const float c = r < 2 ? p.in[I_C][r * 2048 + k] : p.in[I_CCTX][k]; s[i] = c * sigmoidf(c); }
    __syncthreads();
    for (int task = blockIdx.x; task < 192; task += gridDim.x) {
        const int l = task / 96, j0 = (task % 96) * 128, jc = tid & 127, kp = tid >> 7;
        const float* w = p.in[I_WMOD] + (size_t)l * 2048 * 12288 + j0 + jc;
        float a0 = 0.f, a1 = 0.f, a2 = 0.f;
#pragma unroll 8
        for (int k = kp * 512; k < kp * 512 + 512; ++k) { const float wv = w[(size_t)k * 12288]; a0 += s[k] * wv; a1 += s[2048 + k] * wv; a2 += s[4096 + k] * wv; }
        red[(kp * 3 + 0) * 128 + jc] = a0; red[(kp * 3 + 1) * 128 + jc] = a1; red[(kp * 3 + 2) * 128 + jc] = a2;
        __syncthreads();
        if (tid < 384) { const int r = tid >> 7, j = tid & 127;
            const float v = ((red[(0 * 3 + r) * 128 + j] + red[(1 * 3 + r) * 128 + j]) + (red[(2 * 3 + r) * 128 + j] + red[(3 * 3 + r) * 128 + j])) + p.in[I_BMOD][l * 12288 + j0 + j];
            MOD[(size_t)(l * 3 + r) * 12288 + j0 + j] = v; }
        __syncthreads();
    }
    if (blockIdx.x == gridDim.x - 1) {
        float* rc = (float*)(p.ws + OFF_ROPE); float* rs = rc + 2048;
        for (int i = tid; i < 2048; i += 512) { const int pos = i >> 5, j = i & 31; const float fr = powf(10000.0f, -(float)j / 32.0f); const float ang = (float)pos * fr; rc[i] = cosf(ang); rs[i] = sinf(ang); }
    }
}

__device__ void conv_tile(const float* __restrict__ src, int ld_src, int n_valid, int n0, int k0, bf16_t* __restrict__ dst, int ld_dst, float* tile) {
    const int TIDX = otid();
    const int tid = TIDX;
#pragma unroll
    for (int i = 0; i < 2; ++i) { const int kr = (tid >> 4) + i * 32, nc = (tid & 15) * 4; const float* sp = src + (size_t)(k0 + kr) * ld_src + n0 + nc;
        f32x4 v;
        if (n0 + nc + 3 < n_valid) v = *(const f32x4*)sp;
        else { v[0] = (n0 + nc + 0 < n_valid) ? sp[0] : 0.f; v[1] = (n0 + nc + 1 < n_valid) ? sp[1] : 0.f; v[2] = (n0 + nc + 2 < n_valid) ? sp[2] : 0.f; v[3] = (n0 + nc + 3 < n_valid) ? sp[3] : 0.f; }
        float* tp = tile + kr * 65 + nc; tp[0] = v[0]; tp[1] = v[1]; tp[2] = v[2]; tp[3] = v[3]; }
    __syncthreads();
    { const int n = tid >> 3, kc = (tid & 7) * 8; u32x4 o;
#pragma unroll
        for (int j = 0; j < 4; ++j) o[j] = pack2(tile[(kc + 2 * j) * 65 + n], tile[(kc + 2 * j + 1) * 65 + n]);
        *(u32x4*)(dst + (size_t)(n0 + n) * ld_dst + k0 + kc) = o; }
    __syncthreads();
}
__device__ void phase_convert(const Params& p, int l, float* lds) {
    const int TIDX = otid();
    for (int t = blockIdx.x; t < 18816; t += gridDim.x) {
        if (t < 8064) { const int nt = t >> 5, kt = t & 31; conv_tile(p.in[I_WIN] + (size_t)l * 2048 * DIN, DIN, DIN, nt * 64, kt * 64, (bf16_t*)(p.ws + OFF_WIN), 2048, lds); }
        else if (t < 9600) { const int tt = t - 8064, br = tt >> 9, r = tt & 511, nt = r >> 4, kt = r & 15;
            conv_tile(p.in[I_WBR] + (size_t)(l * 3 + br) * 1024 * 2048, 2048, 2048, nt * 64, kt * 64, (bf16_t*)(p.ws + OFF_WBR) + (size_t)br * 2048 * 1024, 1024, lds); }
        else if (t < 10624) { const int tt = t - 9600, nt = tt >> 5, kt = tt & 31; conv_tile(p.in[I_WOUT] + (size_t)l * 2048 * 2048, 2048, 2048, nt * 64, kt * 64, (bf16_t*)(p.ws + OFF_WOUT), 2048, lds); }
        else if (t < 14720) { const int tt = t - 10624, nt = tt >> 5, kt = tt & 31; conv_tile(p.in[I_WFF1] + (size_t)l * 2048 * 8192, 8192, 8192, nt * 64, kt * 64, (bf16_t*)(p.ws + OFF_WFF1), 2048, lds); }
        else { const int tt = t - 14720, nt = tt >> 7, kt = tt & 127; conv_tile(p.in[I_WFF2] + (size_t)l * 8192 * 2048, 2048, 2048, nt * 64, kt * 64, (bf16_t*)(p.ws + OFF_WFF2), 8192, lds); }
    }
    bf16_t* WL = (bf16_t*)(p.ws + OFF_WLORA);
    for (int idx = blockIdx.x * 512 + TIDX; idx < 5120 * 640; idx += gridDim.x * 512) {
        const int n = idx / 640, k = idx - n * 640, blk = n >> 10, nn = n & 1023;
        const int k0 = blk < 4 ? blk * 96 : 384, kw = blk < 4 ? 96 : 256;
        float v = 0.f;
        if (k >= k0 && k < k0 + kw) {
            const float* sp = blk < 2 ? p.in[I_RWWUP] + (size_t)(l * 2 + blk) * 96 * 1024 : (blk < 4 ? p.in[I_RWAUP] + (size_t)(l * 2 + blk - 2) * 96 * 1024 : p.in[I_RWGUP] + (size_t)l * 256 * 1024);
            v = sp[(size_t)(k - k0) * 1024 + nn]; }
        WL[idx] = f2bf(v);
    }
    if (blockIdx.x == 0 && TIDX < 8) ((unsigned*)(p.ws + OFF_CTL))[l * 8 + TIDX] = 0u;
}

__device__ void phase_norm(const float* __restrict__ xlat, const float* __restrict__ xctx, int nrows, const float* __restrict__ g, const float* __restrict__ modl, int ishift, int iscale, bf16_t* __restrict__ H) {
    const int TIDX = otid();
    const int wid = TIDX >> 6, lane = TIDX & 63;
    for (int row = blockIdx.x * 8 + wid; row < nrows; row += gridDim.x * 8) {
        const float* xr = row < NLAT ? xlat + (size_t)row * 2048 : xctx + (size_t)(row - NLAT) * 2048;
        const int mrow = row < NLAT ? (row >> 12) : 2;
        const float* sh = modl + (size_t)mrow * 12288 + ishift * 2048; const float* sc = modl + (size_t)mrow * 12288 + iscale * 2048;
        f32x4 v[8]; float ss = 0.f;
#pragma unroll
        for (int i = 0; i < 8; ++i) { v[i] = *(const f32x4*)(xr + (i * 64 + lane) * 4); ss += v[i][0] * v[i][0] + v[i][1] * v[i][1] + v[i][2] * v[i][2] + v[i][3] * v[i][3]; }
        ss = wsum(ss);
        const float r = rsqrtf(ss * (1.0f / 2048.0f) + 1e-6f);
#pragma unroll
        for (int i = 0; i < 8; ++i) { const int col = (i * 64 + lane) * 4; const f32x4 gg = *(const f32x4*)(g + col), s1 = *(const f32x4*)(sc + col), s0 = *(const f32x4*)(sh + col);
            float o[4];
#pragma unroll
            for (int j = 0; j < 4; ++j) o[j] = (v[i][j] * r * gg[j]) * (1.0f + s1[j]) + s0[j];
            u32x2 w; w[0] = pack2(o[0], o[1]); w[1] = pack2(o[2], o[3]);
            *(u32x2*)(H + (size_t)row * 2048 + col) = w; }
    }
}
__device__ void phase_final(const Params& p) {
    const int TIDX = otid();
    const int wid = TIDX >> 6, lane = TIDX & 63;
    const float* XL = (const float*)(p.ws + OFF_XL); const float* g = p.in[I_FING];
    for (int row = blockIdx.x * 8 + wid; row < NLAT; row += gridDim.x * 8) {
        const float* xr = XL + (size_t)row * 2048;
        f32x4 v[8]; float ss = 0.f;
#pragma unroll
        for (int i = 0; i < 8; ++i) { v[i] = *(const f32x4*)(xr + (i * 64 + lane) * 4); ss += v[i][0] * v[i][0] + v[i][1] * v[i][1] + v[i][2] * v[i][2] + v[i][3] * v[i][3]; }
        ss = wsum(ss);
        const float r = rsqrtf(ss * (1.0f / 2048.0f) + 1e-6f);
#pragma unroll
        for (int i = 0; i < 8; ++i) { const int col = (i * 64 + lane) * 4; const f32x4 gg = *(const f32x4*)(g + col);
            f32x4 o; o[0] = v[i][0] * r * gg[0]; o[1] = v[i][1] * r * gg[1]; o[2] = v[i][2] * r * gg[2]; o[3] = v[i][3] * r * gg[3];
            *(f32x4*)(p.out + (size_t)row * 2048 + col) = o; }
    }
}

DEVI void seq_nbrs(int row, bool& hp, bool& hn) {
    if (row < NLAT) { const int t = row & 4095; hp = t > 0; hn = t < 4095; } else { const int m = (row - NLAT) & 255; hp = m > 0; hn = m < 255; }
}
DEVI float shiftf(float c, float pv, float nx, float mu) { return c + mu * (0.5f * (pv + nx) - c); }

__device__ void phase_prep(const Params& p, int l, bf16_t* ldsT) {
    const int TIDX = otid();
    const bf16_t* P = (const bf16_t*)(p.ws + OFF_P); bf16_t* LA = (bf16_t*)(p.ws + OFF_LA);
    const float* mu = p.in[I_RWMU] + (size_t)l * 3712 + 3072;
    for (int idx = blockIdx.x * 512 + TIDX; idx < NTOK * 80; idx += gridDim.x * 512) {
        const int row = idx / 80, j = (idx - row * 80) * 8;
        bool hp, hn; seq_nbrs(row, hp, hn);
        const bf16_t* pc = P + (size_t)row * NP + RWB + 3072 + j;
        const u32x4 c = *(const u32x4*)pc;
        const u32x4 z = {0u, 0u, 0u, 0u};
        const u32x4 pv = hp ? *(const u32x4*)(pc - NP) : z, nx = hn ? *(const u32x4*)(pc + NP) : z;
        float o[8];
#pragma unroll
        for (int q = 0; q < 4; ++q) { o[2 * q] = shiftf(bflo(c[q]), bflo(pv[q]), bflo(nx[q]), mu[j + 2 * q]); o[2 * q + 1] = shiftf(bfhi(c[q]), bfhi(pv[q]), bfhi(nx[q]), mu[j + 2 * q + 1]); }
        if (j < 192) {
#pragma unroll
            for (int q = 0; q < 8; ++q) o[q] = tanhf(o[q]); }
        else if (j >= 384) {
#pragma unroll
            for (int q = 0; q < 8; ++q) o[q] = sigmoidf(o[q]); }
        u32x4 w; w[0] = pack2(o[0], o[1]); w[1] = pack2(o[2], o[3]); w[2] = pack2(o[4], o[5]); w[3] = pack2(o[6], o[7]);
        *(u32x4*)(LA + (size_t)row * 640 + j) = w;
    }
    bf16_t* VT = (bf16_t*)(p.ws + OFF_VT);
    const int tid = TIDX;
    for (int t = blockIdx.x; t < 136 * 16; t += gridDim.x) {
        const int rt = t >> 4, hd = t & 15, h = hd >> 1, dh = hd & 1;
        const int row0 = rt * 64;
        { const int tl = tid >> 3, dc = (tid & 7) * 8;
            const u32x4 v = *(const u32x4*)(P + (size_t)(row0 + tl) * NP + NAB + 2048 + h * 128 + dh * 64 + dc);
            bf16_t* tp = ldsT + tl * 66 + dc;
#pragma unroll
            for (int q = 0; q < 4; ++q) { tp[2 * q] = (bf16_t)(v[q] & 0xffffu); tp[2 * q + 1] = (bf16_t)(v[q] >> 16); } }
        __syncthreads();
        { const int d = tid >> 3, tc = (tid & 7) * 8;
            int b, pos; if (row0 < NLAT) { b = row0 >> 12; pos = row0 & 4095; } else { b = (row0 - NLAT) >> 8; pos = 4096 + ((row0 - NLAT) & 255); }
            u32x4 o;
#pragma unroll
            for (int q = 0; q < 4; ++q) o[q] = (unsigned)ldsT[(tc + 2 * q) * 66 + d] | ((unsigned)ldsT[(tc + 2 * q + 1) * 66 + d] << 16);
            *(u32x4*)(VT + ((size_t)((b * 8 + h) * 128 + dh * 64 + d)) * 4352 + pos + tc) = o; }
        __syncthreads();
    }
}

DEVI int scan_row(int s, int b, int dir) {
    if (s < 256) { const int m = dir ? 255 - s : s; return NLAT + b * 256 + m; }
    const int t = dir ? 4095 - (s - 256) : s - 256; return b * 4096 + t;
}
__device__ void rwkv_scan(const Params& p, int l, int chain, float* lds) {
    const int TIDX = otid();
    const int b = chain >> 5, h = (chain >> 1) & 15, dir = chain & 1, tid = TIDX;
    const bf16_t* P = (const bf16_t*)(p.ws + OFF_P); const bf16_t* LO = (const bf16_t*)(p.ws + OFF_LO);
    float* YO = (float*)(p.ws + OFF_YRWF) + (size_t)dir * NTOK * 1024 + h * 64;
    const int sl = tid >> 5, e2 = (tid & 31) * 2, ch = h * 64 + e2;
    const float* MU = p.in[I_RWMU] + (size_t)l * 3712;
    const float mur0 = MU[ch], mur1 = MU[ch + 1], muk0 = MU[1024 + ch], muk1 = MU[1024 + ch + 1], muv0 = MU[2048 + ch], muv1 = MU[2048 + ch + 1];
    const float w00 = p.in[I_RWW0][(l * 2 + dir) * 1024 + ch], w01 = p.in[I_RWW0][(l * 2 + dir) * 1024 + ch + 1];
    const float a00 = p.in[I_RWA0][(l * 2 + dir) * 1024 + ch], a01 = p.in[I_RWA0][(l * 2 + dir) * 1024 + ch + 1];
    const float kk0 = p.in[I_RWKK][l * 1024 + ch], kk1 = p.in[I_RWKK][l * 1024 + ch + 1], ka0 = p.in[I_RWKA][l * 1024 + ch], ka1 = p.in[I_RWKA][l * 1024 + ch + 1];
    const int v = tid >> 3, kq = tid & 7;
    float S[8];
#pragma unroll
    for (int j = 0; j < 8; ++j) S[j] = 0.f;
    unsigned rc, rp, rn, kc, kp, kn, vc, vp, vn, wr_, ar_;
    auto issue = [&](int g) {
        const int row = scan_row(g * 16 + sl, b, dir); bool hp, hn; seq_nbrs(row, hp, hn);
        const bf16_t* pr = P + (size_t)row * NP + RWB + ch;
        rc = *(const unsigned*)pr; kc = *(const unsigned*)(pr + 1024); vc = *(const unsigned*)(pr + 2048);
        rp = 0u; kp = 0u; vp = 0u; rn = 0u; kn = 0u; vn = 0u;
        if (hp) { rp = *(const unsigned*)(pr - NP); kp = *(const unsigned*)(pr - NP + 1024); vp = *(const unsigned*)(pr - NP + 2048); }
        if (hn) { rn = *(const unsigned*)(pr + NP); kn = *(const unsigned*)(pr + NP + 1024); vn = *(const unsigned*)(pr + NP + 2048); }
        const bf16_t* lo = LO + (size_t)row * 5120 + dir * 1024 + ch;
        wr_ = *(const unsigned*)lo; ar_ = *(const unsigned*)(lo + 2048);
    };
    auto commit = [&](int buf) {
        float* st = lds + buf * 6144 + sl * 384 + e2;
        const float r0 = shiftf(bflo(rc), bflo(rp), bflo(rn), mur0), r1 = shiftf(bfhi(rc), bfhi(rp), bfhi(rn), mur1);
        const float k0 = shiftf(bflo(kc), bflo(kp), bflo(kn), muk0), k1 = shiftf(bfhi(kc), bfhi(kp), bfhi(kn), muk1);
        const float v0 = shiftf(bflo(vc), bflo(vp), bflo(vn), muv0), v1 = shiftf(bfhi(vc), bfhi(vp), bfhi(vn), muv1);
        const float x0 = -(w00 + bflo(wr_)), x1 = -(w01 + bfhi(wr_));
        const float sp0 = x0 > 20.f ? x0 : log1pf(__expf(x0)), sp1 = x1 > 20.f ? x1 : log1pf(__expf(x1));
        const float d0 = __expf(-__expf(-sp0 - 0.5f)), d1 = __expf(-__expf(-sp1 - 0.5f));
        const float ar0 = sigmoidf(a00 + bflo(ar_)), ar1 = sigmoidf(a01 + bfhi(ar_));
        const float kd0 = k0 * (1.0f + (ar0 - 1.0f) * ka0), kd1 = k1 * (1.0f + (ar1 - 1.0f) * ka1);
        const float q0 = k0 * kk0, q1 = k1 * kk1;
        float ss = q0 * q0 + q1 * q1;
#pragma unroll
        for (int o = 16; o; o >>= 1) ss += __shfl_xor(ss, o);
        const float inv = 1.0f / fmaxf(sqrtf(ss), 1e-12f);
        const float n0 = q0 * inv, n1 = q1 * inv;
        *(f32x2*)(st + 0) = (f32x2){r0, r1}; *(f32x2*)(st + 64) = (f32x2){d0, d1}; *(f32x2*)(st + 128) = (f32x2){kd0, kd1};
        *(f32x2*)(st + 192) = (f32x2){v0, v1}; *(f32x2*)(st + 256) = (f32x2){-n0, -n1}; *(f32x2*)(st + 320) = (f32x2){n0 * ar0, n1 * ar1};
    };
    __syncthreads();
    issue(0); commit(0);
    __syncthreads();
    constexpr int NG = 4352 / 16;
    for (int g = 0; g < NG; ++g) {
        if (g + 1 < NG) issue(g + 1);
        const float* base = lds + (g & 1) * 6144;
#pragma unroll 4
        for (int i = 0; i < 16; ++i) {
            const float* st = base + i * 384;
            const f32x4 a0 = *(const f32x4*)(st + 256 + kq * 8), a1 = *(const f32x4*)(st + 260 + kq * 8);
            float pa = S[0] * a0[0] + S[1] * a0[1] + S[2] * a0[2] + S[3] * a0[3] + S[4] * a1[0] + S[5] * a1[1] + S[6] * a1[2] + S[7] * a1[3];
            pa = red8(pa);
            const f32x4 d0 = *(const f32x4*)(st + 64 + kq * 8), d1 = *(const f32x4*)(st + 68 + kq * 8);
            const f32x4 b0 = *(const f32x4*)(st + 320 + kq * 8), b1 = *(const f32x4*)(st + 324 + kq * 8);
            const f32x4 k0 = *(const f32x4*)(st + 128 + kq * 8), k1 = *(const f32x4*)(st + 132 + kq * 8);
            const float vv = st[192 + v];
#pragma unroll
            for (int j = 0; j < 4; ++j) { S[j] = S[j] * d0[j] + (pa * b0[j] + vv * k0[j]); S[4 + j] = S[4 + j] * d1[j] + (pa * b1[j] + vv * k1[j]); }
            const f32x4 r0 = *(const f32x4*)(st + kq * 8), r1 = *(const f32x4*)(st + 4 + kq * 8);
            float y = S[0] * r0[0] + S[1] * r0[1] + S[2] * r0[2] + S[3] * r0[3] + S[4] * r1[0] + S[5] * r1[1] + S[6] * r1[2] + S[7] * r1[3];
            y = red8(y);
            if (kq == 0) YO[(size_t)scan_row(g * 16 + i, b, dir) * 1024 + v] = y;
        }
        if (g + 1 < NG) commit((g + 1) & 1);
        __syncthreads();
    }
}

__device__ void mlstm_scan(const Params& p, int l, int chain, int rg, float* lds) {
    const int TIDX = otid();
    const int b = chain >> 3, h = (chain >> 1) & 3, dir = chain & 1, tid = TIDX;
    const bf16_t* P = (const bf16_t*)(p.ws + OFF_P);
    const float* RC = (const float*)(p.ws + OFF_ROPE); const float* RS = RC + 2048;
    float* NO = (float*)(p.ws + OFF_MLNUM) + (size_t)dir * NTOK * 4 * 272 + h * 272;
    const int sl = tid >> 5, j = tid & 31;
    const float gbi = p.in[I_MLGB][l * 16 + (dir * 2 + 0) * 4 + h], gbf = p.in[I_MLGB][l * 16 + (dir * 2 + 1) * 4 + h];
    const int rowl = tid >> 3, kq = tid & 7, crow = rg * 64 + rowl;
    float C[16];
#pragma unroll
    for (int i = 0; i < 16; ++i) C[i] = 0.f;
    bf16_t q0, q1, q2, q3, k0, k1, k2, k3, gi, gf; unsigned vv2; float cr, sr, cc, sc;
    auto issue = [&](int g) {
        const int row = scan_row(g * 16 + sl, b, dir);
        const bf16_t* pr = P + (size_t)row * NP;
        const bf16_t* pq = pr + h * 128 + j; const bf16_t* pk = pr + 512 + h * 128 + j;
        q0 = pq[0]; q1 = pq[32]; q2 = pq[64]; q3 = pq[96]; k0 = pk[0]; k1 = pk[32]; k2 = pk[64]; k3 = pk[96];
        vv2 = rg < 4 ? *(const unsigned*)(pr + 1024 + h * 256 + rg * 64 + 2 * j) : 0u;
        gi = pr[3072 + (dir * 2 + 0) * 4 + h]; gf = pr[3072 + (dir * 2 + 1) * 4 + h];
        if (row < NLAT) { const int t = row & 4095, pr_ = t >> 6, pc_ = t & 63; cr = RC[pr_ * 32 + j]; sr = RS[pr_ * 32 + j]; cc = RC[pc_ * 32 + j]; sc = RS[pc_ * 32 + j]; }
        else { cr = 1.f; sr = 0.f; cc = 1.f; sc = 0.f; }
    };
    auto commit = [&](int buf) {
        float* st = lds + buf * 5376 + sl * 336;
        const float scale = 0.08838834764831845f;
        const float a0 = bf2f(q0), a1 = bf2f(q1), a2 = bf2f(q2), a3 = bf2f(q3);
        st[j] = (a0 * cr - a1 * sr) * scale; st[32 + j] = (a0 * sr + a1 * cr) * scale; st[64 + j] = (a2 * cc - a3 * sc) * scale; st[96 + j] = (a2 * sc + a3 * cc) * scale;
        const float c0 = bf2f(k0), c1 = bf2f(k1), c2 = bf2f(k2), c3 = bf2f(k3);
        st[128 + j] = c0 * cr - c1 * sr; st[160 + j] = c0 * sr + c1 * cr; st[192 + j] = c2 * cc - c3 * sc; st[224 + j] = c2 * sc + c3 * cc;
        st[256 + 2 * j] = bflo(vv2); st[257 + 2 * j] = bfhi(vv2);
        if (j == 0) { st[320] = sigmoidf(bf2f(gf) + gbf); st[321] = __expf(bf2f(gi) + gbi); }
    };
    __syncthreads();
    issue(0); commit(0);
    __syncthreads();
    constexpr int NG = 4352 / 16;
    for (int g = 0; g < NG; ++g) {
        if (g + 1 < NG) issue(g + 1);
        const float* base = lds + (g & 1) * 5376;
#pragma unroll 2
        for (int i = 0; i < 16; ++i) {
            const float* st = base + i * 336;
            const float f = st[320], ig = st[321];
            const float vv = crow < 256 ? st[256 + rowl] : (crow == 256 ? 1.0f : 0.0f);
            const float coef = ig * vv;
            float num = 0.f;
#pragma unroll
            for (int c4 = 0; c4 < 4; ++c4) { const f32x4 kk = *(const f32x4*)(st + 128 + kq * 16 + c4 * 4), qq = *(const f32x4*)(st + kq * 16 + c4 * 4);
#pragma unroll
                for (int e = 0; e < 4; ++e) { C[c4 * 4 + e] = f * C[c4 * 4 + e] + coef * kk[e]; num += C[c4 * 4 + e] * qq[e]; } }
            num = red8(num);
            if (kq == 0 && crow <= 256) NO[(size_t)scan_row(g * 16 + i, b, dir) * (4 * 272) + crow] = num;
        }
        if (g + 1 < NG) commit((g + 1) & 1);
        __syncthreads();
    }
}

#define MFMA16(a, b, c) __builtin_amdgcn_mfma_f32_16x16x32_bf16(a, b, c, 0, 0, 0)
__device__ void na_wave(const Params& p, int l, int task) {
    const int TIDX = otid();
    const bf16_t* P = (const bf16_t*)(p.ws + OFF_P); const bf16_t* VT = (const bf16_t*)(p.ws + OFF_VT);
    bf16_t* YN = (bf16_t*)(p.ws + OFF_Y3) + 2ull * NTOK * 1024;
    const int w = TIDX >> 6, lane = TIDX & 63, n16 = lane & 15, g = lane >> 4;
    int b, h, qrow, r = 0, qcol = 0, cs = 0, row_start = 0, c_start = 0; bool lat;
    if (task < 512) { lat = true; b = task >> 8; h = (task >> 5) & 7; const int pair = task & 31; r = pair * 2 + (w >> 2); const int qi = w & 3; qcol = qi * 16 + n16;
        qrow = b * 4096 + r * 64 + qcol; cs = qi == 0 ? 0 : (qi == 1 ? 8 : (qi == 2 ? 24 : 32)); row_start = min(max(r - 4, 0), 56); c_start = min(max(qcol - 8, 0), 48); }
    else { lat = false; const int t2 = task - 512; b = t2 >> 4; h = (t2 >> 1) & 7; const int chunk = t2 & 1; qrow = NLAT + b * 256 + chunk * 128 + w * 16 + n16; }
    bf16x8 qf[4];
#pragma unroll
    for (int c = 0; c < 4; ++c) qf[c] = *(const bf16x8*)(P + (size_t)qrow * NP + NAB + h * 128 + c * 32 + g * 8);
    const float* rpb = p.in[I_RPB] + (size_t)(l * 8 + h) * 15 * 31;
    const bf16_t* vtb = VT + (size_t)((b * 8 + h) * 128) * 4352;
    f32x4 O[8];
#pragma unroll
    for (int i = 0; i < 8; ++i) O[i] = (f32x4){0.f, 0.f, 0.f, 0.f};
    float mrun = -INFINITY, lsum = 0.f;
    const float scale = 0.08838834764831845f;
    for (int pass = lat ? 0 : 2; pass < 4; ++pass) {
        f32x4 S[8];
#pragma unroll
        for (int i = 0; i < 8; ++i) {
            int krowtok;
            if (pass < 2) { const int krow = row_start + pass * 4 + (i >> 1); krowtok = b * 4096 + krow * 64 + cs + (i & 1) * 16 + n16; }
            else krowtok = NLAT + b * 256 + (pass - 2) * 128 + i * 16 + n16;
            const bf16_t* kp = P + (size_t)krowtok * NP + NAB + 1024 + h * 128 + g * 8;
            f32x4 acc = (f32x4){0.f, 0.f, 0.f, 0.f};
#pragma unroll
            for (int c = 0; c < 4; ++c) { const bf16x8 kf = *(const bf16x8*)(kp + c * 32); acc = MFMA16(kf, qf[c], acc); }
            S[i] = acc;
        }
        float mx = -INFINITY;
#pragma unroll
        for (int i = 0; i < 8; ++i) {
            if (pass < 2) { const int krow = row_start + pass * 4 + (i >> 1); const float* rb = rpb + (krow - r + 7) * 31;
#pragma unroll
                for (int jj = 0; jj < 4; ++jj) { const int kc = cs + (i & 1) * 16 + 4 * g + jj; const bool ok = (kc >= c_start) && (kc < c_start + 16);
                    const int co = min(max(kc - qcol, -15), 15) + 15;
                    S[i][jj] = ok ? S[i][jj] * scale + rb[co] : -INFINITY; } }
            else {
#pragma unroll
                for (int jj = 0; jj < 4; ++jj) S[i][jj] *= scale; }
#pragma unroll
            for (int jj = 0; jj < 4; ++jj) mx = fmaxf(mx, S[i][jj]);
        }
        mx = fmaxf(mx, __shfl_xor(mx, 16)); mx = fmaxf(mx, __shfl_xor(mx, 32));
        const float mnew = fmaxf(mrun, mx);
        const float alpha = __expf(mrun - mnew);
        mrun = mnew; lsum *= alpha;
#pragma unroll
        for (int i = 0; i < 8; ++i) { O[i][0] *= alpha; O[i][1] *= alpha; O[i][2] *= alpha; O[i][3] *= alpha; }
        bf16x8 pf[4];
#pragma unroll
        for (int c = 0; c < 4; ++c) {
            float e[8];
#pragma unroll
            for (int jj = 0; jj < 4; ++jj) { e[jj] = __expf(S[2 * c][jj] - mnew); e[4 + jj] = __expf(S[2 * c + 1][jj] - mnew); }
#pragma unroll
            for (int jj = 0; jj < 8; ++jj) lsum += e[jj];
            u32x4 u; u[0] = pack2(e[0], e[1]); u[1] = pack2(e[2], e[3]); u[2] = pack2(e[4], e[5]); u[3] = pack2(e[6], e[7]);
            pf[c] = __builtin_bit_cast(bf16x8, u);
        }
#pragma unroll
        for (int c = 0; c < 4; ++c) {
            int pos0, pos1;
            if (pass < 2) { const int krow = row_start + pass * 4 + c; pos0 = krow * 64 + cs + 4 * g; pos1 = pos0 + 16; }
            else { pos0 = 4096 + (pass - 2) * 128 + c * 32 + 4 * g; pos1 = pos0 + 16; }
#pragma unroll
            for (int dt = 0; dt < 8; ++dt) {
                const bf16_t* vp = vtb + (size_t)(dt * 16 + n16) * 4352;
                const bf16x4 v0 = *(const bf16x4*)(vp + pos0), v1 = *(const bf16x4*)(vp + pos1);
                const bf16x8 vf = __builtin_shufflevector(v0, v1, 0, 1, 2, 3, 4, 5, 6, 7);
                O[dt] = MFMA16(vf, pf[c], O[dt]);
            }
        }
    }
    lsum += __shfl_xor(lsum, 16); lsum += __shfl_xor(lsum, 32);
    const float inv = 1.0f / lsum;
    bf16_t* yo = YN + (size_t)qrow * 1024 + h * 128 + 4 * g;
#pragma unroll
    for (int dt = 0; dt < 8; ++dt) { u32x2 o; o[0] = pack2(O[dt][0] * inv, O[dt][1] * inv); o[1] = pack2(O[dt][2] * inv, O[dt][3] * inv); *(u32x2*)(yo + dt * 16) = o; }
}

__device__ void phase_mix(const Params& p, int l, float* lds) {
    const int TIDX = otid();
    for (int t = blockIdx.x; t < 144; t += gridDim.x) {
        if (t < 64) rwkv_scan(p, l, t, lds);
        else mlstm_scan(p, l, (t - 64) / 5, (t - 64) % 5, lds);
        __syncthreads();
    }
    unsigned* ctr = (unsigned*)(p.ws + OFF_CTL) + l * 8;
    int* stask = (int*)lds;
    const int ntask = l == 0 ? 544 : 512;
    for (;;) {
        __syncthreads();
        if (TIDX == 0) stask[0] = (int)atomicAdd(ctr, 1u);
        __syncthreads();
        const int t = stask[0];
        if (t >= ntask) break;
        na_wave(p, l, t);
    }
}

__device__ void phase_post(const Params& p, int l, int nrows) {
    const int TIDX = otid();
    const int wid = TIDX >> 6, lane = TIDX & 63, gw = blockIdx.x * 8 + wid, nw = gridDim.x * 8;
    const bf16_t* P = (const bf16_t*)(p.ws + OFF_P); const bf16_t* LO = (const bf16_t*)(p.ws + OFF_LO);
    bf16_t* YM = (bf16_t*)(p.ws + OFF_Y3); bf16_t* YR = YM + (size_t)NTOK * 1024;
    const float* NUM = (const float*)(p.ws + OFF_MLNUM); const float* YF = (const float*)(p.ws + OFF_YRWF);
    for (int it = gw; it < nrows * 4; it += nw) {
        const int row = it >> 2, h = it & 3;
        const float* nf = NUM + ((size_t)row * 4 + h) * 272; const float* nb = NUM + ((size_t)(NTOK + row) * 4 + h) * 272;
        const f32x4 a = *(const f32x4*)(nf + lane * 4), c = *(const f32x4*)(nb + lane * 4);
        const float df = 1.0f / fmaxf(fabsf(nf[256]), 1.0f), db = 1.0f / fmaxf(fabsf(nb[256]), 1.0f);
        float hv[4]; float ss = 0.f;
#pragma unroll
        for (int j = 0; j < 4; ++j) { hv[j] = a[j] * df + c[j] * db; ss += hv[j] * hv[j]; }
        ss = wsum(ss);
        const float rr = rsqrtf(ss * (1.0f / 256.0f) + 1e-6f);
        const int col = h * 256 + lane * 4;
        const u32x2 ov = *(const u32x2*)(P + (size_t)row * NP + 2048 + col);
        const f32x4 ng = *(const f32x4*)(p.in[I_MLNG] + l * 1024 + col);
        const float o0 = hv[0] * rr * ng[0] * sigmoidf(bflo(ov[0])), o1 = hv[1] * rr * ng[1] * sigmoidf(bfhi(ov[0]));
        const float o2 = hv[2] * rr * ng[2] * sigmoidf(bflo(ov[1])), o3 = hv[3] * rr * ng[3] * sigmoidf(bfhi(ov[1]));
        u32x2 w; w[0] = pack2(o0, o1); w[1] = pack2(o2, o3);
        *(u32x2*)(YM + (size_t)row * 1024 + col) = w;
    }
    const float* MU = p.in[I_RWMU] + (size_t)l * 3712;
    for (int it = gw; it < nrows * 16; it += nw) {
        const int row = it >> 4, c = (it & 15) * 64 + lane;
        const float y = YF[(size_t)row * 1024 + c] + YF[(size_t)(NTOK + row) * 1024 + c];
        const float mean = wsum(y) * (1.0f / 64.0f);
        const float dy = y - mean;
        const float var = wsum(dy * dy) * (1.0f / 64.0f);
        const float yn = dy * rsqrtf(var + 64e-5f);
        bool hp, hn; seq_nbrs(row, hp, hn);
        const bf16_t* pr = P + (size_t)row * NP + RWB + c;
        const float rc = bf2f(pr[0]), kc = bf2f(pr[1024]), vc = bf2f(pr[2048]);
        const float rp = hp ? bf2f(pr[-NP]) : 0.f, kp = hp ? bf2f(pr[-NP + 1024]) : 0.f, vp = hp ? bf2f(pr[-NP + 2048]) : 0.f;
        const float rn = hn ? bf2f(pr[NP]) : 0.f, kn = hn ? bf2f(pr[NP + 1024]) : 0.f, vn = hn ? bf2f(pr[NP + 2048]) : 0.f;
        const float rr = shiftf(rc, rp, rn, MU[c]), kk = shiftf(kc, kp, kn, MU[1024 + c]), vv = shiftf(vc, vp, vn, MU[2048 + c]);
        const float bonus = wsum(rr * kk * p.in[I_RWRK][l * 1024 + c]) * vv;
        const float gg = bf2f(LO[(size_t)row * 5120 + 4096 + c]);
        const float o = (yn * p.in[I_RWLNW][l * 1024 + c] + p.in[I_RWLNB][l * 1024 + c] + bonus) * gg;
        YR[(size_t)row * 1024 + c] = f2bf(o);
    }
}

#ifndef PHMASK
#define PHMASK 0xFFFF
#endif
__global__ void __launch_bounds__(512, 2) fwd_kernel(Params p) {
    extern __shared__ __attribute__((aligned(16))) unsigned char shm[];
    cg::grid_group grid = cg::this_grid();
    float* ldsf = (float*)shm;
    LAS unsigned char* ldsg = (LAS unsigned char*)shm;
    unsigned char* ws = p.ws;
    const float* MOD = (const float*)(ws + OFF_MOD);
    float* XL = (float*)(ws + OFF_XL);
    bf16_t* H = (bf16_t*)(ws + OFF_H);
    bf16_t* Pb = (bf16_t*)(ws + OFF_P);
    for (int ph = p.ph_lo; ph < p.ph_hi; ++ph) {
        if (ph > p.ph_lo) grid.sync();
        if (ph == 0) { phase_mod(p, ldsf); continue; }
        if (ph == NPHASE - 1) { phase_final(p); continue; }
        const int l = (ph - 1) / 11, sub = (ph - 1) % 11;
        const int Ml = l == 0 ? NTOK : NLAT;
        const float* modl = MOD + (size_t)l * 3 * 12288;
        if (sub == 1 || sub == 3 || sub == 6 || sub == 7 || sub == 9 || sub == 10) {
            pg8::Gemm g; pg8::SchedG S; pg8::EpiG E;
            S.mode = 0; S.mo.init(Ml / 256, (int)gridDim.x, (int)blockIdx.x);
            E.kind = 0; E.O = Pb; E.ldc = NP; E.P = Pb; E.ACC = (float*)(ws + OFF_YRWF);
            E.xin_lat = XL; E.xin_ctx = XL + (size_t)NLAT * 2048; E.XL = XL; E.gate = modl;
            if (sub == 1) { g = pg8::Gemm{H, (const bf16_t*)(ws + OFF_WIN), NTOK, NP, 2048}; }
            else if (sub == 3) { g = pg8::Gemm{(const bf16_t*)(ws + OFF_LA), (const bf16_t*)(ws + OFF_WLORA), NTOK, 5120, 640}; E.O = (bf16_t*)(ws + OFF_LO); E.ldc = 5120; }
            else if (sub == 6) { g = pg8::Gemm{(const bf16_t*)(ws + OFF_Y3), (const bf16_t*)(ws + OFF_WBR), Ml, 2048, 1024}; S.mode = 1; E.kind = 2; E.O = H; }
            else if (sub == 7) { g = pg8::Gemm{H, (const bf16_t*)(ws + OFF_WOUT), Ml, 2048, 2048}; E.kind = 3; E.gate = modl + 2 * 2048;
                if (l == 0) { E.xin_lat = p.in[I_X]; E.xin_ctx = p.in[I_CTX]; } }
            else if (sub == 9) { g = pg8::Gemm{H, (const bf16_t*)(ws + OFF_WFF1), Ml, DFF, 2048}; E.kind = 1; E.ldc = DFF; }
            else { g = pg8::Gemm{Pb, (const bf16_t*)(ws + OFF_WFF2), Ml, 2048, DFF}; E.kind = 3; E.gate = modl + 5 * 2048; }
            S.so.init(g.M, g.N, (int)gridDim.x, (int)blockIdx.x);
            pg8::gemm_phase(ldsg, g, S, E);
            continue;
        }
        switch (sub) {
        case 0: {
            phase_convert(p, l, ldsf);
            if (l == 0) phase_norm(p.in[I_X], p.in[I_CTX], NTOK, p.in[I_N1G] + l * 2048, modl, 0, 1, H);
            else phase_norm(XL, XL + (size_t)NLAT * 2048, NTOK, p.in[I_N1G] + l * 2048, modl, 0, 1, H);
        } break;
        case 2: phase_prep(p, l, (bf16_t*)shm); break;
        case 4: phase_mix(p, l, ldsf); break;
        case 5: phase_post(p, l, Ml); break;
        case 8: phase_norm(XL, XL + (size_t)NLAT * 2048, Ml, p.in[I_N2G] + l * 2048, modl, 3, 4, H); break;
        }
    }
}

extern "C" void kernel_launch(void* const* d_in, const int* in_sizes, int n_in, void* d_out, int out_size, void* d_ws, size_t ws_size, hipStream_t stream) {
    static int grid = 0;
    if (grid == 0) {
        if (n_in != 28 || ws_size < WS_END) { fprintf(stderr, "kernel_launch: need 28 inputs and %zu bytes of workspace (got %d, %zu)\n", (size_t)WS_END, n_in, ws_size); grid = -1; return; }
        if (hipFuncSetAttribute((const void*)fwd_kernel, hipFuncAttributeMaxDynamicSharedMemorySize, LDS_BYTES) != hipSuccess) { fprintf(stderr, "kernel_launch: hipFuncSetAttribute failed\n"); grid = -1; return; }
        int dev = 0, cus = 0, per_cu = 0;
        hipGetDevice(&dev);
        hipDeviceGetAttribute(&cus, hipDeviceAttributeMultiprocessorCount, dev);
        hipOccupancyMaxActiveBlocksPerMultiprocessor(&per_cu, (const void*)fwd_kernel, 512, LDS_BYTES);
        if (per_cu < 1) { fprintf(stderr, "kernel_launch: occupancy query says %d blocks per CU\n", per_cu); per_cu = 1; }
        (void)hipGetLastError();
        grid = cus * 1;
        if (grid > 256) grid = 256;
    }
    if (grid < 0) return;
    Params p{};
    for (int i = 0; i < 28; ++i) p.in[i] = (const float*)d_in[i];
    p.out = (float*)d_out; p.ws = (unsigned char*)d_ws;
#if ONE_LAUNCH
    p.ph_lo = 0; p.ph_hi = NPHASE;
    void* args[] = {&p};
    hipError_t e = hipLaunchCooperativeKernel((const void*)fwd_kernel, dim3(grid), dim3(512), args, LDS_BYTES, stream);
    if (e != hipSuccess) fprintf(stderr, "cooperative launch failed: %s (grid %d)\n", hipGetErrorString(e), grid);
#else
    for (int ph = 0; ph < NPHASE; ++ph) {
        p.ph_lo = ph; p.ph_hi = ph + 1;
        hipLaunchKernelGGL(fwd_kernel, dim3(grid), dim3(512), LDS_BYTES, stream, p);
    }
#endif
}
```

```cpp
#include <hip/hip_runtime.h>
#include <hip/hip_cooperative_groups.h>
#include <cstdio>
namespace cg = cooperative_groups;

#ifndef ONE_LAUNCH
#define ONE_LAUNCH 1
#endif

#define DEVI __device__ __forceinline__
#define LAS __attribute__((address_space(3)))
typedef unsigned short bf16_t;
typedef short bf16x8 __attribute__((ext_vector_type(8)));
typedef short bf16x4 __attribute__((ext_vector_type(4)));
typedef float f32x4 __attribute__((ext_vector_type(4)));
typedef float f32x2 __attribute__((ext_vector_type(2)));
typedef unsigned u32x4 __attribute__((ext_vector_type(4)));
typedef unsigned u32x2 __attribute__((ext_vector_type(2)));

constexpr int D = 2048, NTOK = 8704, NLAT = 8192, NP = 16128, DIN = 16016, DFF = 8192;
constexpr int RWB = 3088, NAB = 6800, GTB = 9872;
constexpr int LDS_BYTES = 131072;
constexpr int NPHASE = 24;

constexpr size_t OFF_CTL = 0;
constexpr size_t OFF_MOD = 4096;
constexpr size_t OFF_ROPE = OFF_MOD + 2ull * 3 * 12288 * 4;
constexpr size_t OFF_WIN = OFF_ROPE + 16384;
constexpr size_t OFF_WBR = OFF_WIN + 16128ull * 2048 * 2;
constexpr size_t OFF_WOUT = OFF_WBR + 3ull * 2048 * 1024 * 2;
constexpr size_t OFF_WFF1 = OFF_WOUT + 2048ull * 2048 * 2;
constexpr size_t OFF_WFF2 = OFF_WFF1 + 8192ull * 2048 * 2;
constexpr size_t OFF_WLORA = OFF_WFF2 + 8192ull * 2048 * 2;
constexpr size_t OFF_XL = OFF_WLORA + 5120ull * 640 * 2;
constexpr size_t OFF_H = OFF_XL + 8704ull * 2048 * 4;
constexpr size_t OFF_P = OFF_H + 8704ull * 2048 * 2;
constexpr size_t OFF_LA = OFF_P + 8704ull * 16128 * 2;
constexpr size_t OFF_LO = OFF_LA + 8704ull * 640 * 2;
constexpr size_t OFF_YRWF = OFF_LO + 8704ull * 5120 * 2;
constexpr size_t OFF_MLNUM = OFF_YRWF + 2ull * 8704 * 1024 * 4;
constexpr size_t OFF_VT = OFF_MLNUM + 2ull * 8704 * 4 * 272 * 4;
constexpr size_t OFF_Y3 = OFF_VT + 2ull * 8 * 128 * 4352 * 2;
constexpr size_t WS_END = OFF_Y3 + 3ull * 8704 * 1024 * 2;

struct Params {
    const float* in[28];
    float* out;
    unsigned char* ws;
    int ph_lo, ph_hi;
};
typedef const __attribute__((address_space(4))) Params* PP;
enum { I_X = 0, I_C, I_CTX, I_CCTX, I_WMOD, I_BMOD, I_N1G, I_WIN, I_MLGB, I_MLNG, I_RWMU, I_RWW0, I_RWWUP, I_RWA0, I_RWAUP, I_RWGUP,
       I_RWKK, I_RWKA, I_RWRK, I_RWLNW, I_RWLNB, I_RPB, I_WBR, I_WOUT, I_N2G, I_WFF1, I_WFF2, I_FING };

DEVI int otid() { int t; asm volatile("v_mov_b32 %0, %1" : "=v"(t) : "v"((int)threadIdx.x)); return t; }
DEVI float bf2f(bf16_t b) { return __uint_as_float(((unsigned)b) << 16); }
DEVI float bflo(unsigned u) { return __uint_as_float(u << 16); }
DEVI float bfhi(unsigned u) { return __uint_as_float(u & 0xffff0000u); }
DEVI bf16_t f2bf(float f) { unsigned u = __float_as_uint(f); u += 0x7FFFu + ((u >> 16) & 1u); return (bf16_t)(u >> 16); }
DEVI unsigned pack2(float lo, float hi) { return (unsigned)f2bf(lo) | ((unsigned)f2bf(hi) << 16); }
DEVI float sigmoidf(float x) { return 1.0f / (1.0f + __expf(-x)); }
DEVI float wsum(float x) {
#pragma unroll
    for (int o = 32; o; o >>= 1) x += __shfl_xor(x, o);
    return x;
}
DEVI float dppf(float x, const int ctrl) { return x; }
#define DPP_ADD(x, CTRL) ((x) + __int_as_float(__builtin_amdgcn_update_dpp(0, __float_as_int(x), CTRL, 0xF, 0xF, true)))
DEVI float red8(float x) {
    x = DPP_ADD(x, 0xB1);
    x = DPP_ADD(x, 0x4E);
    x = DPP_ADD(x, 0x141);
    return x;
}

namespace pg8 {
constexpr int BM = 256, BK = 64, HALF = 128, HTB = HALF * BK * 2, STAGE_BYTES = 8 * HTB, NXCD = 8, WGM = 8;
__host__ __device__ __forceinline__ int lds_byte(int r, int c) { const int st = (r >> 4) * 2 + (c >> 5), rr = r & 15, cc = c & 31, ob = rr * 64 + cc * 2; return st * 1024 + (ob ^ (((ob >> 9) & 1) << 5)); }
__host__ __device__ __forceinline__ void stage_rc(int b, int& R, int& C) { const int st = b / 1024, sb = b % 1024, swz = sb ^ (((sb >> 9) & 1) << 5); R = (st >> 1) * 16 + swz / 64; C = (st & 1) * 32 + (swz % 64) / 2; }
__host__ __device__ __forceinline__ int perm32(int rho) { const int n = rho >> 4, i = rho & 15; return 8 * (i >> 2) + 4 * n + (i & 3); }
struct Unit { int pm, pn; };
struct Gemm { const bf16_t* A; const bf16_t* Bt; int M, N, K; };
struct StaticOrder {
    int nM, nN, nwg, G, c;
    __device__ void init(int M, int N, int G_, int c_) { nM = M / BM; nN = N / BM; nwg = nM * nN; G = G_; c = c_; }
    __device__ bool next(int i, Unit& u) const {
        const long L = (long)i * G + c; if (L >= nwg) return false;
        int wgid = (int)L; { const int q = nwg / NXCD, r = nwg % NXCD, xcd = wgid % NXCD, off = wgid / NXCD; wgid = (xcd < r ? xcd * (q + 1) : r * (q + 1) + (xcd - r) * q) + off; }
        const int nig = WGM * nN, gid = wgid / nig, fm = gid * WGM, gsz = (nM - fm) < WGM ? (nM - fm) : WGM;
        u.pm = fm + ((wgid % nig) % gsz); u.pn = (wgid % nig) / gsz; return true;
    }
    __device__ __forceinline__ void a_ready(const Unit&) const {}
    __device__ __forceinline__ void done(const Unit&) const {}
};
struct MergeOrder {
    int ntiles, G, c;
    __device__ void init(int nM, int G_, int c_) { ntiles = nM * 8; G = G_; c = c_; }
    __device__ bool next(int i, Unit& u) const {
        const int ti = i / 3, br = i - ti * 3; const long L = (long)ti * G + c; if (L >= ntiles) return false;
        const int pm = (int)L >> 3, pn = (int)L & 7; u.pm = br * 34 + pm; u.pn = br * 8 + pn; return true;
    }
    __device__ __forceinline__ void a_ready(const Unit&) const {}
    __device__ __forceinline__ void done(const Unit&) const {}
};
DEVI unsigned cvt_pk_bf16(float lo, float hi) { unsigned r; asm volatile("v_cvt_pk_bf16_f32 %0, %1, %2" : "=v"(r) : "v"(lo), "v"(hi)); return r; }


struct SchedG {
    int mode;
    StaticOrder so; MergeOrder mo;
    __device__ __forceinline__ bool next(int i, Unit& u) const { return mode == 0 ? so.next(i, u) : mo.next(i, u); }
    __device__ __forceinline__ void a_ready(const Unit&) const {}
    __device__ __forceinline__ void done(const Unit&) const {}
};
struct EpiG {
    static constexpr bool PERM = true, AFTER_DRAIN = false;
    int kind;
    bf16_t* O; int ldc;
    const bf16_t* P; float* ACC;
    const float* xin_lat; const float* xin_ctx; float* XL; const float* gate;
    __device__ __forceinline__ void operator()(const f32x4 (&acc)[2][2][4][2], const Unit& u, int wr, int wc, int fr, int fq) const {
        if (kind <= 1) {
            const int row0 = u.pm * BM + wr * 64 + fr, col0 = u.pn * BM + wc * 32 + 8 * fq;
#pragma unroll
            for (int ai = 0; ai < 2; ++ai)
#pragma unroll
                for (int m = 0; m < 4; ++m) { bf16_t* rowp = O + (size_t)(row0 + ai * HALF + m * 16) * ldc + col0;
#pragma unroll
                    for (int bj = 0; bj < 2; ++bj) { f32x4 v0 = acc[ai][bj][m][0], v1 = acc[ai][bj][m][1];
                        if (kind == 1) {
#pragma unroll
                            for (int i = 0; i < 4; ++i) { float a = fmaxf(v0[i], 0.f), b = fmaxf(v1[i], 0.f); v0[i] = a * a; v1[i] = b * b; } }
                        u32x4 o; o[0] = cvt_pk_bf16(v0[0], v0[1]); o[1] = cvt_pk_bf16(v0[2], v0[3]); o[2] = cvt_pk_bf16(v1[0], v1[1]); o[3] = cvt_pk_bf16(v1[2], v1[3]);
                        *(u32x4*)(rowp + bj * HALF) = o; } }
        } else if (kind == 2) {
            const int br = u.pn >> 3, pn = u.pn & 7, pm = u.pm - br * 34;
            const int row0 = pm * BM + wr * 64 + fr, col0 = pn * BM + wc * 32 + 8 * fq;
#pragma unroll
            for (int ai = 0; ai < 2; ++ai)
#pragma unroll
                for (int m = 0; m < 4; ++m) { const size_t row = (size_t)(row0 + ai * HALF + m * 16);
#pragma unroll
                    for (int bj = 0; bj < 2; ++bj) { const int col = col0 + bj * HALF;
                        const u32x4 gv = *(const u32x4*)(P + row * NP + GTB + br * 2048 + col);
                        f32x4 v0 = acc[ai][bj][m][0], v1 = acc[ai][bj][m][1];
                        v0[0] *= sigmoidf(bflo(gv[0])); v0[1] *= sigmoidf(bfhi(gv[0])); v0[2] *= sigmoidf(bflo(gv[1])); v0[3] *= sigmoidf(bfhi(gv[1]));
                        v1[0] *= sigmoidf(bflo(gv[2])); v1[1] *= sigmoidf(bfhi(gv[2])); v1[2] *= sigmoidf(bflo(gv[3])); v1[3] *= sigmoidf(bfhi(gv[3]));
                        float* ap = ACC + row * 2048 + col;
                        if (br == 0) { *(f32x4*)ap = v0; *(f32x4*)(ap + 4) = v1; }
                        else { v0 += *(const f32x4*)ap; v1 += *(const f32x4*)(ap + 4);
                            if (br == 1) { *(f32x4*)ap = v0; *(f32x4*)(ap + 4) = v1; }
                            else { u32x4 o; o[0] = cvt_pk_bf16(v0[0], v0[1]); o[1] = cvt_pk_bf16(v0[2], v0[3]); o[2] = cvt_pk_bf16(v1[0], v1[1]); o[3] = cvt_pk_bf16(v1[2], v1[3]);
                                *(u32x4*)(O + row * 2048 + col) = o; } } } }
        } else {
            const int row0 = u.pm * BM + wr * 64 + fr, col0 = u.pn * BM + wc * 32 + 8 * fq;
#pragma unroll
            for (int ai = 0; ai < 2; ++ai)
#pragma unroll
                for (int m = 0; m < 4; ++m) { const int row = row0 + ai * HALF + m * 16;
                    const int mrow = row < NLAT ? (row >> 12) : 2;
                    const float* xr = row < NLAT ? xin_lat + (size_t)row * 2048 : xin_ctx + (size_t)(row - NLAT) * 2048;
                    const float* gr = gate + (size_t)mrow * 12288; float* orow = XL + (size_t)row * 2048;
#pragma unroll
                    for (int bj = 0; bj < 2; ++bj)
#pragma unroll
                        for (int n = 0; n < 2; ++n) { const int col = col0 + bj * HALF + n * 4;
                            const f32x4 g = *(const f32x4*)(gr + col), x = *(const f32x4*)(xr + col);
                            *(f32x4*)(orow + col) = x + g * acc[ai][bj][m][n]; } }
        }
    }
};
template <class Epi, class Sched>
__device__ __forceinline__ void gemm_phase(LAS unsigned char* lds, const Gemm g, const Sched& S, const Epi& E) {
    const int tid = otid(), wid = __builtin_amdgcn_readfirstlane(tid >> 6), lane = tid & 63, wr = wid >> 2, wc = wid & 3, fr = lane & 15, fq = lane >> 4;
    const int K = g.K, nt = K / BK;
    unsigned voffA[2], voffB[2];
#pragma unroll
    for (int i = 0; i < 2; ++i) { int R, C; stage_rc(tid * 16 + i * 8192, R, C); const int Rb = Epi::PERM ? ((R & ~31) + perm32(R & 31)) : R;
        voffA[i] = (unsigned)(R * K + C) * 2u; voffB[i] = (unsigned)(Rb * K + C) * 2u; }
    const size_t kstep = (size_t)(BK * 2);
    const size_t hstep = (size_t)HALF * K * 2;
    const size_t tstep = 2 * hstep;
    const unsigned ldsw = (unsigned)wid * 1024u;
    const int aoff = lds_byte(wr * 64 + fr, fq * 8), boff = lds_byte(wc * 32 + fr, fq * 8);
#define PG8_SA(b, h) (((b) * 2 + (h)) * HTB)
#define PG8_SB(b, h) ((4 + (b) * 2 + (h)) * HTB)
#define PG8_STAGE(bufoff, gbase, voff) do { _Pragma("unroll") for (int _i = 0; _i < 2; ++_i) \
        __builtin_amdgcn_global_load_lds((const unsigned*)((const char*)(gbase) + (voff)[_i]), (LAS unsigned*)(lds + (bufoff) + ldsw + _i * 8192), 16, 0, 0); } while (0)
#define PG8_LDA(dst, b, h) do { _Pragma("unroll") for (int m = 0; m < 4; ++m) _Pragma("unroll") for (int k = 0; k < 2; ++k) dst[m][k] = *(const LAS bf16x8*)(lds + PG8_SA(b, h) + aoff + m * 2048 + k * 1024); } while (0)
#define PG8_LDB(dst, b, h) do { _Pragma("unroll") for (int n = 0; n < 2; ++n) _Pragma("unroll") for (int k = 0; k < 2; ++k) dst[n][k] = *(const LAS bf16x8*)(lds + PG8_SB(b, h) + boff + n * 2048 + k * 1024); } while (0)
#define PG8_MMA(ai, bj, At, Bt) do { __builtin_amdgcn_s_setprio(1); _Pragma("unroll") for (int m = 0; m < 4; ++m) _Pragma("unroll") for (int n = 0; n < 2; ++n) _Pragma("unroll") for (int k = 0; k < 2; ++k) \
        acc[ai][bj][m][n] = __builtin_amdgcn_mfma_f32_16x16x32_bf16(Bt[n][k], At[m][k], acc[ai][bj][m][n], 0, 0, 0); __builtin_amdgcn_s_setprio(0); } while (0)
#define PG8_WAIT_V(n) asm volatile("s_waitcnt vmcnt(" #n ")" ::: "memory")
#define PG8_WAIT_L(n) asm volatile("s_waitcnt lgkmcnt(" #n ")" ::: "memory")
#define PG8_BAR __builtin_amdgcn_s_barrier()
#define PG8_SCHED __builtin_amdgcn_sched_barrier(0)
    Unit cur, nxt; int ui = 0;
    if (!S.next(0, cur)) return;
    f32x4 acc[2][2][4][2];
#pragma unroll
    for (int a = 0; a < 2; ++a)
#pragma unroll
        for (int b = 0; b < 2; ++b)
#pragma unroll
            for (int m = 0; m < 4; ++m)
#pragma unroll
                for (int n = 0; n < 2; ++n) acc[a][b][m][n] = (f32x4){0.f, 0.f, 0.f, 0.f};
    bf16x8 At[4][2], B0[2][2], B1[2][2];
    const char* cA = (const char*)g.A + (size_t)cur.pm * tstep; const char* cB = (const char*)g.Bt + (size_t)cur.pn * tstep;
    S.a_ready(cur);
    PG8_STAGE(PG8_SB(0, 0), cB, voffB); PG8_STAGE(PG8_SA(0, 0), cA, voffA); PG8_STAGE(PG8_SB(0, 1), cB + hstep, voffB); PG8_STAGE(PG8_SA(0, 1), cA + hstep, voffA);
    if (wr == 1) PG8_BAR;
    PG8_WAIT_V(4); PG8_BAR;
    PG8_STAGE(PG8_SB(1, 0), cB + kstep, voffB); PG8_STAGE(PG8_SA(1, 0), cA + kstep, voffA); PG8_STAGE(PG8_SB(1, 1), cB + hstep + kstep, voffB);
    PG8_WAIT_V(6); PG8_BAR;
    for (;;) {
        const bool has_next = S.next(ui + 1, nxt);
        const char* nA = has_next ? (const char*)g.A + (size_t)nxt.pm * tstep : cA; const char* nB = has_next ? (const char*)g.Bt + (size_t)nxt.pn * tstep : cB;
        for (int t = 0; t < nt; t += 2) {
            const bool last = (t == nt - 2);
            const char* a1 = cA + (size_t)(t + 1) * kstep;
            const char* a2 = last ? nA : cA + (size_t)(t + 2) * kstep; const char* b2 = last ? nB : cB + (size_t)(t + 2) * kstep;
            const char* a3 = a2 + kstep; const char* b3 = b2 + kstep;
            if (last && has_next) S.a_ready(nxt);
            PG8_LDB(B0, 0, 0); PG8_SCHED; PG8_LDA(At, 0, 0); PG8_STAGE(PG8_SA(1, 1), a1 + hstep, voffA);
            PG8_WAIT_L(8); PG8_BAR; PG8_WAIT_L(0); PG8_MMA(0, 0, At, B0); PG8_BAR; PG8_SCHED;
            PG8_LDB(B1, 0, 1); PG8_STAGE(PG8_SB(0, 0), b2, voffB);
            PG8_BAR; PG8_WAIT_L(0); PG8_MMA(0, 1, At, B1); PG8_BAR;
            PG8_LDA(At, 0, 1); PG8_STAGE(PG8_SA(0, 0), a2, voffA);
            PG8_BAR; PG8_WAIT_L(0); PG8_MMA(1, 0, At, B0); PG8_BAR; PG8_SCHED;
            PG8_STAGE(PG8_SB(0, 1), b2 + hstep, voffB);
            PG8_WAIT_V(6); PG8_BAR; PG8_MMA(1, 1, At, B1); PG8_BAR;
            PG8_LDB(B0, 1, 0); PG8_SCHED; PG8_LDA(At, 1, 0); PG8_STAGE(PG8_SA(0, 1), a2 + hstep, voffA);
            PG8_WAIT_L(8); PG8_BAR; PG8_WAIT_L(0); PG8_MMA(0, 0, At, B0); PG8_BAR; PG8_SCHED;
            PG8_LDB(B1, 1, 1); PG8_STAGE(PG8_SB(1, 0), b3, voffB);
            PG8_BAR; PG8_WAIT_L(0); PG8_MMA(0, 1, At, B1); PG8_BAR;
            PG8_LDA(At, 1, 1); PG8_STAGE(PG8_SA(1, 0), a3, voffA);
            PG8_BAR; PG8_WAIT_L(0); PG8_MMA(1, 0, At, B0); PG8_BAR; PG8_SCHED;
            PG8_STAGE(PG8_SB(1, 1), b3 + hstep, voffB);
            PG8_WAIT_V(6); PG8_BAR; PG8_MMA(1, 1, At, B1); PG8_BAR;
        }
        if constexpr (!Epi::AFTER_DRAIN) { E(acc, cur, wr, wc, fr, fq); S.done(cur); }
        if (!has_next) break;
#pragma unroll
        for (int a = 0; a < 2; ++a)
#pragma unroll
            for (int b = 0; b < 2; ++b)
#pragma unroll
                for (int m = 0; m < 4; ++m)
#pragma unroll
                    for (int n = 0; n < 2; ++n) acc[a][b][m][n] = (f32x4){0.f, 0.f, 0.f, 0.f};
        cur = nxt; cA = nA; cB = nB; ++ui;
    }
    PG8_WAIT_V(0);
    if (wr == 0) PG8_BAR;
    PG8_BAR;
    if constexpr (Epi::AFTER_DRAIN) { E.fused(acc, cur, wr, wc, fr, fq, lds, wid, lane); S.done(cur); }
#undef PG8_SA
#undef PG8_SB
#undef PG8_STAGE
#undef PG8_LDA
#undef PG8_LDB
#undef PG8_MMA
#undef PG8_WAIT_V
#undef PG8_WAIT_L
#undef PG8_BAR
#undef PG8_SCHED
}
}

__device__ void phase_mod(PP p, float* lds) {
    const int TIDX = otid();
    const int tid = TIDX;
    float* s = lds;
    float* red = lds + 3 * 2048;
    float* MOD = (float*)(p->ws + OFF_MOD);
    for (int i = tid; i < 3 * 2048; i += 512) { const int r = i >> 11, k = i & 2047; const float c = r < 2 ? p->in[I_C][r * 2048 + k] : p->in[I_CCTX][k]; s[i] = c * sigmoidf(c); }
    __syncthreads();
    for (int task = blockIdx.x; task < 192; task += gridDim.x) {
        const int l = task / 96, j0 = (task % 96) * 128, jc = tid & 127, kp = tid >> 7;
        const float* w = p->in[I_WMOD] + (size_t)l * 2048 * 12288 + j0 + jc;
        float a0 = 0.f, a1 = 0.f, a2 = 0.f;
#pragma unroll 8
        for (int k = kp * 512; k < kp * 512 + 512; ++k) { const float wv = w[(size_t)k * 12288]; a0 += s[k] * wv; a1 += s[2048 + k] * wv; a2 += s[4096 + k] * wv; }
        red[(kp * 3 + 0) * 128 + jc] = a0; red[(kp * 3 + 1) * 128 + jc] = a1; red[(kp * 3 + 2) * 128 + jc] = a2;
        __syncthreads();
        if (tid < 384) { const int r = tid >> 7, j = tid & 127;
            const float v = ((red[(0 * 3 + r) * 128 + j] + red[(1 * 3 + r) * 128 + j]) + (red[(2 * 3 + r) * 128 + j] + red[(3 * 3 + r) * 128 + j])) + p->in[I_BMOD][l * 12288 + j0 + j];
            MOD[(size_t)(l * 3 + r) * 12288 + j0 + j] = v; }
        __syncthreads();
    }
    if (blockIdx.x == gridDim.x - 1) {
        float* rc = (float*)(p->ws + OFF_ROPE); float* rs = rc + 2048;
        for (int i = tid; i < 2048; i += 512) { const int pos = i >> 5, j = i & 31; const float fr = powf(10000.0f, -(float)j / 32.0f); const float ang = (float)pos * fr; rc[i] = cosf(ang); rs[i] = sinf(ang); }
    }
}

__device__ void conv_tile(const float* __restrict__ src, int ld_src, int n_valid, int n0, int k0, bf16_t* __restrict__ dst, int ld_dst, float* tile) {
    const int TIDX = otid();
    const int tid = TIDX;
#pragma unroll
    for (int i = 0; i < 2; ++i) { const int kr = (tid >> 4) + i * 32, nc = (tid & 15) * 4; const float* sp = src + (size_t)(k0 + kr) * ld_src + n0 + nc;
        f32x4 v;
        if (n0 + nc + 3 < n_valid) v = *(const f32x4*)sp;
        else { v[0] = (n0 + nc + 0 < n_valid) ? sp[0] : 0.f; v[1] = (n0 + nc + 1 < n_valid) ? sp[1] : 0.f; v[2] = (n0 + nc + 2 < n_valid) ? sp[2] : 0.f; v[3] = (n0 + nc + 3 < n_valid) ? sp[3] : 0.f; }
        float* tp = tile + kr * 65 + nc; tp[0] = v[0]; tp[1] = v[1]; tp[2] = v[2]; tp[3] = v[3]; }
    __syncthreads();
    { const int n = tid >> 3, kc = (tid & 7) * 8; u32x4 o;
#pragma unroll
        for (int j = 0; j < 4; ++j) o[j] = pack2(tile[(kc + 2 * j) * 65 + n], tile[(kc + 2 * j + 1) * 65 + n]);
        *(u32x4*)(dst + (size_t)(n0 + n) * ld_dst + k0 + kc) = o; }
    __syncthreads();
}
__device__ void phase_convert(PP p, int l, float* lds) {
    const int TIDX = otid();
    for (int t = blockIdx.x; t < 18816; t += gridDim.x) {
        if (t < 8064) { const int nt = t >> 5, kt = t & 31; conv_tile(p->in[I_WIN] + (size_t)l * 2048 * DIN, DIN, DIN, nt * 64, kt * 64, (bf16_t*)(p->ws + OFF_WIN), 2048, lds); }
        else if (t < 9600) { const int tt = t - 8064, br = tt >> 9, r = tt & 511, nt = r >> 4, kt = r & 15;
            conv_tile(p->in[I_WBR] + (size_t)(l * 3 + br) * 1024 * 2048, 2048, 2048, nt * 64, kt * 64, (bf16_t*)(p->ws + OFF_WBR) + (size_t)br * 2048 * 1024, 1024, lds); }
        else if (t < 10624) { const int tt = t - 9600, nt = tt >> 5, kt = tt & 31; conv_tile(p->in[I_WOUT] + (size_t)l * 2048 * 2048, 2048, 2048, nt * 64, kt * 64, (bf16_t*)(p->ws + OFF_WOUT), 2048, lds); }
        else if (t < 14720) { const int tt = t - 10624, nt = tt >> 5, kt = tt & 31; conv_tile(p->in[I_WFF1] + (size_t)l * 2048 * 8192, 8192, 8192, nt * 64, kt * 64, (bf16_t*)(p->ws + OFF_WFF1), 2048, lds); }
        else { const int tt = t - 14720, nt = tt >> 7, kt = tt & 127; conv_tile(p->in[I_WFF2] + (size_t)l * 8192 * 2048, 2048, 2048, nt * 64, kt * 64, (bf16_t*)(p->ws + OFF_WFF2), 8192, lds); }
    }
    bf16_t* WL = (bf16_t*)(p->ws + OFF_WLORA);
    for (int idx = blockIdx.x * 512 + TIDX; idx < 5120 * 640; idx += gridDim.x * 512) {
        const int n = idx / 640, k = idx - n * 640, blk = n >> 10, nn = n & 1023;
        const int k0 = blk < 4 ? blk * 96 : 384, kw = blk < 4 ? 96 : 256;
        float v = 0.f;
        if (k >= k0 && k < k0 + kw) {
            const float* sp = blk < 2 ? p->in[I_RWWUP] + (size_t)(l * 2 + blk) * 96 * 1024 : (blk < 4 ? p->in[I_RWAUP] + (size_t)(l * 2 + blk - 2) * 96 * 1024 : p->in[I_RWGUP] + (size_t)l * 256 * 1024);
            v = sp[(size_t)(k - k0) * 1024 + nn]; }
        WL[idx] = f2bf(v);
    }
    if (blockIdx.x == 0 && TIDX < 8) ((unsigned*)(p->ws + OFF_CTL))[l * 8 + TIDX] = 0u;
}

__device__ void phase_norm(const float* __restrict__ xlat, const float* __restrict__ xctx, int nrows, const float* __restrict__ g, const float* __restrict__ modl, int ishift, int iscale, bf16_t* __restrict__ H) {
    const int TIDX = otid();
    const int wid = TIDX >> 6, lane = TIDX & 63;
    for (int row = blockIdx.x * 8 + wid; row < nrows; row += gridDim.x * 8) {
        const float* xr = row < NLAT ? xlat + (size_t)row * 2048 : xctx + (size_t)(row - NLAT) * 2048;
        const int mrow = row < NLAT ? (row >> 12) : 2;
        const float* sh = modl + (size_t)mrow * 12288 + ishift * 2048; const float* sc = modl + (size_t)mrow * 12288 + iscale * 2048;
        f32x4 v[8]; float ss = 0.f;
#pragma unroll
        for (int i = 0; i < 8; ++i) { v[i] = *(const f32x4*)(xr + (i * 64 + lane) * 4); ss += v[i][0] * v[i][0] + v[i][1] * v[i][1] + v[i][2] * v[i][2] + v[i][3] * v[i][3]; }
        ss = wsum(ss);
        const float r = rsqrtf(ss * (1.0f / 2048.0f) + 1e-6f);
#pragma unroll
        for (int i = 0; i < 8; ++i) { const int col = (i * 64 + lane) * 4; const f32x4 gg = *(const f32x4*)(g + col), s1 = *(const f32x4*)(sc + col), s0 = *(const f32x4*)(sh + col);
            float o[4];
#pragma unroll
            for (int j = 0; j < 4; ++j) o[j] = (v[i][j] * r * gg[j]) * (1.0f + s1[j]) + s0[j];
            u32x2 w; w[0] = pack2(o[0], o[1]); w[1] = pack2(o[2], o[3]);
            *(u32x2*)(H + (size_t)row * 2048 + col) = w; }
    }
}
__device__ void phase_final(PP p) {
    const int TIDX = otid();
    const int wid = TIDX >> 6, lane = TIDX & 63;
    const float* XL = (const float*)(p->ws + OFF_XL); const float* g = p->in[I_FING];
    for (int row = blockIdx.x * 8 + wid; row < NLAT; row += gridDim.x * 8) {
        const float* xr = XL + (size_t)row * 2048;
        f32x4 v[8]; float ss = 0.f;
#pragma unroll
        for (int i = 0; i < 8; ++i) { v[i] = *(const f32x4*)(xr + (i * 64 + lane) * 4); ss += v[i][0] * v[i][0] + v[i][1] * v[i][1] + v[i][2] * v[i][2] + v[i][3] * v[i][3]; }
        ss = wsum(ss);
        const float r = rsqrtf(ss * (1.0f / 2048.0f) + 1e-6f);
#pragma unroll
        for (int i = 0; i < 8; ++i) { const int col = (i * 64 + lane) * 4; const f32x4 gg = *(const f32x4*)(g + col);
            f32x4 o; o[0] = v[i][0] * r * gg[0]; o[1] = v[i][1] * r * gg[1]; o[2] = v[i][2] * r * gg[2]; o[3] = v[i][3] * r * gg[3];
            *(f32x4*)(p->out + (size_t)row * 2048 + col) = o; }
    }
}

DEVI void seq_nbrs(int row, bool& hp, bool& hn) {
    if (row < NLAT) { const int t = row & 4095; hp = t > 0; hn = t < 4095; } else { const int m = (row - NLAT) & 255; hp = m > 0; hn = m < 255; }
}
DEVI float shiftf(float c, float pv, float nx, float mu) { return c + mu * (0.5f * (pv + nx) - c); }

__device__ void phase_prep(PP p, int l, bf16_t* ldsT) {
    const int TIDX = otid();
    const bf16_t* P = (const bf16_t*)(p->ws + OFF_P); bf16_t* LA = (bf16_t*)(p->ws + OFF_LA);
    const float* mu = p->in[I_RWMU] + (size_t)l * 3712 + 3072;
    for (int idx = blockIdx.x * 512 + TIDX; idx < NTOK * 80; idx += gridDim.x * 512) {
        const int row = idx / 80, j = (idx - row * 80) * 8;
        bool hp, hn; seq_nbrs(row, hp, hn);
        const bf16_t* pc = P + (size_t)row * NP + RWB + 3072 + j;
        const u32x4 c = *(const u32x4*)pc;
        const u32x4 z = {0u, 0u, 0u, 0u};
        const u32x4 pv = hp ? *(const u32x4*)(pc - NP) : z, nx = hn ? *(const u32x4*)(pc + NP) : z;
        float o[8];
#pragma unroll
        for (int q = 0; q < 4; ++q) { o[2 * q] = shiftf(bflo(c[q]), bflo(pv[q]), bflo(nx[q]), mu[j + 2 * q]); o[2 * q + 1] = shiftf(bfhi(c[q]), bfhi(pv[q]), bfhi(nx[q]), mu[j + 2 * q + 1]); }
        if (j < 192) {
#pragma unroll
            for (int q = 0; q < 8; ++q) o[q] = tanhf(o[q]); }
        else if (j >= 384) {
#pragma unroll
            for (int q = 0; q < 8; ++q) o[q] = sigmoidf(o[q]); }
        u32x4 w; w[0] = pack2(o[0], o[1]); w[1] = pack2(o[2], o[3]); w[2] = pack2(o[4], o[5]); w[3] = pack2(o[6], o[7]);
        *(u32x4*)(LA + (size_t)row * 640 + j) = w;
    }
    bf16_t* VT = (bf16_t*)(p->ws + OFF_VT);
    const int tid = TIDX;
    for (int t = blockIdx.x; t < 136 * 16; t += gridDim.x) {
        const int rt = t >> 4, hd = t & 15, h = hd >> 1, dh = hd & 1;
        const int row0 = rt * 64;
        { const int tl = tid >> 3, dc = (tid & 7) * 8;
            const u32x4 v = *(const u32x4*)(P + (size_t)(row0 + tl) * NP + NAB + 2048 + h * 128 + dh * 64 + dc);
            bf16_t* tp = ldsT + tl * 66 + dc;
#pragma unroll
            for (int q = 0; q < 4; ++q) { tp[2 * q] = (bf16_t)(v[q] & 0xffffu); tp[2 * q + 1] = (bf16_t)(v[q] >> 16); } }
        __syncthreads();
        { const int d = tid >> 3, tc = (tid & 7) * 8;
            int b, pos; if (row0 < NLAT) { b = row0 >> 12; pos = row0 & 4095; } else { b = (row0 - NLAT) >> 8; pos = 4096 + ((row0 - NLAT) & 255); }
            u32x4 o;
#pragma unroll
            for (int q = 0; q < 4; ++q) o[q] = (unsigned)ldsT[(tc + 2 * q) * 66 + d] | ((unsigned)ldsT[(tc + 2 * q + 1) * 66 + d] << 16);
            *(u32x4*)(VT + ((size_t)((b * 8 + h) * 128 + dh * 64 + d)) * 4352 + pos + tc) = o; }
        __syncthreads();
    }
}

DEVI int scan_row(int s, int b, int dir) {
    if (s < 256) { const int m = dir ? 255 - s : s; return NLAT + b * 256 + m; }
    const int t = dir ? 4095 - (s - 256) : s - 256; return b * 4096 + t;
}
__device__ void rwkv_scan(PP p, int l, int task, float* lds) {
    const int TIDX = otid();
    const int chain = task >> 1, half = task & 1;
    const int b = chain >> 5, h = (chain >> 1) & 15, dir = chain & 1, tid = TIDX;
    const bf16_t* P = (const bf16_t*)(p->ws + OFF_P); const bf16_t* LO = (const bf16_t*)(p->ws + OFF_LO);
    float* YO = (float*)(p->ws + OFF_YRWF) + (size_t)dir * NTOK * 1024 + h * 64;
    const int sl = tid >> 5, e2 = (tid & 31) * 2, ch = h * 64 + e2;
    const float* MU = p->in[I_RWMU] + (size_t)l * 3712;
    const float mur0 = MU[ch], mur1 = MU[ch + 1], muk0 = MU[1024 + ch], muk1 = MU[1024 + ch + 1], muv0 = MU[2048 + ch], muv1 = MU[2048 + ch + 1];
    const float w00 = p->in[I_RWW0][(l * 2 + dir) * 1024 + ch], w01 = p->in[I_RWW0][(l * 2 + dir) * 1024 + ch + 1];
    const float a00 = p->in[I_RWA0][(l * 2 + dir) * 1024 + ch], a01 = p->in[I_RWA0][(l * 2 + dir) * 1024 + ch + 1];
    const float kk0 = p->in[I_RWKK][l * 1024 + ch], kk1 = p->in[I_RWKK][l * 1024 + ch + 1], ka0 = p->in[I_RWKA][l * 1024 + ch], ka1 = p->in[I_RWKA][l * 1024 + ch + 1];
    const int kq = tid & 7, v = half * 32 + ((tid >> 3) & 31);
    f32x2 S[4];
#pragma unroll
    for (int j = 0; j < 4; ++j) S[j] = (f32x2){0.f, 0.f};
    unsigned rc, rp, rn, kc, kp, kn, vc, vp, vn, wr_, ar_;
    auto issue = [&](int g) {
        const int row = scan_row(g * 16 + sl, b, dir); bool hp, hn; seq_nbrs(row, hp, hn);
        const bf16_t* pr = P + (size_t)row * NP + RWB + ch;
        rc = *(const unsigned*)pr; kc = *(const unsigned*)(pr + 1024); vc = *(const unsigned*)(pr + 2048);
        rp = 0u; kp = 0u; vp = 0u; rn = 0u; kn = 0u; vn = 0u;
        if (hp) { rp = *(const unsigned*)(pr - NP); kp = *(const unsigned*)(pr - NP + 1024); vp = *(const unsigned*)(pr - NP + 2048); }
        if (hn) { rn = *(const unsigned*)(pr + NP); kn = *(const unsigned*)(pr + NP + 1024); vn = *(const unsigned*)(pr + NP + 2048); }
        const bf16_t* lo = LO + (size_t)row * 5120 + dir * 1024 + ch;
        wr_ = *(const unsigned*)lo; ar_ = *(const unsigned*)(lo + 2048);
    };
    auto commit = [&](int buf) {
        float* st = lds + buf * 6144 + sl * 384 + e2;
        const float r0 = shiftf(bflo(rc), bflo(rp), bflo(rn), mur0), r1 = shiftf(bfhi(rc), bfhi(rp), bfhi(rn), mur1);
        const float k0 = shiftf(bflo(kc), bflo(kp), bflo(kn), muk0), k1 = shiftf(bfhi(kc), bfhi(kp), bfhi(kn), muk1);
        const float v0 = shiftf(bflo(vc), bflo(vp), bflo(vn), muv0), v1 = shiftf(bfhi(vc), bfhi(vp), bfhi(vn), muv1);
        const float x0 = -(w00 + bflo(wr_)), x1 = -(w01 + bfhi(wr_));
        const float sp0 = x0 > 20.f ? x0 : log1pf(__expf(x0)), sp1 = x1 > 20.f ? x1 : log1pf(__expf(x1));
        const float d0 = __expf(-__expf(-sp0 - 0.5f)), d1 = __expf(-__expf(-sp1 - 0.5f));
        const float ar0 = sigmoidf(a00 + bflo(ar_)), ar1 = sigmoidf(a01 + bfhi(ar_));
        const float kd0 = k0 * (1.0f + (ar0 - 1.0f) * ka0), kd1 = k1 * (1.0f + (ar1 - 1.0f) * ka1);
        const float q0 = k0 * kk0, q1 = k1 * kk1;
        float ss = q0 * q0 + q1 * q1;
#pragma unroll
        for (int o = 16; o; o >>= 1) ss += __shfl_xor(ss, o);
        const float inv = 1.0f / fmaxf(sqrtf(ss), 1e-12f);
        const float n0 = q0 * inv, n1 = q1 * inv;
        *(f32x2*)(st + 0) = (f32x2){r0, r1}; *(f32x2*)(st + 64) = (f32x2){d0, d1}; *(f32x2*)(st + 128) = (f32x2){kd0, kd1};
        *(f32x2*)(st + 192) = (f32x2){v0, v1}; *(f32x2*)(st + 256) = (f32x2){-n0, -n1}; *(f32x2*)(st + 320) = (f32x2){n0 * ar0, n1 * ar1};
    };
    __syncthreads();
    issue(0); commit(0);
    __syncthreads();
    constexpr int NG = 4352 / 16;
    for (int g = 0; g < NG; ++g) {
        if (g + 1 < NG) issue(g + 1);
        if (tid < 256) {
            const float* base = lds + (g & 1) * 6144 + kq * 8;
            float ykeep = 0.f;
            f32x4 nA0, nA1, nD0, nD1, nB0, nB1, nK0, nK1, nR0, nR1; float nV;
#define RW_LOAD(i_) do { const float* st_ = base + (i_) * 384; nA0 = *(const f32x4*)(st_ + 256); nA1 = *(const f32x4*)(st_ + 260); nD0 = *(const f32x4*)(st_ + 64); nD1 = *(const f32x4*)(st_ + 68); \
                nB0 = *(const f32x4*)(st_ + 320); nB1 = *(const f32x4*)(st_ + 324); nK0 = *(const f32x4*)(st_ + 128); nK1 = *(const f32x4*)(st_ + 132); nR0 = *(const f32x4*)(st_); nR1 = *(const f32x4*)(st_ + 4); \
                nV = st_[192 - kq * 8 + v]; } while (0)
            RW_LOAD(0);
#pragma unroll
            for (int i = 0; i < 16; ++i) {
                const f32x4 a0 = nA0, a1 = nA1, d0 = nD0, d1 = nD1, b0 = nB0, b1 = nB1, k0 = nK0, k1 = nK1, r0 = nR0, r1 = nR1; const float vv = nV;
                if (i < 15) { RW_LOAD(i + 1); }
                __builtin_amdgcn_sched_barrier(0x77);
                f32x2 pa2 = S[0] * (f32x2){a0[0], a0[1]};
                pa2 = S[1] * (f32x2){a0[2], a0[3]} + pa2; pa2 = S[2] * (f32x2){a1[0], a1[1]} + pa2; pa2 = S[3] * (f32x2){a1[2], a1[3]} + pa2;
                const float pa = red8(pa2[0] + pa2[1]);
                const f32x2 pab = (f32x2){pa, pa}, vvb = (f32x2){vv, vv};
                S[0] = S[0] * (f32x2){d0[0], d0[1]} + (vvb * (f32x2){k0[0], k0[1]} + pab * (f32x2){b0[0], b0[1]});
                S[1] = S[1] * (f32x2){d0[2], d0[3]} + (vvb * (f32x2){k0[2], k0[3]} + pab * (f32x2){b0[2], b0[3]});
                S[2] = S[2] * (f32x2){d1[0], d1[1]} + (vvb * (f32x2){k1[0], k1[1]} + pab * (f32x2){b1[0], b1[1]});
                S[3] = S[3] * (f32x2){d1[2], d1[3]} + (vvb * (f32x2){k1[2], k1[3]} + pab * (f32x2){b1[2], b1[3]});
                f32x2 y2 = S[0] * (f32x2){r0[0], r0[1]};
                y2 = S[1] * (f32x2){r0[2], r0[3]} + y2; y2 = S[2] * (f32x2){r1[0], r1[1]} + y2; y2 = S[3] * (f32x2){r1[2], r1[3]} + y2;
                const float y = red8(y2[0] + y2[1]);
                ykeep = (kq == (i & 7)) ? y : ykeep;
                if ((i & 7) == 7) YO[(size_t)scan_row(g * 16 + (i - 7) + kq, b, dir) * 1024 + v] = ykeep;
            }
#undef RW_LOAD
        }
        if (g + 1 < NG) commit((g + 1) & 1);
        __syncthreads();
    }
}

__device__ void mlstm_scan(PP p, int l, int chain, int rg, float* lds) {
    const int TIDX = otid();
    const int b = chain >> 3, h = (chain >> 1) & 3, dir = chain & 1, tid = TIDX;
    const bf16_t* P = (const bf16_t*)(p->ws + OFF_P);
    const float* RC = (const float*)(p->ws + OFF_ROPE); const float* RS = RC + 2048;
    float* NO = (float*)(p->ws + OFF_MLNUM) + (size_t)dir * NTOK * 4 * 272 + h * 272;
    const int sl = tid >> 5, j = tid & 31;
    const float gbi = p->in[I_MLGB][l * 16 + (dir * 2 + 0) * 4 + h], gbf = p->in[I_MLGB][l * 16 + (dir * 2 + 1) * 4 + h];
    const int rowl = (tid >> 3) & 31, kq = tid & 7, crow = rg * 64 + rowl;
    f32x2 C[8], E[8];
#pragma unroll
    for (int i = 0; i < 8; ++i) { C[i] = (f32x2){0.f, 0.f}; E[i] = (f32x2){0.f, 0.f}; }
    bf16_t q0, q1, q2, q3, k0, k1, k2, k3, gi, gf; unsigned vv2; float cr, sr, cc, sc;
    auto issue = [&](int g) {
        const int row = scan_row(g * 16 + sl, b, dir);
        const bf16_t* pr = P + (size_t)row * NP;
        const bf16_t* pq = pr + h * 128 + j; const bf16_t* pk = pr + 512 + h * 128 + j;
        q0 = pq[0]; q1 = pq[32]; q2 = pq[64]; q3 = pq[96]; k0 = pk[0]; k1 = pk[32]; k2 = pk[64]; k3 = pk[96];
        vv2 = rg < 4 ? *(const unsigned*)(pr + 1024 + h * 256 + rg * 64 + 2 * j) : 0u;
        gi = pr[3072 + (dir * 2 + 0) * 4 + h]; gf = pr[3072 + (dir * 2 + 1) * 4 + h];
        if (row < NLAT) { const int t = row & 4095, pr_ = t >> 6, pc_ = t & 63; cr = RC[pr_ * 32 + j]; sr = RS[pr_ * 32 + j]; cc = RC[pc_ * 32 + j]; sc = RS[pc_ * 32 + j]; }
        else { cr = 1.f; sr = 0.f; cc = 1.f; sc = 0.f; }
    };
    auto commit = [&](int buf) {
        float* st = lds + buf * 5376 + sl * 336;
        const float scale = 0.08838834764831845f;
        const float a0 = bf2f(q0), a1 = bf2f(q1), a2 = bf2f(q2), a3 = bf2f(q3);
        st[j] = (a0 * cr - a1 * sr) * scale; st[32 + j] = (a0 * sr + a1 * cr) * scale; st[64 + j] = (a2 * cc - a3 * sc) * scale; st[96 + j] = (a2 * sc + a3 * cc) * scale;
        const float c0 = bf2f(k0), c1 = bf2f(k1), c2 = bf2f(k2), c3 = bf2f(k3);
        st[128 + j] = c0 * cr - c1 * sr; st[160 + j] = c0 * sr + c1 * cr; st[192 + j] = c2 * cc - c3 * sc; st[224 + j] = c2 * sc + c3 * cc;
        st[256 + 2 * j] = bflo(vv2); st[257 + 2 * j] = bfhi(vv2);
        if (j == 0) { st[320] = sigmoidf(bf2f(gf) + gbf); st[321] = __expf(bf2f(gi) + gbi); }
    };
    __syncthreads();
    issue(0); commit(0);
    __syncthreads();
    constexpr int NG = 4352 / 16;
    for (int g = 0; g < NG; ++g) {
        if (g + 1 < NG) issue(g + 1);
        if (tid < 256) {
        const float* base = lds + (g & 1) * 5376;
        float nkeep = 0.f, mkeep = 0.f;
        const int col0 = crow <= 256 ? crow : 257 + (rowl & 7), col1 = crow < 224 ? crow + 32 : 265 + (rowl & 3);
        f32x4 nK[4], nQ[4]; float nF, nI, nV0, nV1;
#define ML_LOAD(i_) do { const float* st_ = base + (i_) * 336; _Pragma("unroll") for (int c4 = 0; c4 < 4; ++c4) { nK[c4] = *(const f32x4*)(st_ + 128 + c4 * 32 + kq * 4); nQ[c4] = *(const f32x4*)(st_ + c4 * 32 + kq * 4); } \
            nF = st_[320]; nI = st_[321]; nV0 = st_[256 + rowl]; nV1 = st_[288 + rowl]; } while (0)
        ML_LOAD(0);
#pragma unroll
        for (int i = 0; i < 16; ++i) {
            f32x4 kk[4], qq[4];
#pragma unroll
            for (int c4 = 0; c4 < 4; ++c4) { kk[c4] = nK[c4]; qq[c4] = nQ[c4]; }
            const float f = nF, ig = nI;
            const float vv = crow < 256 ? nV0 : (crow == 256 ? 1.0f : 0.0f);
            const float vw = crow < 224 ? nV1 : 0.0f;
            if (i < 15) { ML_LOAD(i + 1); }
            __builtin_amdgcn_sched_barrier(0x77);
            const float coef = ig * vv, coeg = ig * vw;
            const f32x2 cf = (f32x2){coef, coef}, cg2 = (f32x2){coeg, coeg}, ff = (f32x2){f, f};
            f32x2 num2 = (f32x2){0.f, 0.f}, nun2 = (f32x2){0.f, 0.f};
#pragma unroll
            for (int c4 = 0; c4 < 4; ++c4) {
                const f32x2 KA = (f32x2){kk[c4][0], kk[c4][1]}, KB = (f32x2){kk[c4][2], kk[c4][3]}, QA = (f32x2){qq[c4][0], qq[c4][1]}, QB = (f32x2){qq[c4][2], qq[c4][3]};
                C[2 * c4] = ff * C[2 * c4] + cf * KA; C[2 * c4 + 1] = ff * C[2 * c4 + 1] + cf * KB;
                E[2 * c4] = ff * E[2 * c4] + cg2 * KA; E[2 * c4 + 1] = ff * E[2 * c4 + 1] + cg2 * KB;
                num2 = C[2 * c4] * QA + num2; num2 = C[2 * c4 + 1] * QB + num2;
                nun2 = E[2 * c4] * QA + nun2; nun2 = E[2 * c4 + 1] * QB + nun2; }
            const float num = red8(num2[0] + num2[1]), nun = red8(nun2[0] + nun2[1]);
            nkeep = (kq == (i & 7)) ? num : nkeep; mkeep = (kq == (i & 7)) ? nun : mkeep;
            if ((i & 7) == 7) { float* no = NO + (size_t)scan_row(g * 16 + (i - 7) + kq, b, dir) * (4 * 272); no[col0] = nkeep; no[col1] = mkeep; }
        }
#undef ML_LOAD
        }
        if (g + 1 < NG) commit((g + 1) & 1);
        __syncthreads();
    }
}

#define MFMA16(a, b, c) __builtin_amdgcn_mfma_f32_16x16x32_bf16(a, b, c, 0, 0, 0)
__device__ void na_wave(PP p, int l, int task) {
    const int TIDX = otid();
    const bf16_t* P = (const bf16_t*)(p->ws + OFF_P); const bf16_t* VT = (const bf16_t*)(p->ws + OFF_VT);
    bf16_t* YN = (bf16_t*)(p->ws + OFF_Y3) + 2ull * NTOK * 1024;
    const int w = TIDX >> 6, lane = TIDX & 63, n16 = lane & 15, g = lane >> 4;
    int b, h, qrow, r = 0, qcol = 0, cs = 0, row_start = 0, c_start = 0; bool lat;
    if (task < 512) { lat = true; b = task >> 8; h = (task >> 5) & 7; const int pair = task & 31; r = pair * 2 + (w >> 2); const int qi = w & 3; qcol = qi * 16 + n16;
        qrow = b * 4096 + r * 64 + qcol; cs = qi == 0 ? 0 : (qi == 1 ? 8 : (qi == 2 ? 24 : 32)); row_start = min(max(r - 4, 0), 56); c_start = min(max(qcol - 8, 0), 48); }
    else { lat = false; const int t2 = task - 512; b = t2 >> 4; h = (t2 >> 1) & 7; const int chunk = t2 & 1; qrow = NLAT + b * 256 + chunk * 128 + w * 16 + n16; }
    bf16x8 qf[4];
#pragma unroll
    for (int c = 0; c < 4; ++c) qf[c] = *(const bf16x8*)(P + (size_t)qrow * NP + NAB + h * 128 + c * 32 + g * 8);
    const float* rpb = p->in[I_RPB] + (size_t)(l * 8 + h) * 15 * 31;
    const bf16_t* vtb = VT + (size_t)((b * 8 + h) * 128) * 4352;
    f32x4 O[8];
#pragma unroll
    for (int i = 0; i < 8; ++i) O[i] = (f32x4){0.f, 0.f, 0.f, 0.f};
    float mrun = -INFINITY, lsum = 0.f;
    const float scale = 0.08838834764831845f;
    for (int pass = lat ? 0 : 2; pass < 4; ++pass) {
        f32x4 S[8];
#pragma unroll
        for (int i = 0; i < 8; ++i) {
            int krowtok;
            if (pass < 2) { const int krow = row_start + pass * 4 + (i >> 1); krowtok = b * 4096 + krow * 64 + cs + (i & 1) * 16 + n16; }
            else krowtok = NLAT + b * 256 + (pass - 2) * 128 + i * 16 + n16;
            const bf16_t* kp = P + (size_t)krowtok * NP + NAB + 1024 + h * 128 + g * 8;
            f32x4 acc = (f32x4){0.f, 0.f, 0.f, 0.f};
#pragma unroll
            for (int c = 0; c < 4; ++c) { const bf16x8 kf = *(const bf16x8*)(kp + c * 32); acc = MFMA16(kf, qf[c], acc); }
            S[i] = acc;
        }
        float mx = -INFINITY;
#pragma unroll
        for (int i = 0; i < 8; ++i) {
            if (pass < 2) { const int krow = row_start + pass * 4 + (i >> 1); const float* rb = rpb + (krow - r + 7) * 31;
#pragma unroll
                for (int jj = 0; jj < 4; ++jj) { const int kc = cs + (i & 1) * 16 + 4 * g + jj; const bool ok = (kc >= c_start) && (kc < c_start + 16);
                    const int co = min(max(kc - qcol, -15), 15) + 15;
                    S[i][jj] = ok ? S[i][jj] * scale + rb[co] : -INFINITY; } }
            else {
#pragma unroll
                for (int jj = 0; jj < 4; ++jj) S[i][jj] *= scale; }
#pragma unroll
            for (int jj = 0; jj < 4; ++jj) mx = fmaxf(mx, S[i][jj]);
        }
        mx = fmaxf(mx, __shfl_xor(mx, 16)); mx = fmaxf(mx, __shfl_xor(mx, 32));
        const float mnew = fmaxf(mrun, mx);
        const float alpha = __expf(mrun - mnew);
        mrun = mnew; lsum *= alpha;
#pragma unroll
        for (int i = 0; i < 8; ++i) { O[i][0] *= alpha; O[i][1] *= alpha; O[i][2] *= alpha; O[i][3] *= alpha; }
        bf16x8 pf[4];
#pragma unroll
        for (int c = 0; c < 4; ++c) {
            float e[8];
#pragma unroll
            for (int jj = 0; jj < 4; ++jj) { e[jj] = __expf(S[2 * c][jj] - mnew); e[4 + jj] = __expf(S[2 * c + 1][jj] - mnew); }
#pragma unroll
            for (int jj = 0; jj < 8; ++jj) lsum += e[jj];
            u32x4 u; u[0] = pack2(e[0], e[1]); u[1] = pack2(e[2], e[3]); u[2] = pack2(e[4], e[5]); u[3] = pack2(e[6], e[7]);
            pf[c] = __builtin_bit_cast(bf16x8, u);
        }
#pragma unroll
        for (int c = 0; c < 4; ++c) {
            int pos0, pos1;
            if (pass < 2) { const int krow = row_start + pass * 4 + c; pos0 = krow * 64 + cs + 4 * g; pos1 = pos0 + 16; }
            else { pos0 = 4096 + (pass - 2) * 128 + c * 32 + 4 * g; pos1 = pos0 + 16; }
#pragma unroll
            for (int dt = 0; dt < 8; ++dt) {
                const bf16_t* vp = vtb + (size_t)(dt * 16 + n16) * 4352;
                const bf16x4 v0 = *(const bf16x4*)(vp + pos0), v1 = *(const bf16x4*)(vp + pos1);
                const bf16x8 vf = __builtin_shufflevector(v0, v1, 0, 1, 2, 3, 4, 5, 6, 7);
                O[dt] = MFMA16(vf, pf[c], O[dt]);
            }
        }
    }
    lsum += __shfl_xor(lsum, 16); lsum += __shfl_xor(lsum, 32);
    const float inv = 1.0f / lsum;
    bf16_t* yo = YN + (size_t)qrow * 1024 + h * 128 + 4 * g;
#pragma unroll
    for (int dt = 0; dt < 8; ++dt) { u32x2 o; o[0] = pack2(O[dt][0] * inv, O[dt][1] * inv); o[1] = pack2(O[dt][2] * inv, O[dt][3] * inv); *(u32x2*)(yo + dt * 16) = o; }
}

__device__ void phase_mix(PP p, int l, float* lds, int which = 7) {
    const int TIDX = otid();
    for (int t = blockIdx.x; t < 208; t += gridDim.x) {
        if (t < 128) { if (which & 1) rwkv_scan(p, l, t, lds); }
        else if (which & 2) mlstm_scan(p, l, (t - 128) / 5, (t - 128) % 5, lds);
        __syncthreads();
    }
    unsigned* ctr = (unsigned*)(p->ws + OFF_CTL) + l * 8 + ((which & 8) ? 1 : 0);
    if (!(which & 4)) return;
    int* stask = (int*)lds;
    const int ntask = l == 0 ? 544 : 512;
    for (;;) {
        __syncthreads();
        if (TIDX == 0) stask[0] = (int)atomicAdd(ctr, 1u);
        __syncthreads();
        const int t = stask[0];
        if (t >= ntask) break;
        na_wave(p, l, t);
    }
}

__device__ void phase_post(PP p, int l, int nrows) {
    const int TIDX = otid();
    const int wid = TIDX >> 6, lane = TIDX & 63, gw = blockIdx.x * 8 + wid, nw = gridDim.x * 8;
    const bf16_t* P = (const bf16_t*)(p->ws + OFF_P); const bf16_t* LO = (const bf16_t*)(p->ws + OFF_LO);
    bf16_t* YM = (bf16_t*)(p->ws + OFF_Y3); bf16_t* YR = YM + (size_t)NTOK * 1024;
    const float* NUM = (const float*)(p->ws + OFF_MLNUM); const float* YF = (const float*)(p->ws + OFF_YRWF);
    for (int it = gw; it < nrows * 4; it += nw) {
        const int row = it >> 2, h = it & 3;
        const float* nf = NUM + ((size_t)row * 4 + h) * 272; const float* nb = NUM + ((size_t)(NTOK + row) * 4 + h) * 272;
        const f32x4 a = *(const f32x4*)(nf + lane * 4), c = *(const f32x4*)(nb + lane * 4);
        const float df = 1.0f / fmaxf(fabsf(nf[256]), 1.0f), db = 1.0f / fmaxf(fabsf(nb[256]), 1.0f);
        float hv[4]; float ss = 0.f;
#pragma unroll
        for (int j = 0; j < 4; ++j) { hv[j] = a[j] * df + c[j] * db; ss += hv[j] * hv[j]; }
        ss = wsum(ss);
        const float rr = rsqrtf(ss * (1.0f / 256.0f) + 1e-6f);
        const int col = h * 256 + lane * 4;
        const u32x2 ov = *(const u32x2*)(P + (size_t)row * NP + 2048 + col);
        const f32x4 ng = *(const f32x4*)(p->in[I_MLNG] + l * 1024 + col);
        const float o0 = hv[0] * rr * ng[0] * sigmoidf(bflo(ov[0])), o1 = hv[1] * rr * ng[1] * sigmoidf(bfhi(ov[0]));
        const float o2 = hv[2] * rr * ng[2] * sigmoidf(bflo(ov[1])), o3 = hv[3] * rr * ng[3] * sigmoidf(bfhi(ov[1]));
        u32x2 w; w[0] = pack2(o0, o1); w[1] = pack2(o2, o3);
        *(u32x2*)(YM + (size_t)row * 1024 + col) = w;
    }
    const float* MU = p->in[I_RWMU] + (size_t)l * 3712;
    for (int it = gw; it < nrows * 16; it += nw) {
        const int row = it >> 4, c = (it & 15) * 64 + lane;
        const float y = YF[(size_t)row * 1024 + c] + YF[(size_t)(NTOK + row) * 1024 + c];
        const float mean = wsum(y) * (1.0f / 64.0f);
        const float dy = y - mean;
        const float var = wsum(dy * dy) * (1.0f / 64.0f);
        const float yn = dy * rsqrtf(var + 64e-5f);
        bool hp, hn; seq_nbrs(row, hp, hn);
        const bf16_t* pr = P + (size_t)row * NP + RWB + c;
        const float rc = bf2f(pr[0]), kc = bf2f(pr[1024]), vc = bf2f(pr[2048]);
        const float rp = hp ? bf2f(pr[-NP]) : 0.f, kp = hp ? bf2f(pr[-NP + 1024]) : 0.f, vp = hp ? bf2f(pr[-NP + 2048]) : 0.f;
        const float rn = hn ? bf2f(pr[NP]) : 0.f, kn = hn ? bf2f(pr[NP + 1024]) : 0.f, vn = hn ? bf2f(pr[NP + 2048]) : 0.f;
        const float rr = shiftf(rc, rp, rn, MU[c]), kk = shiftf(kc, kp, kn, MU[1024 + c]), vv = shiftf(vc, vp, vn, MU[2048 + c]);
        const float bonus = wsum(rr * kk * p->in[I_RWRK][l * 1024 + c]) * vv;
        const float gg = bf2f(LO[(size_t)row * 5120 + 4096 + c]);
        const float o = (yn * p->in[I_RWLNW][l * 1024 + c] + p->in[I_RWLNB][l * 1024 + c] + bonus) * gg;
        YR[(size_t)row * 1024 + c] = f2bf(o);
    }
}

#ifndef DUPMASK
#define DUPMASK 0
#endif
#ifndef DUPWHICH
#define DUPWHICH 3
#endif
__global__ void __launch_bounds__(512, 2) fwd_kernel(Params p0) {
    extern __shared__ __attribute__((aligned(16))) unsigned char shm[];
    cg::grid_group grid = cg::this_grid();
    float* ldsf = (float*)shm;
    LAS unsigned char* ldsg = (LAS unsigned char*)shm;
    const int ph_lo = p0.ph_lo, ph_hi = p0.ph_hi;
    auto kseg = __builtin_amdgcn_kernarg_segment_ptr();
    for (int ph = ph_lo; ph < ph_hi; ++ph) {
        if (ph > ph_lo) grid.sync();
        PP p = (PP)kseg; asm volatile("" : "+s"(p));
        unsigned char* ws = p->ws;
        const float* MOD = (const float*)(ws + OFF_MOD);
        float* XL = (float*)(ws + OFF_XL);
        bf16_t* H = (bf16_t*)(ws + OFF_H);
        bf16_t* Pb = (bf16_t*)(ws + OFF_P);
        if (ph == 0) { phase_mod(p, ldsf); continue; }
        if (ph == NPHASE - 1) { phase_final(p); continue; }
        const int l = (ph - 1) / 11, sub = (ph - 1) % 11;
#if DUPMASK
        for (int rep = 0; rep < (((DUPMASK >> sub) & 1) ? 2 : 1); ++rep) { if (rep) grid.sync();
#endif
        const int Ml = l == 0 ? NTOK : NLAT;
        const float* modl = MOD + (size_t)l * 3 * 12288;
        if (sub == 1 || sub == 3 || sub == 6 || sub == 7 || sub == 9 || sub == 10) {
            pg8::Gemm g; pg8::SchedG S; pg8::EpiG E;
            S.mode = 0; S.mo.init(Ml / 256, (int)gridDim.x, (int)blockIdx.x);
            E.kind = 0; E.O = Pb; E.ldc = NP; E.P = Pb; E.ACC = (float*)(ws + OFF_YRWF);
            E.xin_lat = XL; E.xin_ctx = XL + (size_t)NLAT * 2048; E.XL = XL; E.gate = modl;
            if (sub == 1) { g = pg8::Gemm{H, (const bf16_t*)(ws + OFF_WIN), NTOK, NP, 2048}; }
            else if (sub == 3) { g = pg8::Gemm{(const bf16_t*)(ws + OFF_LA), (const bf16_t*)(ws + OFF_WLORA), NTOK, 5120, 640}; E.O = (bf16_t*)(ws + OFF_LO); E.ldc = 5120; }
            else if (sub == 6) { g = pg8::Gemm{(const bf16_t*)(ws + OFF_Y3), (const bf16_t*)(ws + OFF_WBR), Ml, 2048, 1024}; S.mode = 1; E.kind = 2; E.O = H; }
            else if (sub == 7) { g = pg8::Gemm{H, (const bf16_t*)(ws + OFF_WOUT), Ml, 2048, 2048}; E.kind = 3; E.gate = modl + 2 * 2048;
                if (l == 0) { E.xin_lat = p->in[I_X]; E.xin_ctx = p->in[I_CTX]; } }
            else if (sub == 9) { g = pg8::Gemm{H, (const bf16_t*)(ws + OFF_WFF1), Ml, DFF, 2048}; E.kind = 1; E.ldc = DFF; }
            else { g = pg8::Gemm{Pb, (const bf16_t*)(ws + OFF_WFF2), Ml, 2048, DFF}; E.kind = 3; E.gate = modl + 5 * 2048; }
            S.so.init(g.M, g.N, (int)gridDim.x, (int)blockIdx.x);
            pg8::gemm_phase(ldsg, g, S, E);
        } else
        switch (sub) {
        case 0: {
            phase_convert(p, l, ldsf);
            if (l == 0) phase_norm(p->in[I_X], p->in[I_CTX], NTOK, p->in[I_N1G] + l * 2048, modl, 0, 1, H);
            else phase_norm(XL, XL + (size_t)NLAT * 2048, NTOK, p->in[I_N1G] + l * 2048, modl, 0, 1, H);
        } break;
        case 2: phase_prep(p, l, (bf16_t*)shm); break;
#if DUPMASK
        case 4: phase_mix(p, l, ldsf, rep ? DUPWHICH : 7); break;
#else
        case 4: phase_mix(p, l, ldsf); break;
#endif
        case 5: phase_post(p, l, Ml); break;
        case 8: phase_norm(XL, XL + (size_t)NLAT * 2048, Ml, p->in[I_N2G] + l * 2048, modl, 3, 4, H); break;
        }
#if DUPMASK
        }
#endif
    }
}

extern "C" void kernel_launch(void* const* d_in, const int* in_sizes, int n_in, void* d_out, int out_size, void* d_ws, size_t ws_size, hipStream_t stream) {
    static int grid = 0;
    if (grid == 0) {
        if (n_in != 28 || ws_size < WS_END) { fprintf(stderr, "kernel_launch: need 28 inputs and %zu bytes of workspace (got %d, %zu)\n", (size_t)WS_END, n_in, ws_size); grid = -1; return; }
        if (hipFuncSetAttribute((const void*)fwd_kernel, hipFuncAttributeMaxDynamicSharedMemorySize, LDS_BYTES) != hipSuccess) { fprintf(stderr, "kernel_launch: hipFuncSetAttribute failed\n"); grid = -1; return; }
        int dev = 0, cus = 0, per_cu = 0;
        hipGetDevice(&dev);
        hipDeviceGetAttribute(&cus, hipDeviceAttributeMultiprocessorCount, dev);
        hipOccupancyMaxActiveBlocksPerMultiprocessor(&per_cu, (const void*)fwd_kernel, 512, LDS_BYTES);
        if (per_cu < 1) { fprintf(stderr, "kernel_launch: occupancy query says %d blocks per CU\n", per_cu); per_cu = 1; }
        (void)hipGetLastError();
        grid = cus * 1;
        if (grid > 256) grid = 256;
    }
    if (grid < 0) return;
    Params p{};
    for (int i = 0; i < 28; ++i) p.in[i] = (const float*)d_in[i];
    p.out = (float*)d_out; p.ws = (unsigned char*)d_ws;
#if ONE_LAUNCH
    p.ph_lo = 0; p.ph_hi = NPHASE;
    void* args[] = {&p};
    hipError_t e = hipLaunchCooperativeKernel((const void*)fwd_kernel, dim3(grid), dim3(512), args, LDS_BYTES, stream);
    if (e != hipSuccess) fprintf(stderr, "cooperative launch failed: %s (grid %d)\n", hipGetErrorString(e), grid);
#else
    for (int ph = 0; ph < NPHASE; ++ph) {
        p.ph_lo = ph; p.ph_hi = ph + 1;
        hipLaunchKernelGGL(fwd_kernel, dim3(grid), dim3(512), LDS_BYTES, stream, p);
    }
#endif
}
```

```cpp
#include <hip/hip_runtime.h>
#include <hip/hip_cooperative_groups.h>
#include <cstdio>
namespace cg = cooperative_groups;

#ifndef ONE_LAUNCH
#define ONE_LAUNCH 1
#endif

#define DEVI __device__ __forceinline__
#define LAS __attribute__((address_space(3)))
typedef unsigned short bf16_t;
typedef short bf16x8 __attribute__((ext_vector_type(8)));
typedef short bf16x4 __attribute__((ext_vector_type(4)));
typedef float f32x4 __attribute__((ext_vector_type(4)));
typedef float f32x2 __attribute__((ext_vector_type(2)));
typedef unsigned u32x4 __attribute__((ext_vector_type(4)));
typedef unsigned u32x2 __attribute__((ext_vector_type(2)));

constexpr int D = 2048, NTOK = 8704, NLAT = 8192, NP = 16128, DIN = 16016, DFF = 8192;
constexpr int RWB = 3088, NAB = 6800, GTB = 9872;
constexpr int LDS_BYTES = 131072;
constexpr int NPHASE = 24;

constexpr size_t OFF_CTL = 0;
constexpr size_t OFF_MOD = 4096;
constexpr size_t OFF_ROPE = OFF_MOD + 2ull * 3 * 12288 * 4;
constexpr size_t OFF_WIN = OFF_ROPE + 16384;
constexpr size_t OFF_WBR = OFF_WIN + 16128ull * 2048 * 2;
constexpr size_t OFF_WOUT = OFF_WBR + 3ull * 2048 * 1024 * 2;
constexpr size_t OFF_WFF1 = OFF_WOUT + 2048ull * 2048 * 2;
constexpr size_t OFF_WFF2 = OFF_WFF1 + 8192ull * 2048 * 2;
constexpr size_t OFF_WLORA = OFF_WFF2 + 8192ull * 2048 * 2;
constexpr size_t OFF_XL = OFF_WLORA + 5120ull * 640 * 2;
constexpr size_t OFF_H = OFF_XL + 8704ull * 2048 * 4;
constexpr size_t OFF_P = OFF_H + 8704ull * 2048 * 2;
constexpr size_t OFF_LA = OFF_P + 8704ull * 16128 * 2;
constexpr size_t OFF_LO = OFF_LA + 8704ull * 640 * 2;
constexpr size_t OFF_YRWF = OFF_LO + 8704ull * 5120 * 2;
constexpr size_t OFF_MLNUM = OFF_YRWF + 2ull * 8704 * 1024 * 4;
constexpr size_t OFF_VT = OFF_MLNUM + 2ull * 8704 * 4 * 272 * 4;
constexpr size_t OFF_Y3 = OFF_VT + 2ull * 8 * 128 * 4352 * 2;
constexpr size_t WS_END = OFF_Y3 + 3ull * 8704 * 1024 * 2;

struct Params {
    const float* in[28];
    float* out;
    unsigned char* ws;
    int ph_lo, ph_hi;
};
typedef const __attribute__((address_space(4))) Params* PP;
enum { I_X = 0, I_C, I_CTX, I_CCTX, I_WMOD, I_BMOD, I_N1G, I_WIN, I_MLGB, I_MLNG, I_RWMU, I_RWW0, I_RWWUP, I_RWA0, I_RWAUP, I_RWGUP,
       I_RWKK, I_RWKA, I_RWRK, I_RWLNW, I_RWLNB, I_RPB, I_WBR, I_WOUT, I_N2G, I_WFF1, I_WFF2, I_FING };

DEVI int otid() { int t; asm volatile("v_mov_b32 %0, %1" : "=v"(t) : "v"((int)threadIdx.x)); return t; }
DEVI float bf2f(bf16_t b) { return __uint_as_float(((unsigned)b) << 16); }
DEVI float bflo(unsigned u) { return __uint_as_float(u << 16); }
DEVI float bfhi(unsigned u) { return __uint_as_float(u & 0xffff0000u); }
DEVI bf16_t f2bf(float f) { unsigned u = __float_as_uint(f); u += 0x7FFFu + ((u >> 16) & 1u); return (bf16_t)(u >> 16); }
DEVI unsigned pack2(float lo, float hi) { return (unsigned)f2bf(lo) | ((unsigned)f2bf(hi) << 16); }
DEVI float sigmoidf(float x) { return 1.0f / (1.0f + __expf(-x)); }
#define DPP_ADD(x, CTRL) ((x) + __int_as_float(__builtin_amdgcn_update_dpp(0, __float_as_int(x), CTRL, 0xF, 0xF, true)))
DEVI float wsum(float x) {
    x = DPP_ADD(x, 0xB1); x = DPP_ADD(x, 0x4E); x = DPP_ADD(x, 0x141); x = DPP_ADD(x, 0x140);
    const int xi = __float_as_int(x);
    return (__int_as_float(__builtin_amdgcn_readlane(xi, 0)) + __int_as_float(__builtin_amdgcn_readlane(xi, 16))) + (__int_as_float(__builtin_amdgcn_readlane(xi, 32)) + __int_as_float(__builtin_amdgcn_readlane(xi, 48)));
}
DEVI float red8(float x) {
    x = DPP_ADD(x, 0xB1);
    x = DPP_ADD(x, 0x4E);
    x = DPP_ADD(x, 0x141);
    return x;
}

DEVI float red16(float x) {
    x = DPP_ADD(x, 0xB1); x = DPP_ADD(x, 0x4E); x = DPP_ADD(x, 0x141); x = DPP_ADD(x, 0x140);
    return x;
}
DEVI float sfma(float a, float b, float c) { float d; asm("v_fma_f32 %0, %1, %2, %3" : "=v"(d) : "v"(a), "v"(b), "v"(c)); return d; }
DEVI float smul(float a, float b) { float d; asm("v_mul_f32 %0, %1, %2" : "=v"(d) : "v"(a), "v"(b)); return d; }
DEVI float frcp(float x) { return __builtin_amdgcn_rcpf(x); }
DEVI float fsigmoid(float x) { return __builtin_amdgcn_rcpf(1.0f + __expf(-x)); }

namespace pg8 {
constexpr int BM = 256, BK = 64, HALF = 128, HTB = HALF * BK * 2, STAGE_BYTES = 8 * HTB, NXCD = 8, WGM = 8;
__host__ __device__ __forceinline__ int lds_byte(int r, int c) { const int st = (r >> 4) * 2 + (c >> 5), rr = r & 15, cc = c & 31, ob = rr * 64 + cc * 2; return st * 1024 + (ob ^ (((ob >> 9) & 1) << 5)); }
__host__ __device__ __forceinline__ void stage_rc(int b, int& R, int& C) { const int st = b / 1024, sb = b % 1024, swz = sb ^ (((sb >> 9) & 1) << 5); R = (st >> 1) * 16 + swz / 64; C = (st & 1) * 32 + (swz % 64) / 2; }
__host__ __device__ __forceinline__ int perm32(int rho) { const int n = rho >> 4, i = rho & 15; return 8 * (i >> 2) + 4 * n + (i & 3); }
struct Unit { int pm, pn; };
struct Gemm { const bf16_t* A; const bf16_t* Bt; int M, N, K; };
struct StaticOrder {
    int nM, nN, nwg, G, c;
    __device__ void init(int M, int N, int G_, int c_) { nM = M / BM; nN = N / BM; nwg = nM * nN; G = G_; c = c_; }
    __device__ bool next(int i, Unit& u) const {
        const long L = (long)i * G + c; if (L >= nwg) return false;
        int wgid = (int)L; { const int q = nwg / NXCD, r = nwg % NXCD, xcd = wgid % NXCD, off = wgid / NXCD; wgid = (xcd < r ? xcd * (q + 1) : r * (q + 1) + (xcd - r) * q) + off; }
        const int nig = WGM * nN, gid = wgid / nig, fm = gid * WGM, gsz = (nM - fm) < WGM ? (nM - fm) : WGM;
        u.pm = fm + ((wgid % nig) % gsz); u.pn = (wgid % nig) / gsz; return true;
    }
    __device__ __forceinline__ void a_ready(const Unit&) const {}
    __device__ __forceinline__ void done(const Unit&) const {}
};
struct MergeOrder {
    int ntiles, G, c;
    __device__ void init(int nM, int G_, int c_) { ntiles = nM * 8; G = G_; c = c_; }
    __device__ bool next(int i, Unit& u) const {
        const int ti = i / 3, br = i - ti * 3; const long L = (long)ti * G + c; if (L >= ntiles) return false;
        const int pm = (int)L >> 3, pn = (int)L & 7; u.pm = br * 34 + pm; u.pn = br * 8 + pn; return true;
    }
    __device__ __forceinline__ void a_ready(const Unit&) const {}
    __device__ __forceinline__ void done(const Unit&) const {}
};
DEVI unsigned cvt_pk_bf16(float lo, float hi) { unsigned r; asm volatile("v_cvt_pk_bf16_f32 %0, %1, %2" : "=v"(r) : "v"(lo), "v"(hi)); return r; }


struct SchedG {
    int mode;
    StaticOrder so; MergeOrder mo;
    __device__ __forceinline__ bool next(int i, Unit& u) const { return mode == 0 ? so.next(i, u) : mo.next(i, u); }
    __device__ __forceinline__ void a_ready(const Unit&) const {}
    __device__ __forceinline__ void done(const Unit&) const {}
};
struct EpiG {
    static constexpr bool PERM = true, AFTER_DRAIN = false;
    int kind;
    bf16_t* O; int ldc;
    const bf16_t* P; float* ACC;
    const float* xin_lat; const float* xin_ctx; float* XL; const float* gate;
    __device__ __forceinline__ void operator()(const f32x4 (&acc)[2][2][4][2], const Unit& u, int wr, int wc, int fr, int fq) const {
        if (kind <= 1) {
            const int row0 = u.pm * BM + wr * 64 + fr, col0 = u.pn * BM + wc * 32 + 8 * fq;
#pragma unroll
            for (int ai = 0; ai < 2; ++ai)
#pragma unroll
                for (int m = 0; m < 4; ++m) { bf16_t* rowp = O + (size_t)(row0 + ai * HALF + m * 16) * ldc + col0;
#pragma unroll
                    for (int bj = 0; bj < 2; ++bj) { f32x4 v0 = acc[ai][bj][m][0], v1 = acc[ai][bj][m][1];
                        if (kind == 1) {
#pragma unroll
                            for (int i = 0; i < 4; ++i) { float a = fmaxf(v0[i], 0.f), b = fmaxf(v1[i], 0.f); v0[i] = a * a; v1[i] = b * b; } }
                        u32x4 o; o[0] = cvt_pk_bf16(v0[0], v0[1]); o[1] = cvt_pk_bf16(v0[2], v0[3]); o[2] = cvt_pk_bf16(v1[0], v1[1]); o[3] = cvt_pk_bf16(v1[2], v1[3]);
                        *(u32x4*)(rowp + bj * HALF) = o; } }
        } else if (kind == 2) {
            const int br = u.pn >> 3, pn = u.pn & 7, pm = u.pm - br * 34;
            const int row0 = pm * BM + wr * 64 + fr, col0 = pn * BM + wc * 32 + 8 * fq;
#pragma unroll
            for (int ai = 0; ai < 2; ++ai)
#pragma unroll
                for (int m = 0; m < 4; ++m) { const size_t row = (size_t)(row0 + ai * HALF + m * 16);
#pragma unroll
                    for (int bj = 0; bj < 2; ++bj) { const int col = col0 + bj * HALF;
                        const u32x4 gv = *(const u32x4*)(P + row * NP + GTB + br * 2048 + col);
                        f32x4 v0 = acc[ai][bj][m][0], v1 = acc[ai][bj][m][1];
                        v0[0] *= sigmoidf(bflo(gv[0])); v0[1] *= sigmoidf(bfhi(gv[0])); v0[2] *= sigmoidf(bflo(gv[1])); v0[3] *= sigmoidf(bfhi(gv[1]));
                        v1[0] *= sigmoidf(bflo(gv[2])); v1[1] *= sigmoidf(bfhi(gv[2])); v1[2] *= sigmoidf(bflo(gv[3])); v1[3] *= sigmoidf(bfhi(gv[3]));
                        float* ap = ACC + row * 2048 + col;
                        if (br == 0) { *(f32x4*)ap = v0; *(f32x4*)(ap + 4) = v1; }
                        else { v0 += *(const f32x4*)ap; v1 += *(const f32x4*)(ap + 4);
                            if (br == 1) { *(f32x4*)ap = v0; *(f32x4*)(ap + 4) = v1; }
                            else { u32x4 o; o[0] = cvt_pk_bf16(v0[0], v0[1]); o[1] = cvt_pk_bf16(v0[2], v0[3]); o[2] = cvt_pk_bf16(v1[0], v1[1]); o[3] = cvt_pk_bf16(v1[2], v1[3]);
                                *(u32x4*)(O + row * 2048 + col) = o; } } } }
        } else {
            const int row0 = u.pm * BM + wr * 64 + fr, col0 = u.pn * BM + wc * 32 + 8 * fq;
#pragma unroll
            for (int ai = 0; ai < 2; ++ai)
#pragma unroll
                for (int m = 0; m < 4; ++m) { const int row = row0 + ai * HALF + m * 16;
                    const int mrow = row < NLAT ? (row >> 12) : 2;
                    const float* xr = row < NLAT ? xin_lat + (size_t)row * 2048 : xin_ctx + (size_t)(row - NLAT) * 2048;
                    const float* gr = gate + (size_t)mrow * 12288; float* orow = XL + (size_t)row * 2048;
#pragma unroll
                    for (int bj = 0; bj < 2; ++bj)
#pragma unroll
                        for (int n = 0; n < 2; ++n) { const int col = col0 + bj * HALF + n * 4;
                            const f32x4 g = *(const f32x4*)(gr + col), x = *(const f32x4*)(xr + col);
                            *(f32x4*)(orow + col) = x + g * acc[ai][bj][m][n]; } }
        }
    }
};
template <class Epi, class Sched>
__device__ __forceinline__ void gemm_phase(LAS unsigned char* lds, const Gemm g, const Sched& S, const Epi& E) {
    const int tid = otid(), wid = __builtin_amdgcn_readfirstlane(tid >> 6), lane = tid & 63, wr = wid >> 2, wc = wid & 3, fr = lane & 15, fq = lane >> 4;
    const int K = g.K, nt = K / BK;
    unsigned voffA[2], voffB[2];
#pragma unroll
    for (int i = 0; i < 2; ++i) { int R, C; stage_rc(tid * 16 + i * 8192, R, C); const int Rb = Epi::PERM ? ((R & ~31) + perm32(R & 31)) : R;
        voffA[i] = (unsigned)(R * K + C) * 2u; voffB[i] = (unsigned)(Rb * K + C) * 2u; }
    const size_t kstep = (size_t)(BK * 2);
    const size_t hstep = (size_t)HALF * K * 2;
    const size_t tstep = 2 * hstep;
    const unsigned ldsw = (unsigned)wid * 1024u;
    const int aoff = lds_byte(wr * 64 + fr, fq * 8), boff = lds_byte(wc * 32 + fr, fq * 8);
#define PG8_SA(b, h) (((b) * 2 + (h)) * HTB)
#define PG8_SB(b, h) ((4 + (b) * 2 + (h)) * HTB)
#define PG8_STAGE(bufoff, gbase, voff) do { _Pragma("unroll") for (int _i = 0; _i < 2; ++_i) \
        __builtin_amdgcn_global_load_lds((const unsigned*)((const char*)(gbase) + (voff)[_i]), (LAS unsigned*)(lds + (bufoff) + ldsw + _i * 8192), 16, 0, 0); } while (0)
#define PG8_LDA(dst, b, h) do { _Pragma("unroll") for (int m = 0; m < 4; ++m) _Pragma("unroll") for (int k = 0; k < 2; ++k) dst[m][k] = *(const LAS bf16x8*)(lds + PG8_SA(b, h) + aoff + m * 2048 + k * 1024); } while (0)
#define PG8_LDB(dst, b, h) do { _Pragma("unroll") for (int n = 0; n < 2; ++n) _Pragma("unroll") for (int k = 0; k < 2; ++k) dst[n][k] = *(const LAS bf16x8*)(lds + PG8_SB(b, h) + boff + n * 2048 + k * 1024); } while (0)
#define PG8_MMA(ai, bj, At, Bt) do { __builtin_amdgcn_s_setprio(1); _Pragma("unroll") for (int m = 0; m < 4; ++m) _Pragma("unroll") for (int n = 0; n < 2; ++n) _Pragma("unroll") for (int k = 0; k < 2; ++k) \
        acc[ai][bj][m][n] = __builtin_amdgcn_mfma_f32_16x16x32_bf16(Bt[n][k], At[m][k], acc[ai][bj][m][n], 0, 0, 0); __builtin_amdgcn_s_setprio(0); } while (0)
#define PG8_WAIT_V(n) asm volatile("s_waitcnt vmcnt(" #n ")" ::: "memory")
#define PG8_WAIT_L(n) asm volatile("s_waitcnt lgkmcnt(" #n ")" ::: "memory")
#define PG8_BAR __builtin_amdgcn_s_barrier()
#define PG8_SCHED __builtin_amdgcn_sched_barrier(0)
    Unit cur, nxt; int ui = 0;
    if (!S.next(0, cur)) return;
    f32x4 acc[2][2][4][2];
#pragma unroll
    for (int a = 0; a < 2; ++a)
#pragma unroll
        for (int b = 0; b < 2; ++b)
#pragma unroll
            for (int m = 0; m < 4; ++m)
#pragma unroll
                for (int n = 0; n < 2; ++n) acc[a][b][m][n] = (f32x4){0.f, 0.f, 0.f, 0.f};
    bf16x8 At[4][2], B0[2][2], B1[2][2];
    const char* cA = (const char*)g.A + (size_t)cur.pm * tstep; const char* cB = (const char*)g.Bt + (size_t)cur.pn * tstep;
    S.a_ready(cur);
    PG8_STAGE(PG8_SB(0, 0), cB, voffB); PG8_STAGE(PG8_SA(0, 0), cA, voffA); PG8_STAGE(PG8_SB(0, 1), cB + hstep, voffB); PG8_STAGE(PG8_SA(0, 1), cA + hstep, voffA);
    if (wr == 1) PG8_BAR;
    PG8_WAIT_V(4); PG8_BAR;
    PG8_STAGE(PG8_SB(1, 0), cB + kstep, voffB); PG8_STAGE(PG8_SA(1, 0), cA + kstep, voffA); PG8_STAGE(PG8_SB(1, 1), cB + hstep + kstep, voffB);
    PG8_WAIT_V(6); PG8_BAR;
    for (;;) {
        const bool has_next = S.next(ui + 1, nxt);
        const char* nA = has_next ? (const char*)g.A + (size_t)nxt.pm * tstep : cA; const char* nB = has_next ? (const char*)g.Bt + (size_t)nxt.pn * tstep : cB;
        for (int t = 0; t < nt; t += 2) {
            const bool last = (t == nt - 2);
            const char* a1 = cA + (size_t)(t + 1) * kstep;
            const char* a2 = last ? nA : cA + (size_t)(t + 2) * kstep; const char* b2 = last ? nB : cB + (size_t)(t + 2) * kstep;
            const char* a3 = a2 + kstep; const char* b3 = b2 + kstep;
            if (last && has_next) S.a_ready(nxt);
            PG8_LDB(B0, 0, 0); PG8_SCHED; PG8_LDA(At, 0, 0); PG8_STAGE(PG8_SA(1, 1), a1 + hstep, voffA);
            PG8_WAIT_L(8); PG8_BAR; PG8_WAIT_L(0); PG8_MMA(0, 0, At, B0); PG8_BAR; PG8_SCHED;
            PG8_LDB(B1, 0, 1); PG8_STAGE(PG8_SB(0, 0), b2, voffB);
            PG8_BAR; PG8_WAIT_L(0); PG8_MMA(0, 1, At, B1); PG8_BAR;
            PG8_LDA(At, 0, 1); PG8_STAGE(PG8_SA(0, 0), a2, voffA);
            PG8_BAR; PG8_WAIT_L(0); PG8_MMA(1, 0, At, B0); PG8_BAR; PG8_SCHED;
            PG8_STAGE(PG8_SB(0, 1), b2 + hstep, voffB);
            PG8_WAIT_V(6); PG8_BAR; PG8_MMA(1, 1, At, B1); PG8_BAR;
            PG8_LDB(B0, 1, 0); PG8_SCHED; PG8_LDA(At, 1, 0); PG8_STAGE(PG8_SA(0, 1), a2 + hstep, voffA);
            PG8_WAIT_L(8); PG8_BAR; PG8_WAIT_L(0); PG8_MMA(0, 0, At, B0); PG8_BAR; PG8_SCHED;
            PG8_LDB(B1, 1, 1); PG8_STAGE(PG8_SB(1, 0), b3, voffB);
            PG8_BAR; PG8_WAIT_L(0); PG8_MMA(0, 1, At, B1); PG8_BAR;
            PG8_LDA(At, 1, 1); PG8_STAGE(PG8_SA(1, 0), a3, voffA);
            PG8_BAR; PG8_WAIT_L(0); PG8_MMA(1, 0, At, B0); PG8_BAR; PG8_SCHED;
            PG8_STAGE(PG8_SB(1, 1), b3 + hstep, voffB);
            PG8_WAIT_V(6); PG8_BAR; PG8_MMA(1, 1, At, B1); PG8_BAR;
        }
        if constexpr (!Epi::AFTER_DRAIN) { E(acc, cur, wr, wc, fr, fq); S.done(cur); }
        if (!has_next) break;
#pragma unroll
        for (int a = 0; a < 2; ++a)
#pragma unroll
            for (int b = 0; b < 2; ++b)
#pragma unroll
                for (int m = 0; m < 4; ++m)
#pragma unroll
                    for (int n = 0; n < 2; ++n) acc[a][b][m][n] = (f32x4){0.f, 0.f, 0.f, 0.f};
        cur = nxt; cA = nA; cB = nB; ++ui;
    }
    PG8_WAIT_V(0);
    if (wr == 0) PG8_BAR;
    PG8_BAR;
    if constexpr (Epi::AFTER_DRAIN) { E.fused(acc, cur, wr, wc, fr, fq, lds, wid, lane); S.done(cur); }
#undef PG8_SA
#undef PG8_SB
#undef PG8_STAGE
#undef PG8_LDA
#undef PG8_LDB
#undef PG8_MMA
#undef PG8_WAIT_V
#undef PG8_WAIT_L
#undef PG8_BAR
#undef PG8_SCHED
}
}

__device__ void phase_mod(PP p, float* lds) {
    const int TIDX = otid();
    const int tid = TIDX;
    float* s = lds;
    float* red = lds + 3 * 2048;
    float* MOD = (float*)(p->ws + OFF_MOD);
    for (int i = tid; i < 3 * 2048; i += 512) { const int r = i >> 11, k = i & 2047; const float c = r < 2 ? p->in[I_C][r * 2048 + k] : p->in[I_CCTX][k]; s[i] = c * sigmoidf(c); }
    __syncthreads();
    for (int task = blockIdx.x; task < 192; task += gridDim.x) {
        const int l = task / 96, j0 = (task % 96) * 128, jc = tid & 127, kp = tid >> 7;
        const float* w = p->in[I_WMOD] + (size_t)l * 2048 * 12288 + j0 + jc;
        float a0 = 0.f, a1 = 0.f, a2 = 0.f;
#pragma unroll 8
        for (int k = kp * 512; k < kp * 512 + 512; ++k) { const float wv = w[(size_t)k * 12288]; a0 += s[k] * wv; a1 += s[2048 + k] * wv; a2 += s[4096 + k] * wv; }
        red[(kp * 3 + 0) * 128 + jc] = a0; red[(kp * 3 + 1) * 128 + jc] = a1; red[(kp * 3 + 2) * 128 + jc] = a2;
        __syncthreads();
        if (tid < 384) { const int r = tid >> 7, j = tid & 127;
            const float v = ((red[(0 * 3 + r) * 128 + j] + red[(1 * 3 + r) * 128 + j]) + (red[(2 * 3 + r) * 128 + j] + red[(3 * 3 + r) * 128 + j])) + p->in[I_BMOD][l * 12288 + j0 + j];
            MOD[(size_t)(l * 3 + r) * 12288 + j0 + j] = v; }
        __syncthreads();
    }
    if (blockIdx.x == gridDim.x - 1) {
        float* rc = (float*)(p->ws + OFF_ROPE); float* rs = rc + 2048;
        for (int i = tid; i < 2048; i += 512) { const int pos = i >> 5, j = i & 31; const float fr = powf(10000.0f, -(float)j / 32.0f); const float ang = (float)pos * fr; rc[i] = cosf(ang); rs[i] = sinf(ang); }
    }
}

__device__ void conv_tile(const float* __restrict__ src, int ld_src, int n_valid, int n0, int k0, bf16_t* __restrict__ dst, int ld_dst, float* tile) {
    const int TIDX = otid();
    const int tid = TIDX;
#pragma unroll
    for (int i = 0; i < 2; ++i) { const int kr = (tid >> 4) + i * 32, nc = (tid & 15) * 4; const float* sp = src + (size_t)(k0 + kr) * ld_src + n0 + nc;
        f32x4 v;
        if (n0 + nc + 3 < n_valid) v = *(const f32x4*)sp;
        else { v[0] = (n0 + nc + 0 < n_valid) ? sp[0] : 0.f; v[1] = (n0 + nc + 1 < n_valid) ? sp[1] : 0.f; v[2] = (n0 + nc + 2 < n_valid) ? sp[2] : 0.f; v[3] = (n0 + nc + 3 < n_valid) ? sp[3] : 0.f; }
        float* tp = tile + kr * 65 + nc; tp[0] = v[0]; tp[1] = v[1]; tp[2] = v[2]; tp[3] = v[3]; }
    __syncthreads();
    { const int n = tid >> 3, kc = (tid & 7) * 8; u32x4 o;
#pragma unroll
        for (int j = 0; j < 4; ++j) o[j] = pack2(tile[(kc + 2 * j) * 65 + n], tile[(kc + 2 * j + 1) * 65 + n]);
        *(u32x4*)(dst + (size_t)(n0 + n) * ld_dst + k0 + kc) = o; }
    __syncthreads();
}
__device__ void phase_convert(PP p, int l, float* lds) {
    const int TIDX = otid();
    for (int t = blockIdx.x; t < 18816; t += gridDim.x) {
        if (t < 8064) { const int nt = t >> 5, kt = t & 31; conv_tile(p->in[I_WIN] + (size_t)l * 2048 * DIN, DIN, DIN, nt * 64, kt * 64, (bf16_t*)(p->ws + OFF_WIN), 2048, lds); }
        else if (t < 9600) { const int tt = t - 8064, br = tt >> 9, r = tt & 511, nt = r >> 4, kt = r & 15;
            conv_tile(p->in[I_WBR] + (size_t)(l * 3 + br) * 1024 * 2048, 2048, 2048, nt * 64, kt * 64, (bf16_t*)(p->ws + OFF_WBR) + (size_t)br * 2048 * 1024, 1024, lds); }
        else if (t < 10624) { const int tt = t - 9600, nt = tt >> 5, kt = tt & 31; conv_tile(p->in[I_WOUT] + (size_t)l * 2048 * 2048, 2048, 2048, nt * 64, kt * 64, (bf16_t*)(p->ws + OFF_WOUT), 2048, lds); }
        else if (t < 14720) { const int tt = t - 10624, nt = tt >> 5, kt = tt & 31; conv_tile(p->in[I_WFF1] + (size_t)l * 2048 * 8192, 8192, 8192, nt * 64, kt * 64, (bf16_t*)(p->ws + OFF_WFF1), 2048, lds); }
        else { const int tt = t - 14720, nt = tt >> 7, kt = tt & 127; conv_tile(p->in[I_WFF2] + (size_t)l * 8192 * 2048, 2048, 2048, nt * 64, kt * 64, (bf16_t*)(p->ws + OFF_WFF2), 8192, lds); }
    }
    bf16_t* WL = (bf16_t*)(p->ws + OFF_WLORA);
    for (int idx = blockIdx.x * 512 + TIDX; idx < 5120 * 640; idx += gridDim.x * 512) {
        const int n = idx / 640, k = idx - n * 640, blk = n >> 10, nn = n & 1023;
        const int k0 = blk < 4 ? blk * 96 : 384, kw = blk < 4 ? 96 : 256;
        float v = 0.f;
        if (k >= k0 && k < k0 + kw) {
            const float* sp = blk < 2 ? p->in[I_RWWUP] + (size_t)(l * 2 + blk) * 96 * 1024 : (blk < 4 ? p->in[I_RWAUP] + (size_t)(l * 2 + blk - 2) * 96 * 1024 : p->in[I_RWGUP] + (size_t)l * 256 * 1024);
            v = sp[(size_t)(k - k0) * 1024 + nn]; }
        WL[idx] = f2bf(v);
    }
    if (blockIdx.x == 0 && TIDX < 8) ((unsigned*)(p->ws + OFF_CTL))[l * 8 + TIDX] = 0u;
}

__device__ void phase_norm(const float* __restrict__ xlat, const float* __restrict__ xctx, int nrows, const float* __restrict__ g, const float* __restrict__ modl, int ishift, int iscale, bf16_t* __restrict__ H) {
    const int TIDX = otid();
    const int wid = TIDX >> 6, lane = TIDX & 63;
    for (int row = blockIdx.x * 8 + wid; row < nrows; row += gridDim.x * 8) {
        const float* xr = row < NLAT ? xlat + (size_t)row * 2048 : xctx + (size_t)(row - NLAT) * 2048;
        const int mrow = row < NLAT ? (row >> 12) : 2;
        const float* sh = modl + (size_t)mrow * 12288 + ishift * 2048; const float* sc = modl + (size_t)mrow * 12288 + iscale * 2048;
        f32x4 v[8]; float ss = 0.f;
#pragma unroll
        for (int i = 0; i < 8; ++i) { v[i] = *(const f32x4*)(xr + (i * 64 + lane) * 4); ss += v[i][0] * v[i][0] + v[i][1] * v[i][1] + v[i][2] * v[i][2] + v[i][3] * v[i][3]; }
        ss = wsum(ss);
        const float r = rsqrtf(ss * (1.0f / 2048.0f) + 1e-6f);
#pragma unroll
        for (int i = 0; i < 8; ++i) { const int col = (i * 64 + lane) * 4; const f32x4 gg = *(const f32x4*)(g + col), s1 = *(const f32x4*)(sc + col), s0 = *(const f32x4*)(sh + col);
            float o[4];
#pragma unroll
            for (int j = 0; j < 4; ++j) o[j] = (v[i][j] * r * gg[j]) * (1.0f + s1[j]) + s0[j];
            u32x2 w; w[0] = pack2(o[0], o[1]); w[1] = pack2(o[2], o[3]);
            *(u32x2*)(H + (size_t)row * 2048 + col) = w; }
    }
}
__device__ void phase_final(PP p) {
    const int TIDX = otid();
    const int wid = TIDX >> 6, lane = TIDX & 63;
    const float* XL = (const float*)(p->ws + OFF_XL); const float* g = p->in[I_FING];
    for (int row = blockIdx.x * 8 + wid; row < NLAT; row += gridDim.x * 8) {
        const float* xr = XL + (size_t)row * 2048;
        f32x4 v[8]; float ss = 0.f;
#pragma unroll
        for (int i = 0; i < 8; ++i) { v[i] = *(const f32x4*)(xr + (i * 64 + lane) * 4); ss += v[i][0] * v[i][0] + v[i][1] * v[i][1] + v[i][2] * v[i][2] + v[i][3] * v[i][3]; }
        ss = wsum(ss);
        const float r = rsqrtf(ss * (1.0f / 2048.0f) + 1e-6f);
#pragma unroll
        for (int i = 0; i < 8; ++i) { const int col = (i * 64 + lane) * 4; const f32x4 gg = *(const f32x4*)(g + col);
            f32x4 o; o[0] = v[i][0] * r * gg[0]; o[1] = v[i][1] * r * gg[1]; o[2] = v[i][2] * r * gg[2]; o[3] = v[i][3] * r * gg[3];
            *(f32x4*)(p->out + (size_t)row * 2048 + col) = o; }
    }
}

DEVI void seq_nbrs(int row, bool& hp, bool& hn) {
    if (row < NLAT) { const int t = row & 4095; hp = t > 0; hn = t < 4095; } else { const int m = (row - NLAT) & 255; hp = m > 0; hn = m < 255; }
}
DEVI float shiftf(float c, float pv, float nx, float mu) { return c + mu * (0.5f * (pv + nx) - c); }

__device__ void phase_prep(PP p, int l, bf16_t* ldsT) {
    const int TIDX = otid();
    const bf16_t* P = (const bf16_t*)(p->ws + OFF_P); bf16_t* LA = (bf16_t*)(p->ws + OFF_LA);
    const float* mu = p->in[I_RWMU] + (size_t)l * 3712 + 3072;
    for (int idx = blockIdx.x * 512 + TIDX; idx < NTOK * 80; idx += gridDim.x * 512) {
        const int row = idx / 80, j = (idx - row * 80) * 8;
        bool hp, hn; seq_nbrs(row, hp, hn);
        const bf16_t* pc = P + (size_t)row * NP + RWB + 3072 + j;
        const u32x4 c = *(const u32x4*)pc;
        const u32x4 z = {0u, 0u, 0u, 0u};
        const u32x4 pv = hp ? *(const u32x4*)(pc - NP) : z, nx = hn ? *(const u32x4*)(pc + NP) : z;
        float o[8];
#pragma unroll
        for (int q = 0; q < 4; ++q) { o[2 * q] = shiftf(bflo(c[q]), bflo(pv[q]), bflo(nx[q]), mu[j + 2 * q]); o[2 * q + 1] = shiftf(bfhi(c[q]), bfhi(pv[q]), bfhi(nx[q]), mu[j + 2 * q + 1]); }
        if (j < 192) {
#pragma unroll
            for (int q = 0; q < 8; ++q) o[q] = tanhf(o[q]); }
        else if (j >= 384) {
#pragma unroll
            for (int q = 0; q < 8; ++q) o[q] = sigmoidf(o[q]); }
        u32x4 w; w[0] = pack2(o[0], o[1]); w[1] = pack2(o[2], o[3]); w[2] = pack2(o[4], o[5]); w[3] = pack2(o[6], o[7]);
        *(u32x4*)(LA + (size_t)row * 640 + j) = w;
    }
    bf16_t* VT = (bf16_t*)(p->ws + OFF_VT);
    const int tid = TIDX;
    for (int t = blockIdx.x; t < 136 * 16; t += gridDim.x) {
        const int rt = t >> 4, hd = t & 15, h = hd >> 1, dh = hd & 1;
        const int row0 = rt * 64;
        { const int tl = tid >> 3, dc = (tid & 7) * 8;
            const u32x4 v = *(const u32x4*)(P + (size_t)(row0 + tl) * NP + NAB + 2048 + h * 128 + dh * 64 + dc);
            bf16_t* tp = ldsT + tl * 66 + dc;
#pragma unroll
            for (int q = 0; q < 4; ++q) { tp[2 * q] = (bf16_t)(v[q] & 0xffffu); tp[2 * q + 1] = (bf16_t)(v[q] >> 16); } }
        __syncthreads();
        { const int d = tid >> 3, tc = (tid & 7) * 8;
            int b, pos; if (row0 < NLAT) { b = row0 >> 12; pos = row0 & 4095; } else { b = (row0 - NLAT) >> 8; pos = 4096 + ((row0 - NLAT) & 255); }
            u32x4 o;
#pragma unroll
            for (int q = 0; q < 4; ++q) o[q] = (unsigned)ldsT[(tc + 2 * q) * 66 + d] | ((unsigned)ldsT[(tc + 2 * q + 1) * 66 + d] << 16);
            *(u32x4*)(VT + ((size_t)((b * 8 + h) * 128 + dh * 64 + d)) * 4352 + pos + tc) = o; }
        __syncthreads();
    }
}

DEVI int scan_row(int s, int b, int dir) {
    if (s < 256) { const int m = dir ? 255 - s : s; return NLAT + b * 256 + m; }
    const int t = dir ? 4095 - (s - 256) : s - 256; return b * 4096 + t;
}
__device__ void rwkv_scan(PP p, int l, int task, float* lds) {
    const int TIDX = otid();
    const int chain = task >> 1, half = task & 1;
    const int b = chain >> 5, h = (chain >> 1) & 15, dir = chain & 1, tid = TIDX;
    const bf16_t* P = (const bf16_t*)(p->ws + OFF_P); const bf16_t* LO = (const bf16_t*)(p->ws + OFF_LO);
    float* YO = (float*)(p->ws + OFF_YRWF) + (size_t)dir * NTOK * 1024 + h * 64;
    const int sl = tid >> 5, e2 = (tid & 31) * 2, ch = h * 64 + e2;
    const float* MU = p->in[I_RWMU] + (size_t)l * 3712;
    const float mur0 = MU[ch], mur1 = MU[ch + 1], muk0 = MU[1024 + ch], muk1 = MU[1024 + ch + 1], muv0 = MU[2048 + ch], muv1 = MU[2048 + ch + 1];
    const float w00 = p->in[I_RWW0][(l * 2 + dir) * 1024 + ch], w01 = p->in[I_RWW0][(l * 2 + dir) * 1024 + ch + 1];
    const float a00 = p->in[I_RWA0][(l * 2 + dir) * 1024 + ch], a01 = p->in[I_RWA0][(l * 2 + dir) * 1024 + ch + 1];
    const float kk0 = p->in[I_RWKK][l * 1024 + ch], kk1 = p->in[I_RWKK][l * 1024 + ch + 1], ka0 = p->in[I_RWKA][l * 1024 + ch], ka1 = p->in[I_RWKA][l * 1024 + ch + 1];
    const int kq = tid & 15, v = half * 32 + (tid >> 4);
    f32x2 S0 = (f32x2){0.f, 0.f}, S1 = (f32x2){0.f, 0.f};
    unsigned rc, rp, rn, kc, kp, kn, vc, vp, vn, wr_, ar_;
    auto issue = [&](int g) {
        const int row = scan_row(g * 16 + sl, b, dir); bool hp, hn; seq_nbrs(row, hp, hn);
        const bf16_t* pr = P + (size_t)row * NP + RWB + ch;
        rc = *(const unsigned*)pr; kc = *(const unsigned*)(pr + 1024); vc = *(const unsigned*)(pr + 2048);
        rp = 0u; kp = 0u; vp = 0u; rn = 0u; kn = 0u; vn = 0u;
        if (hp) { rp = *(const unsigned*)(pr - NP); kp = *(const unsigned*)(pr - NP + 1024); vp = *(const unsigned*)(pr - NP + 2048); }
        if (hn) { rn = *(const unsigned*)(pr + NP); kn = *(const unsigned*)(pr + NP + 1024); vn = *(const unsigned*)(pr + NP + 2048); }
        const bf16_t* lo = LO + (size_t)row * 5120 + dir * 1024 + ch;
        wr_ = *(const unsigned*)lo; ar_ = *(const unsigned*)(lo + 2048);
    };
    auto commit = [&](int buf) {
        float* st = lds + buf * 6144 + sl * 384 + e2;
        const float r0 = shiftf(bflo(rc), bflo(rp), bflo(rn), mur0), r1 = shiftf(bfhi(rc), bfhi(rp), bfhi(rn), mur1);
        const float k0 = shiftf(bflo(kc), bflo(kp), bflo(kn), muk0), k1 = shiftf(bfhi(kc), bfhi(kp), bfhi(kn), muk1);
        const float v0 = shiftf(bflo(vc), bflo(vp), bflo(vn), muv0), v1 = shiftf(bfhi(vc), bfhi(vp), bfhi(vn), muv1);
        const float x0 = -(w00 + bflo(wr_)), x1 = -(w01 + bfhi(wr_));
        const float sp0 = x0 > 20.f ? x0 : __logf(1.0f + __expf(x0)), sp1 = x1 > 20.f ? x1 : __logf(1.0f + __expf(x1));
        const float d0 = __expf(-__expf(-sp0 - 0.5f)), d1 = __expf(-__expf(-sp1 - 0.5f));
        const float ar0 = fsigmoid(a00 + bflo(ar_)), ar1 = fsigmoid(a01 + bfhi(ar_));
        const float kd0 = k0 * (1.0f + (ar0 - 1.0f) * ka0), kd1 = k1 * (1.0f + (ar1 - 1.0f) * ka1);
        const float q0 = k0 * kk0, q1 = k1 * kk1;
        float ss = red16(q0 * q0 + q1 * q1);
        ss += __shfl_xor(ss, 16);
        const float inv = frcp(fmaxf(__builtin_amdgcn_sqrtf(ss), 1e-12f));
        const float n0 = q0 * inv, n1 = q1 * inv;
        *(f32x2*)(st + 0) = (f32x2){r0, r1}; *(f32x2*)(st + 64) = (f32x2){d0, d1}; *(f32x2*)(st + 128) = (f32x2){kd0, kd1};
        *(f32x2*)(st + 192) = (f32x2){v0, v1}; *(f32x2*)(st + 256) = (f32x2){-n0, -n1}; *(f32x2*)(st + 320) = (f32x2){n0 * ar0, n1 * ar1};
    };
    __syncthreads();
    issue(0); commit(0);
    __syncthreads();
    constexpr int NG = 4352 / 16;
    for (int g = 0; g < NG; ++g) {
        if (g + 1 < NG) issue(g + 1);
        {
            const float* base = lds + (g & 1) * 6144 + kq * 4;
            float ykeep = 0.f;
            f32x4 nA, nD, nB, nK, nR; float nV;
#define RW_LOAD(i_) do { const float* st_ = base + (i_) * 384; nA = *(const f32x4*)(st_ + 256); nD = *(const f32x4*)(st_ + 64); nB = *(const f32x4*)(st_ + 320); nK = *(const f32x4*)(st_ + 128); nR = *(const f32x4*)(st_); \
                nV = st_[192 - kq * 4 + v]; } while (0)
            RW_LOAD(0);
#pragma unroll
            for (int i = 0; i < 16; ++i) {
                const f32x4 a = nA, d = nD, bb = nB, k = nK, r = nR; const float vv = nV;
                if (i < 15) { RW_LOAD(i + 1); }
                __builtin_amdgcn_sched_barrier(0x77);
                f32x2 pa2 = S0 * (f32x2){a[0], a[1]}; pa2 = S1 * (f32x2){a[2], a[3]} + pa2;
                const f32x2 vvb = (f32x2){vv, vv};
                const f32x2 u0 = S0 * (f32x2){d[0], d[1]} + vvb * (f32x2){k[0], k[1]}, u1 = S1 * (f32x2){d[2], d[3]} + vvb * (f32x2){k[2], k[3]};
                const float pa = red16(pa2[0] + pa2[1]);
                const f32x2 pab = (f32x2){pa, pa};
                S0 = pab * (f32x2){bb[0], bb[1]} + u0; S1 = pab * (f32x2){bb[2], bb[3]} + u1;
                f32x2 y2 = S0 * (f32x2){r[0], r[1]}; y2 = S1 * (f32x2){r[2], r[3]} + y2;
                const float y = red16(y2[0] + y2[1]);
                ykeep = (kq == i) ? y : ykeep;
            }
#undef RW_LOAD
            YO[(size_t)scan_row(g * 16 + kq, b, dir) * 1024 + v] = ykeep;
        }
        if (g + 1 < NG) commit((g + 1) & 1);
        __syncthreads();
    }
}

__device__ void mlstm_scan(PP p, int l, int chain, int g8, float* lds) {
    const int TIDX = otid();
    const int b = chain >> 3, h = (chain >> 1) & 3, dir = chain & 1, tid = TIDX;
    const bf16_t* P = (const bf16_t*)(p->ws + OFF_P);
    const float* RC = (const float*)(p->ws + OFF_ROPE); const float* RS = RC + 2048;
    float* NO = (float*)(p->ws + OFF_MLNUM) + (size_t)dir * NTOK * 4 * 272 + h * 272;
    const int sl = tid >> 5, j = tid & 31;
    const float gbi = p->in[I_MLGB][l * 16 + (dir * 2 + 0) * 4 + h], gbf = p->in[I_MLGB][l * 16 + (dir * 2 + 1) * 4 + h];
    const int rowl = (tid >> 3) & 31, kq = tid & 7, crow = g8 * 32 + rowl, lane = tid & 63;
    f32x2 C[8];
#pragma unroll
    for (int i = 0; i < 8; ++i) C[i] = (f32x2){0.f, 0.f};
    f32x2 nst = (f32x2){0.f, 0.f};
    bf16_t q0, q1, q2, q3, k0, k1, k2, k3, gi, gf; unsigned vv2; float cr, sr, cc, sc;
    auto issue = [&](int g) {
        const int row = scan_row(g * 16 + sl, b, dir);
        const bf16_t* pr = P + (size_t)row * NP;
        const bf16_t* pq = pr + h * 128 + j; const bf16_t* pk = pr + 512 + h * 128 + j;
        q0 = pq[0]; q1 = pq[32]; q2 = pq[64]; q3 = pq[96]; k0 = pk[0]; k1 = pk[32]; k2 = pk[64]; k3 = pk[96];
        vv2 = j < 16 ? *(const unsigned*)(pr + 1024 + h * 256 + g8 * 32 + 2 * j) : 0u;
        gi = pr[3072 + (dir * 2 + 0) * 4 + h]; gf = pr[3072 + (dir * 2 + 1) * 4 + h];
        if (row < NLAT) { const int t = row & 4095, pr_ = t >> 6, pc_ = t & 63; cr = RC[pr_ * 32 + j]; sr = RS[pr_ * 32 + j]; cc = RC[pc_ * 32 + j]; sc = RS[pc_ * 32 + j]; }
        else { cr = 1.f; sr = 0.f; cc = 1.f; sc = 0.f; }
    };
    auto commit = [&](int buf) {
        float* st = lds + buf * 5376 + sl * 336;
        const float scale = 0.08838834764831845f;
        const float a0 = bf2f(q0), a1 = bf2f(q1), a2 = bf2f(q2), a3 = bf2f(q3);
        st[j] = (a0 * cr - a1 * sr) * scale; st[32 + j] = (a0 * sr + a1 * cr) * scale; st[64 + j] = (a2 * cc - a3 * sc) * scale; st[96 + j] = (a2 * sc + a3 * cc) * scale;
        const float c0 = bf2f(k0), c1 = bf2f(k1), c2 = bf2f(k2), c3 = bf2f(k3);
        st[128 + j] = c0 * cr - c1 * sr; st[160 + j] = c0 * sr + c1 * cr; st[192 + j] = c2 * cc - c3 * sc; st[224 + j] = c2 * sc + c3 * cc;
        if (j < 16) { st[256 + 2 * j] = bflo(vv2); st[257 + 2 * j] = bfhi(vv2); }
        if (j == 0) { st[320] = fsigmoid(bf2f(gf) + gbf); st[321] = __expf(bf2f(gi) + gbi); }
    };
    __syncthreads();
    issue(0); commit(0);
    __syncthreads();
    constexpr int NG = 4352 / 16;
    for (int g = 0; g < NG; ++g) {
        if (g + 1 < NG) issue(g + 1);
        const float* base = lds + (g & 1) * 5376;
        if (tid < 256) {
            float nkeep = 0.f;
            f32x4 nK[4], nQ[4]; float nF, nI, nV0;
#define ML_LOAD(i_) do { const float* st_ = base + (i_) * 336; _Pragma("unroll") for (int c4 = 0; c4 < 4; ++c4) { nK[c4] = *(const f32x4*)(st_ + 128 + c4 * 32 + kq * 4); nQ[c4] = *(const f32x4*)(st_ + c4 * 32 + kq * 4); } \
                nF = st_[320]; nI = st_[321]; nV0 = st_[256 + rowl]; } while (0)
            ML_LOAD(0);
#pragma unroll
            for (int i = 0; i < 16; ++i) {
                f32x4 kk[4], qq[4];
#pragma unroll
                for (int c4 = 0; c4 < 4; ++c4) { kk[c4] = nK[c4]; qq[c4] = nQ[c4]; }
                const float f = nF, coef = nI * nV0;
                if (i < 15) { ML_LOAD(i + 1); }
                __builtin_amdgcn_sched_barrier(0x77);
                const f32x2 cf = (f32x2){coef, coef}, ff = (f32x2){f, f};
                f32x2 num2 = (f32x2){0.f, 0.f}, num3 = (f32x2){0.f, 0.f};
#pragma unroll
                for (int c4 = 0; c4 < 4; ++c4) {
                    const f32x2 KA = (f32x2){kk[c4][0], kk[c4][1]}, KB = (f32x2){kk[c4][2], kk[c4][3]}, QA = (f32x2){qq[c4][0], qq[c4][1]}, QB = (f32x2){qq[c4][2], qq[c4][3]};
                    C[2 * c4] = ff * C[2 * c4] + cf * KA; C[2 * c4 + 1] = ff * C[2 * c4 + 1] + cf * KB;
                    num2 = C[2 * c4] * QA + num2; num3 = C[2 * c4 + 1] * QB + num3; }
                num2 += num3;
                const float num = red8(num2[0] + num2[1]);
                nkeep = (kq == (i & 7)) ? num : nkeep;
                if ((i & 7) == 7) NO[(size_t)scan_row(g * 16 + (i - 7) + kq, b, dir) * (4 * 272) + crow] = nkeep;
            }
#undef ML_LOAD
        } else if (g8 == 0 && tid < 320) {
            float nkeep = 0.f;
#pragma unroll
            for (int i = 0; i < 16; ++i) {
                const float* st = base + i * 336;
                const f32x2 kk = *(const f32x2*)(st + 128 + 2 * lane), qq = *(const f32x2*)(st + 2 * lane);
                const float f = st[320], ig = st[321];
                nst = (f32x2){f, f} * nst + (f32x2){ig, ig} * kk;
                const f32x2 d2 = nst * qq;
                const float den = wsum(d2[0] + d2[1]);
                nkeep = (lane == i) ? den : nkeep;
            }
            if (lane < 16) NO[(size_t)scan_row(g * 16 + lane, b, dir) * (4 * 272) + 256] = nkeep;
        }
        if (g + 1 < NG) commit((g + 1) & 1);
        __syncthreads();
    }
}

#define MFMA16(a, b, c) __builtin_amdgcn_mfma_f32_16x16x32_bf16(a, b, c, 0, 0, 0)
__device__ void na_wave(PP p, int l, int task) {
    const int TIDX = otid();
    const bf16_t* P = (const bf16_t*)(p->ws + OFF_P); const bf16_t* VT = (const bf16_t*)(p->ws + OFF_VT);
    bf16_t* YN = (bf16_t*)(p->ws + OFF_Y3) + 2ull * NTOK * 1024;
    const int w = TIDX >> 6, lane = TIDX & 63, n16 = lane & 15, g = lane >> 4;
    int b, h, qrow, r = 0, qcol = 0, cs = 0, row_start = 0, c_start = 0; bool lat;
    if (task < 512) { lat = true; b = task >> 8; h = (task >> 5) & 7; const int pair = task & 31; r = pair * 2 + (w >> 2); const int qi = w & 3; qcol = qi * 16 + n16;
        qrow = b * 4096 + r * 64 + qcol; cs = qi == 0 ? 0 : (qi == 1 ? 8 : (qi == 2 ? 24 : 32)); row_start = min(max(r - 4, 0), 56); c_start = min(max(qcol - 8, 0), 48); }
    else { lat = false; const int t2 = task - 512; b = t2 >> 4; h = (t2 >> 1) & 7; const int chunk = t2 & 1; qrow = NLAT + b * 256 + chunk * 128 + w * 16 + n16; }
    bf16x8 qf[4];
#pragma unroll
    for (int c = 0; c < 4; ++c) qf[c] = *(const bf16x8*)(P + (size_t)qrow * NP + NAB + h * 128 + c * 32 + g * 8);
    const float* rpb = p->in[I_RPB] + (size_t)(l * 8 + h) * 15 * 31;
    const bf16_t* vtb = VT + (size_t)((b * 8 + h) * 128) * 4352;
    f32x4 O[8];
#pragma unroll
    for (int i = 0; i < 8; ++i) O[i] = (f32x4){0.f, 0.f, 0.f, 0.f};
    float mrun = -INFINITY, lsum = 0.f;
    const float scale = 0.08838834764831845f;
    for (int pass = lat ? 0 : 2; pass < 4; ++pass) {
        f32x4 S[8];
#pragma unroll
        for (int i = 0; i < 8; ++i) {
            int krowtok;
            if (pass < 2) { const int krow = row_start + pass * 4 + (i >> 1); krowtok = b * 4096 + krow * 64 + cs + (i & 1) * 16 + n16; }
            else krowtok = NLAT + b * 256 + (pass - 2) * 128 + i * 16 + n16;
            const bf16_t* kp = P + (size_t)krowtok * NP + NAB + 1024 + h * 128 + g * 8;
            f32x4 acc = (f32x4){0.f, 0.f, 0.f, 0.f};
#pragma unroll
            for (int c = 0; c < 4; ++c) { const bf16x8 kf = *(const bf16x8*)(kp + c * 32); acc = MFMA16(kf, qf[c], acc); }
            S[i] = acc;
        }
        float mx = -INFINITY;
#pragma unroll
        for (int i = 0; i < 8; ++i) {
            if (pass < 2) { const int krow = row_start + pass * 4 + (i >> 1); const float* rb = rpb + (krow - r + 7) * 31;
#pragma unroll
                for (int jj = 0; jj < 4; ++jj) { const int kc = cs + (i & 1) * 16 + 4 * g + jj; const bool ok = (kc >= c_start) && (kc < c_start + 16);
                    const int co = min(max(kc - qcol, -15), 15) + 15;
                    S[i][jj] = ok ? S[i][jj] * scale + rb[co] : -INFINITY; } }
            else {
#pragma unroll
                for (int jj = 0; jj < 4; ++jj) S[i][jj] *= scale; }
#pragma unroll
            for (int jj = 0; jj < 4; ++jj) mx = fmaxf(mx, S[i][jj]);
        }
        mx = fmaxf(mx, __shfl_xor(mx, 16)); mx = fmaxf(mx, __shfl_xor(mx, 32));
        const float mnew = fmaxf(mrun, mx);
        const float alpha = __expf(mrun - mnew);
        mrun = mnew; lsum *= alpha;
#pragma unroll
        for (int i = 0; i < 8; ++i) { O[i][0] *= alpha; O[i][1] *= alpha; O[i][2] *= alpha; O[i][3] *= alpha; }
        bf16x8 pf[4];
#pragma unroll
        for (int c = 0; c < 4; ++c) {
            float e[8];
#pragma unroll
            for (int jj = 0; jj < 4; ++jj) { e[jj] = __expf(S[2 * c][jj] - mnew); e[4 + jj] = __expf(S[2 * c + 1][jj] - mnew); }
#pragma unroll
            for (int jj = 0; jj < 8; ++jj) lsum += e[jj];
            u32x4 u; u[0] = pack2(e[0], e[1]); u[1] = pack2(e[2], e[3]); u[2] = pack2(e[4], e[5]); u[3] = pack2(e[6], e[7]);
            pf[c] = __builtin_bit_cast(bf16x8, u);
        }
#pragma unroll
        for (int c = 0; c < 4; ++c) {
            int pos0, pos1;
            if (pass < 2) { const int krow = row_start + pass * 4 + c; pos0 = krow * 64 + cs + 4 * g; pos1 = pos0 + 16; }
            else { pos0 = 4096 + (pass - 2) * 128 + c * 32 + 4 * g; pos1 = pos0 + 16; }
#pragma unroll
            for (int dt = 0; dt < 8; ++dt) {
                const bf16_t* vp = vtb + (size_t)(dt * 16 + n16) * 4352;
                const bf16x4 v0 = *(const bf16x4*)(vp + pos0), v1 = *(const bf16x4*)(vp + pos1);
                const bf16x8 vf = __builtin_shufflevector(v0, v1, 0, 1, 2, 3, 4, 5, 6, 7);
                O[dt] = MFMA16(vf, pf[c], O[dt]);
            }
        }
    }
    lsum += __shfl_xor(lsum, 16); lsum += __shfl_xor(lsum, 32);
    const float inv = 1.0f / lsum;
    bf16_t* yo = YN + (size_t)qrow * 1024 + h * 128 + 4 * g;
#pragma unroll
    for (int dt = 0; dt < 8; ++dt) { u32x2 o; o[0] = pack2(O[dt][0] * inv, O[dt][1] * inv); o[1] = pack2(O[dt][2] * inv, O[dt][3] * inv); *(u32x2*)(yo + dt * 16) = o; }
}

__device__ void na_block(PP p, int l, int task, unsigned char* lds) {
    const int TIDX = otid();
    const bf16_t* P = (const bf16_t*)(p->ws + OFF_P); const bf16_t* VT = (const bf16_t*)(p->ws + OFF_VT);
    bf16_t* YN = (bf16_t*)(p->ws + OFF_Y3) + 2ull * NTOK * 1024;
    const int tid = TIDX, w = tid >> 6, lane = tid & 63, n16 = lane & 15, g = lane >> 4, qi = w & 3, kh = w >> 2;
    const int b = task >> 9, h = (task >> 6) & 7, r = task & 63;
    const int qcol = qi * 16 + n16, qrow = b * 4096 + r * 64 + qcol;
    const int cs = qi == 0 ? 0 : (qi == 1 ? 8 : (qi == 2 ? 24 : 32)), row_start = min(max(r - 4, 0), 56), c_start = min(max(qcol - 8, 0), 48);
    unsigned char* KT = lds; unsigned char* VL = lds + 65536;
    bf16x8 qf[4];
#pragma unroll
    for (int c = 0; c < 4; ++c) qf[c] = *(const bf16x8*)(P + (size_t)qrow * NP + NAB + h * 128 + c * 32 + g * 8);
    const float* rpb = p->in[I_RPB] + (size_t)(l * 8 + h) * 15 * 31;
    const bf16_t* vtb = VT + (size_t)((b * 8 + h) * 128) * 4352;
    const bf16_t* kgb = P + NAB + 1024 + h * 128;
    f32x4 O[8];
#pragma unroll
    for (int i = 0; i < 8; ++i) O[i] = (f32x4){0.f, 0.f, 0.f, 0.f};
    float mrun = -INFINITY, lsum = 0.f;
    const float scale = 0.08838834764831845f;
    u32x4 kreg[8], vreg[8];
    auto gload = [&](int pass) {
#pragma unroll
        for (int i = 0; i < 8; ++i) { const int key = i * 32 + (tid >> 4), c16 = tid & 15, s_ = key >> 6, kk = key & 63;
            if (pass < 2) { const int krow = row_start + (s_ < 2 ? 2 * pass + s_ : 2 + 2 * pass + s_);
                kreg[i] = *(const u32x4*)(kgb + (size_t)(b * 4096 + krow * 64 + kk) * NP + c16 * 8); }
            else if (i < 4) { const int m = (s_ == 0 ? 0 : 128) + 64 * (pass - 2) + kk;
                kreg[i] = *(const u32x4*)(kgb + (size_t)(NLAT + b * 256 + m) * NP + c16 * 8); } }
#pragma unroll
        for (int i = 0; i < 8; ++i) { const int d = i * 16 + (tid >> 5), key8 = (tid & 31) * 8, s_ = key8 >> 6, kk = key8 & 63;
            if (pass < 2) { const int krow = row_start + (s_ < 2 ? 2 * pass + s_ : 2 + 2 * pass + s_);
                vreg[i] = *(const u32x4*)(vtb + (size_t)d * 4352 + krow * 64 + kk); }
            else if (key8 < 128) { const int m = (s_ == 0 ? 0 : 128) + 64 * (pass - 2) + kk;
                vreg[i] = *(const u32x4*)(vtb + (size_t)d * 4352 + 4096 + m); } }
    };
    auto lstore = [&](int pass) {
#pragma unroll
        for (int i = 0; i < 8; ++i) { const int key = i * 32 + (tid >> 4), c16 = tid & 15;
            if (pass < 2 || i < 4) *(u32x4*)(KT + key * 256 + ((c16 ^ (key & 15)) * 16)) = kreg[i]; }
#pragma unroll
        for (int i = 0; i < 8; ++i) { const int d = i * 16 + (tid >> 5), kc16 = tid & 31;
            if (pass < 2 || kc16 < 16) *(u32x4*)(VL + d * 512 + ((kc16 ^ (d & 15)) * 16)) = vreg[i]; }
    };
    gload(0);
    for (int pass = 0; pass < 4; ++pass) {
        __syncthreads();
        lstore(pass);
        __syncthreads();
        if (pass < 3) gload(pass + 1);
        f32x4 S[4];
#pragma unroll
        for (int i = 0; i < 4; ++i) {
            const int keyl = pass < 2 ? (kh * 2 + (i >> 1)) * 64 + cs + (i & 1) * 16 + n16 : kh * 64 + i * 16 + n16;
            const unsigned char* kp = KT + keyl * 256;
            f32x4 acc = (f32x4){0.f, 0.f, 0.f, 0.f};
#pragma unroll
            for (int c = 0; c < 4; ++c) { const bf16x8 kf = *(const bf16x8*)(kp + (((c * 4 + g) ^ (keyl & 15)) * 16)); acc = MFMA16(kf, qf[c], acc); }
            S[i] = acc;
        }
        float mx = -INFINITY;
#pragma unroll
        for (int i = 0; i < 4; ++i) {
            if (pass < 2) { const int krow = row_start + kh * 4 + 2 * pass + (i >> 1); const float* rb = rpb + (krow - r + 7) * 31;
#pragma unroll
                for (int jj = 0; jj < 4; ++jj) { const int kc = cs + (i & 1) * 16 + 4 * g + jj; const bool ok = (kc >= c_start) && (kc < c_start + 16);
                    const int co = min(max(kc - qcol, -15), 15) + 15;
                    S[i][jj] = ok ? S[i][jj] * scale + rb[co] : -INFINITY; } }
            else {
#pragma unroll
                for (int jj = 0; jj < 4; ++jj) S[i][jj] *= scale; }
#pragma unroll
            for (int jj = 0; jj < 4; ++jj) mx = fmaxf(mx, S[i][jj]);
        }
        mx = fmaxf(mx, __shfl_xor(mx, 16)); mx = fmaxf(mx, __shfl_xor(mx, 32));
        const float mnew = fmaxf(mrun, mx);
        const float alpha = __expf(mrun - mnew);
        mrun = mnew; lsum *= alpha;
#pragma unroll
        for (int i = 0; i < 8; ++i) { O[i][0] *= alpha; O[i][1] *= alpha; O[i][2] *= alpha; O[i][3] *= alpha; }
#pragma unroll
        for (int c = 0; c < 2; ++c) {
            float e[8];
#pragma unroll
            for (int jj = 0; jj < 4; ++jj) { e[jj] = __expf(S[2 * c][jj] - mnew); e[4 + jj] = __expf(S[2 * c + 1][jj] - mnew); }
#pragma unroll
            for (int jj = 0; jj < 8; ++jj) lsum += e[jj];
            u32x4 u; u[0] = pack2(e[0], e[1]); u[1] = pack2(e[2], e[3]); u[2] = pack2(e[4], e[5]); u[3] = pack2(e[6], e[7]);
            const bf16x8 pf = __builtin_bit_cast(bf16x8, u);
            const int key0 = pass < 2 ? (kh * 2 + c) * 64 + cs + 4 * g : kh * 64 + c * 32 + 4 * g;
            const int kc8a = key0 >> 2, kc8b = kc8a + 4;
#pragma unroll
            for (int dt = 0; dt < 8; ++dt) { const int d = dt * 16 + n16; const unsigned char* vp = VL + d * 512;
                const bf16x4 v0 = *(const bf16x4*)(vp + (((kc8a >> 1) ^ (d & 15)) * 16) + (kc8a & 1) * 8), v1 = *(const bf16x4*)(vp + (((kc8b >> 1) ^ (d & 15)) * 16) + (kc8b & 1) * 8);
                const bf16x8 vf = __builtin_shufflevector(v0, v1, 0, 1, 2, 3, 4, 5, 6, 7);
                O[dt] = MFMA16(vf, pf, O[dt]); }
        }
    }
    lsum += __shfl_xor(lsum, 16); lsum += __shfl_xor(lsum, 32);
    __syncthreads();
    float* cmb = (float*)lds + (size_t)qi * 34 * 64 + lane;
    if (kh == 1) { cmb[0] = mrun; cmb[64] = lsum;
#pragma unroll
        for (int dt = 0; dt < 8; ++dt)
#pragma unroll
            for (int jj = 0; jj < 4; ++jj) cmb[(2 + dt * 4 + jj) * 64] = O[dt][jj]; }
    __syncthreads();
    if (kh == 0) { const float m1 = cmb[0], l1 = cmb[64];
        const float mn = fmaxf(mrun, m1), a0 = __expf(mrun - mn), a1 = __expf(m1 - mn);
        const float inv = 1.0f / (lsum * a0 + l1 * a1);
        bf16_t* yo = YN + (size_t)qrow * 1024 + h * 128 + 4 * g;
#pragma unroll
        for (int dt = 0; dt < 8; ++dt) { float o[4];
#pragma unroll
            for (int jj = 0; jj < 4; ++jj) o[jj] = (O[dt][jj] * a0 + cmb[(2 + dt * 4 + jj) * 64] * a1) * inv;
            u32x2 ov; ov[0] = pack2(o[0], o[1]); ov[1] = pack2(o[2], o[3]); *(u32x2*)(yo + dt * 16) = ov; } }
}

__device__ void phase_mix(PP p, int l, float* lds, int which = 7) {
    const int TIDX = otid();
    for (int t = blockIdx.x; t < 256; t += gridDim.x) {
        if (t < 128) { if (which & 1) rwkv_scan(p, l, t, lds); }
        else if (which & 2) mlstm_scan(p, l, (t - 128) >> 3, (t - 128) & 7, lds);
        __syncthreads();
    }
    unsigned* ctr = (unsigned*)(p->ws + OFF_CTL) + l * 8 + ((which & 8) ? 1 : 0);
    if (!(which & 4)) return;
    int* stask = (int*)lds;
    const int ntask = l == 0 ? 1056 : 1024;
    for (;;) {
        __syncthreads();
        if (TIDX == 0) stask[0] = (int)atomicAdd(ctr, 1u);
        __syncthreads();
        const int t = stask[0];
        if (t >= ntask) break;
        if (t < 1024) na_block(p, l, t, (unsigned char*)lds); else na_wave(p, l, t - 512);
    }
}

__device__ void phase_post(PP p, int l, int nrows) {
    const int TIDX = otid();
    const int wid = TIDX >> 6, lane = TIDX & 63, gw = blockIdx.x * 8 + wid, nw = gridDim.x * 8;
    const bf16_t* P = (const bf16_t*)(p->ws + OFF_P); const bf16_t* LO = (const bf16_t*)(p->ws + OFF_LO);
    bf16_t* YM = (bf16_t*)(p->ws + OFF_Y3); bf16_t* YR = YM + (size_t)NTOK * 1024;
    const float* NUM = (const float*)(p->ws + OFF_MLNUM); const float* YF = (const float*)(p->ws + OFF_YRWF);
    for (int row = gw; row < nrows; row += nw) {
        f32x4 a[4], c[4], ng[4]; float dfr[4], dbr[4]; u32x2 ov[4];
#pragma unroll
        for (int h = 0; h < 4; ++h) {
            const float* nf = NUM + ((size_t)row * 4 + h) * 272; const float* nb = NUM + ((size_t)(NTOK + row) * 4 + h) * 272;
            a[h] = *(const f32x4*)(nf + lane * 4); c[h] = *(const f32x4*)(nb + lane * 4); dfr[h] = nf[256]; dbr[h] = nb[256];
            ov[h] = *(const u32x2*)(P + (size_t)row * NP + 2048 + h * 256 + lane * 4);
            ng[h] = *(const f32x4*)(p->in[I_MLNG] + l * 1024 + h * 256 + lane * 4); }
#pragma unroll
        for (int h = 0; h < 4; ++h) {
            const float df = 1.0f / fmaxf(fabsf(dfr[h]), 1.0f), db = 1.0f / fmaxf(fabsf(dbr[h]), 1.0f);
            float hv[4]; float ss = 0.f;
#pragma unroll
            for (int j = 0; j < 4; ++j) { hv[j] = a[h][j] * df + c[h][j] * db; ss += hv[j] * hv[j]; }
            ss = wsum(ss);
            const float rr = rsqrtf(ss * (1.0f / 256.0f) + 1e-6f);
            const float o0 = hv[0] * rr * ng[h][0] * sigmoidf(bflo(ov[h][0])), o1 = hv[1] * rr * ng[h][1] * sigmoidf(bfhi(ov[h][0]));
            const float o2 = hv[2] * rr * ng[h][2] * sigmoidf(bflo(ov[h][1])), o3 = hv[3] * rr * ng[h][3] * sigmoidf(bfhi(ov[h][1]));
            u32x2 w; w[0] = pack2(o0, o1); w[1] = pack2(o2, o3);
            *(u32x2*)(YM + (size_t)row * 1024 + h * 256 + lane * 4) = w; }
    }
    const float* MU = p->in[I_RWMU] + (size_t)l * 3712;
    for (int it = gw; it < nrows * 4; it += nw) {
        const int row = it >> 2, hq = (it & 3) * 4;
        bool hp, hn; seq_nbrs(row, hp, hn);
        float y0[4], y1[4], gg[4]; bf16_t rc[4], kc[4], vc[4], rp[4], kp[4], vp[4], rn[4], kn[4], vn[4];
#pragma unroll
        for (int u = 0; u < 4; ++u) { const int c = (hq + u) * 64 + lane;
            y0[u] = YF[(size_t)row * 1024 + c]; y1[u] = YF[(size_t)(NTOK + row) * 1024 + c];
            const bf16_t* pr = P + (size_t)row * NP + RWB + c;
            rc[u] = pr[0]; kc[u] = pr[1024]; vc[u] = pr[2048];
            rp[u] = hp ? pr[-NP] : (bf16_t)0; kp[u] = hp ? pr[-NP + 1024] : (bf16_t)0; vp[u] = hp ? pr[-NP + 2048] : (bf16_t)0;
            rn[u] = hn ? pr[NP] : (bf16_t)0; kn[u] = hn ? pr[NP + 1024] : (bf16_t)0; vn[u] = hn ? pr[NP + 2048] : (bf16_t)0;
            gg[u] = bf2f(LO[(size_t)row * 5120 + 4096 + c]); }
#pragma unroll
        for (int u = 0; u < 4; ++u) { const int c = (hq + u) * 64 + lane;
            const float y = y0[u] + y1[u];
            const float mean = wsum(y) * (1.0f / 64.0f);
            const float dy = y - mean;
            const float var = wsum(dy * dy) * (1.0f / 64.0f);
            const float yn = dy * rsqrtf(var + 64e-5f);
            const float rr = shiftf(bf2f(rc[u]), bf2f(rp[u]), bf2f(rn[u]), MU[c]), kk = shiftf(bf2f(kc[u]), bf2f(kp[u]), bf2f(kn[u]), MU[1024 + c]), vv = shiftf(bf2f(vc[u]), bf2f(vp[u]), bf2f(vn[u]), MU[2048 + c]);
            const float bonus = wsum(rr * kk * p->in[I_RWRK][l * 1024 + c]) * vv;
            const float o = (yn * p->in[I_RWLNW][l * 1024 + c] + p->in[I_RWLNB][l * 1024 + c] + bonus) * gg[u];
            YR[(size_t)row * 1024 + c] = f2bf(o); }
    }
}


#ifndef DUPMASK
#define DUPMASK 0
#endif
#ifndef DUPWHICH
#define DUPWHICH 3
#endif
__global__ void __launch_bounds__(512, 2) fwd_kernel(Params p0) {
    extern __shared__ __attribute__((aligned(16))) unsigned char shm[];
    cg::grid_group grid = cg::this_grid();
    float* ldsf = (float*)shm;
    LAS unsigned char* ldsg = (LAS unsigned char*)shm;
    const int ph_lo = p0.ph_lo, ph_hi = p0.ph_hi;
    auto kseg = __builtin_amdgcn_kernarg_segment_ptr();
    for (int ph = ph_lo; ph < ph_hi; ++ph) {
        if (ph > ph_lo) grid.sync();
        PP p = (PP)kseg; asm volatile("" : "+s"(p));
        unsigned char* ws = p->ws;
        const float* MOD = (const float*)(ws + OFF_MOD);
        float* XL = (float*)(ws + OFF_XL);
        bf16_t* H = (bf16_t*)(ws + OFF_H);
        bf16_t* Pb = (bf16_t*)(ws + OFF_P);
        if (ph == 0) { phase_mod(p, ldsf); continue; }
        if (ph == NPHASE - 1) { phase_final(p); continue; }
        const int l = (ph - 1) / 11, sub = (ph - 1) % 11;
#if DUPMASK
        for (int rep = 0; rep < (((DUPMASK >> sub) & 1) ? 2 : 1); ++rep) { if (rep) grid.sync();
#endif
        const int Ml = l == 0 ? NTOK : NLAT;
        const float* modl = MOD + (size_t)l * 3 * 12288;
        if (sub == 1 || sub == 3 || sub == 6 || sub == 7 || sub == 9 || sub == 10) {
            pg8::Gemm g; pg8::SchedG S; pg8::EpiG E;
            S.mode = 0; S.mo.init(Ml / 256, (int)gridDim.x, (int)blockIdx.x);
            E.kind = 0; E.O = Pb; E.ldc = NP; E.P = Pb; E.ACC = (float*)(ws + OFF_YRWF);
            E.xin_lat = XL; E.xin_ctx = XL + (size_t)NLAT * 2048; E.XL = XL; E.gate = modl;
            if (sub == 1) { g = pg8::Gemm{H, (const bf16_t*)(ws + OFF_WIN), NTOK, NP, 2048}; }
            else if (sub == 3) { g = pg8::Gemm{(const bf16_t*)(ws + OFF_LA), (const bf16_t*)(ws + OFF_WLORA), NTOK, 5120, 640}; E.O = (bf16_t*)(ws + OFF_LO); E.ldc = 5120; }
            else if (sub == 6) { g = pg8::Gemm{(const bf16_t*)(ws + OFF_Y3), (const bf16_t*)(ws + OFF_WBR), Ml, 2048, 1024}; S.mode = 1; E.kind = 2; E.O = H; }
            else if (sub == 7) { g = pg8::Gemm{H, (const bf16_t*)(ws + OFF_WOUT), Ml, 2048, 2048}; E.kind = 3; E.gate = modl + 2 * 2048;
                if (l == 0) { E.xin_lat = p->in[I_X]; E.xin_ctx = p->in[I_CTX]; } }
            else if (sub == 9) { g = pg8::Gemm{H, (const bf16_t*)(ws + OFF_WFF1), Ml, DFF, 2048}; E.kind = 1; E.ldc = DFF; }
            else { g = pg8::Gemm{Pb, (const bf16_t*)(ws + OFF_WFF2), Ml, 2048, DFF}; E.kind = 3; E.gate = modl + 5 * 2048; }
            S.so.init(g.M, g.N, (int)gridDim.x, (int)blockIdx.x);
            pg8::gemm_phase(ldsg, g, S, E);
        } else
        switch (sub) {
        case 0: {
            phase_convert(p, l, ldsf);
            if (l == 0) phase_norm(p->in[I_X], p->in[I_CTX], NTOK, p->in[I_N1G] + l * 2048, modl, 0, 1, H);
            else phase_norm(XL, XL + (size_t)NLAT * 2048, NTOK, p->in[I_N1G] + l * 2048, modl, 0, 1, H);
        } break;
        case 2: phase_prep(p, l, (bf16_t*)shm); break;
#if DUPMASK
        case 4: phase_mix(p, l, ldsf, rep ? DUPWHICH : 7); break;
#else
        case 4: phase_mix(p, l, ldsf); break;
#endif
        case 5: phase_post(p, l, Ml); break;
        case 8: phase_norm(XL, XL + (size_t)NLAT * 2048, Ml, p->in[I_N2G] + l * 2048, modl, 3, 4, H); break;
        }
#if DUPMASK
        }
#endif
    }
}

extern "C" void kernel_launch(void* const* d_in, const int* in_sizes, int n_in, void* d_out, int out_size, void* d_ws, size_t ws_size, hipStream_t stream) {
    static int grid = 0;
    if (grid == 0) {
        if (n_in != 28 || ws_size < WS_END) { fprintf(stderr, "kernel_launch: need 28 inputs and %zu bytes of workspace (got %d, %zu)\n", (size_t)WS_END, n_in, ws_size); grid = -1; return; }
        if (hipFuncSetAttribute((const void*)fwd_kernel, hipFuncAttributeMaxDynamicSharedMemorySize, LDS_BYTES) != hipSuccess) { fprintf(stderr, "kernel_launch: hipFuncSetAttribute failed\n"); grid = -1; return; }
        int dev = 0, cus = 0, per_cu = 0;
        hipGetDevice(&dev);
        hipDeviceGetAttribute(&cus, hipDeviceAttributeMultiprocessorCount, dev);
        hipOccupancyMaxActiveBlocksPerMultiprocessor(&per_cu, (const void*)fwd_kernel, 512, LDS_BYTES);
        if (per_cu < 1) { fprintf(stderr, "kernel_launch: occupancy query says %d blocks per CU\n", per_cu); per_cu = 1; }
        (void)hipGetLastError();
        grid = cus * 1;
        if (grid > 256) grid = 256;
    }
    if (grid < 0) return;
    Params p{};
    for (int i = 0; i < 28; ++i) p.in[i] = (const float*)d_in[i];
    p.out = (float*)d_out; p.ws = (unsigned char*)d_ws;
#if ONE_LAUNCH
    p.ph_lo = 0; p.ph_hi = NPHASE;
    void* args[] = {&p};
    hipError_t e = hipLaunchCooperativeKernel((const void*)fwd_kernel, dim3(grid), dim3(512), args, LDS_BYTES, stream);
    if (e != hipSuccess) fprintf(stderr, "cooperative launch failed: %s (grid %d)\n", hipGetErrorString(e), grid);
#else
    for (int ph = 0; ph < NPHASE; ++ph) {
        p.ph_lo = ph; p.ph_hi = ph + 1;
        hipLaunchKernelGGL(fwd_kernel, dim3(grid), dim3(512), LDS_BYTES, stream, p);
    }
#endif
}
```

```cpp
#include <hip/hip_runtime.h>
#include <hip/hip_cooperative_groups.h>
#include <cstdio>
namespace cg = cooperative_groups;

#ifndef ONE_LAUNCH
#define ONE_LAUNCH 1
#endif

#define DEVI __device__ __forceinline__
#define LAS __attribute__((address_space(3)))
typedef unsigned short bf16_t;
typedef short bf16x8 __attribute__((ext_vector_type(8)));
typedef short bf16x4 __attribute__((ext_vector_type(4)));
typedef float f32x4 __attribute__((ext_vector_type(4)));
typedef float f32x2 __attribute__((ext_vector_type(2)));
typedef unsigned u32x4 __attribute__((ext_vector_type(4)));
typedef unsigned u32x2 __attribute__((ext_vector_type(2)));

constexpr int D = 2048, NTOK = 8704, NLAT = 8192, NP = 16128, DIN = 16016, DFF = 8192;
constexpr int RWB = 3088, NAB = 6800, GTB = 9872;
constexpr int LDS_BYTES = 131072;
constexpr int NPHASE = 24;

constexpr size_t OFF_CTL = 0;
constexpr size_t OFF_MOD = 4096;
constexpr size_t OFF_ROPE = OFF_MOD + 2ull * 3 * 12288 * 4;
constexpr size_t OFF_WIN = OFF_ROPE + 16384;
constexpr size_t OFF_WBR = OFF_WIN + 16128ull * 2048 * 2;
constexpr size_t OFF_WOUT = OFF_WBR + 3ull * 2048 * 1024 * 2;
constexpr size_t OFF_WFF1 = OFF_WOUT + 2048ull * 2048 * 2;
constexpr size_t OFF_WFF2 = OFF_WFF1 + 8192ull * 2048 * 2;
constexpr size_t OFF_WLORA = OFF_WFF2 + 8192ull * 2048 * 2;
constexpr size_t OFF_XL = OFF_WLORA + 5120ull * 640 * 2;
constexpr size_t OFF_H = OFF_XL + 8704ull * 2048 * 4;
constexpr size_t OFF_P = OFF_H + 8704ull * 2048 * 2;
constexpr size_t OFF_LA = OFF_P + 8704ull * 16128 * 2;
constexpr size_t OFF_LO = OFF_LA + 8704ull * 640 * 2;
constexpr size_t OFF_YRWF = OFF_LO + 8704ull * 5120 * 2;
constexpr size_t OFF_MLNUM = OFF_YRWF + 2ull * 8704 * 1024 * 4;
constexpr size_t OFF_VT = OFF_MLNUM + 2ull * 8704 * 4 * 272 * 4;
constexpr size_t OFF_Y3 = OFF_VT + 2ull * 8 * 128 * 4352 * 2;
constexpr size_t WS_END = OFF_Y3 + 3ull * 8704 * 1024 * 2;
constexpr size_t WT_BYTES = OFF_XL - OFF_WIN, WT_SHIFT = WS_END - OFF_WIN;

struct Params {
    const float* in[28];
    float* out;
    unsigned char* ws;
    int ph_lo, ph_hi, two_wt, pad_;
};
typedef const __attribute__((address_space(4))) Params* PP;
enum { I_X = 0, I_C, I_CTX, I_CCTX, I_WMOD, I_BMOD, I_N1G, I_WIN, I_MLGB, I_MLNG, I_RWMU, I_RWW0, I_RWWUP, I_RWA0, I_RWAUP, I_RWGUP,
       I_RWKK, I_RWKA, I_RWRK, I_RWLNW, I_RWLNB, I_RPB, I_WBR, I_WOUT, I_N2G, I_WFF1, I_WFF2, I_FING };

DEVI int otid() { int t; asm volatile("v_mov_b32 %0, %1" : "=v"(t) : "v"((int)threadIdx.x)); return t; }
DEVI float bf2f(bf16_t b) { return __uint_as_float(((unsigned)b) << 16); }
DEVI float bflo(unsigned u) { return __uint_as_float(u << 16); }
DEVI float bfhi(unsigned u) { return __uint_as_float(u & 0xffff0000u); }
DEVI bf16_t f2bf(float f) { unsigned u = __float_as_uint(f); u += 0x7FFFu + ((u >> 16) & 1u); return (bf16_t)(u >> 16); }
DEVI unsigned pack2(float lo, float hi) { return (unsigned)f2bf(lo) | ((unsigned)f2bf(hi) << 16); }
DEVI float sigmoidf(float x) { return 1.0f / (1.0f + __expf(-x)); }
#define DPP_ADD(x, CTRL) ((x) + __int_as_float(__builtin_amdgcn_update_dpp(0, __float_as_int(x), CTRL, 0xF, 0xF, true)))
DEVI float wsum(float x) {
    x = DPP_ADD(x, 0xB1); x = DPP_ADD(x, 0x4E); x = DPP_ADD(x, 0x141); x = DPP_ADD(x, 0x140);
    const int xi = __float_as_int(x);
    return (__int_as_float(__builtin_amdgcn_readlane(xi, 0)) + __int_as_float(__builtin_amdgcn_readlane(xi, 16))) + (__int_as_float(__builtin_amdgcn_readlane(xi, 32)) + __int_as_float(__builtin_amdgcn_readlane(xi, 48)));
}
DEVI float red8(float x) {
    x = DPP_ADD(x, 0xB1);
    x = DPP_ADD(x, 0x4E);
    x = DPP_ADD(x, 0x141);
    return x;
}

DEVI float red16(float x) {
    x = DPP_ADD(x, 0xB1); x = DPP_ADD(x, 0x4E); x = DPP_ADD(x, 0x141); x = DPP_ADD(x, 0x140);
    return x;
}
DEVI float sfma(float a, float b, float c) { float d; asm("v_fma_f32 %0, %1, %2, %3" : "=v"(d) : "v"(a), "v"(b), "v"(c)); return d; }
DEVI float smul(float a, float b) { float d; asm("v_mul_f32 %0, %1, %2" : "=v"(d) : "v"(a), "v"(b)); return d; }
DEVI float frcp(float x) { return __builtin_amdgcn_rcpf(x); }
DEVI float fsigmoid(float x) { return __builtin_amdgcn_rcpf(1.0f + __expf(-x)); }

namespace pg8 {
constexpr int BM = 256, BK = 64, HALF = 128, HTB = HALF * BK * 2, STAGE_BYTES = 8 * HTB, NXCD = 8, WGM = 8;
__host__ __device__ __forceinline__ int lds_byte(int r, int c) { const int st = (r >> 4) * 2 + (c >> 5), rr = r & 15, cc = c & 31, ob = rr * 64 + cc * 2; return st * 1024 + (ob ^ (((ob >> 9) & 1) << 5)); }
__host__ __device__ __forceinline__ void stage_rc(int b, int& R, int& C) { const int st = b / 1024, sb = b % 1024, swz = sb ^ (((sb >> 9) & 1) << 5); R = (st >> 1) * 16 + swz / 64; C = (st & 1) * 32 + (swz % 64) / 2; }
__host__ __device__ __forceinline__ int perm32(int rho) { const int n = rho >> 4, i = rho & 15; return 8 * (i >> 2) + 4 * n + (i & 3); }
struct Unit { int pm, pn; };
struct Gemm { const bf16_t* A; const bf16_t* Bt; int M, N, K; };
struct StaticOrder {
    int nM, nN, nwg, G, c;
    __device__ void init(int M, int N, int G_, int c_) { nM = M / BM; nN = N / BM; nwg = nM * nN; G = G_; c = c_; }
    __device__ bool next(int i, Unit& u) const {
        const long L = (long)i * G + c; if (L >= nwg) return false;
        int wgid = (int)L; { const int q = nwg / NXCD, r = nwg % NXCD, xcd = wgid % NXCD, off = wgid / NXCD; wgid = (xcd < r ? xcd * (q + 1) : r * (q + 1) + (xcd - r) * q) + off; }
        const int nig = WGM * nN, gid = wgid / nig, fm = gid * WGM, gsz = (nM - fm) < WGM ? (nM - fm) : WGM;
        u.pm = fm + ((wgid % nig) % gsz); u.pn = (wgid % nig) / gsz; return true;
    }
    __device__ __forceinline__ void a_ready(const Unit&) const {}
    __device__ __forceinline__ void done(const Unit&) const {}
};
struct MergeOrder {
    int ntiles, G, c;
    __device__ void init(int nM, int G_, int c_) { ntiles = nM * 8; G = G_; c = c_; }
    __device__ bool next(int i, Unit& u) const {
        const int ti = i / 3, br = i - ti * 3; const long L = (long)ti * G + c; if (L >= ntiles) return false;
        const int pm = (int)L >> 3, pn = (int)L & 7; u.pm = br * 34 + pm; u.pn = br * 8 + pn; return true;
    }
    __device__ __forceinline__ void a_ready(const Unit&) const {}
    __device__ __forceinline__ void done(const Unit&) const {}
};
DEVI unsigned cvt_pk_bf16(float lo, float hi) { unsigned r; asm volatile("v_cvt_pk_bf16_f32 %0, %1, %2" : "=v"(r) : "v"(lo), "v"(hi)); return r; }


struct SchedG {
    int mode;
    StaticOrder so; MergeOrder mo;
    __device__ __forceinline__ bool next(int i, Unit& u) const { return mode == 0 ? so.next(i, u) : mo.next(i, u); }
    __device__ __forceinline__ void a_ready(const Unit&) const {}
    __device__ __forceinline__ void done(const Unit&) const {}
};
struct EpiG {
    static constexpr bool PERM = true, AFTER_DRAIN = false;
    int kind;
    bf16_t* O; int ldc;
    const bf16_t* P; float* ACC;
    const float* xin_lat; const float* xin_ctx; float* XL; const float* gate;
    __device__ __forceinline__ void operator()(const f32x4 (&acc)[2][2][4][2], const Unit& u, int wr, int wc, int fr, int fq) const {
        if (kind <= 1) {
            const int row0 = u.pm * BM + wr * 64 + fr, col0 = u.pn * BM + wc * 32 + 8 * fq;
#pragma unroll
            for (int ai = 0; ai < 2; ++ai)
#pragma unroll
                for (int m = 0; m < 4; ++m) { bf16_t* rowp = O + (size_t)(row0 + ai * HALF + m * 16) * ldc + col0;
#pragma unroll
                    for (int bj = 0; bj < 2; ++bj) { f32x4 v0 = acc[ai][bj][m][0], v1 = acc[ai][bj][m][1];
                        if (kind == 1) {
#pragma unroll
                            for (int i = 0; i < 4; ++i) { float a = fmaxf(v0[i], 0.f), b = fmaxf(v1[i], 0.f); v0[i] = a * a; v1[i] = b * b; } }
                        u32x4 o; o[0] = cvt_pk_bf16(v0[0], v0[1]); o[1] = cvt_pk_bf16(v0[2], v0[3]); o[2] = cvt_pk_bf16(v1[0], v1[1]); o[3] = cvt_pk_bf16(v1[2], v1[3]);
                        *(u32x4*)(rowp + bj * HALF) = o; } }
        } else if (kind == 2) {
            const int br = u.pn >> 3, pn = u.pn & 7, pm = u.pm - br * 34;
            const int row0 = pm * BM + wr * 64 + fr, col0 = pn * BM + wc * 32 + 8 * fq;
#pragma unroll
            for (int ai = 0; ai < 2; ++ai)
#pragma unroll
                for (int m = 0; m < 4; ++m) { const size_t row = (size_t)(row0 + ai * HALF + m * 16);
#pragma unroll
                    for (int bj = 0; bj < 2; ++bj) { const int col = col0 + bj * HALF;
                        const u32x4 gv = *(const u32x4*)(P + row * NP + GTB + br * 2048 + col);
                        f32x4 v0 = acc[ai][bj][m][0], v1 = acc[ai][bj][m][1];
                        v0[0] *= sigmoidf(bflo(gv[0])); v0[1] *= sigmoidf(bfhi(gv[0])); v0[2] *= sigmoidf(bflo(gv[1])); v0[3] *= sigmoidf(bfhi(gv[1]));
                        v1[0] *= sigmoidf(bflo(gv[2])); v1[1] *= sigmoidf(bfhi(gv[2])); v1[2] *= sigmoidf(bflo(gv[3])); v1[3] *= sigmoidf(bfhi(gv[3]));
                        float* ap = ACC + row * 2048 + col;
                        if (br == 0) { *(f32x4*)ap = v0; *(f32x4*)(ap + 4) = v1; }
                        else { v0 += *(const f32x4*)ap; v1 += *(const f32x4*)(ap + 4);
                            if (br == 1) { *(f32x4*)ap = v0; *(f32x4*)(ap + 4) = v1; }
                            else { u32x4 o; o[0] = cvt_pk_bf16(v0[0], v0[1]); o[1] = cvt_pk_bf16(v0[2], v0[3]); o[2] = cvt_pk_bf16(v1[0], v1[1]); o[3] = cvt_pk_bf16(v1[2], v1[3]);
                                *(u32x4*)(O + row * 2048 + col) = o; } } } }
        } else {
            const int row0 = u.pm * BM + wr * 64 + fr, col0 = u.pn * BM + wc * 32 + 8 * fq;
#pragma unroll
            for (int ai = 0; ai < 2; ++ai)
#pragma unroll
                for (int m = 0; m < 4; ++m) { const int row = row0 + ai * HALF + m * 16;
                    const int mrow = row < NLAT ? (row >> 12) : 2;
                    const float* xr = row < NLAT ? xin_lat + (size_t)row * 2048 : xin_ctx + (size_t)(row - NLAT) * 2048;
                    const float* gr = gate + (size_t)mrow * 12288; float* orow = XL + (size_t)row * 2048;
#pragma unroll
                    for (int bj = 0; bj < 2; ++bj)
#pragma unroll
                        for (int n = 0; n < 2; ++n) { const int col = col0 + bj * HALF + n * 4;
                            const f32x4 g = *(const f32x4*)(gr + col), x = *(const f32x4*)(xr + col);
                            *(f32x4*)(orow + col) = x + g * acc[ai][bj][m][n]; } }
        }
    }
};
template <class Epi, class Sched>
__device__ __forceinline__ void gemm_phase(LAS unsigned char* lds, const Gemm g, const Sched& S, const Epi& E) {
    const int tid = otid(), wid = __builtin_amdgcn_readfirstlane(tid >> 6), lane = tid & 63, wr = wid >> 2, wc = wid & 3, fr = lane & 15, fq = lane >> 4;
    const int K = g.K, nt = K / BK;
    unsigned voffA[2], voffB[2];
#pragma unroll
    for (int i = 0; i < 2; ++i) { int R, C; stage_rc(tid * 16 + i * 8192, R, C); const int Rb = Epi::PERM ? ((R & ~31) + perm32(R & 31)) : R;
        voffA[i] = (unsigned)(R * K + C) * 2u; voffB[i] = (unsigned)(Rb * K + C) * 2u; }
    const size_t kstep = (size_t)(BK * 2);
    const size_t hstep = (size_t)HALF * K * 2;
    const size_t tstep = 2 * hstep;
    const unsigned ldsw = (unsigned)wid * 1024u;
    const int aoff = lds_byte(wr * 64 + fr, fq * 8), boff = lds_byte(wc * 32 + fr, fq * 8);
#define PG8_SA(b, h) (((b) * 2 + (h)) * HTB)
#define PG8_SB(b, h) ((4 + (b) * 2 + (h)) * HTB)
#define PG8_STAGE(bufoff, gbase, voff) do { _Pragma("unroll") for (int _i = 0; _i < 2; ++_i) \
        __builtin_amdgcn_global_load_lds((const unsigned*)((const char*)(gbase) + (voff)[_i]), (LAS unsigned*)(lds + (bufoff) + ldsw + _i * 8192), 16, 0, 0); } while (0)
#define PG8_LDA(dst, b, h) do { _Pragma("unroll") for (int m = 0; m < 4; ++m) _Pragma("unroll") for (int k = 0; k < 2; ++k) dst[m][k] = *(const LAS bf16x8*)(lds + PG8_SA(b, h) + aoff + m * 2048 + k * 1024); } while (0)
#define PG8_LDB(dst, b, h) do { _Pragma("unroll") for (int n = 0; n < 2; ++n) _Pragma("unroll") for (int k = 0; k < 2; ++k) dst[n][k] = *(const LAS bf16x8*)(lds + PG8_SB(b, h) + boff + n * 2048 + k * 1024); } while (0)
#define PG8_MMA(ai, bj, At, Bt) do { __builtin_amdgcn_s_setprio(1); _Pragma("unroll") for (int m = 0; m < 4; ++m) _Pragma("unroll") for (int n = 0; n < 2; ++n) _Pragma("unroll") for (int k = 0; k < 2; ++k) \
        acc[ai][bj][m][n] = __builtin_amdgcn_mfma_f32_16x16x32_bf16(Bt[n][k], At[m][k], acc[ai][bj][m][n], 0, 0, 0); __builtin_amdgcn_s_setprio(0); } while (0)
#define PG8_WAIT_V(n) asm volatile("s_waitcnt vmcnt(" #n ")" ::: "memory")
#define PG8_WAIT_L(n) asm volatile("s_waitcnt lgkmcnt(" #n ")" ::: "memory")
#define PG8_BAR __builtin_amdgcn_s_barrier()
#define PG8_SCHED __builtin_amdgcn_sched_barrier(0)
    Unit cur, nxt; int ui = 0;
    if (!S.next(0, cur)) return;
    f32x4 acc[2][2][4][2];
#pragma unroll
    for (int a = 0; a < 2; ++a)
#pragma unroll
        for (int b = 0; b < 2; ++b)
#pragma unroll
            for (int m = 0; m < 4; ++m)
#pragma unroll
                for (int n = 0; n < 2; ++n) acc[a][b][m][n] = (f32x4){0.f, 0.f, 0.f, 0.f};
    bf16x8 At[4][2], B0[2][2], B1[2][2];
    const char* cA = (const char*)g.A + (size_t)cur.pm * tstep; const char* cB = (const char*)g.Bt + (size_t)cur.pn * tstep;
    S.a_ready(cur);
    PG8_STAGE(PG8_SB(0, 0), cB, voffB); PG8_STAGE(PG8_SA(0, 0), cA, voffA); PG8_STAGE(PG8_SB(0, 1), cB + hstep, voffB); PG8_STAGE(PG8_SA(0, 1), cA + hstep, voffA);
    if (wr == 1) PG8_BAR;
    PG8_WAIT_V(4); PG8_BAR;
    PG8_STAGE(PG8_SB(1, 0), cB + kstep, voffB); PG8_STAGE(PG8_SA(1, 0), cA + kstep, voffA); PG8_STAGE(PG8_SB(1, 1), cB + hstep + kstep, voffB);
    PG8_WAIT_V(6); PG8_BAR;
    for (;;) {
        const bool has_next = S.next(ui + 1, nxt);
        const char* nA = has_next ? (const char*)g.A + (size_t)nxt.pm * tstep : cA; const char* nB = has_next ? (const char*)g.Bt + (size_t)nxt.pn * tstep : cB;
        for (int t = 0; t < nt; t += 2) {
            const bool last = (t == nt - 2);
            const char* a1 = cA + (size_t)(t + 1) * kstep;
            const char* a2 = last ? nA : cA + (size_t)(t + 2) * kstep; const char* b2 = last ? nB : cB + (size_t)(t + 2) * kstep;
            const char* a3 = a2 + kstep; const char* b3 = b2 + kstep;
            if (last && has_next) S.a_ready(nxt);
            PG8_LDB(B0, 0, 0); PG8_SCHED; PG8_LDA(At, 0, 0); PG8_STAGE(PG8_SA(1, 1), a1 + hstep, voffA);
            PG8_WAIT_L(8); PG8_BAR; PG8_WAIT_L(0); PG8_MMA(0, 0, At, B0); PG8_BAR; PG8_SCHED;
            PG8_LDB(B1, 0, 1); PG8_STAGE(PG8_SB(0, 0), b2, voffB);
            PG8_BAR; PG8_WAIT_L(0); PG8_MMA(0, 1, At, B1); PG8_BAR;
            PG8_LDA(At, 0, 1); PG8_STAGE(PG8_SA(0, 0), a2, voffA);
            PG8_BAR; PG8_WAIT_L(0); PG8_MMA(1, 0, At, B0); PG8_BAR; PG8_SCHED;
            PG8_STAGE(PG8_SB(0, 1), b2 + hstep, voffB);
            PG8_WAIT_V(6); PG8_BAR; PG8_MMA(1, 1, At, B1); PG8_BAR;
            PG8_LDB(B0, 1, 0); PG8_SCHED; PG8_LDA(At, 1, 0); PG8_STAGE(PG8_SA(0, 1), a2 + hstep, voffA);
            PG8_WAIT_L(8); PG8_BAR; PG8_WAIT_L(0); PG8_MMA(0, 0, At, B0); PG8_BAR; PG8_SCHED;
            PG8_LDB(B1, 1, 1); PG8_STAGE(PG8_SB(1, 0), b3, voffB);
            PG8_BAR; PG8_WAIT_L(0); PG8_MMA(0, 1, At, B1); PG8_BAR;
            PG8_LDA(At, 1, 1); PG8_STAGE(PG8_SA(1, 0), a3, voffA);
            PG8_BAR; PG8_WAIT_L(0); PG8_MMA(1, 0, At, B0); PG8_BAR; PG8_SCHED;
            PG8_STAGE(PG8_SB(1, 1), b3 + hstep, voffB);
            PG8_WAIT_V(6); PG8_BAR; PG8_MMA(1, 1, At, B1); PG8_BAR;
        }
        if constexpr (!Epi::AFTER_DRAIN) { E(acc, cur, wr, wc, fr, fq); S.done(cur); }
        if (!has_next) break;
#pragma unroll
        for (int a = 0; a < 2; ++a)
#pragma unroll
            for (int b = 0; b < 2; ++b)
#pragma unroll
                for (int m = 0; m < 4; ++m)
#pragma unroll
                    for (int n = 0; n < 2; ++n) acc[a][b][m][n] = (f32x4){0.f, 0.f, 0.f, 0.f};
        cur = nxt; cA = nA; cB = nB; ++ui;
    }
    PG8_WAIT_V(0);
    if (wr == 0) PG8_BAR;
    PG8_BAR;
    if constexpr (Epi::AFTER_DRAIN) { E.fused(acc, cur, wr, wc, fr, fq, lds, wid, lane); S.done(cur); }
#undef PG8_SA
#undef PG8_SB
#undef PG8_STAGE
#undef PG8_LDA
#undef PG8_LDB
#undef PG8_MMA
#undef PG8_WAIT_V
#undef PG8_WAIT_L
#undef PG8_BAR
#undef PG8_SCHED
}
}

__device__ void phase_mod(PP p, float* lds) {
    const int TIDX = otid();
    const int tid = TIDX;
    float* s = lds;
    float* red = lds + 3 * 2048;
    float* MOD = (float*)(p->ws + OFF_MOD);
    for (int i = tid; i < 3 * 2048; i += 512) { const int r = i >> 11, k = i & 2047; const float c = r < 2 ? p->in[I_C][r * 2048 + k] : p->in[I_CCTX][k]; s[i] = c * sigmoidf(c); }
    __syncthreads();
    for (int task = blockIdx.x; task < 192; task += gridDim.x) {
        const int l = task / 96, j0 = (task % 96) * 128, jc = tid & 127, kp = tid >> 7;
        const float* w = p->in[I_WMOD] + (size_t)l * 2048 * 12288 + j0 + jc;
        float a0 = 0.f, a1 = 0.f, a2 = 0.f;
#pragma unroll 8
        for (int k = kp * 512; k < kp * 512 + 512; ++k) { const float wv = w[(size_t)k * 12288]; a0 += s[k] * wv; a1 += s[2048 + k] * wv; a2 += s[4096 + k] * wv; }
        red[(kp * 3 + 0) * 128 + jc] = a0; red[(kp * 3 + 1) * 128 + jc] = a1; red[(kp * 3 + 2) * 128 + jc] = a2;
        __syncthreads();
        if (tid < 384) { const int r = tid >> 7, j = tid & 127;
            const float v = ((red[(0 * 3 + r) * 128 + j] + red[(1 * 3 + r) * 128 + j]) + (red[(2 * 3 + r) * 128 + j] + red[(3 * 3 + r) * 128 + j])) + p->in[I_BMOD][l * 12288 + j0 + j];
            MOD[(size_t)(l * 3 + r) * 12288 + j0 + j] = v; }
        __syncthreads();
    }
    if (blockIdx.x == gridDim.x - 1) {
        float* rc = (float*)(p->ws + OFF_ROPE); float* rs = rc + 2048;
        for (int i = tid; i < 2048; i += 512) { const int pos = i >> 5, j = i & 31; const float fr = powf(10000.0f, -(float)j / 32.0f); const float ang = (float)pos * fr; rc[i] = cosf(ang); rs[i] = sinf(ang); }
    }
}

__device__ void conv_tile(const float* __restrict__ src, int ld_src, int n_valid, int n0, int k0, bf16_t* __restrict__ dst, int ld_dst, float* tile) {
    const int TIDX = otid();
    const int tid = TIDX;
#pragma unroll
    for (int i = 0; i < 2; ++i) { const int kr = (tid >> 4) + i * 32, nc = (tid & 15) * 4; const float* sp = src + (size_t)(k0 + kr) * ld_src + n0 + nc;
        f32x4 v;
        if (n0 + nc + 3 < n_valid) v = *(const f32x4*)sp;
        else { v[0] = (n0 + nc + 0 < n_valid) ? sp[0] : 0.f; v[1] = (n0 + nc + 1 < n_valid) ? sp[1] : 0.f; v[2] = (n0 + nc + 2 < n_valid) ? sp[2] : 0.f; v[3] = (n0 + nc + 3 < n_valid) ? sp[3] : 0.f; }
        float* tp = tile + kr * 65 + nc; tp[0] = v[0]; tp[1] = v[1]; tp[2] = v[2]; tp[3] = v[3]; }
    __syncthreads();
    { const int n = tid >> 3, kc = (tid & 7) * 8; u32x4 o;
#pragma unroll
        for (int j = 0; j < 4; ++j) o[j] = pack2(tile[(kc + 2 * j) * 65 + n], tile[(kc + 2 * j + 1) * 65 + n]);
        *(u32x4*)(dst + (size_t)(n0 + n) * ld_dst + k0 + kc) = o; }
    __syncthreads();
}
__device__ void phase_convert(PP p, int l, float* lds, int vb, int vg, size_t wsh) {
    const int TIDX = otid();
    unsigned char* wsw = p->ws + wsh;
    for (int t = vb; t < 18816; t += vg) {
        if (t < 8064) { const int nt = t >> 5, kt = t & 31; conv_tile(p->in[I_WIN] + (size_t)l * 2048 * DIN, DIN, DIN, nt * 64, kt * 64, (bf16_t*)(wsw + OFF_WIN), 2048, lds); }
        else if (t < 9600) { const int tt = t - 8064, br = tt >> 9, r = tt & 511, nt = r >> 4, kt = r & 15;
            conv_tile(p->in[I_WBR] + (size_t)(l * 3 + br) * 1024 * 2048, 2048, 2048, nt * 64, kt * 64, (bf16_t*)(wsw + OFF_WBR) + (size_t)br * 2048 * 1024, 1024, lds); }
        else if (t < 10624) { const int tt = t - 9600, nt = tt >> 5, kt = tt & 31; conv_tile(p->in[I_WOUT] + (size_t)l * 2048 * 2048, 2048, 2048, nt * 64, kt * 64, (bf16_t*)(wsw + OFF_WOUT), 2048, lds); }
        else if (t < 14720) { const int tt = t - 10624, nt = tt >> 5, kt = tt & 31; conv_tile(p->in[I_WFF1] + (size_t)l * 2048 * 8192, 8192, 8192, nt * 64, kt * 64, (bf16_t*)(wsw + OFF_WFF1), 2048, lds); }
        else { const int tt = t - 14720, nt = tt >> 7, kt = tt & 127; conv_tile(p->in[I_WFF2] + (size_t)l * 8192 * 2048, 2048, 2048, nt * 64, kt * 64, (bf16_t*)(wsw + OFF_WFF2), 8192, lds); }
    }
    bf16_t* WL = (bf16_t*)(wsw + OFF_WLORA);
    for (int idx = vb * 512 + TIDX; idx < 5120 * 640; idx += vg * 512) {
        const int n = idx / 640, k = idx - n * 640, blk = n >> 10, nn = n & 1023;
        const int k0 = blk < 4 ? blk * 96 : 384, kw = blk < 4 ? 96 : 256;
        float v = 0.f;
        if (k >= k0 && k < k0 + kw) {
            const float* sp = blk < 2 ? p->in[I_RWWUP] + (size_t)(l * 2 + blk) * 96 * 1024 : (blk < 4 ? p->in[I_RWAUP] + (size_t)(l * 2 + blk - 2) * 96 * 1024 : p->in[I_RWGUP] + (size_t)l * 256 * 1024);
            v = sp[(size_t)(k - k0) * 1024 + nn]; }
        WL[idx] = f2bf(v);
    }
}
__device__ void phase_init(PP p, int l) {
    const int TIDX = otid();
    if (blockIdx.x == 0 && TIDX < 8) ((unsigned*)(p->ws + OFF_CTL))[l * 8 + TIDX] = 0u;
}

__device__ void phase_norm(const float* __restrict__ xlat, const float* __restrict__ xctx, int nrows, const float* __restrict__ g, const float* __restrict__ modl, int ishift, int iscale, bf16_t* __restrict__ H) {
    const int TIDX = otid();
    const int wid = TIDX >> 6, lane = TIDX & 63;
    for (int row = blockIdx.x * 8 + wid; row < nrows; row += gridDim.x * 8) {
        const float* xr = row < NLAT ? xlat + (size_t)row * 2048 : xctx + (size_t)(row - NLAT) * 2048;
        const int mrow = row < NLAT ? (row >> 12) : 2;
        const float* sh = modl + (size_t)mrow * 12288 + ishift * 2048; const float* sc = modl + (size_t)mrow * 12288 + iscale * 2048;
        f32x4 v[8]; float ss = 0.f;
#pragma unroll
        for (int i = 0; i < 8; ++i) { v[i] = *(const f32x4*)(xr + (i * 64 + lane) * 4); ss += v[i][0] * v[i][0] + v[i][1] * v[i][1] + v[i][2] * v[i][2] + v[i][3] * v[i][3]; }
        ss = wsum(ss);
        const float r = rsqrtf(ss * (1.0f / 2048.0f) + 1e-6f);
#pragma unroll
        for (int i = 0; i < 8; ++i) { const int col = (i * 64 + lane) * 4; const f32x4 gg = *(const f32x4*)(g + col), s1 = *(const f32x4*)(sc + col), s0 = *(const f32x4*)(sh + col);
            float o[4];
#pragma unroll
            for (int j = 0; j < 4; ++j) o[j] = (v[i][j] * r * gg[j]) * (1.0f + s1[j]) + s0[j];
            u32x2 w; w[0] = pack2(o[0], o[1]); w[1] = pack2(o[2], o[3]);
            *(u32x2*)(H + (size_t)row * 2048 + col) = w; }
    }
}
__device__ void phase_final(PP p) {
    const int TIDX = otid();
    const int wid = TIDX >> 6, lane = TIDX & 63;
    const float* XL = (const float*)(p->ws + OFF_XL); const float* g = p->in[I_FING];
    for (int row = blockIdx.x * 8 + wid; row < NLAT; row += gridDim.x * 8) {
        const float* xr = XL + (size_t)row * 2048;
        f32x4 v[8]; float ss = 0.f;
#pragma unroll
        for (int i = 0; i < 8; ++i) { v[i] = *(const f32x4*)(xr + (i * 64 + lane) * 4); ss += v[i][0] * v[i][0] + v[i][1] * v[i][1] + v[i][2] * v[i][2] + v[i][3] * v[i][3]; }
        ss = wsum(ss);
        const float r = rsqrtf(ss * (1.0f / 2048.0f) + 1e-6f);
#pragma unroll
        for (int i = 0; i < 8; ++i) { const int col = (i * 64 + lane) * 4; const f32x4 gg = *(const f32x4*)(g + col);
            f32x4 o; o[0] = v[i][0] * r * gg[0]; o[1] = v[i][1] * r * gg[1]; o[2] = v[i][2] * r * gg[2]; o[3] = v[i][3] * r * gg[3];
            *(f32x4*)(p->out + (size_t)row * 2048 + col) = o; }
    }
}

DEVI void seq_nbrs(int row, bool& hp, bool& hn) {
    if (row < NLAT) { const int t = row & 4095; hp = t > 0; hn = t < 4095; } else { const int m = (row - NLAT) & 255; hp = m > 0; hn = m < 255; }
}
DEVI float shiftf(float c, float pv, float nx, float mu) { return c + mu * (0.5f * (pv + nx) - c); }

__device__ void phase_prep(PP p, int l, bf16_t* ldsT) {
    const int TIDX = otid();
    const bf16_t* P = (const bf16_t*)(p->ws + OFF_P); bf16_t* LA = (bf16_t*)(p->ws + OFF_LA);
    const float* mu = p->in[I_RWMU] + (size_t)l * 3712 + 3072;
    for (int idx = blockIdx.x * 512 + TIDX; idx < NTOK * 80; idx += gridDim.x * 512) {
        const int row = idx / 80, j = (idx - row * 80) * 8;
        bool hp, hn; seq_nbrs(row, hp, hn);
        const bf16_t* pc = P + (size_t)row * NP + RWB + 3072 + j;
        const u32x4 c = *(const u32x4*)pc;
        const u32x4 z = {0u, 0u, 0u, 0u};
        const u32x4 pv = hp ? *(const u32x4*)(pc - NP) : z, nx = hn ? *(const u32x4*)(pc + NP) : z;
        float o[8];
#pragma unroll
        for (int q = 0; q < 4; ++q) { o[2 * q] = shiftf(bflo(c[q]), bflo(pv[q]), bflo(nx[q]), mu[j + 2 * q]); o[2 * q + 1] = shiftf(bfhi(c[q]), bfhi(pv[q]), bfhi(nx[q]), mu[j + 2 * q + 1]); }
        if (j < 192) {
#pragma unroll
            for (int q = 0; q < 8; ++q) o[q] = tanhf(o[q]); }
        else if (j >= 384) {
#pragma unroll
            for (int q = 0; q < 8; ++q) o[q] = sigmoidf(o[q]); }
        u32x4 w; w[0] = pack2(o[0], o[1]); w[1] = pack2(o[2], o[3]); w[2] = pack2(o[4], o[5]); w[3] = pack2(o[6], o[7]);
        *(u32x4*)(LA + (size_t)row * 640 + j) = w;
    }
    bf16_t* VT = (bf16_t*)(p->ws + OFF_VT);
    const int tid = TIDX;
    for (int t = blockIdx.x; t < 136 * 16; t += gridDim.x) {
        const int rt = t >> 4, hd = t & 15, h = hd >> 1, dh = hd & 1;
        const int row0 = rt * 64;
        { const int tl = tid >> 3, dc = (tid & 7) * 8;
            const u32x4 v = *(const u32x4*)(P + (size_t)(row0 + tl) * NP + NAB + 2048 + h * 128 + dh * 64 + dc);
            bf16_t* tp = ldsT + tl * 66 + dc;
#pragma unroll
            for (int q = 0; q < 4; ++q) { tp[2 * q] = (bf16_t)(v[q] & 0xffffu); tp[2 * q + 1] = (bf16_t)(v[q] >> 16); } }
        __syncthreads();
        { const int d = tid >> 3, tc = (tid & 7) * 8;
            int b, pos; if (row0 < NLAT) { b = row0 >> 12; pos = row0 & 4095; } else { b = (row0 - NLAT) >> 8; pos = 4096 + ((row0 - NLAT) & 255); }
            u32x4 o;
#pragma unroll
            for (int q = 0; q < 4; ++q) o[q] = (unsigned)ldsT[(tc + 2 * q) * 66 + d] | ((unsigned)ldsT[(tc + 2 * q + 1) * 66 + d] << 16);
            *(u32x4*)(VT + ((size_t)((b * 8 + h) * 128 + dh * 64 + d)) * 4352 + pos + tc) = o; }
        __syncthreads();
    }
}

DEVI int scan_row(int s, int b, int dir) {
    if (s < 256) { const int m = dir ? 255 - s : s; return NLAT + b * 256 + m; }
    const int t = dir ? 4095 - (s - 256) : s - 256; return b * 4096 + t;
}
__device__ void rwkv_scan(PP p, int l, int task, float* lds) {
    const int TIDX = otid();
    const int chain = task >> 1, half = task & 1;
    const int b = chain >> 5, h = (chain >> 1) & 15, dir = chain & 1, tid = TIDX;
    const bf16_t* P = (const bf16_t*)(p->ws + OFF_P); const bf16_t* LO = (const bf16_t*)(p->ws + OFF_LO);
    float* YO = (float*)(p->ws + OFF_YRWF) + (size_t)dir * NTOK * 1024 + h * 64;
    const int sl = tid >> 5, e2 = (tid & 31) * 2, ch = h * 64 + e2;
    const float* MU = p->in[I_RWMU] + (size_t)l * 3712;
    const float mur0 = MU[ch], mur1 = MU[ch + 1], muk0 = MU[1024 + ch], muk1 = MU[1024 + ch + 1], muv0 = MU[2048 + ch], muv1 = MU[2048 + ch + 1];
    const float w00 = p->in[I_RWW0][(l * 2 + dir) * 1024 + ch], w01 = p->in[I_RWW0][(l * 2 + dir) * 1024 + ch + 1];
    const float a00 = p->in[I_RWA0][(l * 2 + dir) * 1024 + ch], a01 = p->in[I_RWA0][(l * 2 + dir) * 1024 + ch + 1];
    const float kk0 = p->in[I_RWKK][l * 1024 + ch], kk1 = p->in[I_RWKK][l * 1024 + ch + 1], ka0 = p->in[I_RWKA][l * 1024 + ch], ka1 = p->in[I_RWKA][l * 1024 + ch + 1];
    const int kq = tid & 15, v = half * 32 + (tid >> 4);
    f32x2 S0 = (f32x2){0.f, 0.f}, S1 = (f32x2){0.f, 0.f};
    unsigned rc, rp, rn, kc, kp, kn, vc, vp, vn, wr_, ar_;
    auto issue = [&](int g) {
        const int row = scan_row(g * 16 + sl, b, dir); bool hp, hn; seq_nbrs(row, hp, hn);
        const bf16_t* pr = P + (size_t)row * NP + RWB + ch;
        rc = *(const unsigned*)pr; kc = *(const unsigned*)(pr + 1024); vc = *(const unsigned*)(pr + 2048);
        rp = 0u; kp = 0u; vp = 0u; rn = 0u; kn = 0u; vn = 0u;
        if (hp) { rp = *(const unsigned*)(pr - NP); kp = *(const unsigned*)(pr - NP + 1024); vp = *(const unsigned*)(pr - NP + 2048); }
        if (hn) { rn = *(const unsigned*)(pr + NP); kn = *(const unsigned*)(pr + NP + 1024); vn = *(const unsigned*)(pr + NP + 2048); }
        const bf16_t* lo = LO + (size_t)row * 5120 + dir * 1024 + ch;
        wr_ = *(const unsigned*)lo; ar_ = *(const unsigned*)(lo + 2048);
    };
    auto commit = [&](int buf) {
        float* st = lds + buf * 6144 + sl * 384 + e2;
        const float r0 = shiftf(bflo(rc), bflo(rp), bflo(rn), mur0), r1 = shiftf(bfhi(rc), bfhi(rp), bfhi(rn), mur1);
        const float k0 = shiftf(bflo(kc), bflo(kp), bflo(kn), muk0), k1 = shiftf(bfhi(kc), bfhi(kp), bfhi(kn), muk1);
        const float v0 = shiftf(bflo(vc), bflo(vp), bflo(vn), muv0), v1 = shiftf(bfhi(vc), bfhi(vp), bfhi(vn), muv1);
        const float x0 = -(w00 + bflo(wr_)), x1 = -(w01 + bfhi(wr_));
        const float sp0 = x0 > 20.f ? x0 : __logf(1.0f + __expf(x0)), sp1 = x1 > 20.f ? x1 : __logf(1.0f + __expf(x1));
        const float d0 = __expf(-__expf(-sp0 - 0.5f)), d1 = __expf(-__expf(-sp1 - 0.5f));
        const float ar0 = fsigmoid(a00 + bflo(ar_)), ar1 = fsigmoid(a01 + bfhi(ar_));
        const float kd0 = k0 * (1.0f + (ar0 - 1.0f) * ka0), kd1 = k1 * (1.0f + (ar1 - 1.0f) * ka1);
        const float q0 = k0 * kk0, q1 = k1 * kk1;
        float ss = red16(q0 * q0 + q1 * q1);
        ss += __shfl_xor(ss, 16);
        const float inv = frcp(fmaxf(__builtin_amdgcn_sqrtf(ss), 1e-12f));
        const float n0 = q0 * inv, n1 = q1 * inv;
        *(f32x2*)(st + 0) = (f32x2){r0, r1}; *(f32x2*)(st + 64) = (f32x2){d0, d1}; *(f32x2*)(st + 128) = (f32x2){kd0, kd1};
        *(f32x2*)(st + 192) = (f32x2){v0, v1}; *(f32x2*)(st + 256) = (f32x2){-n0, -n1}; *(f32x2*)(st + 320) = (f32x2){n0 * ar0, n1 * ar1};
    };
    __syncthreads();
    issue(0); commit(0);
    __syncthreads();
    constexpr int NG = 4352 / 16;
    for (int g = 0; g < NG; ++g) {
        if (g + 1 < NG) issue(g + 1);
        {
            const float* base = lds + (g & 1) * 6144 + kq * 4;
            float ykeep = 0.f;
            f32x4 nA, nD, nB, nK, nR; float nV;
#define RW_LOAD(i_) do { const float* st_ = base + (i_) * 384; nA = *(const f32x4*)(st_ + 256); nD = *(const f32x4*)(st_ + 64); nB = *(const f32x4*)(st_ + 320); nK = *(const f32x4*)(st_ + 128); nR = *(const f32x4*)(st_); \
                nV = st_[192 - kq * 4 + v]; } while (0)
            RW_LOAD(0);
#pragma unroll
            for (int i = 0; i < 16; ++i) {
                const f32x4 a = nA, d = nD, bb = nB, k = nK, r = nR; const float vv = nV;
                if (i < 15) { RW_LOAD(i + 1); }
                __builtin_amdgcn_sched_barrier(0x77);
                f32x2 pa2 = S0 * (f32x2){a[0], a[1]}; pa2 = S1 * (f32x2){a[2], a[3]} + pa2;
                const f32x2 vvb = (f32x2){vv, vv};
                const f32x2 u0 = S0 * (f32x2){d[0], d[1]} + vvb * (f32x2){k[0], k[1]}, u1 = S1 * (f32x2){d[2], d[3]} + vvb * (f32x2){k[2], k[3]};
                const float pa = red16(pa2[0] + pa2[1]);
                const f32x2 pab = (f32x2){pa, pa};
                S0 = pab * (f32x2){bb[0], bb[1]} + u0; S1 = pab * (f32x2){bb[2], bb[3]} + u1;
                f32x2 y2 = S0 * (f32x2){r[0], r[1]}; y2 = S1 * (f32x2){r[2], r[3]} + y2;
                const float y = red16(y2[0] + y2[1]);
                ykeep = (kq == i) ? y : ykeep;
            }
#undef RW_LOAD
            YO[(size_t)scan_row(g * 16 + kq, b, dir) * 1024 + v] = ykeep;
        }
        if (g + 1 < NG) commit((g + 1) & 1);
        __syncthreads();
    }
}

__device__ void mlstm_scan(PP p, int l, int chain, int g8, float* lds) {
    const int TIDX = otid();
    const int b = chain >> 3, h = (chain >> 1) & 3, dir = chain & 1, tid = TIDX;
    const bf16_t* P = (const bf16_t*)(p->ws + OFF_P);
    const float* RC = (const float*)(p->ws + OFF_ROPE); const float* RS = RC + 2048;
    float* NO = (float*)(p->ws + OFF_MLNUM) + (size_t)dir * NTOK * 4 * 272 + h * 272;
    const int sl = tid >> 5, j = tid & 31;
    const float gbi = p->in[I_MLGB][l * 16 + (dir * 2 + 0) * 4 + h], gbf = p->in[I_MLGB][l * 16 + (dir * 2 + 1) * 4 + h];
    const int rowl = (tid >> 3) & 31, kq = tid & 7, crow = g8 * 32 + rowl, lane = tid & 63;
    f32x2 C[8];
#pragma unroll
    for (int i = 0; i < 8; ++i) C[i] = (f32x2){0.f, 0.f};
    f32x2 nst = (f32x2){0.f, 0.f};
    bf16_t q0, q1, q2, q3, k0, k1, k2, k3, gi, gf; unsigned vv2; float cr, sr, cc, sc;
    auto issue = [&](int g) {
        const int row = scan_row(g * 16 + sl, b, dir);
        const bf16_t* pr = P + (size_t)row * NP;
        const bf16_t* pq = pr + h * 128 + j; const bf16_t* pk = pr + 512 + h * 128 + j;
        q0 = pq[0]; q1 = pq[32]; q2 = pq[64]; q3 = pq[96]; k0 = pk[0]; k1 = pk[32]; k2 = pk[64]; k3 = pk[96];
        vv2 = j < 16 ? *(const unsigned*)(pr + 1024 + h * 256 + g8 * 32 + 2 * j) : 0u;
        gi = pr[3072 + (dir * 2 + 0) * 4 + h]; gf = pr[3072 + (dir * 2 + 1) * 4 + h];
        if (row < NLAT) { const int t = row & 4095, pr_ = t >> 6, pc_ = t & 63; cr = RC[pr_ * 32 + j]; sr = RS[pr_ * 32 + j]; cc = RC[pc_ * 32 + j]; sc = RS[pc_ * 32 + j]; }
        else { cr = 1.f; sr = 0.f; cc = 1.f; sc = 0.f; }
    };
    auto commit = [&](int buf) {
        float* st = lds + buf * 5376 + sl * 336;
        const float scale = 0.08838834764831845f;
        const float a0 = bf2f(q0), a1 = bf2f(q1), a2 = bf2f(q2), a3 = bf2f(q3);
        st[j] = (a0 * cr - a1 * sr) * scale; st[32 + j] = (a0 * sr + a1 * cr) * scale; st[64 + j] = (a2 * cc - a3 * sc) * scale; st[96 + j] = (a2 * sc + a3 * cc) * scale;
        const float c0 = bf2f(k0), c1 = bf2f(k1), c2 = bf2f(k2), c3 = bf2f(k3);
        st[128 + j] = c0 * cr - c1 * sr; st[160 + j] = c0 * sr + c1 * cr; st[192 + j] = c2 * cc - c3 * sc; st[224 + j] = c2 * sc + c3 * cc;
        if (j < 16) { st[256 + 2 * j] = bflo(vv2); st[257 + 2 * j] = bfhi(vv2); }
        if (j == 0) { st[320] = fsigmoid(bf2f(gf) + gbf); st[321] = __expf(bf2f(gi) + gbi); }
    };
    __syncthreads();
    issue(0); commit(0);
    __syncthreads();
    constexpr int NG = 4352 / 16;
    for (int g = 0; g < NG; ++g) {
        if (g + 1 < NG) issue(g + 1);
        const float* base = lds + (g & 1) * 5376;
        if (tid < 256) {
            float nkeep = 0.f;
            f32x4 nK[4], nQ[4]; float nF, nI, nV0;
#define ML_LOAD(i_) do { const float* st_ = base + (i_) * 336; _Pragma("unroll") for (int c4 = 0; c4 < 4; ++c4) { nK[c4] = *(const f32x4*)(st_ + 128 + c4 * 32 + kq * 4); nQ[c4] = *(const f32x4*)(st_ + c4 * 32 + kq * 4); } \
                nF = st_[320]; nI = st_[321]; nV0 = st_[256 + rowl]; } while (0)
            ML_LOAD(0);
#pragma unroll
            for (int i = 0; i < 16; ++i) {
                f32x4 kk[4], qq[4];
#pragma unroll
                for (int c4 = 0; c4 < 4; ++c4) { kk[c4] = nK[c4]; qq[c4] = nQ[c4]; }
                const float f = nF, coef = nI * nV0;
                if (i < 15) { ML_LOAD(i + 1); }
                __builtin_amdgcn_sched_barrier(0x77);
                const f32x2 cf = (f32x2){coef, coef}, ff = (f32x2){f, f};
                f32x2 num2 = (f32x2){0.f, 0.f}, num3 = (f32x2){0.f, 0.f};
#pragma unroll
                for (int c4 = 0; c4 < 4; ++c4) {
                    const f32x2 KA = (f32x2){kk[c4][0], kk[c4][1]}, KB = (f32x2){kk[c4][2], kk[c4][3]}, QA = (f32x2){qq[c4][0], qq[c4][1]}, QB = (f32x2){qq[c4][2], qq[c4][3]};
                    C[2 * c4] = ff * C[2 * c4] + cf * KA; C[2 * c4 + 1] = ff * C[2 * c4 + 1] + cf * KB;
                    num2 = C[2 * c4] * QA + num2; num3 = C[2 * c4 + 1] * QB + num3; }
                num2 += num3;
                const float num = red8(num2[0] + num2[1]);
                nkeep = (kq == (i & 7)) ? num : nkeep;
                if ((i & 7) == 7) NO[(size_t)scan_row(g * 16 + (i - 7) + kq, b, dir) * (4 * 272) + crow] = nkeep;
            }
#undef ML_LOAD
        } else if (g8 == 0 && tid < 320) {
            float nkeep = 0.f;
            f32x2 nk, nq; float nf, ni;
#define MN_LOAD(i_) do { const float* st_ = base + (i_) * 336; nk = *(const f32x2*)(st_ + 128 + 2 * lane); nq = *(const f32x2*)(st_ + 2 * lane); nf = st_[320]; ni = st_[321]; } while (0)
            MN_LOAD(0);
#pragma unroll
            for (int i = 0; i < 16; ++i) {
                const f32x2 kk = nk, qq = nq; const float f = nf, ig = ni;
                if (i < 15) { MN_LOAD(i + 1); }
                __builtin_amdgcn_sched_barrier(0x77);
                nst = (f32x2){f, f} * nst + (f32x2){ig, ig} * kk;
                const f32x2 d2 = nst * qq;
                const float den16 = red16(d2[0] + d2[1]);
                nkeep = ((lane & 15) == i) ? den16 : nkeep;
            }
#undef MN_LOAD
            nkeep += __shfl_xor(nkeep, 16); nkeep += __shfl_xor(nkeep, 32);
            if (lane < 16) NO[(size_t)scan_row(g * 16 + lane, b, dir) * (4 * 272) + 256] = nkeep;
        }
        if (g + 1 < NG) commit((g + 1) & 1);
        __syncthreads();
    }
}

#define MFMA16(a, b, c) __builtin_amdgcn_mfma_f32_16x16x32_bf16(a, b, c, 0, 0, 0)
__device__ void na_wave(PP p, int l, int task) {
    const int TIDX = otid();
    const bf16_t* P = (const bf16_t*)(p->ws + OFF_P); const bf16_t* VT = (const bf16_t*)(p->ws + OFF_VT);
    bf16_t* YN = (bf16_t*)(p->ws + OFF_Y3) + 2ull * NTOK * 1024;
    const int w = TIDX >> 6, lane = TIDX & 63, n16 = lane & 15, g = lane >> 4;
    int b, h, qrow, r = 0, qcol = 0, cs = 0, row_start = 0, c_start = 0; bool lat;
    if (task < 512) { lat = true; b = task >> 8; h = (task >> 5) & 7; const int pair = task & 31; r = pair * 2 + (w >> 2); const int qi = w & 3; qcol = qi * 16 + n16;
        qrow = b * 4096 + r * 64 + qcol; cs = qi == 0 ? 0 : (qi == 1 ? 8 : (qi == 2 ? 24 : 32)); row_start = min(max(r - 4, 0), 56); c_start = min(max(qcol - 8, 0), 48); }
    else { lat = false; const int t2 = task - 512; b = t2 >> 4; h = (t2 >> 1) & 7; const int chunk = t2 & 1; qrow = NLAT + b * 256 + chunk * 128 + w * 16 + n16; }
    bf16x8 qf[4];
#pragma unroll
    for (int c = 0; c < 4; ++c) qf[c] = *(const bf16x8*)(P + (size_t)qrow * NP + NAB + h * 128 + c * 32 + g * 8);
    const float* rpb = p->in[I_RPB] + (size_t)(l * 8 + h) * 15 * 31;
    const bf16_t* vtb = VT + (size_t)((b * 8 + h) * 128) * 4352;
    f32x4 O[8];
#pragma unroll
    for (int i = 0; i < 8; ++i) O[i] = (f32x4){0.f, 0.f, 0.f, 0.f};
    float mrun = -INFINITY, lsum = 0.f;
    const float scale = 0.08838834764831845f;
    for (int pass = lat ? 0 : 2; pass < 4; ++pass) {
        f32x4 S[8];
#pragma unroll
        for (int i = 0; i < 8; ++i) {
            int krowtok;
            if (pass < 2) { const int krow = row_start + pass * 4 + (i >> 1); krowtok = b * 4096 + krow * 64 + cs + (i & 1) * 16 + n16; }
            else krowtok = NLAT + b * 256 + (pass - 2) * 128 + i * 16 + n16;
            const bf16_t* kp = P + (size_t)krowtok * NP + NAB + 1024 + h * 128 + g * 8;
            f32x4 acc = (f32x4){0.f, 0.f, 0.f, 0.f};
#pragma unroll
            for (int c = 0; c < 4; ++c) { const bf16x8 kf = *(const bf16x8*)(kp + c * 32); acc = MFMA16(kf, qf[c], acc); }
            S[i] = acc;
        }
        float mx = -INFINITY;
#pragma unroll
        for (int i = 0; i < 8; ++i) {
            if (pass < 2) { const int krow = row_start + pass * 4 + (i >> 1); const float* rb = rpb + (krow - r + 7) * 31;
#pragma unroll
                for (int jj = 0; jj < 4; ++jj) { const int kc = cs + (i & 1) * 16 + 4 * g + jj; const bool ok = (kc >= c_start) && (kc < c_start + 16);
                    const int co = min(max(kc - qcol, -15), 15) + 15;
                    S[i][jj] = ok ? S[i][jj] * scale + rb[co] : -INFINITY; } }
            else {
#pragma unroll
                for (int jj = 0; jj < 4; ++jj) S[i][jj] *= scale; }
#pragma unroll
            for (int jj = 0; jj < 4; ++jj) mx = fmaxf(mx, S[i][jj]);
        }
        mx = fmaxf(mx, __shfl_xor(mx, 16)); mx = fmaxf(mx, __shfl_xor(mx, 32));
        const float mnew = fmaxf(mrun, mx);
        const float alpha = __expf(mrun - mnew);
        mrun = mnew; lsum *= alpha;
#pragma unroll
        for (int i = 0; i < 8; ++i) { O[i][0] *= alpha; O[i][1] *= alpha; O[i][2] *= alpha; O[i][3] *= alpha; }
        bf16x8 pf[4];
#pragma unroll
        for (int c = 0; c < 4; ++c) {
            float e[8];
#pragma unroll
            for (int jj = 0; jj < 4; ++jj) { e[jj] = __expf(S[2 * c][jj] - mnew); e[4 + jj] = __expf(S[2 * c + 1][jj] - mnew); }
#pragma unroll
            for (int jj = 0; jj < 8; ++jj) lsum += e[jj];
            u32x4 u; u[0] = pack2(e[0], e[1]); u[1] = pack2(e[2], e[3]); u[2] = pack2(e[4], e[5]); u[3] = pack2(e[6], e[7]);
            pf[c] = __builtin_bit_cast(bf16x8, u);
        }
#pragma unroll
        for (int c = 0; c < 4; ++c) {
            int pos0, pos1;
            if (pass < 2) { const int krow = row_start + pass * 4 + c; pos0 = krow * 64 + cs + 4 * g; pos1 = pos0 + 16; }
            else { pos0 = 4096 + (pass - 2) * 128 + c * 32 + 4 * g; pos1 = pos0 + 16; }
#pragma unroll
            for (int dt = 0; dt < 8; ++dt) {
                const bf16_t* vp = vtb + (size_t)(dt * 16 + n16) * 4352;
                const bf16x4 v0 = *(const bf16x4*)(vp + pos0), v1 = *(const bf16x4*)(vp + pos1);
                const bf16x8 vf = __builtin_shufflevector(v0, v1, 0, 1, 2, 3, 4, 5, 6, 7);
                O[dt] = MFMA16(vf, pf[c], O[dt]);
            }
        }
    }
    lsum += __shfl_xor(lsum, 16); lsum += __shfl_xor(lsum, 32);
    const float inv = 1.0f / lsum;
    bf16_t* yo = YN + (size_t)qrow * 1024 + h * 128 + 4 * g;
#pragma unroll
    for (int dt = 0; dt < 8; ++dt) { u32x2 o; o[0] = pack2(O[dt][0] * inv, O[dt][1] * inv); o[1] = pack2(O[dt][2] * inv, O[dt][3] * inv); *(u32x2*)(yo + dt * 16) = o; }
}

__device__ void na_block(PP p, int l, int task, unsigned char* lds) {
    const int TIDX = otid();
    const bf16_t* P = (const bf16_t*)(p->ws + OFF_P); const bf16_t* VT = (const bf16_t*)(p->ws + OFF_VT);
    bf16_t* YN = (bf16_t*)(p->ws + OFF_Y3) + 2ull * NTOK * 1024;
    const int tid = TIDX, w = tid >> 6, lane = tid & 63, n16 = lane & 15, g = lane >> 4, qi = w & 3, kh = w >> 2;
    const int b = task >> 9, h = (task >> 6) & 7, r = task & 63;
    const int qcol = qi * 16 + n16, qrow = b * 4096 + r * 64 + qcol;
    const int cs = qi == 0 ? 0 : (qi == 1 ? 8 : (qi == 2 ? 24 : 32)), row_start = min(max(r - 4, 0), 56), c_start = min(max(qcol - 8, 0), 48);
    unsigned char* KT = lds; unsigned char* VL = lds + 65536;
    bf16x8 qf[4];
#pragma unroll
    for (int c = 0; c < 4; ++c) qf[c] = *(const bf16x8*)(P + (size_t)qrow * NP + NAB + h * 128 + c * 32 + g * 8);
    const float* rpb = p->in[I_RPB] + (size_t)(l * 8 + h) * 15 * 31;
    const bf16_t* vtb = VT + (size_t)((b * 8 + h) * 128) * 4352;
    const bf16_t* kgb = P + NAB + 1024 + h * 128;
    f32x4 O[8];
#pragma unroll
    for (int i = 0; i < 8; ++i) O[i] = (f32x4){0.f, 0.f, 0.f, 0.f};
    float mrun = -INFINITY, lsum = 0.f;
    const float scale = 0.08838834764831845f;
    u32x4 kreg[8], vreg[8];
    auto gload = [&](int pass) {
#pragma unroll
        for (int i = 0; i < 8; ++i) { const int key = i * 32 + (tid >> 4), c16 = tid & 15, s_ = key >> 6, kk = key & 63;
            if (pass < 2) { const int krow = row_start + (s_ < 2 ? 2 * pass + s_ : 2 + 2 * pass + s_);
                kreg[i] = *(const u32x4*)(kgb + (size_t)(b * 4096 + krow * 64 + kk) * NP + c16 * 8); }
            else if (i < 4) { const int m = (s_ == 0 ? 0 : 128) + 64 * (pass - 2) + kk;
                kreg[i] = *(const u32x4*)(kgb + (size_t)(NLAT + b * 256 + m) * NP + c16 * 8); } }
#pragma unroll
        for (int i = 0; i < 8; ++i) { const int d = i * 16 + (tid >> 5), key8 = (tid & 31) * 8, s_ = key8 >> 6, kk = key8 & 63;
            if (pass < 2) { const int krow = row_start + (s_ < 2 ? 2 * pass + s_ : 2 + 2 * pass + s_);
                vreg[i] = *(const u32x4*)(vtb + (size_t)d * 4352 + krow * 64 + kk); }
            else if (key8 < 128) { const int m = (s_ == 0 ? 0 : 128) + 64 * (pass - 2) + kk;
                vreg[i] = *(const u32x4*)(vtb + (size_t)d * 4352 + 4096 + m); } }
    };
    auto lstore = [&](int pass) {
#pragma unroll
        for (int i = 0; i < 8; ++i) { const int key = i * 32 + (tid >> 4), c16 = tid & 15;
            if (pass < 2 || i < 4) *(u32x4*)(KT + key * 256 + ((c16 ^ (key & 15)) * 16)) = kreg[i]; }
#pragma unroll
        for (int i = 0; i < 8; ++i) { const int d = i * 16 + (tid >> 5), kc16 = tid & 31;
            if (pass < 2 || kc16 < 16) *(u32x4*)(VL + d * 512 + ((kc16 ^ (d & 15)) * 16)) = vreg[i]; }
    };
    gload(0);
    for (int pass = 0; pass < 4; ++pass) {
        __syncthreads();
        lstore(pass);
        __syncthreads();
        if (pass < 3) gload(pass + 1);
        f32x4 S[4];
#pragma unroll
        for (int i = 0; i < 4; ++i) {
            const int keyl = pass < 2 ? (kh * 2 + (i >> 1)) * 64 + cs + (i & 1) * 16 + n16 : kh * 64 + i * 16 + n16;
            const unsigned char* kp = KT + keyl * 256;
            f32x4 acc = (f32x4){0.f, 0.f, 0.f, 0.f};
#pragma unroll
            for (int c = 0; c < 4; ++c) { const bf16x8 kf = *(const bf16x8*)(kp + (((c * 4 + g) ^ (keyl & 15)) * 16)); acc = MFMA16(kf, qf[c], acc); }
            S[i] = acc;
        }
        float mx = -INFINITY;
#pragma unroll
        for (int i = 0; i < 4; ++i) {
            if (pass < 2) { const int krow = row_start + kh * 4 + 2 * pass + (i >> 1); const float* rb = rpb + (krow - r + 7) * 31;
#pragma unroll
                for (int jj = 0; jj < 4; ++jj) { const int kc = cs + (i & 1) * 16 + 4 * g + jj; const bool ok = (kc >= c_start) && (kc < c_start + 16);
                    const int co = min(max(kc - qcol, -15), 15) + 15;
                    S[i][jj] = ok ? S[i][jj] * scale + rb[co] : -INFINITY; } }
            else {
#pragma unroll
                for (int jj = 0; jj < 4; ++jj) S[i][jj] *= scale; }
#pragma unroll
            for (int jj = 0; jj < 4; ++jj) mx = fmaxf(mx, S[i][jj]);
        }
        mx = fmaxf(mx, __shfl_xor(mx, 16)); mx = fmaxf(mx, __shfl_xor(mx, 32));
        const float mnew = fmaxf(mrun, mx);
        const float alpha = __expf(mrun - mnew);
        mrun = mnew; lsum *= alpha;
#pragma unroll
        for (int i = 0; i < 8; ++i) { O[i][0] *= alpha; O[i][1] *= alpha; O[i][2] *= alpha; O[i][3] *= alpha; }
#pragma unroll
        for (int c = 0; c < 2; ++c) {
            float e[8];
#pragma unroll
            for (int jj = 0; jj < 4; ++jj) { e[jj] = __expf(S[2 * c][jj] - mnew); e[4 + jj] = __expf(S[2 * c + 1][jj] - mnew); }
#pragma unroll
            for (int jj = 0; jj < 8; ++jj) lsum += e[jj];
            u32x4 u; u[0] = pack2(e[0], e[1]); u[1] = pack2(e[2], e[3]); u[2] = pack2(e[4], e[5]); u[3] = pack2(e[6], e[7]);
            const bf16x8 pf = __builtin_bit_cast(bf16x8, u);
            const int key0 = pass < 2 ? (kh * 2 + c) * 64 + cs + 4 * g : kh * 64 + c * 32 + 4 * g;
            const int kc8a = key0 >> 2, kc8b = kc8a + 4;
#pragma unroll
            for (int dt = 0; dt < 8; ++dt) { const int d = dt * 16 + n16; const unsigned char* vp = VL + d * 512;
                const bf16x4 v0 = *(const bf16x4*)(vp + (((kc8a >> 1) ^ (d & 15)) * 16) + (kc8a & 1) * 8), v1 = *(const bf16x4*)(vp + (((kc8b >> 1) ^ (d & 15)) * 16) + (kc8b & 1) * 8);
                const bf16x8 vf = __builtin_shufflevector(v0, v1, 0, 1, 2, 3, 4, 5, 6, 7);
                O[dt] = MFMA16(vf, pf, O[dt]); }
        }
    }
    lsum += __shfl_xor(lsum, 16); lsum += __shfl_xor(lsum, 32);
    __syncthreads();
    float* cmb = (float*)lds + (size_t)qi * 34 * 64 + lane;
    if (kh == 1) { cmb[0] = mrun; cmb[64] = lsum;
#pragma unroll
        for (int dt = 0; dt < 8; ++dt)
#pragma unroll
            for (int jj = 0; jj < 4; ++jj) cmb[(2 + dt * 4 + jj) * 64] = O[dt][jj]; }
    __syncthreads();
    if (kh == 0) { const float m1 = cmb[0], l1 = cmb[64];
        const float mn = fmaxf(mrun, m1), a0 = __expf(mrun - mn), a1 = __expf(m1 - mn);
        const float inv = 1.0f / (lsum * a0 + l1 * a1);
        bf16_t* yo = YN + (size_t)qrow * 1024 + h * 128 + 4 * g;
#pragma unroll
        for (int dt = 0; dt < 8; ++dt) { float o[4];
#pragma unroll
            for (int jj = 0; jj < 4; ++jj) o[jj] = (O[dt][jj] * a0 + cmb[(2 + dt * 4 + jj) * 64] * a1) * inv;
            u32x2 ov; ov[0] = pack2(o[0], o[1]); ov[1] = pack2(o[2], o[3]); *(u32x2*)(yo + dt * 16) = ov; } }
}

__device__ void phase_mix(PP p, int l, float* lds, int which = 7) {
    const int TIDX = otid();
    for (int t = blockIdx.x; t < 256; t += gridDim.x) {
        if (t < 128) { if (which & 1) rwkv_scan(p, l, t, lds); }
        else if (which & 2) mlstm_scan(p, l, (t - 128) >> 3, (t - 128) & 7, lds);
        __syncthreads();
    }
    unsigned* ctr = (unsigned*)(p->ws + OFF_CTL) + l * 8 + ((which & 8) ? 1 : 0);
    if (!(which & 4)) return;
    int* stask = (int*)lds;
    const int ntask = l == 0 ? 1056 : 1024;
    for (;;) {
        __syncthreads();
        if (TIDX == 0) stask[0] = (int)atomicAdd(ctr, 1u);
        __syncthreads();
        const int t = stask[0];
        if (t >= ntask) break;
        if (t < 1024) na_block(p, l, t, (unsigned char*)lds); else na_wave(p, l, t - 512);
    }
}

__device__ void phase_post(PP p, int l, int nrows) {
    const int TIDX = otid();
    const int wid = TIDX >> 6, lane = TIDX & 63, gw = blockIdx.x * 8 + wid, nw = gridDim.x * 8;
    const bf16_t* P = (const bf16_t*)(p->ws + OFF_P); const bf16_t* LO = (const bf16_t*)(p->ws + OFF_LO);
    bf16_t* YM = (bf16_t*)(p->ws + OFF_Y3); bf16_t* YR = YM + (size_t)NTOK * 1024;
    const float* NUM = (const float*)(p->ws + OFF_MLNUM); const float* YF = (const float*)(p->ws + OFF_YRWF);
    for (int row = gw; row < nrows; row += nw) {
        f32x4 a[4], c[4], ng[4]; float dfr[4], dbr[4]; u32x2 ov[4];
#pragma unroll
        for (int h = 0; h < 4; ++h) {
            const float* nf = NUM + ((size_t)row * 4 + h) * 272; const float* nb = NUM + ((size_t)(NTOK + row) * 4 + h) * 272;
            a[h] = *(const f32x4*)(nf + lane * 4); c[h] = *(const f32x4*)(nb + lane * 4); dfr[h] = nf[256]; dbr[h] = nb[256];
            ov[h] = *(const u32x2*)(P + (size_t)row * NP + 2048 + h * 256 + lane * 4);
            ng[h] = *(const f32x4*)(p->in[I_MLNG] + l * 1024 + h * 256 + lane * 4); }
#pragma unroll
        for (int h = 0; h < 4; ++h) {
            const float df = 1.0f / fmaxf(fabsf(dfr[h]), 1.0f), db = 1.0f / fmaxf(fabsf(dbr[h]), 1.0f);
            float hv[4]; float ss = 0.f;
#pragma unroll
            for (int j = 0; j < 4; ++j) { hv[j] = a[h][j] * df + c[h][j] * db; ss += hv[j] * hv[j]; }
            ss = wsum(ss);
            const float rr = rsqrtf(ss * (1.0f / 256.0f) + 1e-6f);
            const float o0 = hv[0] * rr * ng[h][0] * sigmoidf(bflo(ov[h][0])), o1 = hv[1] * rr * ng[h][1] * sigmoidf(bfhi(ov[h][0]));
            const float o2 = hv[2] * rr * ng[h][2] * sigmoidf(bflo(ov[h][1])), o3 = hv[3] * rr * ng[h][3] * sigmoidf(bfhi(ov[h][1]));
            u32x2 w; w[0] = pack2(o0, o1); w[1] = pack2(o2, o3);
            *(u32x2*)(YM + (size_t)row * 1024 + h * 256 + lane * 4) = w; }
    }
    const float* MU = p->in[I_RWMU] + (size_t)l * 3712;
    for (int it = gw; it < nrows * 2; it += nw) {
        const int row = it >> 1, hq = (it & 1) * 8;
        bool hp, hn; seq_nbrs(row, hp, hn);
        float y0[8], y1[8], gg[8]; bf16_t rc[8], kc[8], vc[8], rp[8], kp[8], vp[8], rn[8], kn[8], vn[8];
#pragma unroll
        for (int u = 0; u < 8; ++u) { const int c = (hq + u) * 64 + lane;
            y0[u] = YF[(size_t)row * 1024 + c]; y1[u] = YF[(size_t)(NTOK + row) * 1024 + c];
            const bf16_t* pr = P + (size_t)row * NP + RWB + c;
            rc[u] = pr[0]; kc[u] = pr[1024]; vc[u] = pr[2048];
            rp[u] = hp ? pr[-NP] : (bf16_t)0; kp[u] = hp ? pr[-NP + 1024] : (bf16_t)0; vp[u] = hp ? pr[-NP + 2048] : (bf16_t)0;
            rn[u] = hn ? pr[NP] : (bf16_t)0; kn[u] = hn ? pr[NP + 1024] : (bf16_t)0; vn[u] = hn ? pr[NP + 2048] : (bf16_t)0;
            gg[u] = bf2f(LO[(size_t)row * 5120 + 4096 + c]); }
#pragma unroll
        for (int u = 0; u < 8; ++u) { const int c = (hq + u) * 64 + lane;
            const float y = y0[u] + y1[u];
            const float mean = wsum(y) * (1.0f / 64.0f);
            const float dy = y - mean;
            const float var = wsum(dy * dy) * (1.0f / 64.0f);
            const float yn = dy * rsqrtf(var + 64e-5f);
            const float rr = shiftf(bf2f(rc[u]), bf2f(rp[u]), bf2f(rn[u]), MU[c]), kk = shiftf(bf2f(kc[u]), bf2f(kp[u]), bf2f(kn[u]), MU[1024 + c]), vv = shiftf(bf2f(vc[u]), bf2f(vp[u]), bf2f(vn[u]), MU[2048 + c]);
            const float bonus = wsum(rr * kk * p->in[I_RWRK][l * 1024 + c]) * vv;
            const float o = (yn * p->in[I_RWLNW][l * 1024 + c] + p->in[I_RWLNB][l * 1024 + c] + bonus) * gg[u];
            YR[(size_t)row * 1024 + c] = f2bf(o); }
    }
}


#ifndef DUPMASK
#define DUPMASK 0
#endif
#ifndef DUPWHICH
#define DUPWHICH 3
#endif
__global__ void __launch_bounds__(512, 2) fwd_kernel(Params p0) {
    extern __shared__ __attribute__((aligned(16))) unsigned char shm[];
    cg::grid_group grid = cg::this_grid();
    float* ldsf = (float*)shm;
    LAS unsigned char* ldsg = (LAS unsigned char*)shm;
    const int ph_lo = p0.ph_lo, ph_hi = p0.ph_hi;
    auto kseg = __builtin_amdgcn_kernarg_segment_ptr();
    for (int ph = ph_lo; ph < ph_hi; ++ph) {
        if (ph > ph_lo) grid.sync();
        PP p = (PP)kseg; asm volatile("" : "+s"(p));
        unsigned char* ws = p->ws;
        const float* MOD = (const float*)(ws + OFF_MOD);
        float* XL = (float*)(ws + OFF_XL);
        bf16_t* H = (bf16_t*)(ws + OFF_H);
        bf16_t* Pb = (bf16_t*)(ws + OFF_P);
        if (ph == 0) { phase_mod(p, ldsf); __syncthreads(); phase_convert(p, 0, ldsf, (int)blockIdx.x, (int)gridDim.x, 0); continue; }
        if (ph == NPHASE - 1) { phase_final(p); continue; }
        const int l = (ph - 1) / 11, sub = (ph - 1) % 11;
        const int two_wt = p->two_wt;
        const size_t wsh = (l == 1 && two_wt) ? WT_SHIFT : 0;
#if DUPMASK
        for (int rep = 0; rep < (((DUPMASK >> sub) & 1) ? 2 : 1); ++rep) { if (rep) grid.sync();
#endif
        const int Ml = l == 0 ? NTOK : NLAT;
        const float* modl = MOD + (size_t)l * 3 * 12288;
        if (sub == 1 || sub == 3 || sub == 6 || sub == 7 || sub == 9 || sub == 10) {
            pg8::Gemm g; pg8::SchedG S; pg8::EpiG E;
            S.mode = 0; S.mo.init(Ml / 256, (int)gridDim.x, (int)blockIdx.x);
            E.kind = 0; E.O = Pb; E.ldc = NP; E.P = Pb; E.ACC = (float*)(ws + OFF_YRWF);
            E.xin_lat = XL; E.xin_ctx = XL + (size_t)NLAT * 2048; E.XL = XL; E.gate = modl;
            if (sub == 1) { g = pg8::Gemm{H, (const bf16_t*)(ws + wsh + OFF_WIN), NTOK, NP, 2048}; }
            else if (sub == 3) { g = pg8::Gemm{(const bf16_t*)(ws + OFF_LA), (const bf16_t*)(ws + wsh + OFF_WLORA), NTOK, 5120, 640}; E.O = (bf16_t*)(ws + OFF_LO); E.ldc = 5120; }
            else if (sub == 6) { g = pg8::Gemm{(const bf16_t*)(ws + OFF_Y3), (const bf16_t*)(ws + wsh + OFF_WBR), Ml, 2048, 1024}; S.mode = 1; E.kind = 2; E.O = H; }
            else if (sub == 7) { g = pg8::Gemm{H, (const bf16_t*)(ws + wsh + OFF_WOUT), Ml, 2048, 2048}; E.kind = 3; E.gate = modl + 2 * 2048;
                if (l == 0) { E.xin_lat = p->in[I_X]; E.xin_ctx = p->in[I_CTX]; } }
            else if (sub == 9) { g = pg8::Gemm{H, (const bf16_t*)(ws + wsh + OFF_WFF1), Ml, DFF, 2048}; E.kind = 1; E.ldc = DFF; }
            else { g = pg8::Gemm{Pb, (const bf16_t*)(ws + wsh + OFF_WFF2), Ml, 2048, DFF}; E.kind = 3; E.gate = modl + 5 * 2048; }
            S.so.init(g.M, g.N, (int)gridDim.x, (int)blockIdx.x);
            pg8::gemm_phase(ldsg, g, S, E);
            if (sub == 10 && l == 0 && two_wt) {
                const int idle0 = gridDim.x == 256 ? 16 : 0;
                if ((int)blockIdx.x >= idle0) phase_convert(p, 1, ldsf, (int)blockIdx.x - idle0, (int)gridDim.x - idle0, WT_SHIFT);
            }
        } else
        switch (sub) {
        case 0: {
            phase_init(p, l);
            if (l == 1 && !two_wt) phase_convert(p, l, ldsf, (int)blockIdx.x, (int)gridDim.x, wsh);
            if (l == 0) phase_norm(p->in[I_X], p->in[I_CTX], NTOK, p->in[I_N1G] + l * 2048, modl, 0, 1, H);
            else phase_norm(XL, XL + (size_t)NLAT * 2048, NTOK, p->in[I_N1G] + l * 2048, modl, 0, 1, H);
        } break;
        case 2: phase_prep(p, l, (bf16_t*)shm); break;
#if DUPMASK
        case 4: phase_mix(p, l, ldsf, rep ? DUPWHICH : 7); break;
#else
        case 4: phase_mix(p, l, ldsf); break;
#endif
        case 5: phase_post(p, l, Ml); break;
        case 8: phase_norm(XL, XL + (size_t)NLAT * 2048, Ml, p->in[I_N2G] + l * 2048, modl, 3, 4, H); break;
        }
#if DUPMASK
        }
#endif
    }
}

extern "C" void kernel_launch(void* const* d_in, const int* in_sizes, int n_in, void* d_out, int out_size, void* d_ws, size_t ws_size, hipStream_t stream) {
    static int grid = 0;
    if (grid == 0) {
        if (n_in != 28 || ws_size < WS_END) { fprintf(stderr, "kernel_launch: need 28 inputs and %zu bytes of workspace (got %d, %zu)\n", (size_t)WS_END, n_in, ws_size); grid = -1; return; }
        if (hipFuncSetAttribute((const void*)fwd_kernel, hipFuncAttributeMaxDynamicSharedMemorySize, LDS_BYTES) != hipSuccess) { fprintf(stderr, "kernel_launch: hipFuncSetAttribute failed\n"); grid = -1; return; }
        int dev = 0, cus = 0, per_cu = 0;
        hipGetDevice(&dev);
        hipDeviceGetAttribute(&cus, hipDeviceAttributeMultiprocessorCount, dev);
        hipOccupancyMaxActiveBlocksPerMultiprocessor(&per_cu, (const void*)fwd_kernel, 512, LDS_BYTES);
        if (per_cu < 1) { fprintf(stderr, "kernel_launch: occupancy query says %d blocks per CU\n", per_cu); per_cu = 1; }
        (void)hipGetLastError();
        grid = cus * 1;
        if (grid > 256) grid = 256;
    }
    if (grid < 0) return;
    Params p{};
    for (int i = 0; i < 28; ++i) p.in[i] = (const float*)d_in[i];
    p.out = (float*)d_out; p.ws = (unsigned char*)d_ws; p.two_wt = (ws_size >= WS_END + WT_BYTES) ? 1 : 0;
#if ONE_LAUNCH
    p.ph_lo = 0; p.ph_hi = NPHASE;
    void* args[] = {&p};
    hipError_t e = hipLaunchCooperativeKernel((const void*)fwd_kernel, dim3(grid), dim3(512), args, LDS_BYTES, stream);
    if (e != hipSuccess) fprintf(stderr, "cooperative launch failed: %s (grid %d)\n", hipGetErrorString(e), grid);
#else
    for (int ph = 0; ph < NPHASE; ++ph) {
        p.ph_lo = ph; p.ph_hi = ph + 1;
        hipLaunchKernelGGL(fwd_kernel, dim3(grid), dim3(512), LDS_BYTES, stream, p);
    }
#endif
}
```

```cpp
#include <hip/hip_runtime.h>
#include <hip/hip_cooperative_groups.h>
#include <cstdio>
namespace cg = cooperative_groups;

#ifndef ONE_LAUNCH
#define ONE_LAUNCH 1
#endif

#define DEVI __device__ __forceinline__
#define LAS __attribute__((address_space(3)))
typedef unsigned short bf16_t;
typedef short bf16x8 __attribute__((ext_vector_type(8)));
typedef short bf16x4 __attribute__((ext_vector_type(4)));
typedef float f32x4 __attribute__((ext_vector_type(4)));
typedef float f32x2 __attribute__((ext_vector_type(2)));
typedef unsigned u32x4 __attribute__((ext_vector_type(4)));
typedef unsigned u32x2 __attribute__((ext_vector_type(2)));

constexpr int D = 2048, NTOK = 8704, NLAT = 8192, NP = 16128, DIN = 16016, DFF = 8192;
constexpr int RWB = 3088, NAB = 6800, GTB = 9872;
constexpr int LDS_BYTES = 131072;
constexpr int NPHASE = 24;

constexpr size_t OFF_CTL = 0;
constexpr size_t OFF_MOD = 4096;
constexpr size_t OFF_ROPE = OFF_MOD + 2ull * 3 * 12288 * 4;
constexpr size_t OFF_WIN = OFF_ROPE + 16384;
constexpr size_t OFF_WBR = OFF_WIN + 16128ull * 2048 * 2;
constexpr size_t OFF_WOUT = OFF_WBR + 3ull * 2048 * 1024 * 2;
constexpr size_t OFF_WFF1 = OFF_WOUT + 2048ull * 2048 * 2;
constexpr size_t OFF_WFF2 = OFF_WFF1 + 8192ull * 2048 * 2;
constexpr size_t OFF_WLORA = OFF_WFF2 + 8192ull * 2048 * 2;
constexpr size_t OFF_XL = OFF_WLORA + 5120ull * 640 * 2;
constexpr size_t OFF_H = OFF_XL + 8704ull * 2048 * 4;
constexpr size_t OFF_P = OFF_H + 8704ull * 2048 * 2;
constexpr size_t OFF_LA = OFF_P + 8704ull * 16128 * 2;
constexpr size_t OFF_LO = OFF_LA + 8704ull * 640 * 2;
constexpr size_t OFF_YRWF = OFF_LO + 8704ull * 5120 * 2;
constexpr size_t OFF_MLNUM = OFF_YRWF + 2ull * 8704 * 1024 * 4;
constexpr size_t OFF_VT = OFF_MLNUM + 2ull * 8704 * 4 * 272 * 4;
constexpr size_t OFF_Y3 = OFF_VT + 2ull * 8 * 128 * 4352 * 2;
constexpr size_t OFF_RK = OFF_Y3 + 3ull * 8704 * 1024 * 2;
constexpr size_t WS_END = OFF_RK + 8704ull * 16 * 4;
constexpr size_t WT_BYTES = OFF_XL - OFF_WIN, WT_SHIFT = WS_END - OFF_WIN;

struct Params {
    const float* in[28];
    float* out;
    unsigned char* ws;
    int ph_lo, ph_hi, two_wt, pad_;
};
typedef const __attribute__((address_space(4))) Params* PP;
enum { I_X = 0, I_C, I_CTX, I_CCTX, I_WMOD, I_BMOD, I_N1G, I_WIN, I_MLGB, I_MLNG, I_RWMU, I_RWW0, I_RWWUP, I_RWA0, I_RWAUP, I_RWGUP,
       I_RWKK, I_RWKA, I_RWRK, I_RWLNW, I_RWLNB, I_RPB, I_WBR, I_WOUT, I_N2G, I_WFF1, I_WFF2, I_FING };

DEVI int otid() { int t; asm volatile("v_mov_b32 %0, %1" : "=v"(t) : "v"((int)threadIdx.x)); return t; }
DEVI float bf2f(bf16_t b) { return __uint_as_float(((unsigned)b) << 16); }
DEVI float bflo(unsigned u) { return __uint_as_float(u << 16); }
DEVI float bfhi(unsigned u) { return __uint_as_float(u & 0xffff0000u); }
DEVI bf16_t f2bf(float f) { unsigned u = __float_as_uint(f); u += 0x7FFFu + ((u >> 16) & 1u); return (bf16_t)(u >> 16); }
DEVI unsigned pack2(float lo, float hi) { return (unsigned)f2bf(lo) | ((unsigned)f2bf(hi) << 16); }
DEVI float sigmoidf(float x) { return 1.0f / (1.0f + __expf(-x)); }
#define DPP_ADD(x, CTRL) ((x) + __int_as_float(__builtin_amdgcn_update_dpp(0, __float_as_int(x), CTRL, 0xF, 0xF, true)))
DEVI float wsum(float x) {
    x = DPP_ADD(x, 0xB1); x = DPP_ADD(x, 0x4E); x = DPP_ADD(x, 0x141); x = DPP_ADD(x, 0x140);
    const int xi = __float_as_int(x);
    return (__int_as_float(__builtin_amdgcn_readlane(xi, 0)) + __int_as_float(__builtin_amdgcn_readlane(xi, 16))) + (__int_as_float(__builtin_amdgcn_readlane(xi, 32)) + __int_as_float(__builtin_amdgcn_readlane(xi, 48)));
}
DEVI float red8(float x) {
    x = DPP_ADD(x, 0xB1);
    x = DPP_ADD(x, 0x4E);
    x = DPP_ADD(x, 0x141);
    return x;
}

DEVI float red16(float x) {
    x = DPP_ADD(x, 0xB1); x = DPP_ADD(x, 0x4E); x = DPP_ADD(x, 0x141); x = DPP_ADD(x, 0x140);
    return x;
}
DEVI float sfma(float a, float b, float c) { float d; asm("v_fma_f32 %0, %1, %2, %3" : "=v"(d) : "v"(a), "v"(b), "v"(c)); return d; }
DEVI float smul(float a, float b) { float d; asm("v_mul_f32 %0, %1, %2" : "=v"(d) : "v"(a), "v"(b)); return d; }
DEVI void fadd_g(float* ptr, float v) { (void)__builtin_amdgcn_global_atomic_fadd_f32((__attribute__((address_space(1))) float*)ptr, v); }
DEVI float frcp(float x) { return __builtin_amdgcn_rcpf(x); }
DEVI float fsigmoid(float x) { return __builtin_amdgcn_rcpf(1.0f + __expf(-x)); }

namespace pg8 {
constexpr int BM = 256, BK = 64, HALF = 128, HTB = HALF * BK * 2, STAGE_BYTES = 8 * HTB, NXCD = 8, WGM = 8;
__host__ __device__ __forceinline__ int lds_byte(int r, int c) { const int st = (r >> 4) * 2 + (c >> 5), rr = r & 15, cc = c & 31, ob = rr * 64 + cc * 2; return st * 1024 + (ob ^ (((ob >> 9) & 1) << 5)); }
__host__ __device__ __forceinline__ void stage_rc(int b, int& R, int& C) { const int st = b / 1024, sb = b % 1024, swz = sb ^ (((sb >> 9) & 1) << 5); R = (st >> 1) * 16 + swz / 64; C = (st & 1) * 32 + (swz % 64) / 2; }
__host__ __device__ __forceinline__ int perm32(int rho) { const int n = rho >> 4, i = rho & 15; return 8 * (i >> 2) + 4 * n + (i & 3); }
struct Unit { int pm, pn; };
struct Gemm { const bf16_t* A; const bf16_t* Bt; int M, N, K, nt; };
struct StaticOrder {
    int nM, nN, nwg, G, c;
    __device__ void init(int M, int N, int G_, int c_) { nM = M / BM; nN = N / BM; nwg = nM * nN; G = G_; c = c_; }
    __device__ bool next(int i, Unit& u) const {
        const long L = (long)i * G + c; if (L >= nwg) return false;
        int wgid = (int)L; { const int q = nwg / NXCD, r = nwg % NXCD, xcd = wgid % NXCD, off = wgid / NXCD; wgid = (xcd < r ? xcd * (q + 1) : r * (q + 1) + (xcd - r) * q) + off; }
        const int nig = WGM * nN, gid = wgid / nig, fm = gid * WGM, gsz = (nM - fm) < WGM ? (nM - fm) : WGM;
        u.pm = fm + ((wgid % nig) % gsz); u.pn = (wgid % nig) / gsz; return true;
    }
    __device__ __forceinline__ void a_ready(const Unit&) const {}
    __device__ __forceinline__ void done(const Unit&) const {}
};
struct MergeOrder {
    int ntiles, G, c;
    __device__ void init(int nM, int G_, int c_) { ntiles = nM * 8; G = G_; c = c_; }
    __device__ bool next(int i, Unit& u) const {
        const int ti = i / 3, br = i - ti * 3; const long L = (long)ti * G + c; if (L >= ntiles) return false;
        const int pm = (int)L >> 3, pn = (int)L & 7; u.pm = br * 34 + pm; u.pn = br * 8 + pn; return true;
    }
    __device__ __forceinline__ void a_ready(const Unit&) const {}
    __device__ __forceinline__ void done(const Unit&) const {}
};
DEVI unsigned cvt_pk_bf16(float lo, float hi) { unsigned r; asm volatile("v_cvt_pk_bf16_f32 %0, %1, %2" : "=v"(r) : "v"(lo), "v"(hi)); return r; }


struct SchedG {
    int mode;
    StaticOrder so; MergeOrder mo;
    __device__ __forceinline__ bool next(int i, Unit& u) const {
        if (mode == 2) { if (i > 0) return false; const int cu = so.c >> 4; u.pm = 32 + (cu >> 3); u.pn = cu & 7; return true; }
        return mode == 0 ? so.next(i, u) : mo.next(i, u); }
    __device__ __forceinline__ void a_ready(const Unit&) const {}
    __device__ __forceinline__ void done(const Unit&) const {}
};
struct EpiG {
    static constexpr bool PERM = true, AFTER_DRAIN = false;
    int kind, split;
    bf16_t* O; int ldc;
    const bf16_t* P; float* ACC;
    const float* xin_lat; const float* xin_ctx; float* XL; const float* gate; float* part;
    __device__ __forceinline__ void operator()(const f32x4 (&acc)[2][2][4][2], const Unit& u, int wr, int wc, int fr, int fq) const {
        if (kind <= 1) {
            const int row0 = u.pm * BM + wr * 64 + fr, col0 = u.pn * BM + wc * 32 + 8 * fq;
#pragma unroll
            for (int ai = 0; ai < 2; ++ai)
#pragma unroll
                for (int m = 0; m < 4; ++m) { bf16_t* rowp = O + (size_t)(row0 + ai * HALF + m * 16) * ldc + col0;
#pragma unroll
                    for (int bj = 0; bj < 2; ++bj) { f32x4 v0 = acc[ai][bj][m][0], v1 = acc[ai][bj][m][1];
                        if (kind == 1) {
#pragma unroll
                            for (int i = 0; i < 4; ++i) { float a = fmaxf(v0[i], 0.f), b = fmaxf(v1[i], 0.f); v0[i] = a * a; v1[i] = b * b; } }
                        u32x4 o; o[0] = cvt_pk_bf16(v0[0], v0[1]); o[1] = cvt_pk_bf16(v0[2], v0[3]); o[2] = cvt_pk_bf16(v1[0], v1[1]); o[3] = cvt_pk_bf16(v1[2], v1[3]);
                        *(u32x4*)(rowp + bj * HALF) = o; } }
        } else if (kind == 2) {
            const int br = u.pn >> 3, pn = u.pn & 7, pm = u.pm - br * 34;
            const int row0 = pm * BM + wr * 64 + fr, col0 = pn * BM + wc * 32 + 8 * fq;
#pragma unroll
            for (int ai = 0; ai < 2; ++ai)
#pragma unroll
                for (int m = 0; m < 4; ++m) { const size_t row = (size_t)(row0 + ai * HALF + m * 16);
#pragma unroll
                    for (int bj = 0; bj < 2; ++bj) { const int col = col0 + bj * HALF;
                        const u32x4 gv = *(const u32x4*)(P + row * NP + GTB + br * 2048 + col);
                        f32x4 v0 = acc[ai][bj][m][0], v1 = acc[ai][bj][m][1];
                        v0[0] *= sigmoidf(bflo(gv[0])); v0[1] *= sigmoidf(bfhi(gv[0])); v0[2] *= sigmoidf(bflo(gv[1])); v0[3] *= sigmoidf(bfhi(gv[1]));
                        v1[0] *= sigmoidf(bflo(gv[2])); v1[1] *= sigmoidf(bfhi(gv[2])); v1[2] *= sigmoidf(bflo(gv[3])); v1[3] *= sigmoidf(bfhi(gv[3]));
                        float* ap = ACC + row * 2048 + col;
                        if (br == 0) { *(f32x4*)ap = v0; *(f32x4*)(ap + 4) = v1; }
                        else { v0 += *(const f32x4*)ap; v1 += *(const f32x4*)(ap + 4);
                            if (br == 1) { *(f32x4*)ap = v0; *(f32x4*)(ap + 4) = v1; }
                            else { u32x4 o; o[0] = cvt_pk_bf16(v0[0], v0[1]); o[1] = cvt_pk_bf16(v0[2], v0[3]); o[2] = cvt_pk_bf16(v1[0], v1[1]); o[3] = cvt_pk_bf16(v1[2], v1[3]);
                                *(u32x4*)(O + row * 2048 + col) = o; } } } }
        } else {
            const int row0 = u.pm * BM + wr * 64 + fr, col0 = u.pn * BM + wc * 32 + 8 * fq;
#pragma unroll
            for (int ai = 0; ai < 2; ++ai)
#pragma unroll
                for (int m = 0; m < 4; ++m) { const int row = row0 + ai * HALF + m * 16;
                    const int mrow = row < NLAT ? (row >> 12) : 2;
                    const float* xr = row < NLAT ? xin_lat + (size_t)row * 2048 : xin_ctx + (size_t)(row - NLAT) * 2048;
                    const float* gr = gate + (size_t)mrow * 12288; float* orow = XL + (size_t)row * 2048;
#pragma unroll
                    for (int bj = 0; bj < 2; ++bj)
#pragma unroll
                        for (int n = 0; n < 2; ++n) { const int col = col0 + bj * HALF + n * 4;
                            const f32x4 g = *(const f32x4*)(gr + col);
                            if (split) *(f32x4*)(part + (size_t)(row - NLAT) * 2048 + col) = acc[ai][bj][m][n];
                            else { const f32x4 x = *(const f32x4*)(xr + col); *(f32x4*)(orow + col) = x + g * acc[ai][bj][m][n]; } } }
        }
    }
};
template <class Epi, class Sched>
__device__ __forceinline__ void gemm_phase(LAS unsigned char* lds, const Gemm g, const Sched& S, const Epi& E) {
    const int tid = otid(), wid = __builtin_amdgcn_readfirstlane(tid >> 6), lane = tid & 63, wr = wid >> 2, wc = wid & 3, fr = lane & 15, fq = lane >> 4;
    const int K = g.K, nt = g.nt;
    unsigned voffA[2], voffB[2];
#pragma unroll
    for (int i = 0; i < 2; ++i) { int R, C; stage_rc(tid * 16 + i * 8192, R, C); const int Rb = Epi::PERM ? ((R & ~31) + perm32(R & 31)) : R;
        voffA[i] = (unsigned)(R * K + C) * 2u; voffB[i] = (unsigned)(Rb * K + C) * 2u; }
    const size_t kstep = (size_t)(BK * 2);
    const size_t hstep = (size_t)HALF * K * 2;
    const size_t tstep = 2 * hstep;
    const unsigned ldsw = (unsigned)wid * 1024u;
    const int aoff = lds_byte(wr * 64 + fr, fq * 8), boff = lds_byte(wc * 32 + fr, fq * 8);
#define PG8_SA(b, h) (((b) * 2 + (h)) * HTB)
#define PG8_SB(b, h) ((4 + (b) * 2 + (h)) * HTB)
#define PG8_STAGE(bufoff, gbase, voff) do { _Pragma("unroll") for (int _i = 0; _i < 2; ++_i) \
        __builtin_amdgcn_global_load_lds((const unsigned*)((const char*)(gbase) + (voff)[_i]), (LAS unsigned*)(lds + (bufoff) + ldsw + _i * 8192), 16, 0, 0); } while (0)
#define PG8_LDA(dst, b, h) do { _Pragma("unroll") for (int m = 0; m < 4; ++m) _Pragma("unroll") for (int k = 0; k < 2; ++k) dst[m][k] = *(const LAS bf16x8*)(lds + PG8_SA(b, h) + aoff + m * 2048 + k * 1024); } while (0)
#define PG8_LDB(dst, b, h) do { _Pragma("unroll") for (int n = 0; n < 2; ++n) _Pragma("unroll") for (int k = 0; k < 2; ++k) dst[n][k] = *(const LAS bf16x8*)(lds + PG8_SB(b, h) + boff + n * 2048 + k * 1024); } while (0)
#define PG8_MMA(ai, bj, At, Bt) do { __builtin_amdgcn_s_setprio(1); _Pragma("unroll") for (int m = 0; m < 4; ++m) _Pragma("unroll") for (int n = 0; n < 2; ++n) _Pragma("unroll") for (int k = 0; k < 2; ++k) \
        acc[ai][bj][m][n] = __builtin_amdgcn_mfma_f32_16x16x32_bf16(Bt[n][k], At[m][k], acc[ai][bj][m][n], 0, 0, 0); __builtin_amdgcn_s_setprio(0); } while (0)
#define PG8_WAIT_V(n) asm volatile("s_waitcnt vmcnt(" #n ")" ::: "memory")
#define PG8_WAIT_L(n) asm volatile("s_waitcnt lgkmcnt(" #n ")" ::: "memory")
#define PG8_BAR __builtin_amdgcn_s_barrier()
#define PG8_SCHED __builtin_amdgcn_sched_barrier(0)
    Unit cur, nxt; int ui = 0;
    if (!S.next(0, cur)) return;
    f32x4 acc[2][2][4][2];
#pragma unroll
    for (int a = 0; a < 2; ++a)
#pragma unroll
        for (int b = 0; b < 2; ++b)
#pragma unroll
            for (int m = 0; m < 4; ++m)
#pragma unroll
                for (int n = 0; n < 2; ++n) acc[a][b][m][n] = (f32x4){0.f, 0.f, 0.f, 0.f};
    bf16x8 At[4][2], B0[2][2], B1[2][2];
    const char* cA = (const char*)g.A + (size_t)cur.pm * tstep; const char* cB = (const char*)g.Bt + (size_t)cur.pn * tstep;
    S.a_ready(cur);
    PG8_STAGE(PG8_SB(0, 0), cB, voffB); PG8_STAGE(PG8_SA(0, 0), cA, voffA); PG8_STAGE(PG8_SB(0, 1), cB + hstep, voffB); PG8_STAGE(PG8_SA(0, 1), cA + hstep, voffA);
    if (wr == 1) PG8_BAR;
    PG8_WAIT_V(4); PG8_BAR;
    PG8_STAGE(PG8_SB(1, 0), cB + kstep, voffB); PG8_STAGE(PG8_SA(1, 0), cA + kstep, voffA); PG8_STAGE(PG8_SB(1, 1), cB + hstep + kstep, voffB);
    PG8_WAIT_V(6); PG8_BAR;
    for (;;) {
        const bool has_next = S.next(ui + 1, nxt);
        const char* nA = has_next ? (const char*)g.A + (size_t)nxt.pm * tstep : cA; const char* nB = has_next ? (const char*)g.Bt + (size_t)nxt.pn * tstep : cB;
        for (int t = 0; t < nt; t += 2) {
            const bool last = (t == nt - 2);
            const char* a1 = cA + (size_t)(t + 1) * kstep;
            const char* a2 = last ? nA : cA + (size_t)(t + 2) * kstep; const char* b2 = last ? nB : cB + (size_t)(t + 2) * kstep;
            const char* a3 = a2 + kstep; const char* b3 = b2 + kstep;
            if (last && has_next) S.a_ready(nxt);
            PG8_LDB(B0, 0, 0); PG8_SCHED; PG8_LDA(At, 0, 0); PG8_STAGE(PG8_SA(1, 1), a1 + hstep, voffA);
            PG8_WAIT_L(8); PG8_BAR; PG8_WAIT_L(0); PG8_MMA(0, 0, At, B0); PG8_BAR; PG8_SCHED;
            PG8_LDB(B1, 0, 1); PG8_STAGE(PG8_SB(0, 0), b2, voffB);
            PG8_BAR; PG8_WAIT_L(0); PG8_MMA(0, 1, At, B1); PG8_BAR;
            PG8_LDA(At, 0, 1); PG8_STAGE(PG8_SA(0, 0), a2, voffA);
            PG8_BAR; PG8_WAIT_L(0); PG8_MMA(1, 0, At, B0); PG8_BAR; PG8_SCHED;
            PG8_STAGE(PG8_SB(0, 1), b2 + hstep, voffB);
            PG8_WAIT_V(6); PG8_BAR; PG8_MMA(1, 1, At, B1); PG8_BAR;
            PG8_LDB(B0, 1, 0); PG8_SCHED; PG8_LDA(At, 1, 0); PG8_STAGE(PG8_SA(0, 1), a2 + hstep, voffA);
            PG8_WAIT_L(8); PG8_BAR; PG8_WAIT_L(0); PG8_MMA(0, 0, At, B0); PG8_BAR; PG8_SCHED;
            PG8_LDB(B1, 1, 1); PG8_STAGE(PG8_SB(1, 0), b3, voffB);
            PG8_BAR; PG8_WAIT_L(0); PG8_MMA(0, 1, At, B1); PG8_BAR;
            PG8_LDA(At, 1, 1); PG8_STAGE(PG8_SA(1, 0), a3, voffA);
            PG8_BAR; PG8_WAIT_L(0); PG8_MMA(1, 0, At, B0); PG8_BAR; PG8_SCHED;
            PG8_STAGE(PG8_SB(1, 1), b3 + hstep, voffB);
            PG8_WAIT_V(6); PG8_BAR; PG8_MMA(1, 1, At, B1); PG8_BAR;
        }
        if constexpr (!Epi::AFTER_DRAIN) { E(acc, cur, wr, wc, fr, fq); S.done(cur); }
        if (!has_next) break;
#pragma unroll
        for (int a = 0; a < 2; ++a)
#pragma unroll
            for (int b = 0; b < 2; ++b)
#pragma unroll
                for (int m = 0; m < 4; ++m)
#pragma unroll
                    for (int n = 0; n < 2; ++n) acc[a][b][m][n] = (f32x4){0.f, 0.f, 0.f, 0.f};
        cur = nxt; cA = nA; cB = nB; ++ui;
    }
    PG8_WAIT_V(0);
    if (wr == 0) PG8_BAR;
    PG8_BAR;
    if constexpr (Epi::AFTER_DRAIN) { E.fused(acc, cur, wr, wc, fr, fq, lds, wid, lane); S.done(cur); }
#undef PG8_SA
#undef PG8_SB
#undef PG8_STAGE
#undef PG8_LDA
#undef PG8_LDB
#undef PG8_MMA
#undef PG8_WAIT_V
#undef PG8_WAIT_L
#undef PG8_BAR
#undef PG8_SCHED
}
}

__device__ void phase_mod(PP p, float* lds) {
    const int TIDX = otid();
    const int tid = TIDX;
    float* s = lds;
    float* red = lds + 3 * 2048;
    float* MOD = (float*)(p->ws + OFF_MOD);
    for (int i = tid; i < 3 * 2048; i += 512) { const int r = i >> 11, k = i & 2047; const float c = r < 2 ? p->in[I_C][r * 2048 + k] : p->in[I_CCTX][k]; s[i] = c * sigmoidf(c); }
    __syncthreads();
    for (int task = blockIdx.x; task < 192; task += gridDim.x) {
        const int l = task / 96, j0 = (task % 96) * 128, jc = tid & 127, kp = tid >> 7;
        const float* w = p->in[I_WMOD] + (size_t)l * 2048 * 12288 + j0 + jc;
        float a0 = 0.f, a1 = 0.f, a2 = 0.f;
#pragma unroll 8
        for (int k = kp * 512; k < kp * 512 + 512; ++k) { const float wv = w[(size_t)k * 12288]; a0 += s[k] * wv; a1 += s[2048 + k] * wv; a2 += s[4096 + k] * wv; }
        red[(kp * 3 + 0) * 128 + jc] = a0; red[(kp * 3 + 1) * 128 + jc] = a1; red[(kp * 3 + 2) * 128 + jc] = a2;
        __syncthreads();
        if (tid < 384) { const int r = tid >> 7, j = tid & 127;
            const float v = ((red[(0 * 3 + r) * 128 + j] + red[(1 * 3 + r) * 128 + j]) + (red[(2 * 3 + r) * 128 + j] + red[(3 * 3 + r) * 128 + j])) + p->in[I_BMOD][l * 12288 + j0 + j];
            MOD[(size_t)(l * 3 + r) * 12288 + j0 + j] = v; }
        __syncthreads();
    }
    if (blockIdx.x == gridDim.x - 1) {
        float* rc = (float*)(p->ws + OFF_ROPE); float* rs = rc + 2048;
        for (int i = tid; i < 2048; i += 512) { const int pos = i >> 5, j = i & 31; const float fr = powf(10000.0f, -(float)j / 32.0f); const float ang = (float)pos * fr; rc[i] = cosf(ang); rs[i] = sinf(ang); }
    }
}

__device__ void conv_tile(const float* __restrict__ src, int ld_src, int n_valid, int n0, int k0, bf16_t* __restrict__ dst, int ld_dst, float* tile) {
    const int TIDX = otid();
    const int tid = TIDX;
#pragma unroll
    for (int i = 0; i < 2; ++i) { const int kr = (tid >> 4) + i * 32, nc = (tid & 15) * 4; const float* sp = src + (size_t)(k0 + kr) * ld_src + n0 + nc;
        f32x4 v;
        if (n0 + nc + 3 < n_valid) v = *(const f32x4*)sp;
        else { v[0] = (n0 + nc + 0 < n_valid) ? sp[0] : 0.f; v[1] = (n0 + nc + 1 < n_valid) ? sp[1] : 0.f; v[2] = (n0 + nc + 2 < n_valid) ? sp[2] : 0.f; v[3] = (n0 + nc + 3 < n_valid) ? sp[3] : 0.f; }
        float* tp = tile + kr * 65 + nc; tp[0] = v[0]; tp[1] = v[1]; tp[2] = v[2]; tp[3] = v[3]; }
    __syncthreads();
    { const int n = tid >> 3, kc = (tid & 7) * 8; u32x4 o;
#pragma unroll
        for (int j = 0; j < 4; ++j) o[j] = pack2(tile[(kc + 2 * j) * 65 + n], tile[(kc + 2 * j + 1) * 65 + n]);
        *(u32x4*)(dst + (size_t)(n0 + n) * ld_dst + k0 + kc) = o; }
    __syncthreads();
}
__device__ void phase_convert(PP p, int l, float* lds, int vb, int vg, size_t wsh, int t_lo, int t_hi, bool lora) {
    const int TIDX = otid();
    unsigned char* wsw = p->ws + wsh;
    for (int t = t_lo + vb; t < t_hi; t += vg) {
        if (t < 8064) { const int nt = t >> 5, kt = t & 31; conv_tile(p->in[I_WIN] + (size_t)l * 2048 * DIN, DIN, DIN, nt * 64, kt * 64, (bf16_t*)(wsw + OFF_WIN), 2048, lds); }
        else if (t < 9600) { const int tt = t - 8064, br = tt >> 9, r = tt & 511, nt = r >> 4, kt = r & 15;
            conv_tile(p->in[I_WBR] + (size_t)(l * 3 + br) * 1024 * 2048, 2048, 2048, nt * 64, kt * 64, (bf16_t*)(wsw + OFF_WBR) + (size_t)br * 2048 * 1024, 1024, lds); }
        else if (t < 10624) { const int tt = t - 9600, nt = tt >> 5, kt = tt & 31; conv_tile(p->in[I_WOUT] + (size_t)l * 2048 * 2048, 2048, 2048, nt * 64, kt * 64, (bf16_t*)(wsw + OFF_WOUT), 2048, lds); }
        else if (t < 14720) { const int tt = t - 10624, nt = tt >> 5, kt = tt & 31; conv_tile(p->in[I_WFF1] + (size_t)l * 2048 * 8192, 8192, 8192, nt * 64, kt * 64, (bf16_t*)(wsw + OFF_WFF1), 2048, lds); }
        else { const int tt = t - 14720, nt = tt >> 7, kt = tt & 127; conv_tile(p->in[I_WFF2] + (size_t)l * 8192 * 2048, 2048, 2048, nt * 64, kt * 64, (bf16_t*)(wsw + OFF_WFF2), 8192, lds); }
    }
    bf16_t* WL = (bf16_t*)(wsw + OFF_WLORA);
    if (lora) for (int idx = vb * 512 + TIDX; idx < 5120 * 640; idx += vg * 512) {
        const int n = idx / 640, k = idx - n * 640, blk = n >> 10, nn = n & 1023;
        const int k0 = blk < 4 ? blk * 96 : 384, kw = blk < 4 ? 96 : 256;
        float v = 0.f;
        if (k >= k0 && k < k0 + kw) {
            const float* sp = blk < 2 ? p->in[I_RWWUP] + (size_t)(l * 2 + blk) * 96 * 1024 : (blk < 4 ? p->in[I_RWAUP] + (size_t)(l * 2 + blk - 2) * 96 * 1024 : p->in[I_RWGUP] + (size_t)l * 256 * 1024);
            v = sp[(size_t)(k - k0) * 1024 + nn]; }
        WL[idx] = f2bf(v);
    }
}
__device__ void phase_init(PP p, int l) {
    const int TIDX = otid();
    if (blockIdx.x == 0 && TIDX < 8) ((unsigned*)(p->ws + OFF_CTL))[l * 8 + TIDX] = 0u;
}

__device__ __forceinline__ void phase_norm(const float* __restrict__ xlat, const float* __restrict__ xctx, int nrows, const float* __restrict__ g, const float* __restrict__ modl, int ishift, int iscale, bf16_t* __restrict__ H,
                           const float* part = nullptr, const float* pgate = nullptr, float* xl_ctx = nullptr) {
    const int TIDX = otid();
    const int wid = TIDX >> 6, lane = TIDX & 63;
    for (int row = blockIdx.x * 8 + wid; row < nrows; row += gridDim.x * 8) {
        const float* xr = row < NLAT ? xlat + (size_t)row * 2048 : xctx + (size_t)(row - NLAT) * 2048;
        const int mrow = row < NLAT ? (row >> 12) : 2;
        const float* sh = modl + (size_t)mrow * 12288 + ishift * 2048; const float* sc = modl + (size_t)mrow * 12288 + iscale * 2048;
        f32x4 v[8]; float ss = 0.f;
#pragma unroll
        for (int i = 0; i < 8; ++i) v[i] = *(const f32x4*)(xr + (i * 64 + lane) * 4);
        if (part != nullptr && row >= NLAT) {
#pragma unroll
            for (int i = 0; i < 8; ++i) { const int col = (i * 64 + lane) * 4; const float* pp = part + (size_t)(row - NLAT) * 2048 + col;
                f32x4 a = *(const f32x4*)pp;
#pragma unroll
                for (int s_ = 1; s_ < 16; ++s_) a += *(const f32x4*)(pp + (size_t)s_ * 512 * 2048);
                v[i] += *(const f32x4*)(pgate + col) * a;
                *(f32x4*)(xl_ctx + (size_t)(row - NLAT) * 2048 + col) = v[i]; } }
#pragma unroll
        for (int i = 0; i < 8; ++i) ss += v[i][0] * v[i][0] + v[i][1] * v[i][1] + v[i][2] * v[i][2] + v[i][3] * v[i][3];
        ss = wsum(ss);
        const float r = rsqrtf(ss * (1.0f / 2048.0f) + 1e-6f);
#pragma unroll
        for (int i = 0; i < 8; ++i) { const int col = (i * 64 + lane) * 4; const f32x4 gg = *(const f32x4*)(g + col), s1 = *(const f32x4*)(sc + col), s0 = *(const f32x4*)(sh + col);
            float o[4];
#pragma unroll
            for (int j = 0; j < 4; ++j) o[j] = (v[i][j] * r * gg[j]) * (1.0f + s1[j]) + s0[j];
            u32x2 w; w[0] = pack2(o[0], o[1]); w[1] = pack2(o[2], o[3]);
            *(u32x2*)(H + (size_t)row * 2048 + col) = w; }
    }
}
__device__ void phase_final(PP p) {
    const int TIDX = otid();
    const int wid = TIDX >> 6, lane = TIDX & 63;
    const float* XL = (const float*)(p->ws + OFF_XL); const float* g = p->in[I_FING];
    for (int row = blockIdx.x * 8 + wid; row < NLAT; row += gridDim.x * 8) {
        const float* xr = XL + (size_t)row * 2048;
        f32x4 v[8]; float ss = 0.f;
#pragma unroll
        for (int i = 0; i < 8; ++i) { v[i] = *(const f32x4*)(xr + (i * 64 + lane) * 4); ss += v[i][0] * v[i][0] + v[i][1] * v[i][1] + v[i][2] * v[i][2] + v[i][3] * v[i][3]; }
        ss = wsum(ss);
        const float r = rsqrtf(ss * (1.0f / 2048.0f) + 1e-6f);
#pragma unroll
        for (int i = 0; i < 8; ++i) { const int col = (i * 64 + lane) * 4; const f32x4 gg = *(const f32x4*)(g + col);
            f32x4 o; o[0] = v[i][0] * r * gg[0]; o[1] = v[i][1] * r * gg[1]; o[2] = v[i][2] * r * gg[2]; o[3] = v[i][3] * r * gg[3];
            *(f32x4*)(p->out + (size_t)row * 2048 + col) = o; }
    }
}

DEVI void seq_nbrs(int row, bool& hp, bool& hn) {
    if (row < NLAT) { const int t = row & 4095; hp = t > 0; hn = t < 4095; } else { const int m = (row - NLAT) & 255; hp = m > 0; hn = m < 255; }
}
DEVI float shiftf(float c, float pv, float nx, float mu) { return c + mu * (0.5f * (pv + nx) - c); }

__device__ void phase_prep(PP p, int l, bf16_t* ldsT) {
    const int TIDX = otid();
    const bf16_t* P = (const bf16_t*)(p->ws + OFF_P); bf16_t* LA = (bf16_t*)(p->ws + OFF_LA);
    const float* mu = p->in[I_RWMU] + (size_t)l * 3712 + 3072;
    for (int idx = blockIdx.x * 512 + TIDX; idx < NTOK * 80; idx += gridDim.x * 512) {
        const int row = idx / 80, j = (idx - row * 80) * 8;
        bool hp, hn; seq_nbrs(row, hp, hn);
        const bf16_t* pc = P + (size_t)row * NP + RWB + 3072 + j;
        const u32x4 c = *(const u32x4*)pc;
        const u32x4 z = {0u, 0u, 0u, 0u};
        const u32x4 pv = hp ? *(const u32x4*)(pc - NP) : z, nx = hn ? *(const u32x4*)(pc + NP) : z;
        float o[8];
#pragma unroll
        for (int q = 0; q < 4; ++q) { o[2 * q] = shiftf(bflo(c[q]), bflo(pv[q]), bflo(nx[q]), mu[j + 2 * q]); o[2 * q + 1] = shiftf(bfhi(c[q]), bfhi(pv[q]), bfhi(nx[q]), mu[j + 2 * q + 1]); }
        if (j < 192) {
#pragma unroll
            for (int q = 0; q < 8; ++q) o[q] = tanhf(o[q]); }
        else if (j >= 384) {
#pragma unroll
            for (int q = 0; q < 8; ++q) o[q] = sigmoidf(o[q]); }
        u32x4 w; w[0] = pack2(o[0], o[1]); w[1] = pack2(o[2], o[3]); w[2] = pack2(o[4], o[5]); w[3] = pack2(o[6], o[7]);
        *(u32x4*)(LA + (size_t)row * 640 + j) = w;
    }
    bf16_t* VT = (bf16_t*)(p->ws + OFF_VT);
    const int tid = TIDX;
    for (int t = blockIdx.x; t < 136 * 16; t += gridDim.x) {
        const int rt = t >> 4, hd = t & 15, h = hd >> 1, dh = hd & 1;
        const int row0 = rt * 64;
        { const int tl = tid >> 3, dc = (tid & 7) * 8;
            const u32x4 v = *(const u32x4*)(P + (size_t)(row0 + tl) * NP + NAB + 2048 + h * 128 + dh * 64 + dc);
            bf16_t* tp = ldsT + tl * 66 + dc;
#pragma unroll
            for (int q = 0; q < 4; ++q) { tp[2 * q] = (bf16_t)(v[q] & 0xffffu); tp[2 * q + 1] = (bf16_t)(v[q] >> 16); } }
        __syncthreads();
        { const int d = tid >> 3, tc = (tid & 7) * 8;
            int b, pos; if (row0 < NLAT) { b = row0 >> 12; pos = row0 & 4095; } else { b = (row0 - NLAT) >> 8; pos = 4096 + ((row0 - NLAT) & 255); }
            u32x4 o;
#pragma unroll
            for (int q = 0; q < 4; ++q) o[q] = (unsigned)ldsT[(tc + 2 * q) * 66 + d] | ((unsigned)ldsT[(tc + 2 * q + 1) * 66 + d] << 16);
            *(u32x4*)(VT + ((size_t)((b * 8 + h) * 128 + dh * 64 + d)) * 4352 + pos + tc) = o; }
        __syncthreads();
    }
}

DEVI int scan_row(int s, int b, int dir) {
    if (s < 256) { const int m = dir ? 255 - s : s; return NLAT + b * 256 + m; }
    const int t = dir ? 4095 - (s - 256) : s - 256; return b * 4096 + t;
}
__device__ void rwkv_scan(PP p, int l, int task, float* lds) {
    const int TIDX = otid();
    const int chain = task >> 1, half = task & 1;
    const int b = chain >> 5, h = (chain >> 1) & 15, dir = chain & 1, tid = TIDX;
    const bf16_t* P = (const bf16_t*)(p->ws + OFF_P); const bf16_t* LO = (const bf16_t*)(p->ws + OFF_LO);
    float* YO = (float*)(p->ws + OFF_YRWF) + (size_t)dir * NTOK * 1024 + h * 64;
    const int sl = tid >> 5, e2 = (tid & 31) * 2, ch = h * 64 + e2;
    const float* MU = p->in[I_RWMU] + (size_t)l * 3712;
    const float mur0 = MU[ch], mur1 = MU[ch + 1], muk0 = MU[1024 + ch], muk1 = MU[1024 + ch + 1], muv0 = MU[2048 + ch], muv1 = MU[2048 + ch + 1];
    const float w00 = p->in[I_RWW0][(l * 2 + dir) * 1024 + ch], w01 = p->in[I_RWW0][(l * 2 + dir) * 1024 + ch + 1];
    const float a00 = p->in[I_RWA0][(l * 2 + dir) * 1024 + ch], a01 = p->in[I_RWA0][(l * 2 + dir) * 1024 + ch + 1];
    const float kk0 = p->in[I_RWKK][l * 1024 + ch], kk1 = p->in[I_RWKK][l * 1024 + ch + 1], ka0 = p->in[I_RWKA][l * 1024 + ch], ka1 = p->in[I_RWKA][l * 1024 + ch + 1];
    const float rk0 = p->in[I_RWRK][l * 1024 + ch], rk1 = p->in[I_RWRK][l * 1024 + ch + 1];
    float* RK = (float*)(p->ws + OFF_RK); const bool wrk = dir == 0 && half == 0; int srow = 0;
    const int kq = tid & 15, v = half * 32 + (tid >> 4);
    f32x2 S0 = (f32x2){0.f, 0.f}, S1 = (f32x2){0.f, 0.f};
    unsigned rc, rp, rn, kc, kp, kn, vc, vp, vn, wr_, ar_;
    auto issue = [&](int g) {
        const int row = scan_row(g * 16 + sl, b, dir); bool hp, hn; seq_nbrs(row, hp, hn); srow = row;
        const bf16_t* pr = P + (size_t)row * NP + RWB + ch;
        rc = *(const unsigned*)pr; kc = *(const unsigned*)(pr + 1024); vc = *(const unsigned*)(pr + 2048);
        rp = 0u; kp = 0u; vp = 0u; rn = 0u; kn = 0u; vn = 0u;
        if (hp) { rp = *(const unsigned*)(pr - NP); kp = *(const unsigned*)(pr - NP + 1024); vp = *(const unsigned*)(pr - NP + 2048); }
        if (hn) { rn = *(const unsigned*)(pr + NP); kn = *(const unsigned*)(pr + NP + 1024); vn = *(const unsigned*)(pr + NP + 2048); }
        const bf16_t* lo = LO + (size_t)row * 5120 + dir * 1024 + ch;
        wr_ = *(const unsigned*)lo; ar_ = *(const unsigned*)(lo + 2048);
    };
    auto commit = [&](int buf) {
        float* st = lds + buf * 6144 + sl * 384 + e2;
        const float r0 = shiftf(bflo(rc), bflo(rp), bflo(rn), mur0), r1 = shiftf(bfhi(rc), bfhi(rp), bfhi(rn), mur1);
        const float k0 = shiftf(bflo(kc), bflo(kp), bflo(kn), muk0), k1 = shiftf(bfhi(kc), bfhi(kp), bfhi(kn), muk1);
        const float v0 = shiftf(bflo(vc), bflo(vp), bflo(vn), muv0), v1 = shiftf(bfhi(vc), bfhi(vp), bfhi(vn), muv1);
        const float x0 = -(w00 + bflo(wr_)), x1 = -(w01 + bfhi(wr_));
        const float sp0 = x0 > 20.f ? x0 : __logf(1.0f + __expf(x0)), sp1 = x1 > 20.f ? x1 : __logf(1.0f + __expf(x1));
        const float d0 = __expf(-__expf(-sp0 - 0.5f)), d1 = __expf(-__expf(-sp1 - 0.5f));
        const float ar0 = fsigmoid(a00 + bflo(ar_)), ar1 = fsigmoid(a01 + bfhi(ar_));
        const float kd0 = k0 * (1.0f + (ar0 - 1.0f) * ka0), kd1 = k1 * (1.0f + (ar1 - 1.0f) * ka1);
        const float q0 = k0 * kk0, q1 = k1 * kk1;
        float ss = red16(q0 * q0 + q1 * q1);
        ss += __shfl_xor(ss, 16);
        const float inv = frcp(fmaxf(__builtin_amdgcn_sqrtf(ss), 1e-12f));
        const float n0 = q0 * inv, n1 = q1 * inv;
        if (wrk) { float t = red16(r0 * k0 * rk0 + r1 * k1 * rk1); t += __shfl_xor(t, 16); if ((tid & 31) == 0) RK[srow * 16 + h] = t; }
        *(f32x2*)(st + 0) = (f32x2){r0, r1}; *(f32x2*)(st + 64) = (f32x2){d0, d1}; *(f32x2*)(st + 128) = (f32x2){kd0, kd1};
        *(f32x2*)(st + 192) = (f32x2){v0, v1}; *(f32x2*)(st + 256) = (f32x2){-n0, -n1}; *(f32x2*)(st + 320) = (f32x2){n0 * ar0, n1 * ar1};
    };
    __syncthreads();
    issue(0); commit(0);
    __syncthreads();
    constexpr int NG = 4352 / 16;
    for (int g = 0; g < NG; ++g) {
        if (g + 1 < NG) issue(g + 1);
        {
            const float* base = lds + (g & 1) * 6144 + kq * 4;
            float ykeep = 0.f;
            f32x4 nA, nD, nB, nK, nR; float nV;
#define RW_LOAD(i_) do { const float* st_ = base + (i_) * 384; nA = *(const f32x4*)(st_ + 256); nD = *(const f32x4*)(st_ + 64); nB = *(const f32x4*)(st_ + 320); nK = *(const f32x4*)(st_ + 128); nR = *(const f32x4*)(st_); \
                nV = st_[192 - kq * 4 + v]; } while (0)
            RW_LOAD(0);
#pragma unroll
            for (int i = 0; i < 16; ++i) {
                const f32x4 a = nA, d = nD, bb = nB, k = nK, r = nR; const float vv = nV;
                if (i < 15) { RW_LOAD(i + 1); }
                __builtin_amdgcn_sched_barrier(0x77);
                f32x2 pa2 = S0 * (f32x2){a[0], a[1]}; pa2 = S1 * (f32x2){a[2], a[3]} + pa2;
                const f32x2 vvb = (f32x2){vv, vv};
                const f32x2 u0 = S0 * (f32x2){d[0], d[1]} + vvb * (f32x2){k[0], k[1]}, u1 = S1 * (f32x2){d[2], d[3]} + vvb * (f32x2){k[2], k[3]};
                const float pa = red16(pa2[0] + pa2[1]);
                const f32x2 pab = (f32x2){pa, pa};
                S0 = pab * (f32x2){bb[0], bb[1]} + u0; S1 = pab * (f32x2){bb[2], bb[3]} + u1;
                f32x2 y2 = S0 * (f32x2){r[0], r[1]}; y2 = S1 * (f32x2){r[2], r[3]} + y2;
                const float y = red16(y2[0] + y2[1]);
                ykeep = (kq == i) ? y : ykeep;
            }
#undef RW_LOAD
            YO[(size_t)scan_row(g * 16 + kq, b, dir) * 1024 + v] = ykeep;
        }
        if (g + 1 < NG) commit((g + 1) & 1);
        __syncthreads();
    }
}

__device__ void mlstm_scan(PP p, int l, int chain, int g8, float* lds) {
    const int TIDX = otid();
    const int b = chain >> 3, h = (chain >> 1) & 3, dir = chain & 1, tid = TIDX;
    const bf16_t* P = (const bf16_t*)(p->ws + OFF_P);
    const float* RC = (const float*)(p->ws + OFF_ROPE); const float* RS = RC + 2048;
    float* NO = (float*)(p->ws + OFF_MLNUM) + (size_t)dir * NTOK * 4 * 272 + h * 272;
    const int sl = tid >> 5, j = tid & 31;
    const float gbi = p->in[I_MLGB][l * 16 + (dir * 2 + 0) * 4 + h], gbf = p->in[I_MLGB][l * 16 + (dir * 2 + 1) * 4 + h];
    const int rowl = (tid >> 3) & 31, kq = tid & 7, crow = g8 * 32 + rowl, lane = tid & 63;
    f32x2 C[8];
#pragma unroll
    for (int i = 0; i < 8; ++i) C[i] = (f32x2){0.f, 0.f};
    f32x2 nst = (f32x2){0.f, 0.f};
    bf16_t q0, q1, q2, q3, k0, k1, k2, k3, gi, gf; unsigned vv2; float cr, sr, cc, sc;
    auto issue = [&](int g) {
        const int row = scan_row(g * 16 + sl, b, dir);
        const bf16_t* pr = P + (size_t)row * NP;
        const bf16_t* pq = pr + h * 128 + j; const bf16_t* pk = pr + 512 + h * 128 + j;
        q0 = pq[0]; q1 = pq[32]; q2 = pq[64]; q3 = pq[96]; k0 = pk[0]; k1 = pk[32]; k2 = pk[64]; k3 = pk[96];
        vv2 = j < 16 ? *(const unsigned*)(pr + 1024 + h * 256 + g8 * 32 + 2 * j) : 0u;
        gi = pr[3072 + (dir * 2 + 0) * 4 + h]; gf = pr[3072 + (dir * 2 + 1) * 4 + h];
        if (row < NLAT) { const int t = row & 4095, pr_ = t >> 6, pc_ = t & 63; cr = RC[pr_ * 32 + j]; sr = RS[pr_ * 32 + j]; cc = RC[pc_ * 32 + j]; sc = RS[pc_ * 32 + j]; }
        else { cr = 1.f; sr = 0.f; cc = 1.f; sc = 0.f; }
    };
    auto commit = [&](int buf) {
        float* st = lds + buf * 5376 + sl * 336;
        const float scale = 0.08838834764831845f;
        const float a0 = bf2f(q0), a1 = bf2f(q1), a2 = bf2f(q2), a3 = bf2f(q3);
        st[j] = (a0 * cr - a1 * sr) * scale; st[32 + j] = (a0 * sr + a1 * cr) * scale; st[64 + j] = (a2 * cc - a3 * sc) * scale; st[96 + j] = (a2 * sc + a3 * cc) * scale;
        const float c0 = bf2f(k0), c1 = bf2f(k1), c2 = bf2f(k2), c3 = bf2f(k3);
        st[128 + j] = c0 * cr - c1 * sr; st[160 + j] = c0 * sr + c1 * cr; st[192 + j] = c2 * cc - c3 * sc; st[224 + j] = c2 * sc + c3 * cc;
        if (j < 16) { st[256 + 2 * j] = bflo(vv2); st[257 + 2 * j] = bfhi(vv2); }
        if (j == 0) { st[320] = fsigmoid(bf2f(gf) + gbf); st[321] = __expf(bf2f(gi) + gbi); }
    };
    __syncthreads();
    issue(0); commit(0);
    __syncthreads();
    constexpr int NG = 4352 / 16;
    for (int g = 0; g < NG; ++g) {
        if (g + 1 < NG) issue(g + 1);
        const float* base = lds + (g & 1) * 5376;
        if (tid < 256) {
            float nkeep = 0.f;
            f32x4 nK[4], nQ[4]; float nF, nI, nV0;
#define ML_LOAD(i_) do { const float* st_ = base + (i_) * 336; _Pragma("unroll") for (int c4 = 0; c4 < 4; ++c4) { nK[c4] = *(const f32x4*)(st_ + 128 + c4 * 32 + kq * 4); nQ[c4] = *(const f32x4*)(st_ + c4 * 32 + kq * 4); } \
                nF = st_[320]; nI = st_[321]; nV0 = st_[256 + rowl]; } while (0)
            ML_LOAD(0);
#pragma unroll
            for (int i = 0; i < 16; ++i) {
                f32x4 kk[4], qq[4];
#pragma unroll
                for (int c4 = 0; c4 < 4; ++c4) { kk[c4] = nK[c4]; qq[c4] = nQ[c4]; }
                const float f = nF, coef = nI * nV0;
                if (i < 15) { ML_LOAD(i + 1); }
                __builtin_amdgcn_sched_barrier(0x77);
                const f32x2 cf = (f32x2){coef, coef}, ff = (f32x2){f, f};
                f32x2 num2 = (f32x2){0.f, 0.f}, num3 = (f32x2){0.f, 0.f};
#pragma unroll
                for (int c4 = 0; c4 < 4; ++c4) {
                    const f32x2 KA = (f32x2){kk[c4][0], kk[c4][1]}, KB = (f32x2){kk[c4][2], kk[c4][3]}, QA = (f32x2){qq[c4][0], qq[c4][1]}, QB = (f32x2){qq[c4][2], qq[c4][3]};
                    C[2 * c4] = ff * C[2 * c4] + cf * KA; C[2 * c4 + 1] = ff * C[2 * c4 + 1] + cf * KB;
                    num2 = C[2 * c4] * QA + num2; num3 = C[2 * c4 + 1] * QB + num3; }
                num2 += num3;
                const float num = red8(num2[0] + num2[1]);
                nkeep = (kq == (i & 7)) ? num : nkeep;
                if ((i & 7) == 7) NO[(size_t)scan_row(g * 16 + (i - 7) + kq, b, dir) * (4 * 272) + crow] = nkeep;
            }
#undef ML_LOAD
        } else if (g8 == 0 && tid < 320) {
            float nkeep = 0.f;
            f32x2 nk, nq; float nf, ni;
#define MN_LOAD(i_) do { const float* st_ = base + (i_) * 336; nk = *(const f32x2*)(st_ + 128 + 2 * lane); nq = *(const f32x2*)(st_ + 2 * lane); nf = st_[320]; ni = st_[321]; } while (0)
            MN_LOAD(0);
#pragma unroll
            for (int i = 0; i < 16; ++i) {
                const f32x2 kk = nk, qq = nq; const float f = nf, ig = ni;
                if (i < 15) { MN_LOAD(i + 1); }
                __builtin_amdgcn_sched_barrier(0x77);
                nst = (f32x2){f, f} * nst + (f32x2){ig, ig} * kk;
                const f32x2 d2 = nst * qq;
                const float den16 = red16(d2[0] + d2[1]);
                nkeep = ((lane & 15) == i) ? den16 : nkeep;
            }
#undef MN_LOAD
            nkeep += __shfl_xor(nkeep, 16); nkeep += __shfl_xor(nkeep, 32);
            if (lane < 16) NO[(size_t)scan_row(g * 16 + lane, b, dir) * (4 * 272) + 256] = nkeep;
        }
        if (g + 1 < NG) commit((g + 1) & 1);
        __syncthreads();
    }
}

#define MFMA16(a, b, c) __builtin_amdgcn_mfma_f32_16x16x32_bf16(a, b, c, 0, 0, 0)
__device__ void na_wave(PP p, int l, int task) {
    const int TIDX = otid();
    const bf16_t* P = (const bf16_t*)(p->ws + OFF_P); const bf16_t* VT = (const bf16_t*)(p->ws + OFF_VT);
    bf16_t* YN = (bf16_t*)(p->ws + OFF_Y3) + 2ull * NTOK * 1024;
    const int w = TIDX >> 6, lane = TIDX & 63, n16 = lane & 15, g = lane >> 4;
    int b, h, qrow, r = 0, qcol = 0, cs = 0, row_start = 0, c_start = 0; bool lat;
    if (task < 512) { lat = true; b = task >> 8; h = (task >> 5) & 7; const int pair = task & 31; r = pair * 2 + (w >> 2); const int qi = w & 3; qcol = qi * 16 + n16;
        qrow = b * 4096 + r * 64 + qcol; cs = qi == 0 ? 0 : (qi == 1 ? 8 : (qi == 2 ? 24 : 32)); row_start = min(max(r - 4, 0), 56); c_start = min(max(qcol - 8, 0), 48); }
    else { lat = false; const int t2 = task - 512; b = t2 >> 4; h = (t2 >> 1) & 7; const int chunk = t2 & 1; qrow = NLAT + b * 256 + chunk * 128 + w * 16 + n16; }
    bf16x8 qf[4];
#pragma unroll
    for (int c = 0; c < 4; ++c) qf[c] = *(const bf16x8*)(P + (size_t)qrow * NP + NAB + h * 128 + c * 32 + g * 8);
    const float* rpb = p->in[I_RPB] + (size_t)(l * 8 + h) * 15 * 31;
    const bf16_t* vtb = VT + (size_t)((b * 8 + h) * 128) * 4352;
    f32x4 O[8];
#pragma unroll
    for (int i = 0; i < 8; ++i) O[i] = (f32x4){0.f, 0.f, 0.f, 0.f};
    float mrun = -INFINITY, lsum = 0.f;
    const float scale = 0.08838834764831845f;
    for (int pass = lat ? 0 : 2; pass < 4; ++pass) {
        f32x4 S[8];
#pragma unroll
        for (int i = 0; i < 8; ++i) {
            int krowtok;
            if (pass < 2) { const int krow = row_start + pass * 4 + (i >> 1); krowtok = b * 4096 + krow * 64 + cs + (i & 1) * 16 + n16; }
            else krowtok = NLAT + b * 256 + (pass - 2) * 128 + i * 16 + n16;
            const bf16_t* kp = P + (size_t)krowtok * NP + NAB + 1024 + h * 128 + g * 8;
            f32x4 acc = (f32x4){0.f, 0.f, 0.f, 0.f};
#pragma unroll
            for (int c = 0; c < 4; ++c) { const bf16x8 kf = *(const bf16x8*)(kp + c * 32); acc = MFMA16(kf, qf[c], acc); }
            S[i] = acc;
        }
        float mx = -INFINITY;
#pragma unroll
        for (int i = 0; i < 8; ++i) {
            if (pass < 2) { const int krow = row_start + pass * 4 + (i >> 1); const float* rb = rpb + (krow - r + 7) * 31;
#pragma unroll
                for (int jj = 0; jj < 4; ++jj) { const int kc = cs + (i & 1) * 16 + 4 * g + jj; const bool ok = (kc >= c_start) && (kc < c_start + 16);
                    const int co = min(max(kc - qcol, -15), 15) + 15;
                    S[i][jj] = ok ? S[i][jj] * scale + rb[co] : -INFINITY; } }
            else {
#pragma unroll
                for (int jj = 0; jj < 4; ++jj) S[i][jj] *= scale; }
#pragma unroll
            for (int jj = 0; jj < 4; ++jj) mx = fmaxf(mx, S[i][jj]);
        }
        mx = fmaxf(mx, __shfl_xor(mx, 16)); mx = fmaxf(mx, __shfl_xor(mx, 32));
        const float mnew = fmaxf(mrun, mx);
        const float alpha = __expf(mrun - mnew);
        mrun = mnew; lsum *= alpha;
#pragma unroll
        for (int i = 0; i < 8; ++i) { O[i][0] *= alpha; O[i][1] *= alpha; O[i][2] *= alpha; O[i][3] *= alpha; }
        bf16x8 pf[4];
#pragma unroll
        for (int c = 0; c < 4; ++c) {
            float e[8];
#pragma unroll
            for (int jj = 0; jj < 4; ++jj) { e[jj] = __expf(S[2 * c][jj] - mnew); e[4 + jj] = __expf(S[2 * c + 1][jj] - mnew); }
#pragma unroll
            for (int jj = 0; jj < 8; ++jj) lsum += e[jj];
            u32x4 u; u[0] = pack2(e[0], e[1]); u[1] = pack2(e[2], e[3]); u[2] = pack2(e[4], e[5]); u[3] = pack2(e[6], e[7]);
            pf[c] = __builtin_bit_cast(bf16x8, u);
        }
#pragma unroll
        for (int c = 0; c < 4; ++c) {
            int pos0, pos1;
            if (pass < 2) { const int krow = row_start + pass * 4 + c; pos0 = krow * 64 + cs + 4 * g; pos1 = pos0 + 16; }
            else { pos0 = 4096 + (pass - 2) * 128 + c * 32 + 4 * g; pos1 = pos0 + 16; }
#pragma unroll
            for (int dt = 0; dt < 8; ++dt) {
                const bf16_t* vp = vtb + (size_t)(dt * 16 + n16) * 4352;
                const bf16x4 v0 = *(const bf16x4*)(vp + pos0), v1 = *(const bf16x4*)(vp + pos1);
                const bf16x8 vf = __builtin_shufflevector(v0, v1, 0, 1, 2, 3, 4, 5, 6, 7);
                O[dt] = MFMA16(vf, pf[c], O[dt]);
            }
        }
    }
    lsum += __shfl_xor(lsum, 16); lsum += __shfl_xor(lsum, 32);
    const float inv = 1.0f / lsum;
    bf16_t* yo = YN + (size_t)qrow * 1024 + h * 128 + 4 * g;
#pragma unroll
    for (int dt = 0; dt < 8; ++dt) { u32x2 o; o[0] = pack2(O[dt][0] * inv, O[dt][1] * inv); o[1] = pack2(O[dt][2] * inv, O[dt][3] * inv); *(u32x2*)(yo + dt * 16) = o; }
}

__device__ void na_block(PP p, int l, int task, unsigned char* lds) {
    const int TIDX = otid();
    const bf16_t* P = (const bf16_t*)(p->ws + OFF_P); const bf16_t* VT = (const bf16_t*)(p->ws + OFF_VT);
    bf16_t* YN = (bf16_t*)(p->ws + OFF_Y3) + 2ull * NTOK * 1024;
    const int tid = TIDX, w = tid >> 6, lane = tid & 63, n16 = lane & 15, g = lane >> 4, qi = w & 3, kh = w >> 2;
    const int b = task >> 9, h = (task >> 6) & 7, r = task & 63;
    const int qcol = qi * 16 + n16, qrow = b * 4096 + r * 64 + qcol;
    const int cs = qi == 0 ? 0 : (qi == 1 ? 8 : (qi == 2 ? 24 : 32)), row_start = min(max(r - 4, 0), 56), c_start = min(max(qcol - 8, 0), 48);
    unsigned char* KT = lds; unsigned char* VL = lds + 65536;
    bf16x8 qf[4];
#pragma unroll
    for (int c = 0; c < 4; ++c) qf[c] = *(const bf16x8*)(P + (size_t)qrow * NP + NAB + h * 128 + c * 32 + g * 8);
    const float* rpb = p->in[I_RPB] + (size_t)(l * 8 + h) * 15 * 31;
    const bf16_t* vtb = VT + (size_t)((b * 8 + h) * 128) * 4352;
    const bf16_t* kgb = P + NAB + 1024 + h * 128;
    f32x4 O[8];
#pragma unroll
    for (int i = 0; i < 8; ++i) O[i] = (f32x4){0.f, 0.f, 0.f, 0.f};
    float mrun = -INFINITY, lsum = 0.f;
    const float scale = 0.08838834764831845f;
    u32x4 kreg[8], vreg[8];
    auto gload = [&](int pass) {
#pragma unroll
        for (int i = 0; i < 8; ++i) { const int key = i * 32 + (tid >> 4), c16 = tid & 15, s_ = key >> 6, kk = key & 63;
            if (pass < 2) { const int krow = row_start + (s_ < 2 ? 2 * pass + s_ : 2 + 2 * pass + s_);
                kreg[i] = *(const u32x4*)(kgb + (size_t)(b * 4096 + krow * 64 + kk) * NP + c16 * 8); }
            else if (i < 4) { const int m = (s_ == 0 ? 0 : 128) + 64 * (pass - 2) + kk;
                kreg[i] = *(const u32x4*)(kgb + (size_t)(NLAT + b * 256 + m) * NP + c16 * 8); } }
#pragma unroll
        for (int i = 0; i < 8; ++i) { const int d = i * 16 + (tid >> 5), key8 = (tid & 31) * 8, s_ = key8 >> 6, kk = key8 & 63;
            if (pass < 2) { const int krow = row_start + (s_ < 2 ? 2 * pass + s_ : 2 + 2 * pass + s_);
                vreg[i] = *(const u32x4*)(vtb + (size_t)d * 4352 + krow * 64 + kk); }
            else if (key8 < 128) { const int m = (s_ == 0 ? 0 : 128) + 64 * (pass - 2) + kk;
                vreg[i] = *(const u32x4*)(vtb + (size_t)d * 4352 + 4096 + m); } }
    };
    auto lstore = [&](int pass) {
#pragma unroll
        for (int i = 0; i < 8; ++i) { const int key = i * 32 + (tid >> 4), c16 = tid & 15;
            if (pass < 2 || i < 4) *(u32x4*)(KT + key * 256 + ((c16 ^ (key & 15)) * 16)) = kreg[i]; }
#pragma unroll
        for (int i = 0; i < 8; ++i) { const int d = i * 16 + (tid >> 5), kc16 = tid & 31;
            if (pass < 2 || kc16 < 16) *(u32x4*)(VL + d * 512 + ((kc16 ^ (d & 15)) * 16)) = vreg[i]; }
    };
    gload(0);
    for (int pass = 0; pass < 4; ++pass) {
        __syncthreads();
        lstore(pass);
        __syncthreads();
        if (pass < 3) gload(pass + 1);
        f32x4 S[4];
#pragma unroll
        for (int i = 0; i < 4; ++i) {
            const int keyl = pass < 2 ? (kh * 2 + (i >> 1)) * 64 + cs + (i & 1) * 16 + n16 : kh * 64 + i * 16 + n16;
            const unsigned char* kp = KT + keyl * 256;
            f32x4 acc = (f32x4){0.f, 0.f, 0.f, 0.f};
#pragma unroll
            for (int c = 0; c < 4; ++c) { const bf16x8 kf = *(const bf16x8*)(kp + (((c * 4 + g) ^ (keyl & 15)) * 16)); acc = MFMA16(kf, qf[c], acc); }
            S[i] = acc;
        }
        float mx = -INFINITY;
#pragma unroll
        for (int i = 0; i < 4; ++i) {
            if (pass < 2) { const int krow = row_start + kh * 4 + 2 * pass + (i >> 1); const float* rb = rpb + (krow - r + 7) * 31;
#pragma unroll
                for (int jj = 0; jj < 4; ++jj) { const int kc = cs + (i & 1) * 16 + 4 * g + jj; const bool ok = (kc >= c_start) && (kc < c_start + 16);
                    const int co = min(max(kc - qcol, -15), 15) + 15;
                    S[i][jj] = ok ? S[i][jj] * scale + rb[co] : -INFINITY; } }
            else {
#pragma unroll
                for (int jj = 0; jj < 4; ++jj) S[i][jj] *= scale; }
#pragma unroll
            for (int jj = 0; jj < 4; ++jj) mx = fmaxf(mx, S[i][jj]);
        }
        mx = fmaxf(mx, __shfl_xor(mx, 16)); mx = fmaxf(mx, __shfl_xor(mx, 32));
        const float mnew = fmaxf(mrun, mx);
        const float alpha = __expf(mrun - mnew);
        mrun = mnew; lsum *= alpha;
#pragma unroll
        for (int i = 0; i < 8; ++i) { O[i][0] *= alpha; O[i][1] *= alpha; O[i][2] *= alpha; O[i][3] *= alpha; }
#pragma unroll
        for (int c = 0; c < 2; ++c) {
            float e[8];
#pragma unroll
            for (int jj = 0; jj < 4; ++jj) { e[jj] = __expf(S[2 * c][jj] - mnew); e[4 + jj] = __expf(S[2 * c + 1][jj] - mnew); }
#pragma unroll
            for (int jj = 0; jj < 8; ++jj) lsum += e[jj];
            u32x4 u; u[0] = pack2(e[0], e[1]); u[1] = pack2(e[2], e[3]); u[2] = pack2(e[4], e[5]); u[3] = pack2(e[6], e[7]);
            const bf16x8 pf = __builtin_bit_cast(bf16x8, u);
            const int key0 = pass < 2 ? (kh * 2 + c) * 64 + cs + 4 * g : kh * 64 + c * 32 + 4 * g;
            const int kc8a = key0 >> 2, kc8b = kc8a + 4;
#pragma unroll
            for (int dt = 0; dt < 8; ++dt) { const int d = dt * 16 + n16; const unsigned char* vp = VL + d * 512;
                const bf16x4 v0 = *(const bf16x4*)(vp + (((kc8a >> 1) ^ (d & 15)) * 16) + (kc8a & 1) * 8), v1 = *(const bf16x4*)(vp + (((kc8b >> 1) ^ (d & 15)) * 16) + (kc8b & 1) * 8);
                const bf16x8 vf = __builtin_shufflevector(v0, v1, 0, 1, 2, 3, 4, 5, 6, 7);
                O[dt] = MFMA16(vf, pf, O[dt]); }
        }
    }
    lsum += __shfl_xor(lsum, 16); lsum += __shfl_xor(lsum, 32);
    __syncthreads();
    float* cmb = (float*)lds + (size_t)qi * 34 * 64 + lane;
    if (kh == 1) { cmb[0] = mrun; cmb[64] = lsum;
#pragma unroll
        for (int dt = 0; dt < 8; ++dt)
#pragma unroll
            for (int jj = 0; jj < 4; ++jj) cmb[(2 + dt * 4 + jj) * 64] = O[dt][jj]; }
    __syncthreads();
    if (kh == 0) { const float m1 = cmb[0], l1 = cmb[64];
        const float mn = fmaxf(mrun, m1), a0 = __expf(mrun - mn), a1 = __expf(m1 - mn);
        const float inv = 1.0f / (lsum * a0 + l1 * a1);
        bf16_t* yo = YN + (size_t)qrow * 1024 + h * 128 + 4 * g;
#pragma unroll
        for (int dt = 0; dt < 8; ++dt) { float o[4];
#pragma unroll
            for (int jj = 0; jj < 4; ++jj) o[jj] = (O[dt][jj] * a0 + cmb[(2 + dt * 4 + jj) * 64] * a1) * inv;
            u32x2 ov; ov[0] = pack2(o[0], o[1]); ov[1] = pack2(o[2], o[3]); *(u32x2*)(yo + dt * 16) = ov; } }
}

__device__ void phase_mix(PP p, int l, float* lds, int which = 7) {
    const int TIDX = otid();
    for (int t = blockIdx.x; t < 256; t += gridDim.x) {
        if (t < 128) { if (which & 1) rwkv_scan(p, l, t, lds); }
        else if (which & 2) mlstm_scan(p, l, (t - 128) >> 3, (t - 128) & 7, lds);
        __syncthreads();
    }
    unsigned* ctr = (unsigned*)(p->ws + OFF_CTL) + l * 8 + ((which & 8) ? 1 : 0);
    if (!(which & 4)) return;
    int* stask = (int*)lds;
    const int ntask = l == 0 ? 1056 : 1024;
    for (;;) {
        __syncthreads();
        if (TIDX == 0) stask[0] = (int)atomicAdd(ctr, 1u);
        __syncthreads();
        const int t = stask[0];
        if (t >= ntask) break;
        if (t < 1024) na_block(p, l, t, (unsigned char*)lds); else na_wave(p, l, t - 512);
    }
}

__device__ void phase_post(PP p, int l, int nrows) {
    const int TIDX = otid();
    const int wid = TIDX >> 6, lane = TIDX & 63, gw = blockIdx.x * 8 + wid, nw = gridDim.x * 8;
    const bf16_t* P = (const bf16_t*)(p->ws + OFF_P); const bf16_t* LO = (const bf16_t*)(p->ws + OFF_LO);
    bf16_t* YM = (bf16_t*)(p->ws + OFF_Y3); bf16_t* YR = YM + (size_t)NTOK * 1024;
    const float* NUM = (const float*)(p->ws + OFF_MLNUM); const float* YF = (const float*)(p->ws + OFF_YRWF);
    for (int row = gw; row < nrows; row += nw) {
        f32x4 a[4], c[4], ng[4]; float dfr[4], dbr[4]; u32x2 ov[4];
#pragma unroll
        for (int h = 0; h < 4; ++h) {
            const float* nf = NUM + ((size_t)row * 4 + h) * 272; const float* nb = NUM + ((size_t)(NTOK + row) * 4 + h) * 272;
            a[h] = *(const f32x4*)(nf + lane * 4); c[h] = *(const f32x4*)(nb + lane * 4); dfr[h] = nf[256]; dbr[h] = nb[256];
            ov[h] = *(const u32x2*)(P + (size_t)row * NP + 2048 + h * 256 + lane * 4);
            ng[h] = *(const f32x4*)(p->in[I_MLNG] + l * 1024 + h * 256 + lane * 4); }
#pragma unroll
        for (int h = 0; h < 4; ++h) {
            const float df = 1.0f / fmaxf(fabsf(dfr[h]), 1.0f), db = 1.0f / fmaxf(fabsf(dbr[h]), 1.0f);
            float hv[4]; float ss = 0.f;
#pragma unroll
            for (int j = 0; j < 4; ++j) { hv[j] = a[h][j] * df + c[h][j] * db; ss += hv[j] * hv[j]; }
            ss = wsum(ss);
            const float rr = rsqrtf(ss * (1.0f / 256.0f) + 1e-6f);
            const float o0 = hv[0] * rr * ng[h][0] * sigmoidf(bflo(ov[h][0])), o1 = hv[1] * rr * ng[h][1] * sigmoidf(bfhi(ov[h][0]));
            const float o2 = hv[2] * rr * ng[h][2] * sigmoidf(bflo(ov[h][1])), o3 = hv[3] * rr * ng[h][3] * sigmoidf(bfhi(ov[h][1]));
            u32x2 w; w[0] = pack2(o0, o1); w[1] = pack2(o2, o3);
            *(u32x2*)(YM + (size_t)row * 1024 + h * 256 + lane * 4) = w; }
    }
    const float* MU = p->in[I_RWMU] + (size_t)l * 3712;
    for (int it = gw; it < nrows * 2; it += nw) {
        const int row = it >> 1, hq = (it & 1) * 8;
        bool hp, hn; seq_nbrs(row, hp, hn);
        float y0[8], y1[8], gg[8], rkv[8]; bf16_t vc[8], vp[8], vn[8];
#pragma unroll
        for (int u = 0; u < 8; ++u) { const int c = (hq + u) * 64 + lane;
            y0[u] = YF[(size_t)row * 1024 + c]; y1[u] = YF[(size_t)(NTOK + row) * 1024 + c];
            const bf16_t* pr = P + (size_t)row * NP + RWB + 2048 + c;
            vc[u] = pr[0]; vp[u] = hp ? pr[-NP] : (bf16_t)0; vn[u] = hn ? pr[NP] : (bf16_t)0;
            rkv[u] = ((const float*)(p->ws + OFF_RK))[row * 16 + hq + u];
            gg[u] = bf2f(LO[(size_t)row * 5120 + 4096 + c]); }
#pragma unroll
        for (int u = 0; u < 8; ++u) { const int c = (hq + u) * 64 + lane;
            const float y = y0[u] + y1[u];
            const float mean = wsum(y) * (1.0f / 64.0f);
            const float dy = y - mean;
            const float var = wsum(dy * dy) * (1.0f / 64.0f);
            const float yn = dy * rsqrtf(var + 64e-5f);
            const float vv = shiftf(bf2f(vc[u]), bf2f(vp[u]), bf2f(vn[u]), MU[2048 + c]);
            const float bonus = rkv[u] * vv;
            const float o = (yn * p->in[I_RWLNW][l * 1024 + c] + p->in[I_RWLNB][l * 1024 + c] + bonus) * gg[u];
            YR[(size_t)row * 1024 + c] = f2bf(o); }
    }
}


constexpr size_t PART_OFF = 150ull << 20;
#ifndef DUPMASK
#define DUPMASK 0
#endif
#ifndef DUPWHICH
#define DUPWHICH 3
#endif
__global__ void __launch_bounds__(512, 2) fwd_kernel(Params p0) {
    extern __shared__ __attribute__((aligned(16))) unsigned char shm[];
    cg::grid_group grid = cg::this_grid();
    float* ldsf = (float*)shm;
    LAS unsigned char* ldsg = (LAS unsigned char*)shm;
    const int ph_lo = p0.ph_lo, ph_hi = p0.ph_hi;
    auto kseg = __builtin_amdgcn_kernarg_segment_ptr();
    for (int ph = ph_lo; ph < ph_hi; ++ph) {
        if (ph > ph_lo) grid.sync();
        PP p = (PP)kseg; asm volatile("" : "+s"(p));
        unsigned char* ws = p->ws;
        const float* MOD = (const float*)(ws + OFF_MOD);
        float* XL = (float*)(ws + OFF_XL);
        bf16_t* H = (bf16_t*)(ws + OFF_H);
        bf16_t* Pb = (bf16_t*)(ws + OFF_P);
        if (ph == 0) { phase_mod(p, ldsf); __syncthreads(); phase_convert(p, 0, ldsf, (int)blockIdx.x, (int)gridDim.x, 0, 0, 18816, true); continue; }
        if (ph == NPHASE - 1) { phase_final(p); continue; }
        const int l = (ph - 1) / 11, sub = (ph - 1) % 11;
        const int two_wt = p->two_wt;
        const size_t wsh = (l == 1 && two_wt) ? WT_SHIFT : 0;
#if DUPMASK
        for (int rep = 0; rep < (((DUPMASK >> sub) & 1) ? 2 : 1); ++rep) { if (rep) grid.sync();
#endif
        const int Ml = l == 0 ? NTOK : NLAT;
        const float* modl = MOD + (size_t)l * 3 * 12288;
        if (sub == 1 || sub == 3 || sub == 6 || sub == 7 || sub == 9 || sub == 10) {
            const bool ksplit = l == 0 && (sub == 7 || sub == 10) && gridDim.x == 256;
            for (int part = 0; part < (ksplit ? 2 : 1); ++part) {
            pg8::Gemm g; pg8::SchedG S; pg8::EpiG E;
            S.mode = 0; S.mo.init(Ml / 256, (int)gridDim.x, (int)blockIdx.x);
            E.kind = 0; E.split = 0; E.O = Pb; E.ldc = NP; E.P = Pb; E.ACC = (float*)(ws + OFF_YRWF);
            E.xin_lat = XL; E.xin_ctx = XL + (size_t)NLAT * 2048; E.XL = XL; E.gate = modl; E.part = nullptr;
            if (sub == 1) { g = pg8::Gemm{H, (const bf16_t*)(ws + wsh + OFF_WIN), NTOK, NP, 2048, 32}; }
            else if (sub == 3) { g = pg8::Gemm{(const bf16_t*)(ws + OFF_LA), (const bf16_t*)(ws + wsh + OFF_WLORA), NTOK, 5120, 640, 10}; E.O = (bf16_t*)(ws + OFF_LO); E.ldc = 5120; }
            else if (sub == 6) { g = pg8::Gemm{(const bf16_t*)(ws + OFF_Y3), (const bf16_t*)(ws + wsh + OFF_WBR), Ml, 2048, 1024, 16}; S.mode = 1; E.kind = 2; E.O = H; }
            else if (sub == 7) { g = pg8::Gemm{H, (const bf16_t*)(ws + wsh + OFF_WOUT), Ml, 2048, 2048, 32}; E.kind = 3; E.gate = modl + 2 * 2048;
                if (l == 0) { E.xin_lat = p->in[I_X]; E.xin_ctx = p->in[I_CTX]; } }
            else if (sub == 9) { g = pg8::Gemm{H, (const bf16_t*)(ws + wsh + OFF_WFF1), Ml, DFF, 2048, 32}; E.kind = 1; E.ldc = DFF; }
            else { g = pg8::Gemm{Pb, (const bf16_t*)(ws + wsh + OFF_WFF2), Ml, 2048, DFF, 128}; E.kind = 3; E.gate = modl + 5 * 2048; }
            if (ksplit) {
                if (part == 0) g.M = NLAT;
                else { const int ks = (int)blockIdx.x & 15; g.nt >>= 4; g.A += (size_t)ks * g.nt * 64; g.Bt += (size_t)ks * g.nt * 64; S.mode = 2; E.split = 1;
                    E.part = (float*)(ws + OFF_P + (sub == 10 ? PART_OFF : 0)) + (size_t)ks * 512 * 2048; }
            }
            S.so.init(g.M, g.N, (int)gridDim.x, (int)blockIdx.x);
            pg8::gemm_phase(ldsg, g, S, E);
            }
            if (two_wt && l == 0 && gridDim.x == 256) {
                if (sub == 1 && blockIdx.x >= 94) phase_convert(p, 1, ldsf, (int)blockIdx.x - 94, 162, WT_SHIFT, 0, 4000, false);
                if (sub == 6 && blockIdx.x >= 16) phase_convert(p, 1, ldsf, (int)blockIdx.x - 16, 240, WT_SHIFT, 4000, 11500, false);
                if (sub == 9 && blockIdx.x >= 64) phase_convert(p, 1, ldsf, (int)blockIdx.x - 64, 192, WT_SHIFT, 11500, 18816, true);
            } else if (two_wt && l == 0 && sub == 10) phase_convert(p, 1, ldsf, (int)blockIdx.x, (int)gridDim.x, WT_SHIFT, 0, 18816, true);
        } else
        switch (sub) {
        case 0: {
            phase_init(p, l);
            if (l == 1 && !two_wt) phase_convert(p, l, ldsf, (int)blockIdx.x, (int)gridDim.x, wsh, 0, 18816, true);
            if (l == 0) phase_norm(p->in[I_X], p->in[I_CTX], NTOK, p->in[I_N1G] + l * 2048, modl, 0, 1, H);
            else if (gridDim.x == 256) phase_norm(XL, XL + (size_t)NLAT * 2048, NTOK, p->in[I_N1G] + l * 2048, modl, 0, 1, H, (const float*)(ws + OFF_P + PART_OFF), MOD + 2 * 12288 + 5 * 2048, XL + (size_t)NLAT * 2048);
            else phase_norm(XL, XL + (size_t)NLAT * 2048, NTOK, p->in[I_N1G] + l * 2048, modl, 0, 1, H);
        } break;
        case 2: phase_prep(p, l, (bf16_t*)shm); break;
#if DUPMASK
        case 4: phase_mix(p, l, ldsf, rep ? DUPWHICH : 7); break;
#else
        case 4: phase_mix(p, l, ldsf); break;
#endif
        case 5: phase_post(p, l, Ml); break;
        case 8: if (l == 0 && gridDim.x == 256) phase_norm(XL, p->in[I_CTX], Ml, p->in[I_N2G] + l * 2048, modl, 3, 4, H, (const float*)(ws + OFF_P), modl + 2 * 12288 + 2 * 2048, XL + (size_t)NLAT * 2048);
                else phase_norm(XL, XL + (size_t)NLAT * 2048, Ml, p->in[I_N2G] + l * 2048, modl, 3, 4, H); break;
        }
#if DUPMASK
        }
#endif
    }
}

extern "C" void kernel_launch(void* const* d_in, const int* in_sizes, int n_in, void* d_out, int out_size, void* d_ws, size_t ws_size, hipStream_t stream) {
    static int grid = 0;
    if (grid == 0) {
        if (n_in != 28 || ws_size < WS_END) { fprintf(stderr, "kernel_launch: need 28 inputs and %zu bytes of workspace (got %d, %zu)\n", (size_t)WS_END, n_in, ws_size); grid = -1; return; }
        if (hipFuncSetAttribute((const void*)fwd_kernel, hipFuncAttributeMaxDynamicSharedMemorySize, LDS_BYTES) != hipSuccess) { fprintf(stderr, "kernel_launch: hipFuncSetAttribute failed\n"); grid = -1; return; }
        int dev = 0, cus = 0, per_cu = 0;
        hipGetDevice(&dev);
        hipDeviceGetAttribute(&cus, hipDeviceAttributeMultiprocessorCount, dev);
        hipOccupancyMaxActiveBlocksPerMultiprocessor(&per_cu, (const void*)fwd_kernel, 512, LDS_BYTES);
        if (per_cu < 1) { fprintf(stderr, "kernel_launch: occupancy query says %d blocks per CU\n", per_cu); per_cu = 1; }
        (void)hipGetLastError();
        grid = cus * 1;
        if (grid > 256) grid = 256;
    }
    if (grid < 0) return;
    Params p{};
    for (int i = 0; i < 28; ++i) p.in[i] = (const float*)d_in[i];
    p.out = (float*)d_out; p.ws = (unsigned char*)d_ws; p.two_wt = (ws_size >= WS_END + WT_BYTES) ? 1 : 0;
#if ONE_LAUNCH
    p.ph_lo = 0; p.ph_hi = NPHASE;
    void* args[] = {&p};
    hipError_t e = hipLaunchCooperativeKernel((const void*)fwd_kernel, dim3(grid), dim3(512), args, LDS_BYTES, stream);
    if (e != hipSuccess) fprintf(stderr, "cooperative launch failed: %s (grid %d)\n", hipGetErrorString(e), grid);
#else
    for (int ph = 0; ph < NPHASE; ++ph) {
        p.ph_lo = ph; p.ph_hi = ph + 1;
        hipLaunchKernelGGL(fwd_kernel, dim3(grid), dim3(512), LDS_BYTES, stream, p);
    }
#endif
}
```

```cpp
#include <hip/hip_runtime.h>
#include <hip/hip_cooperative_groups.h>
#include <cstdio>
namespace cg = cooperative_groups;

#ifndef ONE_LAUNCH
#define ONE_LAUNCH 1
#endif

#define DEVI __device__ __forceinline__
#define LAS __attribute__((address_space(3)))
typedef unsigned short bf16_t;
typedef short bf16x8 __attribute__((ext_vector_type(8)));
typedef short bf16x4 __attribute__((ext_vector_type(4)));
typedef float f32x4 __attribute__((ext_vector_type(4)));
typedef float f32x2 __attribute__((ext_vector_type(2)));
typedef unsigned u32x4 __attribute__((ext_vector_type(4)));
typedef unsigned u32x2 __attribute__((ext_vector_type(2)));

constexpr int D = 2048, NTOK = 8704, NLAT = 8192, NP = 16128, DIN = 16016, DFF = 8192;
constexpr int RWB = 3088, NAB = 6800, GTB = 9872;
constexpr int LDS_BYTES = 131072;
constexpr int NPHASE = 24;

constexpr size_t OFF_CTL = 0;
constexpr size_t OFF_MOD = 4096;
constexpr size_t OFF_ROPE = OFF_MOD + 2ull * 3 * 12288 * 4;
constexpr size_t OFF_WIN = OFF_ROPE + 16384;
constexpr size_t OFF_WBR = OFF_WIN + 16128ull * 2048 * 2;
constexpr size_t OFF_WOUT = OFF_WBR + 3ull * 2048 * 1024 * 2;
constexpr size_t OFF_WFF1 = OFF_WOUT + 2048ull * 2048 * 2;
constexpr size_t OFF_WFF2 = OFF_WFF1 + 8192ull * 2048 * 2;
constexpr size_t OFF_WLORA = OFF_WFF2 + 8192ull * 2048 * 2;
constexpr size_t OFF_XL = OFF_WLORA + 5120ull * 640 * 2;
constexpr size_t OFF_H = OFF_XL + 8704ull * 2048 * 4;
constexpr size_t OFF_P = OFF_H + 8704ull * 2048 * 2;
constexpr size_t OFF_LA = OFF_P + 8704ull * 16128 * 2;
constexpr size_t OFF_LO = OFF_LA + 8704ull * 640 * 2;
constexpr size_t OFF_YRWF = OFF_LO + 8704ull * 5120 * 2;
constexpr size_t OFF_MLNUM = OFF_YRWF + 2ull * 8704 * 1024 * 4;
constexpr size_t OFF_VT = OFF_MLNUM + 2ull * 8704 * 4 * 272 * 4;
constexpr size_t OFF_Y3 = OFF_VT + 2ull * 8 * 128 * 4352 * 2;
constexpr size_t OFF_RK = OFF_Y3 + 3ull * 8704 * 1024 * 2;
constexpr size_t WS_END = OFF_RK + 8704ull * 16 * 4;
constexpr size_t WT_BYTES = OFF_XL - OFF_WIN, WT_SHIFT = WS_END - OFF_WIN;

struct Params {
    const float* in[28];
    float* out;
    unsigned char* ws;
    int ph_lo, ph_hi, two_wt, pad_;
};
typedef const __attribute__((address_space(4))) Params* PP;
enum { I_X = 0, I_C, I_CTX, I_CCTX, I_WMOD, I_BMOD, I_N1G, I_WIN, I_MLGB, I_MLNG, I_RWMU, I_RWW0, I_RWWUP, I_RWA0, I_RWAUP, I_RWGUP,
       I_RWKK, I_RWKA, I_RWRK, I_RWLNW, I_RWLNB, I_RPB, I_WBR, I_WOUT, I_N2G, I_WFF1, I_WFF2, I_FING };

DEVI int otid() { int t; asm volatile("v_mov_b32 %0, %1" : "=v"(t) : "v"((int)threadIdx.x)); return t; }
DEVI float bf2f(bf16_t b) { return __uint_as_float(((unsigned)b) << 16); }
DEVI float bflo(unsigned u) { return __uint_as_float(u << 16); }
DEVI float bfhi(unsigned u) { return __uint_as_float(u & 0xffff0000u); }
DEVI bf16_t f2bf(float f) { unsigned u = __float_as_uint(f); u += 0x7FFFu + ((u >> 16) & 1u); return (bf16_t)(u >> 16); }
DEVI unsigned pack2(float lo, float hi) { return (unsigned)f2bf(lo) | ((unsigned)f2bf(hi) << 16); }
DEVI float sigmoidf(float x) { return 1.0f / (1.0f + __expf(-x)); }
#define DPP_ADD(x, CTRL) ((x) + __int_as_float(__builtin_amdgcn_update_dpp(0, __float_as_int(x), CTRL, 0xF, 0xF, true)))
DEVI float wsum(float x) {
    x = DPP_ADD(x, 0xB1); x = DPP_ADD(x, 0x4E); x = DPP_ADD(x, 0x141); x = DPP_ADD(x, 0x140);
    const int xi = __float_as_int(x);
    return (__int_as_float(__builtin_amdgcn_readlane(xi, 0)) + __int_as_float(__builtin_amdgcn_readlane(xi, 16))) + (__int_as_float(__builtin_amdgcn_readlane(xi, 32)) + __int_as_float(__builtin_amdgcn_readlane(xi, 48)));
}
DEVI float red8(float x) {
    x = DPP_ADD(x, 0xB1);
    x = DPP_ADD(x, 0x4E);
    x = DPP_ADD(x, 0x141);
    return x;
}

DEVI float red16(float x) {
    x = DPP_ADD(x, 0xB1); x = DPP_ADD(x, 0x4E); x = DPP_ADD(x, 0x141); x = DPP_ADD(x, 0x140);
    return x;
}
DEVI float sfma(float a, float b, float c) { float d; asm("v_fma_f32 %0, %1, %2, %3" : "=v"(d) : "v"(a), "v"(b), "v"(c)); return d; }
DEVI float smul(float a, float b) { float d; asm("v_mul_f32 %0, %1, %2" : "=v"(d) : "v"(a), "v"(b)); return d; }
DEVI void fadd_g(float* ptr, float v) { (void)__builtin_amdgcn_global_atomic_fadd_f32((__attribute__((address_space(1))) float*)ptr, v); }
DEVI float frcp(float x) { return __builtin_amdgcn_rcpf(x); }
DEVI float fsigmoid(float x) { return __builtin_amdgcn_rcpf(1.0f + __expf(-x)); }

namespace pg8 {
constexpr int BM = 256, BK = 64, HALF = 128, HTB = HALF * BK * 2, STAGE_BYTES = 8 * HTB, NXCD = 8, WGM = 8;
__host__ __device__ __forceinline__ int lds_byte(int r, int c) { const int st = (r >> 4) * 2 + (c >> 5), rr = r & 15, cc = c & 31, ob = rr * 64 + cc * 2; return st * 1024 + (ob ^ (((ob >> 9) & 1) << 5)); }
__host__ __device__ __forceinline__ void stage_rc(int b, int& R, int& C) { const int st = b / 1024, sb = b % 1024, swz = sb ^ (((sb >> 9) & 1) << 5); R = (st >> 1) * 16 + swz / 64; C = (st & 1) * 32 + (swz % 64) / 2; }
__host__ __device__ __forceinline__ int perm32(int rho) { const int n = rho >> 4, i = rho & 15; return 8 * (i >> 2) + 4 * n + (i & 3); }
struct Unit { int pm, pn; };
struct Gemm { const bf16_t* A; const bf16_t* Bt; int M, N, K, nt; };
struct StaticOrder {
    int nM, nN, nwg, G, c;
    __device__ void init(int M, int N, int G_, int c_) { nM = M / BM; nN = N / BM; nwg = nM * nN; G = G_; c = c_; }
    __device__ bool next(int i, Unit& u) const {
        const long L = (long)i * G + c; if (L >= nwg) return false;
        int wgid = (int)L; { const int q = nwg / NXCD, r = nwg % NXCD, xcd = wgid % NXCD, off = wgid / NXCD; wgid = (xcd < r ? xcd * (q + 1) : r * (q + 1) + (xcd - r) * q) + off; }
        const int nig = WGM * nN, gid = wgid / nig, fm = gid * WGM, gsz = (nM - fm) < WGM ? (nM - fm) : WGM;
        u.pm = fm + ((wgid % nig) % gsz); u.pn = (wgid % nig) / gsz; return true;
    }
    __device__ __forceinline__ void a_ready(const Unit&) const {}
    __device__ __forceinline__ void done(const Unit&) const {}
};
struct MergeOrder {
    int ntiles, G, c;
    __device__ void init(int nM, int G_, int c_) { ntiles = nM * 8; G = G_; c = c_; }
    __device__ bool next(int i, Unit& u) const {
        const int ti = i / 3, br = i - ti * 3; const long L = (long)ti * G + c; if (L >= ntiles) return false;
        const int pm = (int)L >> 3, pn = (int)L & 7; u.pm = br * 34 + pm; u.pn = br * 8 + pn; return true;
    }
    __device__ __forceinline__ void a_ready(const Unit&) const {}
    __device__ __forceinline__ void done(const Unit&) const {}
};
DEVI unsigned cvt_pk_bf16(float lo, float hi) { unsigned r; asm volatile("v_cvt_pk_bf16_f32 %0, %1, %2" : "=v"(r) : "v"(lo), "v"(hi)); return r; }


struct SchedG {
    int mode;
    StaticOrder so; MergeOrder mo;
    __device__ __forceinline__ bool next(int i, Unit& u) const {
        if (mode == 2) { if (i > 0) return false; const int cu = so.c >> 4; u.pm = 32 + (cu >> 3); u.pn = cu & 7; return true; }
        return mode == 0 ? so.next(i, u) : mo.next(i, u); }
    __device__ __forceinline__ void a_ready(const Unit&) const {}
    __device__ __forceinline__ void done(const Unit&) const {}
};
struct EpiG {
    static constexpr bool PERM = true, AFTER_DRAIN = false;
    int kind, split;
    bf16_t* O; int ldc;
    const bf16_t* P; float* ACC;
    const float* xin_lat; const float* xin_ctx; float* XL; const float* gate; float* part;
    __device__ __forceinline__ void operator()(const f32x4 (&acc)[2][2][4][2], const Unit& u, int wr, int wc, int fr, int fq) const {
        if (kind <= 1) {
            const int row0 = u.pm * BM + wr * 64 + fr, col0 = u.pn * BM + wc * 32 + 8 * fq;
#pragma unroll
            for (int ai = 0; ai < 2; ++ai)
#pragma unroll
                for (int m = 0; m < 4; ++m) { bf16_t* rowp = O + (size_t)(row0 + ai * HALF + m * 16) * ldc + col0;
#pragma unroll
                    for (int bj = 0; bj < 2; ++bj) { f32x4 v0 = acc[ai][bj][m][0], v1 = acc[ai][bj][m][1];
                        if (kind == 1) {
#pragma unroll
                            for (int i = 0; i < 4; ++i) { float a = fmaxf(v0[i], 0.f), b = fmaxf(v1[i], 0.f); v0[i] = a * a; v1[i] = b * b; } }
                        u32x4 o; o[0] = cvt_pk_bf16(v0[0], v0[1]); o[1] = cvt_pk_bf16(v0[2], v0[3]); o[2] = cvt_pk_bf16(v1[0], v1[1]); o[3] = cvt_pk_bf16(v1[2], v1[3]);
                        *(u32x4*)(rowp + bj * HALF) = o; } }
        } else if (kind == 2) {
            const int br = u.pn >> 3, pn = u.pn & 7, pm = u.pm - br * 34;
            const int row0 = pm * BM + wr * 64 + fr, col0 = pn * BM + wc * 32 + 8 * fq;
#pragma unroll
            for (int ai = 0; ai < 2; ++ai)
#pragma unroll
                for (int m = 0; m < 4; ++m) { const size_t row = (size_t)(row0 + ai * HALF + m * 16);
#pragma unroll
                    for (int bj = 0; bj < 2; ++bj) { const int col = col0 + bj * HALF;
                        const u32x4 gv = *(const u32x4*)(P + row * NP + GTB + br * 2048 + col);
                        f32x4 v0 = acc[ai][bj][m][0], v1 = acc[ai][bj][m][1];
                        v0[0] *= sigmoidf(bflo(gv[0])); v0[1] *= sigmoidf(bfhi(gv[0])); v0[2] *= sigmoidf(bflo(gv[1])); v0[3] *= sigmoidf(bfhi(gv[1]));
                        v1[0] *= sigmoidf(bflo(gv[2])); v1[1] *= sigmoidf(bfhi(gv[2])); v1[2] *= sigmoidf(bflo(gv[3])); v1[3] *= sigmoidf(bfhi(gv[3]));
                        float* ap = ACC + row * 2048 + col;
                        if (br == 0) { *(f32x4*)ap = v0; *(f32x4*)(ap + 4) = v1; }
                        else { v0 += *(const f32x4*)ap; v1 += *(const f32x4*)(ap + 4);
                            if (br == 1) { *(f32x4*)ap = v0; *(f32x4*)(ap + 4) = v1; }
                            else { u32x4 o; o[0] = cvt_pk_bf16(v0[0], v0[1]); o[1] = cvt_pk_bf16(v0[2], v0[3]); o[2] = cvt_pk_bf16(v1[0], v1[1]); o[3] = cvt_pk_bf16(v1[2], v1[3]);
                                *(u32x4*)(O + row * 2048 + col) = o; } } } }
        } else {
            const int row0 = u.pm * BM + wr * 64 + fr, col0 = u.pn * BM + wc * 32 + 8 * fq;
#pragma unroll
            for (int ai = 0; ai < 2; ++ai)
#pragma unroll
                for (int m = 0; m < 4; ++m) { const int row = row0 + ai * HALF + m * 16;
                    const int mrow = row < NLAT ? (row >> 12) : 2;
                    const float* xr = row < NLAT ? xin_lat + (size_t)row * 2048 : xin_ctx + (size_t)(row - NLAT) * 2048;
                    const float* gr = gate + (size_t)mrow * 12288; float* orow = XL + (size_t)row * 2048;
#pragma unroll
                    for (int bj = 0; bj < 2; ++bj)
#pragma unroll
                        for (int n = 0; n < 2; ++n) { const int col = col0 + bj * HALF + n * 4;
                            const f32x4 g = *(const f32x4*)(gr + col);
                            if (split) *(f32x4*)(part + (size_t)(row - NLAT) * 2048 + col) = acc[ai][bj][m][n];
                            else { const f32x4 x = *(const f32x4*)(xr + col); *(f32x4*)(orow + col) = x + g * acc[ai][bj][m][n]; } } }
        }
    }
};
template <class Epi, class Sched>
__device__ __forceinline__ void gemm_phase(LAS unsigned char* lds, const Gemm g, const Sched& S, const Epi& E) {
    const int tid = otid(), wid = __builtin_amdgcn_readfirstlane(tid >> 6), lane = tid & 63, wr = wid >> 2, wc = wid & 3, fr = lane & 15, fq = lane >> 4;
    const int K = g.K, nt = g.nt;
    unsigned voffA[2], voffB[2];
#pragma unroll
    for (int i = 0; i < 2; ++i) { int R, C; stage_rc(tid * 16 + i * 8192, R, C); const int Rb = Epi::PERM ? ((R & ~31) + perm32(R & 31)) : R;
        voffA[i] = (unsigned)(R * K + C) * 2u; voffB[i] = (unsigned)(Rb * K + C) * 2u; }
    const size_t kstep = (size_t)(BK * 2);
    const size_t hstep = (size_t)HALF * K * 2;
    const size_t tstep = 2 * hstep;
    const unsigned ldsw = (unsigned)wid * 1024u;
    const int aoff = lds_byte(wr * 64 + fr, fq * 8), boff = lds_byte(wc * 32 + fr, fq * 8);
#define PG8_SA(b, h) (((b) * 2 + (h)) * HTB)
#define PG8_SB(b, h) ((4 + (b) * 2 + (h)) * HTB)
#define PG8_STAGE(bufoff, gbase, voff) do { _Pragma("unroll") for (int _i = 0; _i < 2; ++_i) \
        __builtin_amdgcn_global_load_lds((const unsigned*)((const char*)(gbase) + (voff)[_i]), (LAS unsigned*)(lds + (bufoff) + ldsw + _i * 8192), 16, 0, 0); } while (0)
#define PG8_LDA(dst, b, h) do { _Pragma("unroll") for (int m = 0; m < 4; ++m) _Pragma("unroll") for (int k = 0; k < 2; ++k) dst[m][k] = *(const LAS bf16x8*)(lds + PG8_SA(b, h) + aoff + m * 2048 + k * 1024); } while (0)
#define PG8_LDB(dst, b, h) do { _Pragma("unroll") for (int n = 0; n < 2; ++n) _Pragma("unroll") for (int k = 0; k < 2; ++k) dst[n][k] = *(const LAS bf16x8*)(lds + PG8_SB(b, h) + boff + n * 2048 + k * 1024); } while (0)
#define PG8_MMA(ai, bj, At, Bt) do { __builtin_amdgcn_s_setprio(1); _Pragma("unroll") for (int m = 0; m < 4; ++m) _Pragma("unroll") for (int n = 0; n < 2; ++n) _Pragma("unroll") for (int k = 0; k < 2; ++k) \
        acc[ai][bj][m][n] = __builtin_amdgcn_mfma_f32_16x16x32_bf16(Bt[n][k], At[m][k], acc[ai][bj][m][n], 0, 0, 0); __builtin_amdgcn_s_setprio(0); } while (0)
#define PG8_WAIT_V(n) asm volatile("s_waitcnt vmcnt(" #n ")" ::: "memory")
#define PG8_WAIT_L(n) asm volatile("s_waitcnt lgkmcnt(" #n ")" ::: "memory")
#define PG8_BAR __builtin_amdgcn_s_barrier()
#define PG8_SCHED __builtin_amdgcn_sched_barrier(0)
    Unit cur, nxt; int ui = 0;
    if (!S.next(0, cur)) return;
    f32x4 acc[2][2][4][2];
#pragma unroll
    for (int a = 0; a < 2; ++a)
#pragma unroll
        for (int b = 0; b < 2; ++b)
#pragma unroll
            for (int m = 0; m < 4; ++m)
#pragma unroll
                for (int n = 0; n < 2; ++n) acc[a][b][m][n] = (f32x4){0.f, 0.f, 0.f, 0.f};
    bf16x8 At[4][2], B0[2][2], B1[2][2];
    const char* cA = (const char*)g.A + (size_t)cur.pm * tstep; const char* cB = (const char*)g.Bt + (size_t)cur.pn * tstep;
    S.a_ready(cur);
    PG8_STAGE(PG8_SB(0, 0), cB, voffB); PG8_STAGE(PG8_SA(0, 0), cA, voffA); PG8_STAGE(PG8_SB(0, 1), cB + hstep, voffB); PG8_STAGE(PG8_SA(0, 1), cA + hstep, voffA);
    if (wr == 1) PG8_BAR;
    PG8_WAIT_V(4); PG8_BAR;
    PG8_STAGE(PG8_SB(1, 0), cB + kstep, voffB); PG8_STAGE(PG8_SA(1, 0), cA + kstep, voffA); PG8_STAGE(PG8_SB(1, 1), cB + hstep + kstep, voffB);
    PG8_WAIT_V(6); PG8_BAR;
    for (;;) {
        const bool has_next = S.next(ui + 1, nxt);
        const char* nA = has_next ? (const char*)g.A + (size_t)nxt.pm * tstep : cA; const char* nB = has_next ? (const char*)g.Bt + (size_t)nxt.pn * tstep : cB;
        for (int t = 0; t < nt; t += 2) {
            const bool last = (t == nt - 2);
            const char* a1 = cA + (size_t)(t + 1) * kstep;
            const char* a2 = last ? nA : cA + (size_t)(t + 2) * kstep; const char* b2 = last ? nB : cB + (size_t)(t + 2) * kstep;
            const char* a3 = a2 + kstep; const char* b3 = b2 + kstep;
            if (last && has_next) S.a_ready(nxt);
            PG8_LDB(B0, 0, 0); PG8_SCHED; PG8_LDA(At, 0, 0); PG8_STAGE(PG8_SA(1, 1), a1 + hstep, voffA);
            PG8_WAIT_L(8); PG8_BAR; PG8_WAIT_L(0); PG8_MMA(0, 0, At, B0); PG8_BAR; PG8_SCHED;
            PG8_LDB(B1, 0, 1); PG8_STAGE(PG8_SB(0, 0), b2, voffB);
            PG8_BAR; PG8_WAIT_L(0); PG8_MMA(0, 1, At, B1); PG8_BAR;
            PG8_LDA(At, 0, 1); PG8_STAGE(PG8_SA(0, 0), a2, voffA);
            PG8_BAR; PG8_WAIT_L(0); PG8_MMA(1, 0, At, B0); PG8_BAR; PG8_SCHED;
            PG8_STAGE(PG8_SB(0, 1), b2 + hstep, voffB);
            PG8_WAIT_V(6); PG8_BAR; PG8_MMA(1, 1, At, B1); PG8_BAR;
            PG8_LDB(B0, 1, 0); PG8_SCHED; PG8_LDA(At, 1, 0); PG8_STAGE(PG8_SA(0, 1), a2 + hstep, voffA);
            PG8_WAIT_L(8); PG8_BAR; PG8_WAIT_L(0); PG8_MMA(0, 0, At, B0); PG8_BAR; PG8_SCHED;
            PG8_LDB(B1, 1, 1); PG8_STAGE(PG8_SB(1, 0), b3, voffB);
            PG8_BAR; PG8_WAIT_L(0); PG8_MMA(0, 1, At, B1); PG8_BAR;
            PG8_LDA(At, 1, 1); PG8_STAGE(PG8_SA(1, 0), a3, voffA);
            PG8_BAR; PG8_WAIT_L(0); PG8_MMA(1, 0, At, B0); PG8_BAR; PG8_SCHED;
            PG8_STAGE(PG8_SB(1, 1), b3 + hstep, voffB);
            PG8_WAIT_V(6); PG8_BAR; PG8_MMA(1, 1, At, B1); PG8_BAR;
        }
        if constexpr (!Epi::AFTER_DRAIN) { E(acc, cur, wr, wc, fr, fq); S.done(cur); }
        if (!has_next) break;
#pragma unroll
        for (int a = 0; a < 2; ++a)
#pragma unroll
            for (int b = 0; b < 2; ++b)
#pragma unroll
                for (int m = 0; m < 4; ++m)
#pragma unroll
                    for (int n = 0; n < 2; ++n) acc[a][b][m][n] = (f32x4){0.f, 0.f, 0.f, 0.f};
        cur = nxt; cA = nA; cB = nB; ++ui;
    }
    PG8_WAIT_V(0);
    if (wr == 0) PG8_BAR;
    PG8_BAR;
    if constexpr (Epi::AFTER_DRAIN) { E.fused(acc, cur, wr, wc, fr, fq, lds, wid, lane); S.done(cur); }
#undef PG8_SA
#undef PG8_SB
#undef PG8_STAGE
#undef PG8_LDA
#undef PG8_LDB
#undef PG8_MMA
#undef PG8_WAIT_V
#undef PG8_WAIT_L
#undef PG8_BAR
#undef PG8_SCHED
}
}

__device__ void phase_mod(PP p, float* lds) {
    const int TIDX = otid();
    const int tid = TIDX;
    float* s = lds;
    float* red = lds + 3 * 2048;
    float* MOD = (float*)(p->ws + OFF_MOD);
    for (int i = tid; i < 3 * 2048; i += 512) { const int r = i >> 11, k = i & 2047; const float c = r < 2 ? p->in[I_C][r * 2048 + k] : p->in[I_CCTX][k]; s[i] = c * sigmoidf(c); }
    __syncthreads();
    for (int task = blockIdx.x; task < 192; task += gridDim.x) {
        const int l = task / 96, j0 = (task % 96) * 128, jc = tid & 127, kp = tid >> 7;
        const float* w = p->in[I_WMOD] + (size_t)l * 2048 * 12288 + j0 + jc;
        float a0 = 0.f, a1 = 0.f, a2 = 0.f;
#pragma unroll 8
        for (int k = kp * 512; k < kp * 512 + 512; ++k) { const float wv = w[(size_t)k * 12288]; a0 += s[k] * wv; a1 += s[2048 + k] * wv; a2 += s[4096 + k] * wv; }
        red[(kp * 3 + 0) * 128 + jc] = a0; red[(kp * 3 + 1) * 128 + jc] = a1; red[(kp * 3 + 2) * 128 + jc] = a2;
        __syncthreads();
        if (tid < 384) { const int r = tid >> 7, j = tid & 127;
            const float v = ((red[(0 * 3 + r) * 128 + j] + red[(1 * 3 + r) * 128 + j]) + (red[(2 * 3 + r) * 128 + j] + red[(3 * 3 + r) * 128 + j])) + p->in[I_BMOD][l * 12288 + j0 + j];
            MOD[(size_t)(l * 3 + r) * 12288 + j0 + j] = v; }
        __syncthreads();
    }
    if (blockIdx.x == gridDim.x - 1) {
        float* rc = (float*)(p->ws + OFF_ROPE); float* rs = rc + 2048;
        for (int i = tid; i < 2048; i += 512) { const int pos = i >> 5, j = i & 31; const float fr = powf(10000.0f, -(float)j / 32.0f); const float ang = (float)pos * fr; rc[i] = cosf(ang); rs[i] = sinf(ang); }
    }
}

__device__ void conv_tile(const float* __restrict__ src, int ld_src, int n_valid, int n0, int k0, bf16_t* __restrict__ dst, int ld_dst, float* tile) {
    const int TIDX = otid();
    const int tid = TIDX;
#pragma unroll
    for (int i = 0; i < 2; ++i) { const int kr = (tid >> 4) + i * 32, nc = (tid & 15) * 4; const float* sp = src + (size_t)(k0 + kr) * ld_src + n0 + nc;
        f32x4 v;
        if (n0 + nc + 3 < n_valid) v = *(const f32x4*)sp;
        else { v[0] = (n0 + nc + 0 < n_valid) ? sp[0] : 0.f; v[1] = (n0 + nc + 1 < n_valid) ? sp[1] : 0.f; v[2] = (n0 + nc + 2 < n_valid) ? sp[2] : 0.f; v[3] = (n0 + nc + 3 < n_valid) ? sp[3] : 0.f; }
        float* tp = tile + kr * 65 + nc; tp[0] = v[0]; tp[1] = v[1]; tp[2] = v[2]; tp[3] = v[3]; }
    __syncthreads();
    { const int n = tid >> 3, kc = (tid & 7) * 8; u32x4 o;
#pragma unroll
        for (int j = 0; j < 4; ++j) o[j] = pack2(tile[(kc + 2 * j) * 65 + n], tile[(kc + 2 * j + 1) * 65 + n]);
        *(u32x4*)(dst + (size_t)(n0 + n) * ld_dst + k0 + kc) = o; }
    __syncthreads();
}
__device__ void phase_convert(PP p, int l, float* lds, int vb, int vg, size_t wsh, int t_lo, int t_hi, bool lora) {
    const int TIDX = otid();
    unsigned char* wsw = p->ws + wsh;
    for (int t = t_lo + vb; t < t_hi; t += vg) {
        if (t < 8064) { const int nt = t >> 5, kt = t & 31; conv_tile(p->in[I_WIN] + (size_t)l * 2048 * DIN, DIN, DIN, nt * 64, kt * 64, (bf16_t*)(wsw + OFF_WIN), 2048, lds); }
        else if (t < 9600) { const int tt = t - 8064, br = tt >> 9, r = tt & 511, nt = r >> 4, kt = r & 15;
            conv_tile(p->in[I_WBR] + (size_t)(l * 3 + br) * 1024 * 2048, 2048, 2048, nt * 64, kt * 64, (bf16_t*)(wsw + OFF_WBR) + (size_t)br * 2048 * 1024, 1024, lds); }
        else if (t < 10624) { const int tt = t - 9600, nt = tt >> 5, kt = tt & 31; conv_tile(p->in[I_WOUT] + (size_t)l * 2048 * 2048, 2048, 2048, nt * 64, kt * 64, (bf16_t*)(wsw + OFF_WOUT), 2048, lds); }
        else if (t < 14720) { const int tt = t - 10624, nt = tt >> 5, kt = tt & 31; conv_tile(p->in[I_WFF1] + (size_t)l * 2048 * 8192, 8192, 8192, nt * 64, kt * 64, (bf16_t*)(wsw + OFF_WFF1), 2048, lds); }
        else { const int tt = t - 14720, nt = tt >> 7, kt = tt & 127; conv_tile(p->in[I_WFF2] + (size_t)l * 8192 * 2048, 2048, 2048, nt * 64, kt * 64, (bf16_t*)(wsw + OFF_WFF2), 8192, lds); }
    }
    bf16_t* WL = (bf16_t*)(wsw + OFF_WLORA);
    if (lora) for (int idx = vb * 512 + TIDX; idx < 5120 * 640; idx += vg * 512) {
        const int n = idx / 640, k = idx - n * 640, blk = n >> 10, nn = n & 1023;
        const int k0 = blk < 4 ? blk * 96 : 384, kw = blk < 4 ? 96 : 256;
        float v = 0.f;
        if (k >= k0 && k < k0 + kw) {
            const float* sp = blk < 2 ? p->in[I_RWWUP] + (size_t)(l * 2 + blk) * 96 * 1024 : (blk < 4 ? p->in[I_RWAUP] + (size_t)(l * 2 + blk - 2) * 96 * 1024 : p->in[I_RWGUP] + (size_t)l * 256 * 1024);
            v = sp[(size_t)(k - k0) * 1024 + nn]; }
        WL[idx] = f2bf(v);
    }
}
__device__ void phase_init(PP p, int l) {
    const int TIDX = otid();
    if (blockIdx.x == 0 && TIDX < 8) ((unsigned*)(p->ws + OFF_CTL))[l * 8 + TIDX] = 0u;
}

__device__ __forceinline__ void phase_norm(const float* __restrict__ xlat, const float* __restrict__ xctx, int nrows, const float* __restrict__ g, const float* __restrict__ modl, int ishift, int iscale, bf16_t* __restrict__ H,
                           const float* part = nullptr, const float* pgate = nullptr, float* xl_ctx = nullptr) {
    const int TIDX = otid();
    const int wid = TIDX >> 6, lane = TIDX & 63;
    for (int row = blockIdx.x * 8 + wid; row < nrows; row += gridDim.x * 8) {
        const float* xr = row < NLAT ? xlat + (size_t)row * 2048 : xctx + (size_t)(row - NLAT) * 2048;
        const int mrow = row < NLAT ? (row >> 12) : 2;
        const float* sh = modl + (size_t)mrow * 12288 + ishift * 2048; const float* sc = modl + (size_t)mrow * 12288 + iscale * 2048;
        f32x4 v[8]; float ss = 0.f;
#pragma unroll
        for (int i = 0; i < 8; ++i) v[i] = *(const f32x4*)(xr + (i * 64 + lane) * 4);
        if (part != nullptr && row >= NLAT) {
#pragma unroll
            for (int i = 0; i < 8; ++i) { const int col = (i * 64 + lane) * 4; const float* pp = part + (size_t)(row - NLAT) * 2048 + col;
                f32x4 a = *(const f32x4*)pp;
#pragma unroll
                for (int s_ = 1; s_ < 16; ++s_) a += *(const f32x4*)(pp + (size_t)s_ * 512 * 2048);
                v[i] += *(const f32x4*)(pgate + col) * a;
                *(f32x4*)(xl_ctx + (size_t)(row - NLAT) * 2048 + col) = v[i]; } }
#pragma unroll
        for (int i = 0; i < 8; ++i) ss += v[i][0] * v[i][0] + v[i][1] * v[i][1] + v[i][2] * v[i][2] + v[i][3] * v[i][3];
        ss = wsum(ss);
        const float r = rsqrtf(ss * (1.0f / 2048.0f) + 1e-6f);
#pragma unroll
        for (int i = 0; i < 8; ++i) { const int col = (i * 64 + lane) * 4; const f32x4 gg = *(const f32x4*)(g + col), s1 = *(const f32x4*)(sc + col), s0 = *(const f32x4*)(sh + col);
            float o[4];
#pragma unroll
            for (int j = 0; j < 4; ++j) o[j] = (v[i][j] * r * gg[j]) * (1.0f + s1[j]) + s0[j];
            u32x2 w; w[0] = pack2(o[0], o[1]); w[1] = pack2(o[2], o[3]);
            *(u32x2*)(H + (size_t)row * 2048 + col) = w; }
    }
}
__device__ void phase_final(PP p) {
    const int TIDX = otid();
    const int wid = TIDX >> 6, lane = TIDX & 63;
    const float* XL = (const float*)(p->ws + OFF_XL); const float* g = p->in[I_FING];
    for (int row = blockIdx.x * 8 + wid; row < NLAT; row += gridDim.x * 8) {
        const float* xr = XL + (size_t)row * 2048;
        f32x4 v[8]; float ss = 0.f;
#pragma unroll
        for (int i = 0; i < 8; ++i) { v[i] = *(const f32x4*)(xr + (i * 64 + lane) * 4); ss += v[i][0] * v[i][0] + v[i][1] * v[i][1] + v[i][2] * v[i][2] + v[i][3] * v[i][3]; }
        ss = wsum(ss);
        const float r = rsqrtf(ss * (1.0f / 2048.0f) + 1e-6f);
#pragma unroll
        for (int i = 0; i < 8; ++i) { const int col = (i * 64 + lane) * 4; const f32x4 gg = *(const f32x4*)(g + col);
            f32x4 o; o[0] = v[i][0] * r * gg[0]; o[1] = v[i][1] * r * gg[1]; o[2] = v[i][2] * r * gg[2]; o[3] = v[i][3] * r * gg[3];
            *(f32x4*)(p->out + (size_t)row * 2048 + col) = o; }
    }
}

DEVI void seq_nbrs(int row, bool& hp, bool& hn) {
    if (row < NLAT) { const int t = row & 4095; hp = t > 0; hn = t < 4095; } else { const int m = (row - NLAT) & 255; hp = m > 0; hn = m < 255; }
}
DEVI float shiftf(float c, float pv, float nx, float mu) { return c + mu * (0.5f * (pv + nx) - c); }

__device__ void phase_prep(PP p, int l, bf16_t* ldsT) {
    const int TIDX = otid();
    const bf16_t* P = (const bf16_t*)(p->ws + OFF_P); bf16_t* LA = (bf16_t*)(p->ws + OFF_LA);
    const float* mu = p->in[I_RWMU] + (size_t)l * 3712 + 3072;
    for (int idx = blockIdx.x * 512 + TIDX; idx < NTOK * 80; idx += gridDim.x * 512) {
        const int row = idx / 80, j = (idx - row * 80) * 8;
        bool hp, hn; seq_nbrs(row, hp, hn);
        const bf16_t* pc = P + (size_t)row * NP + RWB + 3072 + j;
        const u32x4 c = *(const u32x4*)pc;
        const u32x4 z = {0u, 0u, 0u, 0u};
        const u32x4 pv = hp ? *(const u32x4*)(pc - NP) : z, nx = hn ? *(const u32x4*)(pc + NP) : z;
        float o[8];
#pragma unroll
        for (int q = 0; q < 4; ++q) { o[2 * q] = shiftf(bflo(c[q]), bflo(pv[q]), bflo(nx[q]), mu[j + 2 * q]); o[2 * q + 1] = shiftf(bfhi(c[q]), bfhi(pv[q]), bfhi(nx[q]), mu[j + 2 * q + 1]); }
        if (j < 192) {
#pragma unroll
            for (int q = 0; q < 8; ++q) o[q] = tanhf(o[q]); }
        else if (j >= 384) {
#pragma unroll
            for (int q = 0; q < 8; ++q) o[q] = sigmoidf(o[q]); }
        u32x4 w; w[0] = pack2(o[0], o[1]); w[1] = pack2(o[2], o[3]); w[2] = pack2(o[4], o[5]); w[3] = pack2(o[6], o[7]);
        *(u32x4*)(LA + (size_t)row * 640 + j) = w;
    }
    bf16_t* VT = (bf16_t*)(p->ws + OFF_VT);
    const int tid = TIDX;
    for (int t = blockIdx.x; t < 136 * 16; t += gridDim.x) {
        const int rt = t >> 4, hd = t & 15, h = hd >> 1, dh = hd & 1;
        const int row0 = rt * 64;
        { const int tl = tid >> 3, dc = (tid & 7) * 8;
            const u32x4 v = *(const u32x4*)(P + (size_t)(row0 + tl) * NP + NAB + 2048 + h * 128 + dh * 64 + dc);
            bf16_t* tp = ldsT + tl * 66 + dc;
#pragma unroll
            for (int q = 0; q < 4; ++q) { tp[2 * q] = (bf16_t)(v[q] & 0xffffu); tp[2 * q + 1] = (bf16_t)(v[q] >> 16); } }
        __syncthreads();
        { const int d = tid >> 3, tc = (tid & 7) * 8;
            int b, pos; if (row0 < NLAT) { b = row0 >> 12; pos = row0 & 4095; } else { b = (row0 - NLAT) >> 8; pos = 4096 + ((row0 - NLAT) & 255); }
            u32x4 o;
#pragma unroll
            for (int q = 0; q < 4; ++q) o[q] = (unsigned)ldsT[(tc + 2 * q) * 66 + d] | ((unsigned)ldsT[(tc + 2 * q + 1) * 66 + d] << 16);
            *(u32x4*)(VT + ((size_t)((b * 8 + h) * 128 + dh * 64 + d)) * 4352 + pos + tc) = o; }
        __syncthreads();
    }
}

DEVI int scan_row(int s, int b, int dir) {
    if (s < 256) { const int m = dir ? 255 - s : s; return NLAT + b * 256 + m; }
    const int t = dir ? 4095 - (s - 256) : s - 256; return b * 4096 + t;
}
__device__ void rwkv_scan(PP p, int l, int task, float* lds) {
    const int TIDX = otid();
    const int chain = task >> 1, half = task & 1;
    const int b = chain >> 5, h = (chain >> 1) & 15, dir = chain & 1, tid = TIDX;
    const bf16_t* P = (const bf16_t*)(p->ws + OFF_P); const bf16_t* LO = (const bf16_t*)(p->ws + OFF_LO);
    float* YO = (float*)(p->ws + OFF_YRWF) + (size_t)dir * NTOK * 1024 + h * 64;
    const int sl = tid >> 5, e2 = (tid & 31) * 2, ch = h * 64 + e2;
    const float* MU = p->in[I_RWMU] + (size_t)l * 3712;
    const float mur0 = MU[ch], mur1 = MU[ch + 1], muk0 = MU[1024 + ch], muk1 = MU[1024 + ch + 1], muv0 = MU[2048 + ch], muv1 = MU[2048 + ch + 1];
    const float w00 = p->in[I_RWW0][(l * 2 + dir) * 1024 + ch], w01 = p->in[I_RWW0][(l * 2 + dir) * 1024 + ch + 1];
    const float a00 = p->in[I_RWA0][(l * 2 + dir) * 1024 + ch], a01 = p->in[I_RWA0][(l * 2 + dir) * 1024 + ch + 1];
    const float kk0 = p->in[I_RWKK][l * 1024 + ch], kk1 = p->in[I_RWKK][l * 1024 + ch + 1], ka0 = p->in[I_RWKA][l * 1024 + ch], ka1 = p->in[I_RWKA][l * 1024 + ch + 1];
    const float rk0 = p->in[I_RWRK][l * 1024 + ch], rk1 = p->in[I_RWRK][l * 1024 + ch + 1];
    float* RK = (float*)(p->ws + OFF_RK); const bool wrk = dir == 0 && half == 0; int srow = 0;
    const int kq = tid & 15, v = half * 32 + (tid >> 4);
    f32x2 S0 = (f32x2){0.f, 0.f}, S1 = (f32x2){0.f, 0.f};
    unsigned rc, rp, rn, kc, kp, kn, vc, vp, vn, wr_, ar_;
    auto issue = [&](int g) {
        const int row = scan_row(g * 16 + sl, b, dir); bool hp, hn; seq_nbrs(row, hp, hn); srow = row;
        const bf16_t* pr = P + (size_t)row * NP + RWB + ch;
        rc = *(const unsigned*)pr; kc = *(const unsigned*)(pr + 1024); vc = *(const unsigned*)(pr + 2048);
        rp = 0u; kp = 0u; vp = 0u; rn = 0u; kn = 0u; vn = 0u;
        if (hp) { rp = *(const unsigned*)(pr - NP); kp = *(const unsigned*)(pr - NP + 1024); vp = *(const unsigned*)(pr - NP + 2048); }
        if (hn) { rn = *(const unsigned*)(pr + NP); kn = *(const unsigned*)(pr + NP + 1024); vn = *(const unsigned*)(pr + NP + 2048); }
        const bf16_t* lo = LO + (size_t)row * 5120 + dir * 1024 + ch;
        wr_ = *(const unsigned*)lo; ar_ = *(const unsigned*)(lo + 2048);
    };
    auto commit = [&](int buf) {
        float* st = lds + buf * 6144 + sl * 384 + e2;
        const float r0 = shiftf(bflo(rc), bflo(rp), bflo(rn), mur0), r1 = shiftf(bfhi(rc), bfhi(rp), bfhi(rn), mur1);
        const float k0 = shiftf(bflo(kc), bflo(kp), bflo(kn), muk0), k1 = shiftf(bfhi(kc), bfhi(kp), bfhi(kn), muk1);
        const float v0 = shiftf(bflo(vc), bflo(vp), bflo(vn), muv0), v1 = shiftf(bfhi(vc), bfhi(vp), bfhi(vn), muv1);
        const float x0 = -(w00 + bflo(wr_)), x1 = -(w01 + bfhi(wr_));
        const float sp0 = x0 > 20.f ? x0 : __logf(1.0f + __expf(x0)), sp1 = x1 > 20.f ? x1 : __logf(1.0f + __expf(x1));
        const float d0 = __expf(-__expf(-sp0 - 0.5f)), d1 = __expf(-__expf(-sp1 - 0.5f));
        const float ar0 = fsigmoid(a00 + bflo(ar_)), ar1 = fsigmoid(a01 + bfhi(ar_));
        const float kd0 = k0 * (1.0f + (ar0 - 1.0f) * ka0), kd1 = k1 * (1.0f + (ar1 - 1.0f) * ka1);
        const float q0 = k0 * kk0, q1 = k1 * kk1;
        float ss = red16(q0 * q0 + q1 * q1);
        ss += __shfl_xor(ss, 16);
        const float inv = frcp(fmaxf(__builtin_amdgcn_sqrtf(ss), 1e-12f));
        const float n0 = q0 * inv, n1 = q1 * inv;
        if (wrk) { float t = red16(r0 * k0 * rk0 + r1 * k1 * rk1); t += __shfl_xor(t, 16); if ((tid & 31) == 0) RK[srow * 16 + h] = t; }
        *(f32x2*)(st + 0) = (f32x2){r0, r1}; *(f32x2*)(st + 64) = (f32x2){d0, d1}; *(f32x2*)(st + 128) = (f32x2){kd0, kd1};
        *(f32x2*)(st + 192) = (f32x2){v0, v1}; *(f32x2*)(st + 256) = (f32x2){-n0, -n1}; *(f32x2*)(st + 320) = (f32x2){n0 * ar0, n1 * ar1};
    };
    __syncthreads();
    issue(0); commit(0);
    __syncthreads();
    constexpr int NG = 4352 / 16;
    for (int g = 0; g < NG; ++g) {
        if (g + 1 < NG) issue(g + 1);
        {
            const float* base = lds + (g & 1) * 6144 + kq * 4;
            float ykeep = 0.f;
            f32x4 nA, nD, nB, nK, nR; float nV;
#define RW_LOAD(i_) do { const float* st_ = base + (i_) * 384; nA = *(const f32x4*)(st_ + 256); nD = *(const f32x4*)(st_ + 64); nB = *(const f32x4*)(st_ + 320); nK = *(const f32x4*)(st_ + 128); nR = *(const f32x4*)(st_); \
                nV = st_[192 - kq * 4 + v]; } while (0)
            RW_LOAD(0);
#pragma unroll
            for (int i = 0; i < 16; ++i) {
                const f32x4 a = nA, d = nD, bb = nB, k = nK, r = nR; const float vv = nV;
                if (i < 15) { RW_LOAD(i + 1); }
                __builtin_amdgcn_sched_barrier(0x77);
                f32x2 pa2 = S0 * (f32x2){a[0], a[1]}; pa2 = S1 * (f32x2){a[2], a[3]} + pa2;
                const f32x2 vvb = (f32x2){vv, vv};
                const f32x2 u0 = S0 * (f32x2){d[0], d[1]} + vvb * (f32x2){k[0], k[1]}, u1 = S1 * (f32x2){d[2], d[3]} + vvb * (f32x2){k[2], k[3]};
                const float pa = red16(pa2[0] + pa2[1]);
                const f32x2 pab = (f32x2){pa, pa};
                S0 = pab * (f32x2){bb[0], bb[1]} + u0; S1 = pab * (f32x2){bb[2], bb[3]} + u1;
                f32x2 y2 = S0 * (f32x2){r[0], r[1]}; y2 = S1 * (f32x2){r[2], r[3]} + y2;
                const float y = red16(y2[0] + y2[1]);
                ykeep = (kq == i) ? y : ykeep;
            }
#undef RW_LOAD
            YO[(size_t)scan_row(g * 16 + kq, b, dir) * 1024 + v] = ykeep;
        }
        if (g + 1 < NG) commit((g + 1) & 1);
        __syncthreads();
    }
}

__device__ void mlstm_scan(PP p, int l, int chain, int g8, float* lds) {
    const int TIDX = otid();
    const int b = chain >> 3, h = (chain >> 1) & 3, dir = chain & 1, tid = TIDX;
    const bf16_t* P = (const bf16_t*)(p->ws + OFF_P);
    const float* RC = (const float*)(p->ws + OFF_ROPE); const float* RS = RC + 2048;
    float* NO = (float*)(p->ws + OFF_MLNUM) + (size_t)dir * NTOK * 4 * 272 + h * 272;
    const int sl = tid >> 5, j = tid & 31;
    const float gbi = p->in[I_MLGB][l * 16 + (dir * 2 + 0) * 4 + h], gbf = p->in[I_MLGB][l * 16 + (dir * 2 + 1) * 4 + h];
    const int rowl = (tid >> 3) & 31, kq = tid & 7, crow = g8 * 32 + rowl, lane = tid & 63;
    f32x2 C[8];
#pragma unroll
    for (int i = 0; i < 8; ++i) C[i] = (f32x2){0.f, 0.f};
    f32x2 nst = (f32x2){0.f, 0.f};
    bf16_t q0, q1, q2, q3, k0, k1, k2, k3, gi, gf; unsigned vv2; float cr, sr, cc, sc;
    auto issue = [&](int g) {
        const int row = scan_row(g * 16 + sl, b, dir);
        const bf16_t* pr = P + (size_t)row * NP;
        const bf16_t* pq = pr + h * 128 + j; const bf16_t* pk = pr + 512 + h * 128 + j;
        q0 = pq[0]; q1 = pq[32]; q2 = pq[64]; q3 = pq[96]; k0 = pk[0]; k1 = pk[32]; k2 = pk[64]; k3 = pk[96];
        vv2 = j < 16 ? *(const unsigned*)(pr + 1024 + h * 256 + g8 * 32 + 2 * j) : 0u;
        gi = pr[3072 + (dir * 2 + 0) * 4 + h]; gf = pr[3072 + (dir * 2 + 1) * 4 + h];
        if (row < NLAT) { const int t = row & 4095, pr_ = t >> 6, pc_ = t & 63; cr = RC[pr_ * 32 + j]; sr = RS[pr_ * 32 + j]; cc = RC[pc_ * 32 + j]; sc = RS[pc_ * 32 + j]; }
        else { cr = 1.f; sr = 0.f; cc = 1.f; sc = 0.f; }
    };
    auto commit = [&](int buf) {
        float* st = lds + buf * 5376 + sl * 336;
        const float scale = 0.08838834764831845f;
        const float a0 = bf2f(q0), a1 = bf2f(q1), a2 = bf2f(q2), a3 = bf2f(q3);
        st[j] = (a0 * cr - a1 * sr) * scale; st[32 + j] = (a0 * sr + a1 * cr) * scale; st[64 + j] = (a2 * cc - a3 * sc) * scale; st[96 + j] = (a2 * sc + a3 * cc) * scale;
        const float c0 = bf2f(k0), c1 = bf2f(k1), c2 = bf2f(k2), c3 = bf2f(k3);
        st[128 + j] = c0 * cr - c1 * sr; st[160 + j] = c0 * sr + c1 * cr; st[192 + j] = c2 * cc - c3 * sc; st[224 + j] = c2 * sc + c3 * cc;
        if (j < 16) { st[256 + 2 * j] = bflo(vv2); st[257 + 2 * j] = bfhi(vv2); }
        if (j == 0) { st[320] = fsigmoid(bf2f(gf) + gbf); st[321] = __expf(bf2f(gi) + gbi); }
    };
    __syncthreads();
    issue(0); commit(0);
    __syncthreads();
    constexpr int NG = 4352 / 16;
    for (int g = 0; g < NG; ++g) {
        if (g + 1 < NG) issue(g + 1);
        const float* base = lds + (g & 1) * 5376;
        if (tid < 256) {
            float nkeep = 0.f, Fc = 1.0f;
            f32x4 nK[4], nQ[4]; float nF, nI, nV0;
#define ML_LOAD(i_) do { const float* st_ = base + (i_) * 336; _Pragma("unroll") for (int c4 = 0; c4 < 4; ++c4) { nK[c4] = *(const f32x4*)(st_ + 128 + c4 * 32 + kq * 4); nQ[c4] = *(const f32x4*)(st_ + c4 * 32 + kq * 4); } \
                nF = st_[320]; nI = st_[321]; nV0 = st_[256 + rowl]; } while (0)
            ML_LOAD(0);
#pragma unroll
            for (int i = 0; i < 16; ++i) {
                f32x4 kk[4], qq[4];
#pragma unroll
                for (int c4 = 0; c4 < 4; ++c4) { kk[c4] = nK[c4]; qq[c4] = nQ[c4]; }
                Fc *= nF;
                const float coef = nI * nV0 * frcp(Fc);
                if (i < 15) { ML_LOAD(i + 1); }
                __builtin_amdgcn_sched_barrier(0x77);
                const f32x2 cf = (f32x2){coef, coef};
                f32x2 num2 = (f32x2){0.f, 0.f}, num3 = (f32x2){0.f, 0.f};
#pragma unroll
                for (int c4 = 0; c4 < 4; ++c4) {
                    const f32x2 KA = (f32x2){kk[c4][0], kk[c4][1]}, KB = (f32x2){kk[c4][2], kk[c4][3]}, QA = (f32x2){qq[c4][0], qq[c4][1]}, QB = (f32x2){qq[c4][2], qq[c4][3]};
                    C[2 * c4] = cf * KA + C[2 * c4]; C[2 * c4 + 1] = cf * KB + C[2 * c4 + 1];
                    num2 = C[2 * c4] * QA + num2; num3 = C[2 * c4 + 1] * QB + num3; }
                num2 += num3;
                const float num = red8(num2[0] + num2[1]) * Fc;
                nkeep = (kq == (i & 7)) ? num : nkeep;
                if ((i & 7) == 7) NO[(size_t)scan_row(g * 16 + (i - 7) + kq, b, dir) * (4 * 272) + crow] = nkeep;
            }
            { const f32x2 fb = (f32x2){Fc, Fc};
#pragma unroll
                for (int x = 0; x < 8; ++x) C[x] = C[x] * fb; }
#undef ML_LOAD
        } else if (g8 == 0 && tid < 320) {
            float nkeep = 0.f;
            f32x2 nk, nq; float nf, ni;
#define MN_LOAD(i_) do { const float* st_ = base + (i_) * 336; nk = *(const f32x2*)(st_ + 128 + 2 * lane); nq = *(const f32x2*)(st_ + 2 * lane); nf = st_[320]; ni = st_[321]; } while (0)
            MN_LOAD(0);
#pragma unroll
            for (int i = 0; i < 16; ++i) {
                const f32x2 kk = nk, qq = nq; const float f = nf, ig = ni;
                if (i < 15) { MN_LOAD(i + 1); }
                __builtin_amdgcn_sched_barrier(0x77);
                nst = (f32x2){f, f} * nst + (f32x2){ig, ig} * kk;
                const f32x2 d2 = nst * qq;
                const float den16 = red16(d2[0] + d2[1]);
                nkeep = ((lane & 15) == i) ? den16 : nkeep;
            }
#undef MN_LOAD
            nkeep += __shfl_xor(nkeep, 16); nkeep += __shfl_xor(nkeep, 32);
            if (lane < 16) NO[(size_t)scan_row(g * 16 + lane, b, dir) * (4 * 272) + 256] = nkeep;
        }
        if (g + 1 < NG) commit((g + 1) & 1);
        __syncthreads();
    }
}

#define MFMA16(a, b, c) __builtin_amdgcn_mfma_f32_16x16x32_bf16(a, b, c, 0, 0, 0)
__device__ void na_wave(PP p, int l, int task) {
    const int TIDX = otid();
    const bf16_t* P = (const bf16_t*)(p->ws + OFF_P); const bf16_t* VT = (const bf16_t*)(p->ws + OFF_VT);
    bf16_t* YN = (bf16_t*)(p->ws + OFF_Y3) + 2ull * NTOK * 1024;
    const int w = TIDX >> 6, lane = TIDX & 63, n16 = lane & 15, g = lane >> 4;
    int b, h, qrow, r = 0, qcol = 0, cs = 0, row_start = 0, c_start = 0; bool lat;
    if (task < 512) { lat = true; b = task >> 8; h = (task >> 5) & 7; const int pair = task & 31; r = pair * 2 + (w >> 2); const int qi = w & 3; qcol = qi * 16 + n16;
        qrow = b * 4096 + r * 64 + qcol; cs = qi == 0 ? 0 : (qi == 1 ? 8 : (qi == 2 ? 24 : 32)); row_start = min(max(r - 4, 0), 56); c_start = min(max(qcol - 8, 0), 48); }
    else { lat = false; const int t2 = task - 512; b = t2 >> 4; h = (t2 >> 1) & 7; const int chunk = t2 & 1; qrow = NLAT + b * 256 + chunk * 128 + w * 16 + n16; }
    bf16x8 qf[4];
#pragma unroll
    for (int c = 0; c < 4; ++c) qf[c] = *(const bf16x8*)(P + (size_t)qrow * NP + NAB + h * 128 + c * 32 + g * 8);
    const float* rpb = p->in[I_RPB] + (size_t)(l * 8 + h) * 15 * 31;
    const bf16_t* vtb = VT + (size_t)((b * 8 + h) * 128) * 4352;
    f32x4 O[8];
#pragma unroll
    for (int i = 0; i < 8; ++i) O[i] = (f32x4){0.f, 0.f, 0.f, 0.f};
    float mrun = -INFINITY, lsum = 0.f;
    const float scale = 0.08838834764831845f;
    for (int pass = lat ? 0 : 2; pass < 4; ++pass) {
        f32x4 S[8];
#pragma unroll
        for (int i = 0; i < 8; ++i) {
            int krowtok;
            if (pass < 2) { const int krow = row_start + pass * 4 + (i >> 1); krowtok = b * 4096 + krow * 64 + cs + (i & 1) * 16 + n16; }
            else krowtok = NLAT + b * 256 + (pass - 2) * 128 + i * 16 + n16;
            const bf16_t* kp = P + (size_t)krowtok * NP + NAB + 1024 + h * 128 + g * 8;
            f32x4 acc = (f32x4){0.f, 0.f, 0.f, 0.f};
#pragma unroll
            for (int c = 0; c < 4; ++c) { const bf16x8 kf = *(const bf16x8*)(kp + c * 32); acc = MFMA16(kf, qf[c], acc); }
            S[i] = acc;
        }
        float mx = -INFINITY;
#pragma unroll
        for (int i = 0; i < 8; ++i) {
            if (pass < 2) { const int krow = row_start + pass * 4 + (i >> 1); const float* rb = rpb + (krow - r + 7) * 31;
#pragma unroll
                for (int jj = 0; jj < 4; ++jj) { const int kc = cs + (i & 1) * 16 + 4 * g + jj; const bool ok = (kc >= c_start) && (kc < c_start + 16);
                    const int co = min(max(kc - qcol, -15), 15) + 15;
                    S[i][jj] = ok ? S[i][jj] * scale + rb[co] : -INFINITY; } }
            else {
#pragma unroll
                for (int jj = 0; jj < 4; ++jj) S[i][jj] *= scale; }
#pragma unroll
            for (int jj = 0; jj < 4; ++jj) mx = fmaxf(mx, S[i][jj]);
        }
        mx = fmaxf(mx, __shfl_xor(mx, 16)); mx = fmaxf(mx, __shfl_xor(mx, 32));
        const float mnew = fmaxf(mrun, mx);
        const float alpha = __expf(mrun - mnew);
        mrun = mnew; lsum *= alpha;
#pragma unroll
        for (int i = 0; i < 8; ++i) { O[i][0] *= alpha; O[i][1] *= alpha; O[i][2] *= alpha; O[i][3] *= alpha; }
        bf16x8 pf[4];
#pragma unroll
        for (int c = 0; c < 4; ++c) {
            float e[8];
#pragma unroll
            for (int jj = 0; jj < 4; ++jj) { e[jj] = __expf(S[2 * c][jj] - mnew); e[4 + jj] = __expf(S[2 * c + 1][jj] - mnew); }
#pragma unroll
            for (int jj = 0; jj < 8; ++jj) lsum += e[jj];
            u32x4 u; u[0] = pack2(e[0], e[1]); u[1] = pack2(e[2], e[3]); u[2] = pack2(e[4], e[5]); u[3] = pack2(e[6], e[7]);
            pf[c] = __builtin_bit_cast(bf16x8, u);
        }
#pragma unroll
        for (int c = 0; c < 4; ++c) {
            int pos0, pos1;
            if (pass < 2) { const int krow = row_start + pass * 4 + c; pos0 = krow * 64 + cs + 4 * g; pos1 = pos0 + 16; }
            else { pos0 = 4096 + (pass - 2) * 128 + c * 32 + 4 * g; pos1 = pos0 + 16; }
#pragma unroll
            for (int dt = 0; dt < 8; ++dt) {
                const bf16_t* vp = vtb + (size_t)(dt * 16 + n16) * 4352;
                const bf16x4 v0 = *(const bf16x4*)(vp + pos0), v1 = *(const bf16x4*)(vp + pos1);
                const bf16x8 vf = __builtin_shufflevector(v0, v1, 0, 1, 2, 3, 4, 5, 6, 7);
                O[dt] = MFMA16(vf, pf[c], O[dt]);
            }
        }
    }
    lsum += __shfl_xor(lsum, 16); lsum += __shfl_xor(lsum, 32);
    const float inv = 1.0f / lsum;
    bf16_t* yo = YN + (size_t)qrow * 1024 + h * 128 + 4 * g;
#pragma unroll
    for (int dt = 0; dt < 8; ++dt) { u32x2 o; o[0] = pack2(O[dt][0] * inv, O[dt][1] * inv); o[1] = pack2(O[dt][2] * inv, O[dt][3] * inv); *(u32x2*)(yo + dt * 16) = o; }
}

__device__ void na_block(PP p, int l, int task, unsigned char* lds) {
    const int TIDX = otid();
    const bf16_t* P = (const bf16_t*)(p->ws + OFF_P); const bf16_t* VT = (const bf16_t*)(p->ws + OFF_VT);
    bf16_t* YN = (bf16_t*)(p->ws + OFF_Y3) + 2ull * NTOK * 1024;
    const int tid = TIDX, w = tid >> 6, lane = tid & 63, n16 = lane & 15, g = lane >> 4, qi = w & 3, kh = w >> 2;
    const int b = task >> 9, h = (task >> 6) & 7, r = task & 63;
    const int qcol = qi * 16 + n16, qrow = b * 4096 + r * 64 + qcol;
    const int cs = qi == 0 ? 0 : (qi == 1 ? 8 : (qi == 2 ? 24 : 32)), row_start = min(max(r - 4, 0), 56), c_start = min(max(qcol - 8, 0), 48);
    unsigned char* KT = lds; unsigned char* VL = lds + 65536;
    bf16x8 qf[4];
#pragma unroll
    for (int c = 0; c < 4; ++c) qf[c] = *(const bf16x8*)(P + (size_t)qrow * NP + NAB + h * 128 + c * 32 + g * 8);
    const float* rpb = p->in[I_RPB] + (size_t)(l * 8 + h) * 15 * 31;
    const bf16_t* vtb = VT + (size_t)((b * 8 + h) * 128) * 4352;
    const bf16_t* kgb = P + NAB + 1024 + h * 128;
    f32x4 O[8];
#pragma unroll
    for (int i = 0; i < 8; ++i) O[i] = (f32x4){0.f, 0.f, 0.f, 0.f};
    float mrun = -INFINITY, lsum = 0.f;
    const float scale = 0.08838834764831845f;
    u32x4 kreg[8], vreg[8];
    auto gload = [&](int pass) {
#pragma unroll
        for (int i = 0; i < 8; ++i) { const int key = i * 32 + (tid >> 4), c16 = tid & 15, s_ = key >> 6, kk = key & 63;
            if (pass < 2) { const int krow = row_start + (s_ < 2 ? 2 * pass + s_ : 2 + 2 * pass + s_);
                kreg[i] = *(const u32x4*)(kgb + (size_t)(b * 4096 + krow * 64 + kk) * NP + c16 * 8); }
            else if (i < 4) { const int m = (s_ == 0 ? 0 : 128) + 64 * (pass - 2) + kk;
                kreg[i] = *(const u32x4*)(kgb + (size_t)(NLAT + b * 256 + m) * NP + c16 * 8); } }
#pragma unroll
        for (int i = 0; i < 8; ++i) { const int d = i * 16 + (tid >> 5), key8 = (tid & 31) * 8, s_ = key8 >> 6, kk = key8 & 63;
            if (pass < 2) { const int krow = row_start + (s_ < 2 ? 2 * pass + s_ : 2 + 2 * pass + s_);
                vreg[i] = *(const u32x4*)(vtb + (size_t)d * 4352 + krow * 64 + kk); }
            else if (key8 < 128) { const int m = (s_ == 0 ? 0 : 128) + 64 * (pass - 2) + kk;
                vreg[i] = *(const u32x4*)(vtb + (size_t)d * 4352 + 4096 + m); } }
    };
    auto lstore = [&](int pass) {
#pragma unroll
        for (int i = 0; i < 8; ++i) { const int key = i * 32 + (tid >> 4), c16 = tid & 15;
            if (pass < 2 || i < 4) *(u32x4*)(KT + key * 256 + ((c16 ^ (key & 15)) * 16)) = kreg[i]; }
#pragma unroll
        for (int i = 0; i < 8; ++i) { const int d = i * 16 + (tid >> 5), kc16 = tid & 31;
            if (pass < 2 || kc16 < 16) *(u32x4*)(VL + d * 512 + ((kc16 ^ (d & 15)) * 16)) = vreg[i]; }
    };
    gload(0);
    for (int pass = 0; pass < 4; ++pass) {
        __syncthreads();
        lstore(pass);
        __syncthreads();
        if (pass < 3) gload(pass + 1);
        f32x4 S[4];
#pragma unroll
        for (int i = 0; i < 4; ++i) {
            const int keyl = pass < 2 ? (kh * 2 + (i >> 1)) * 64 + cs + (i & 1) * 16 + n16 : kh * 64 + i * 16 + n16;
            const unsigned char* kp = KT + keyl * 256;
            f32x4 acc = (f32x4){0.f, 0.f, 0.f, 0.f};
#pragma unroll
            for (int c = 0; c < 4; ++c) { const bf16x8 kf = *(const bf16x8*)(kp + (((c * 4 + g) ^ (keyl & 15)) * 16)); acc = MFMA16(kf, qf[c], acc); }
            S[i] = acc;
        }
        float mx = -INFINITY;
#pragma unroll
        for (int i = 0; i < 4; ++i) {
            if (pass < 2) { const int krow = row_start + kh * 4 + 2 * pass + (i >> 1); const float* rb = rpb + (krow - r + 7) * 31;
#pragma unroll
                for (int jj = 0; jj < 4; ++jj) { const int kc = cs + (i & 1) * 16 + 4 * g + jj; const bool ok = (kc >= c_start) && (kc < c_start + 16);
                    const int co = min(max(kc - qcol, -15), 15) + 15;
                    S[i][jj] = ok ? S[i][jj] * scale + rb[co] : -INFINITY; } }
            else {
#pragma unroll
                for (int jj = 0; jj < 4; ++jj) S[i][jj] *= scale; }
#pragma unroll
            for (int jj = 0; jj < 4; ++jj) mx = fmaxf(mx, S[i][jj]);
        }
        mx = fmaxf(mx, __shfl_xor(mx, 16)); mx = fmaxf(mx, __shfl_xor(mx, 32));
        const float mnew = fmaxf(mrun, mx);
        const float alpha = __expf(mrun - mnew);
        mrun = mnew; lsum *= alpha;
#pragma unroll
        for (int i = 0; i < 8; ++i) { O[i][0] *= alpha; O[i][1] *= alpha; O[i][2] *= alpha; O[i][3] *= alpha; }
#pragma unroll
        for (int c = 0; c < 2; ++c) {
            float e[8];
#pragma unroll
            for (int jj = 0; jj < 4; ++jj) { e[jj] = __expf(S[2 * c][jj] - mnew); e[4 + jj] = __expf(S[2 * c + 1][jj] - mnew); }
#pragma unroll
            for (int jj = 0; jj < 8; ++jj) lsum += e[jj];
            u32x4 u; u[0] = pack2(e[0], e[1]); u[1] = pack2(e[2], e[3]); u[2] = pack2(e[4], e[5]); u[3] = pack2(e[6], e[7]);
            const bf16x8 pf = __builtin_bit_cast(bf16x8, u);
            const int key0 = pass < 2 ? (kh * 2 + c) * 64 + cs + 4 * g : kh * 64 + c * 32 + 4 * g;
            const int kc8a = key0 >> 2, kc8b = kc8a + 4;
#pragma unroll
            for (int dt = 0; dt < 8; ++dt) { const int d = dt * 16 + n16; const unsigned char* vp = VL + d * 512;
                const bf16x4 v0 = *(const bf16x4*)(vp + (((kc8a >> 1) ^ (d & 15)) * 16) + (kc8a & 1) * 8), v1 = *(const bf16x4*)(vp + (((kc8b >> 1) ^ (d & 15)) * 16) + (kc8b & 1) * 8);
                const bf16x8 vf = __builtin_shufflevector(v0, v1, 0, 1, 2, 3, 4, 5, 6, 7);
                O[dt] = MFMA16(vf, pf, O[dt]); }
        }
    }
    lsum += __shfl_xor(lsum, 16); lsum += __shfl_xor(lsum, 32);
    __syncthreads();
    float* cmb = (float*)lds + (size_t)qi * 34 * 64 + lane;
    if (kh == 1) { cmb[0] = mrun; cmb[64] = lsum;
#pragma unroll
        for (int dt = 0; dt < 8; ++dt)
#pragma unroll
            for (int jj = 0; jj < 4; ++jj) cmb[(2 + dt * 4 + jj) * 64] = O[dt][jj]; }
    __syncthreads();
    if (kh == 0) { const float m1 = cmb[0], l1 = cmb[64];
        const float mn = fmaxf(mrun, m1), a0 = __expf(mrun - mn), a1 = __expf(m1 - mn);
        const float inv = 1.0f / (lsum * a0 + l1 * a1);
        bf16_t* yo = YN + (size_t)qrow * 1024 + h * 128 + 4 * g;
#pragma unroll
        for (int dt = 0; dt < 8; ++dt) { float o[4];
#pragma unroll
            for (int jj = 0; jj < 4; ++jj) o[jj] = (O[dt][jj] * a0 + cmb[(2 + dt * 4 + jj) * 64] * a1) * inv;
            u32x2 ov; ov[0] = pack2(o[0], o[1]); ov[1] = pack2(o[2], o[3]); *(u32x2*)(yo + dt * 16) = ov; } }
}

__device__ void phase_mix(PP p, int l, float* lds, int which = 7) {
    const int TIDX = otid();
    for (int t = blockIdx.x; t < 256; t += gridDim.x) {
        if (t < 128) { if (which & 1) rwkv_scan(p, l, t, lds); }
        else if (which & 2) mlstm_scan(p, l, (t - 128) >> 3, (t - 128) & 7, lds);
        __syncthreads();
    }
    unsigned* ctr = (unsigned*)(p->ws + OFF_CTL) + l * 8 + ((which & 8) ? 1 : 0);
    if (!(which & 4)) return;
    int* stask = (int*)lds;
    const int ntask = l == 0 ? 1056 : 1024;
    for (;;) {
        __syncthreads();
        if (TIDX == 0) stask[0] = (int)atomicAdd(ctr, 1u);
        __syncthreads();
        const int t = stask[0];
        if (t >= ntask) break;
        if (t < 1024) na_block(p, l, t, (unsigned char*)lds); else na_wave(p, l, t - 512);
    }
}

__device__ void phase_post(PP p, int l, int nrows) {
    const int TIDX = otid();
    const int wid = TIDX >> 6, lane = TIDX & 63, gw = blockIdx.x * 8 + wid, nw = gridDim.x * 8;
    const bf16_t* P = (const bf16_t*)(p->ws + OFF_P); const bf16_t* LO = (const bf16_t*)(p->ws + OFF_LO);
    bf16_t* YM = (bf16_t*)(p->ws + OFF_Y3); bf16_t* YR = YM + (size_t)NTOK * 1024;
    const float* NUM = (const float*)(p->ws + OFF_MLNUM); const float* YF = (const float*)(p->ws + OFF_YRWF);
    for (int row = gw; row < nrows; row += nw) {
        f32x4 a[4], c[4], ng[4]; float dfr[4], dbr[4]; u32x2 ov[4];
#pragma unroll
        for (int h = 0; h < 4; ++h) {
            const float* nf = NUM + ((size_t)row * 4 + h) * 272; const float* nb = NUM + ((size_t)(NTOK + row) * 4 + h) * 272;
            a[h] = *(const f32x4*)(nf + lane * 4); c[h] = *(const f32x4*)(nb + lane * 4); dfr[h] = nf[256]; dbr[h] = nb[256];
            ov[h] = *(const u32x2*)(P + (size_t)row * NP + 2048 + h * 256 + lane * 4);
            ng[h] = *(const f32x4*)(p->in[I_MLNG] + l * 1024 + h * 256 + lane * 4); }
#pragma unroll
        for (int h = 0; h < 4; ++h) {
            const float df = 1.0f / fmaxf(fabsf(dfr[h]), 1.0f), db = 1.0f / fmaxf(fabsf(dbr[h]), 1.0f);
            float hv[4]; float ss = 0.f;
#pragma unroll
            for (int j = 0; j < 4; ++j) { hv[j] = a[h][j] * df + c[h][j] * db; ss += hv[j] * hv[j]; }
            ss = wsum(ss);
            const float rr = rsqrtf(ss * (1.0f / 256.0f) + 1e-6f);
            const float o0 = hv[0] * rr * ng[h][0] * sigmoidf(bflo(ov[h][0])), o1 = hv[1] * rr * ng[h][1] * sigmoidf(bfhi(ov[h][0]));
            const float o2 = hv[2] * rr * ng[h][2] * sigmoidf(bflo(ov[h][1])), o3 = hv[3] * rr * ng[h][3] * sigmoidf(bfhi(ov[h][1]));
            u32x2 w; w[0] = pack2(o0, o1); w[1] = pack2(o2, o3);
            *(u32x2*)(YM + (size_t)row * 1024 + h * 256 + lane * 4) = w; }
    }
    const float* MU = p->in[I_RWMU] + (size_t)l * 3712;
    for (int it = gw; it < nrows * 2; it += nw) {
        const int row = it >> 1, hq = (it & 1) * 8;
        bool hp, hn; seq_nbrs(row, hp, hn);
        float y0[8], y1[8], gg[8], rkv[8]; bf16_t vc[8], vp[8], vn[8];
#pragma unroll
        for (int u = 0; u < 8; ++u) { const int c = (hq + u) * 64 + lane;
            y0[u] = YF[(size_t)row * 1024 + c]; y1[u] = YF[(size_t)(NTOK + row) * 1024 + c];
            const bf16_t* pr = P + (size_t)row * NP + RWB + 2048 + c;
            vc[u] = pr[0]; vp[u] = hp ? pr[-NP] : (bf16_t)0; vn[u] = hn ? pr[NP] : (bf16_t)0;
            rkv[u] = ((const float*)(p->ws + OFF_RK))[row * 16 + hq + u];
            gg[u] = bf2f(LO[(size_t)row * 5120 + 4096 + c]); }
#pragma unroll
        for (int u = 0; u < 8; ++u) { const int c = (hq + u) * 64 + lane;
            const float y = y0[u] + y1[u];
            const float mean = wsum(y) * (1.0f / 64.0f);
            const float dy = y - mean;
            const float var = wsum(dy * dy) * (1.0f / 64.0f);
            const float yn = dy * rsqrtf(var + 64e-5f);
            const float vv = shiftf(bf2f(vc[u]), bf2f(vp[u]), bf2f(vn[u]), MU[2048 + c]);
            const float bonus = rkv[u] * vv;
            const float o = (yn * p->in[I_RWLNW][l * 1024 + c] + p->in[I_RWLNB][l * 1024 + c] + bonus) * gg[u];
            YR[(size_t)row * 1024 + c] = f2bf(o); }
    }
}


constexpr size_t PART_OFF = 150ull << 20;
#ifndef DUPMASK
#define DUPMASK 0
#endif
#ifndef DUPWHICH
#define DUPWHICH 3
#endif
__global__ void __launch_bounds__(512, 2) fwd_kernel(Params p0) {
    extern __shared__ __attribute__((aligned(16))) unsigned char shm[];
    cg::grid_group grid = cg::this_grid();
    float* ldsf = (float*)shm;
    LAS unsigned char* ldsg = (LAS unsigned char*)shm;
    const int ph_lo = p0.ph_lo, ph_hi = p0.ph_hi;
    auto kseg = __builtin_amdgcn_kernarg_segment_ptr();
    for (int ph = ph_lo; ph < ph_hi; ++ph) {
        if (ph > ph_lo) grid.sync();
        PP p = (PP)kseg; asm volatile("" : "+s"(p));
        unsigned char* ws = p->ws;
        const float* MOD = (const float*)(ws + OFF_MOD);
        float* XL = (float*)(ws + OFF_XL);
        bf16_t* H = (bf16_t*)(ws + OFF_H);
        bf16_t* Pb = (bf16_t*)(ws + OFF_P);
        if (ph == 0) { phase_mod(p, ldsf); __syncthreads(); phase_convert(p, 0, ldsf, (int)blockIdx.x, (int)gridDim.x, 0, 0, 18816, true); continue; }
        if (ph == NPHASE - 1) { phase_final(p); continue; }
        const int l = (ph - 1) / 11, sub = (ph - 1) % 11;
        const int two_wt = p->two_wt;
        const size_t wsh = (l == 1 && two_wt) ? WT_SHIFT : 0;
#if DUPMASK
        for (int rep = 0; rep < (((DUPMASK >> sub) & 1) ? 2 : 1); ++rep) { if (rep) grid.sync();
#endif
        const int Ml = l == 0 ? NTOK : NLAT;
        const float* modl = MOD + (size_t)l * 3 * 12288;
        if (sub == 1 || sub == 3 || sub == 6 || sub == 7 || sub == 9 || sub == 10) {
            const bool ksplit = l == 0 && (sub == 7 || sub == 10) && gridDim.x == 256;
            for (int part = 0; part < (ksplit ? 2 : 1); ++part) {
            pg8::Gemm g; pg8::SchedG S; pg8::EpiG E;
            S.mode = 0; S.mo.init(Ml / 256, (int)gridDim.x, (int)blockIdx.x);
            E.kind = 0; E.split = 0; E.O = Pb; E.ldc = NP; E.P = Pb; E.ACC = (float*)(ws + OFF_YRWF);
            E.xin_lat = XL; E.xin_ctx = XL + (size_t)NLAT * 2048; E.XL = XL; E.gate = modl; E.part = nullptr;
            if (sub == 1) { g = pg8::Gemm{H, (const bf16_t*)(ws + wsh + OFF_WIN), NTOK, NP, 2048, 32}; }
            else if (sub == 3) { g = pg8::Gemm{(const bf16_t*)(ws + OFF_LA), (const bf16_t*)(ws + wsh + OFF_WLORA), NTOK, 5120, 640, 10}; E.O = (bf16_t*)(ws + OFF_LO); E.ldc = 5120; }
            else if (sub == 6) { g = pg8::Gemm{(const bf16_t*)(ws + OFF_Y3), (const bf16_t*)(ws + wsh + OFF_WBR), Ml, 2048, 1024, 16}; S.mode = 1; E.kind = 2; E.O = H; }
            else if (sub == 7) { g = pg8::Gemm{H, (const bf16_t*)(ws + wsh + OFF_WOUT), Ml, 2048, 2048, 32}; E.kind = 3; E.gate = modl + 2 * 2048;
                if (l == 0) { E.xin_lat = p->in[I_X]; E.xin_ctx = p->in[I_CTX]; } }
            else if (sub == 9) { g = pg8::Gemm{H, (const bf16_t*)(ws + wsh + OFF_WFF1), Ml, DFF, 2048, 32}; E.kind = 1; E.ldc = DFF; }
            else { g = pg8::Gemm{Pb, (const bf16_t*)(ws + wsh + OFF_WFF2), Ml, 2048, DFF, 128}; E.kind = 3; E.gate = modl + 5 * 2048; }
            if (ksplit) {
                if (part == 0) g.M = NLAT;
                else { const int ks = (int)blockIdx.x & 15; g.nt >>= 4; g.A += (size_t)ks * g.nt * 64; g.Bt += (size_t)ks * g.nt * 64; S.mode = 2; E.split = 1;
                    E.part = (float*)(ws + OFF_P + (sub == 10 ? PART_OFF : 0)) + (size_t)ks * 512 * 2048; }
            }
            S.so.init(g.M, g.N, (int)gridDim.x, (int)blockIdx.x);
            pg8::gemm_phase(ldsg, g, S, E);
            }
            if (two_wt && l == 0 && gridDim.x == 256) {
                if (sub == 1 && blockIdx.x >= 94) phase_convert(p, 1, ldsf, (int)blockIdx.x - 94, 162, WT_SHIFT, 0, 4000, false);
                if (sub == 6 && blockIdx.x >= 16) phase_convert(p, 1, ldsf, (int)blockIdx.x - 16, 240, WT_SHIFT, 4000, 11500, false);
                if (sub == 9 && blockIdx.x >= 64) phase_convert(p, 1, ldsf, (int)blockIdx.x - 64, 192, WT_SHIFT, 11500, 18816, true);
            } else if (two_wt && l == 0 && sub == 10) phase_convert(p, 1, ldsf, (int)blockIdx.x, (int)gridDim.x, WT_SHIFT, 0, 18816, true);
        } else
        switch (sub) {
        case 0: {
            phase_init(p, l);
            if (l == 1 && !two_wt) phase_convert(p, l, ldsf, (int)blockIdx.x, (int)gridDim.x, wsh, 0, 18816, true);
            if (l == 0) phase_norm(p->in[I_X], p->in[I_CTX], NTOK, p->in[I_N1G] + l * 2048, modl, 0, 1, H);
            else if (gridDim.x == 256) phase_norm(XL, XL + (size_t)NLAT * 2048, NTOK, p->in[I_N1G] + l * 2048, modl, 0, 1, H, (const float*)(ws + OFF_P + PART_OFF), MOD + 2 * 12288 + 5 * 2048, XL + (size_t)NLAT * 2048);
            else phase_norm(XL, XL + (size_t)NLAT * 2048, NTOK, p->in[I_N1G] + l * 2048, modl, 0, 1, H);
        } break;
        case 2: phase_prep(p, l, (bf16_t*)shm); break;
#if DUPMASK
        case 4: phase_mix(p, l, ldsf, rep ? DUPWHICH : 7); break;
#else
        case 4: phase_mix(p, l, ldsf); break;
#endif
        case 5: phase_post(p, l, Ml); break;
        case 8: if (l == 0 && gridDim.x == 256) phase_norm(XL, p->in[I_CTX], Ml, p->in[I_N2G] + l * 2048, modl, 3, 4, H, (const float*)(ws + OFF_P), modl + 2 * 12288 + 2 * 2048, XL + (size_t)NLAT * 2048);
                else phase_norm(XL, XL + (size_t)NLAT * 2048, Ml, p->in[I_N2G] + l * 2048, modl, 3, 4, H); break;
        }
#if DUPMASK
        }
#endif
    }
}

extern "C" void kernel_launch(void* const* d_in, const int* in_sizes, int n_in, void* d_out, int out_size, void* d_ws, size_t ws_size, hipStream_t stream) {
    static int grid = 0;
    if (grid == 0) {
        if (n_in != 28 || ws_size < WS_END) { fprintf(stderr, "kernel_launch: need 28 inputs and %zu bytes of workspace (got %d, %zu)\n", (size_t)WS_END, n_in, ws_size); grid = -1; return; }
        if (hipFuncSetAttribute((const void*)fwd_kernel, hipFuncAttributeMaxDynamicSharedMemorySize, LDS_BYTES) != hipSuccess) { fprintf(stderr, "kernel_launch: hipFuncSetAttribute failed\n"); grid = -1; return; }
        int dev = 0, cus = 0, per_cu = 0;
        hipGetDevice(&dev);
        hipDeviceGetAttribute(&cus, hipDeviceAttributeMultiprocessorCount, dev);
        hipOccupancyMaxActiveBlocksPerMultiprocessor(&per_cu, (const void*)fwd_kernel, 512, LDS_BYTES);
        if (per_cu < 1) { fprintf(stderr, "kernel_launch: occupancy query says %d blocks per CU\n", per_cu); per_cu = 1; }
        (void)hipGetLastError();
        grid = cus * 1;
        if (grid > 256) grid = 256;
    }
    if (grid < 0) return;
    Params p{};
    for (int i = 0; i < 28; ++i) p.in[i] = (const float*)d_in[i];
    p.out = (float*)d_out; p.ws = (unsigned char*)d_ws; p.two_wt = (ws_size >= WS_END + WT_BYTES) ? 1 : 0;
#if ONE_LAUNCH
    p.ph_lo = 0; p.ph_hi = NPHASE;
    void* args[] = {&p};
    hipError_t e = hipLaunchCooperativeKernel((const void*)fwd_kernel, dim3(grid), dim3(512), args, LDS_BYTES, stream);
    if (e != hipSuccess) fprintf(stderr, "cooperative launch failed: %s (grid %d)\n", hipGetErrorString(e), grid);
#else
    for (int ph = 0; ph < NPHASE; ++ph) {
        p.ph_lo = ph; p.ph_hi = ph + 1;
        hipLaunchKernelGGL(fwd_kernel, dim3(grid), dim3(512), LDS_BYTES, stream, p);
    }
#endif
}
```

```cpp
#include <hip/hip_runtime.h>
#include <hip/hip_cooperative_groups.h>
#include <cstdio>
namespace cg = cooperative_groups;

#ifndef ONE_LAUNCH
#define ONE_LAUNCH 1
#endif

#define DEVI __device__ __forceinline__
#define LAS __attribute__((address_space(3)))
typedef unsigned short bf16_t;
typedef short bf16x8 __attribute__((ext_vector_type(8)));
typedef short bf16x4 __attribute__((ext_vector_type(4)));
typedef float f32x4 __attribute__((ext_vector_type(4)));
typedef float f32x2 __attribute__((ext_vector_type(2)));
typedef unsigned u32x4 __attribute__((ext_vector_type(4)));
typedef unsigned u32x2 __attribute__((ext_vector_type(2)));

constexpr int D = 2048, NTOK = 8704, NLAT = 8192, NP = 16128, DIN = 16016, DFF = 8192;
constexpr int RWB = 3088, NAB = 6800, GTB = 9872;
constexpr int LDS_BYTES = 131072;
constexpr int NPHASE = 24;

constexpr size_t OFF_CTL = 0;
constexpr size_t OFF_MOD = 4096;
constexpr size_t OFF_ROPE = OFF_MOD + 2ull * 3 * 12288 * 4;
constexpr size_t OFF_WIN = OFF_ROPE + 16384;
constexpr size_t OFF_WBR = OFF_WIN + 16128ull * 2048 * 2;
constexpr size_t OFF_WOUT = OFF_WBR + 3ull * 2048 * 1024 * 2;
constexpr size_t OFF_WFF1 = OFF_WOUT + 2048ull * 2048 * 2;
constexpr size_t OFF_WFF2 = OFF_WFF1 + 8192ull * 2048 * 2;
constexpr size_t OFF_WLORA = OFF_WFF2 + 8192ull * 2048 * 2;
constexpr size_t OFF_XL = OFF_WLORA + 5120ull * 640 * 2;
constexpr size_t OFF_H = OFF_XL + 8704ull * 2048 * 4;
constexpr size_t OFF_P = OFF_H + 8704ull * 2048 * 2;
constexpr size_t OFF_LA = OFF_P + 8704ull * 16128 * 2;
constexpr size_t OFF_LO = OFF_LA + 8704ull * 640 * 2;
constexpr size_t OFF_YRWF = OFF_LO + 8704ull * 5120 * 2;
constexpr size_t OFF_MLNUM = OFF_YRWF + 2ull * 8704 * 1024 * 4;
constexpr size_t OFF_VT = OFF_MLNUM + 2ull * 8704 * 4 * 272 * 4;
constexpr size_t OFF_Y3 = OFF_VT + 2ull * 8 * 128 * 4352 * 2;
constexpr size_t OFF_RK = OFF_Y3 + 3ull * 8704 * 1024 * 2;
constexpr size_t WS_END = OFF_RK + 8704ull * 16 * 4;
constexpr size_t WT_BYTES = OFF_XL - OFF_WIN, WT_SHIFT = WS_END - OFF_WIN;

struct Params {
    const float* in[28];
    float* out;
    unsigned char* ws;
    int ph_lo, ph_hi, two_wt, pad_;
};
typedef const __attribute__((address_space(4))) Params* PP;
enum { I_X = 0, I_C, I_CTX, I_CCTX, I_WMOD, I_BMOD, I_N1G, I_WIN, I_MLGB, I_MLNG, I_RWMU, I_RWW0, I_RWWUP, I_RWA0, I_RWAUP, I_RWGUP,
       I_RWKK, I_RWKA, I_RWRK, I_RWLNW, I_RWLNB, I_RPB, I_WBR, I_WOUT, I_N2G, I_WFF1, I_WFF2, I_FING };

DEVI int otid() { int t; asm volatile("v_mov_b32 %0, %1" : "=v"(t) : "v"((int)threadIdx.x)); return t; }
DEVI float bf2f(bf16_t b) { return __uint_as_float(((unsigned)b) << 16); }
DEVI float bflo(unsigned u) { return __uint_as_float(u << 16); }
DEVI float bfhi(unsigned u) { return __uint_as_float(u & 0xffff0000u); }
DEVI bf16_t f2bf(float f) { unsigned u = __float_as_uint(f); u += 0x7FFFu + ((u >> 16) & 1u); return (bf16_t)(u >> 16); }
DEVI unsigned pack2(float lo, float hi) { return (unsigned)f2bf(lo) | ((unsigned)f2bf(hi) << 16); }
DEVI float sigmoidf(float x) { return 1.0f / (1.0f + __expf(-x)); }
#define DPP_ADD(x, CTRL) ((x) + __int_as_float(__builtin_amdgcn_update_dpp(0, __float_as_int(x), CTRL, 0xF, 0xF, true)))
DEVI float wsum(float x) {
    x = DPP_ADD(x, 0xB1); x = DPP_ADD(x, 0x4E); x = DPP_ADD(x, 0x141); x = DPP_ADD(x, 0x140);
    const int xi = __float_as_int(x);
    return (__int_as_float(__builtin_amdgcn_readlane(xi, 0)) + __int_as_float(__builtin_amdgcn_readlane(xi, 16))) + (__int_as_float(__builtin_amdgcn_readlane(xi, 32)) + __int_as_float(__builtin_amdgcn_readlane(xi, 48)));
}
DEVI float red8(float x) {
    x = DPP_ADD(x, 0xB1);
    x = DPP_ADD(x, 0x4E);
    x = DPP_ADD(x, 0x141);
    return x;
}

DEVI float red16(float x) {
    x = DPP_ADD(x, 0xB1); x = DPP_ADD(x, 0x4E); x = DPP_ADD(x, 0x141); x = DPP_ADD(x, 0x140);
    return x;
}
DEVI float sfma(float a, float b, float c) { float d; asm("v_fma_f32 %0, %1, %2, %3" : "=v"(d) : "v"(a), "v"(b), "v"(c)); return d; }
DEVI float smul(float a, float b) { float d; asm("v_mul_f32 %0, %1, %2" : "=v"(d) : "v"(a), "v"(b)); return d; }
DEVI void fadd_g(float* ptr, float v) { (void)__builtin_amdgcn_global_atomic_fadd_f32((__attribute__((address_space(1))) float*)ptr, v); }
DEVI float frcp(float x) { return __builtin_amdgcn_rcpf(x); }
DEVI float fsigmoid(float x) { return __builtin_amdgcn_rcpf(1.0f + __expf(-x)); }

namespace pg8 {
constexpr int BM = 256, BK = 64, HALF = 128, HTB = HALF * BK * 2, STAGE_BYTES = 8 * HTB, NXCD = 8, WGM = 8;
__host__ __device__ __forceinline__ int lds_byte(int r, int c) { const int st = (r >> 4) * 2 + (c >> 5), rr = r & 15, cc = c & 31, ob = rr * 64 + cc * 2; return st * 1024 + (ob ^ (((ob >> 9) & 1) << 5)); }
__host__ __device__ __forceinline__ void stage_rc(int b, int& R, int& C) { const int st = b / 1024, sb = b % 1024, swz = sb ^ (((sb >> 9) & 1) << 5); R = (st >> 1) * 16 + swz / 64; C = (st & 1) * 32 + (swz % 64) / 2; }
__host__ __device__ __forceinline__ int perm32(int rho) { const int n = rho >> 4, i = rho & 15; return 8 * (i >> 2) + 4 * n + (i & 3); }
struct Unit { int pm, pn; };
struct Gemm { const bf16_t* A; const bf16_t* Bt; int M, N, K, nt; };
struct StaticOrder {
    int nM, nN, nwg, G, c;
    __device__ void init(int M, int N, int G_, int c_) { nM = M / BM; nN = N / BM; nwg = nM * nN; G = G_; c = c_; }
    __device__ bool next(int i, Unit& u) const {
        const long L = (long)i * G + c; if (L >= nwg) return false;
        int wgid = (int)L; { const int q = nwg / NXCD, r = nwg % NXCD, xcd = wgid % NXCD, off = wgid / NXCD; wgid = (xcd < r ? xcd * (q + 1) : r * (q + 1) + (xcd - r) * q) + off; }
        const int nig = WGM * nN, gid = wgid / nig, fm = gid * WGM, gsz = (nM - fm) < WGM ? (nM - fm) : WGM;
        u.pm = fm + ((wgid % nig) % gsz); u.pn = (wgid % nig) / gsz; return true;
    }
    __device__ __forceinline__ void a_ready(const Unit&) const {}
    __device__ __forceinline__ void done(const Unit&) const {}
};
struct MergeOrder {
    int ntiles, G, c;
    __device__ void init(int nM, int G_, int c_) { ntiles = nM * 8; G = G_; c = c_; }
    __device__ bool next(int i, Unit& u) const {
        const int ti = i / 3, br = i - ti * 3; const long L = (long)ti * G + c; if (L >= ntiles) return false;
        const int pm = (int)L >> 3, pn = (int)L & 7; u.pm = br * 34 + pm; u.pn = br * 8 + pn; return true;
    }
    __device__ __forceinline__ void a_ready(const Unit&) const {}
    __device__ __forceinline__ void done(const Unit&) const {}
};
DEVI unsigned cvt_pk_bf16(float lo, float hi) { unsigned r; asm volatile("v_cvt_pk_bf16_f32 %0, %1, %2" : "=v"(r) : "v"(lo), "v"(hi)); return r; }


struct SchedG {
    int mode;
    StaticOrder so; MergeOrder mo;
    __device__ __forceinline__ bool next(int i, Unit& u) const {
        if (mode == 2) { if (i > 0) return false; const int cu = so.c >> 4; u.pm = 32 + (cu >> 3); u.pn = cu & 7; return true; }
        return mode == 0 ? so.next(i, u) : mo.next(i, u); }
    __device__ __forceinline__ void a_ready(const Unit&) const {}
    __device__ __forceinline__ void done(const Unit&) const {}
};
struct EpiG {
    static constexpr bool PERM = true, AFTER_DRAIN = false;
    int kind, split;
    bf16_t* O; int ldc;
    const bf16_t* P; float* ACC;
    const float* xin_lat; const float* xin_ctx; float* XL; const float* gate; float* part;
    __device__ __forceinline__ void operator()(const f32x4 (&acc)[2][2][4][2], const Unit& u, int wr, int wc, int fr, int fq) const {
        if (kind <= 1) {
            const int row0 = u.pm * BM + wr * 64 + fr, col0 = u.pn * BM + wc * 32 + 8 * fq;
#pragma unroll
            for (int ai = 0; ai < 2; ++ai)
#pragma unroll
                for (int m = 0; m < 4; ++m) { bf16_t* rowp = O + (size_t)(row0 + ai * HALF + m * 16) * ldc + col0;
#pragma unroll
                    for (int bj = 0; bj < 2; ++bj) { f32x4 v0 = acc[ai][bj][m][0], v1 = acc[ai][bj][m][1];
                        if (kind == 1) {
#pragma unroll
                            for (int i = 0; i < 4; ++i) { float a = fmaxf(v0[i], 0.f), b = fmaxf(v1[i], 0.f); v0[i] = a * a; v1[i] = b * b; } }
                        u32x4 o; o[0] = cvt_pk_bf16(v0[0], v0[1]); o[1] = cvt_pk_bf16(v0[2], v0[3]); o[2] = cvt_pk_bf16(v1[0], v1[1]); o[3] = cvt_pk_bf16(v1[2], v1[3]);
                        *(u32x4*)(rowp + bj * HALF) = o; } }
        } else if (kind == 2) {
            const int br = u.pn >> 3, pn = u.pn & 7, pm = u.pm - br * 34;
            const int row0 = pm * BM + wr * 64 + fr, col0 = pn * BM + wc * 32 + 8 * fq;
#pragma unroll
            for (int ai = 0; ai < 2; ++ai)
#pragma unroll
                for (int m = 0; m < 4; ++m) { const size_t row = (size_t)(row0 + ai * HALF + m * 16);
#pragma unroll
                    for (int bj = 0; bj < 2; ++bj) { const int col = col0 + bj * HALF;
                        const u32x4 gv = *(const u32x4*)(P + row * NP + GTB + br * 2048 + col);
                        f32x4 v0 = acc[ai][bj][m][0], v1 = acc[ai][bj][m][1];
                        v0[0] *= sigmoidf(bflo(gv[0])); v0[1] *= sigmoidf(bfhi(gv[0])); v0[2] *= sigmoidf(bflo(gv[1])); v0[3] *= sigmoidf(bfhi(gv[1]));
                        v1[0] *= sigmoidf(bflo(gv[2])); v1[1] *= sigmoidf(bfhi(gv[2])); v1[2] *= sigmoidf(bflo(gv[3])); v1[3] *= sigmoidf(bfhi(gv[3]));
                        float* ap = ACC + row * 2048 + col;
                        if (br == 0) { *(f32x4*)ap = v0; *(f32x4*)(ap + 4) = v1; }
                        else { v0 += *(const f32x4*)ap; v1 += *(const f32x4*)(ap + 4);
                            if (br == 1) { *(f32x4*)ap = v0; *(f32x4*)(ap + 4) = v1; }
                            else { u32x4 o; o[0] = cvt_pk_bf16(v0[0], v0[1]); o[1] = cvt_pk_bf16(v0[2], v0[3]); o[2] = cvt_pk_bf16(v1[0], v1[1]); o[3] = cvt_pk_bf16(v1[2], v1[3]);
                                *(u32x4*)(O + row * 2048 + col) = o; } } } }
        } else {
            const int row0 = u.pm * BM + wr * 64 + fr, col0 = u.pn * BM + wc * 32 + 8 * fq;
#pragma unroll
            for (int ai = 0; ai < 2; ++ai)
#pragma unroll
                for (int m = 0; m < 4; ++m) { const int row = row0 + ai * HALF + m * 16;
                    const int mrow = row < NLAT ? (row >> 12) : 2;
                    const float* xr = row < NLAT ? xin_lat + (size_t)row * 2048 : xin_ctx + (size_t)(row - NLAT) * 2048;
                    const float* gr = gate + (size_t)mrow * 12288; float* orow = XL + (size_t)row * 2048;
#pragma unroll
                    for (int bj = 0; bj < 2; ++bj)
#pragma unroll
                        for (int n = 0; n < 2; ++n) { const int col = col0 + bj * HALF + n * 4;
                            const f32x4 g = *(const f32x4*)(gr + col);
                            if (split) *(f32x4*)(part + (size_t)(row - NLAT) * 2048 + col) = acc[ai][bj][m][n];
                            else { const f32x4 x = *(const f32x4*)(xr + col); *(f32x4*)(orow + col) = x + g * acc[ai][bj][m][n]; } } }
        }
    }
};
template <class Epi, class Sched>
__device__ __forceinline__ void gemm_phase(LAS unsigned char* lds, const Gemm g, const Sched& S, const Epi& E) {
    const int tid = otid(), wid = __builtin_amdgcn_readfirstlane(tid >> 6), lane = tid & 63, wr = wid >> 2, wc = wid & 3, fr = lane & 15, fq = lane >> 4;
    const int K = g.K, nt = g.nt;
    unsigned voffA[2], voffB[2];
#pragma unroll
    for (int i = 0; i < 2; ++i) { int R, C; stage_rc(tid * 16 + i * 8192, R, C); const int Rb = Epi::PERM ? ((R & ~31) + perm32(R & 31)) : R;
        voffA[i] = (unsigned)(R * K + C) * 2u; voffB[i] = (unsigned)(Rb * K + C) * 2u; }
    const size_t kstep = (size_t)(BK * 2);
    const size_t hstep = (size_t)HALF * K * 2;
    const size_t tstep = 2 * hstep;
    const unsigned ldsw = (unsigned)wid * 1024u;
    const int aoff = lds_byte(wr * 64 + fr, fq * 8), boff = lds_byte(wc * 32 + fr, fq * 8);
#define PG8_SA(b, h) (((b) * 2 + (h)) * HTB)
#define PG8_SB(b, h) ((4 + (b) * 2 + (h)) * HTB)
#define PG8_STAGE(bufoff, gbase, voff) do { _Pragma("unroll") for (int _i = 0; _i < 2; ++_i) \
        __builtin_amdgcn_global_load_lds((const unsigned*)((const char*)(gbase) + (voff)[_i]), (LAS unsigned*)(lds + (bufoff) + ldsw + _i * 8192), 16, 0, 0); } while (0)
#define PG8_LDA(dst, b, h) do { _Pragma("unroll") for (int m = 0; m < 4; ++m) _Pragma("unroll") for (int k = 0; k < 2; ++k) dst[m][k] = *(const LAS bf16x8*)(lds + PG8_SA(b, h) + aoff + m * 2048 + k * 1024); } while (0)
#define PG8_LDB(dst, b, h) do { _Pragma("unroll") for (int n = 0; n < 2; ++n) _Pragma("unroll") for (int k = 0; k < 2; ++k) dst[n][k] = *(const LAS bf16x8*)(lds + PG8_SB(b, h) + boff + n * 2048 + k * 1024); } while (0)
#define PG8_MMA(ai, bj, At, Bt) do { __builtin_amdgcn_s_setprio(1); _Pragma("unroll") for (int m = 0; m < 4; ++m) _Pragma("unroll") for (int n = 0; n < 2; ++n) _Pragma("unroll") for (int k = 0; k < 2; ++k) \
        acc[ai][bj][m][n] = __builtin_amdgcn_mfma_f32_16x16x32_bf16(Bt[n][k], At[m][k], acc[ai][bj][m][n], 0, 0, 0); __builtin_amdgcn_s_setprio(0); } while (0)
#define PG8_WAIT_V(n) asm volatile("s_waitcnt vmcnt(" #n ")" ::: "memory")
#define PG8_WAIT_L(n) asm volatile("s_waitcnt lgkmcnt(" #n ")" ::: "memory")
#define PG8_BAR __builtin_amdgcn_s_barrier()
#define PG8_SCHED __builtin_amdgcn_sched_barrier(0)
    Unit cur, nxt; int ui = 0;
    if (!S.next(0, cur)) return;
    f32x4 acc[2][2][4][2];
#pragma unroll
    for (int a = 0; a < 2; ++a)
#pragma unroll
        for (int b = 0; b < 2; ++b)
#pragma unroll
            for (int m = 0; m < 4; ++m)
#pragma unroll
                for (int n = 0; n < 2; ++n) acc[a][b][m][n] = (f32x4){0.f, 0.f, 0.f, 0.f};
    bf16x8 At[4][2], B0[2][2], B1[2][2];
    const char* cA = (const char*)g.A + (size_t)cur.pm * tstep; const char* cB = (const char*)g.Bt + (size_t)cur.pn * tstep;
    S.a_ready(cur);
    PG8_STAGE(PG8_SB(0, 0), cB, voffB); PG8_STAGE(PG8_SA(0, 0), cA, voffA); PG8_STAGE(PG8_SB(0, 1), cB + hstep, voffB); PG8_STAGE(PG8_SA(0, 1), cA + hstep, voffA);
    if (wr == 1) PG8_BAR;
    PG8_WAIT_V(4); PG8_BAR;
    PG8_STAGE(PG8_SB(1, 0), cB + kstep, voffB); PG8_STAGE(PG8_SA(1, 0), cA + kstep, voffA); PG8_STAGE(PG8_SB(1, 1), cB + hstep + kstep, voffB);
    PG8_WAIT_V(6); PG8_BAR;
    for (;;) {
        const bool has_next = S.next(ui + 1, nxt);
        const char* nA = has_next ? (const char*)g.A + (size_t)nxt.pm * tstep : cA; const char* nB = has_next ? (const char*)g.Bt + (size_t)nxt.pn * tstep : cB;
        for (int t = 0; t < nt; t += 2) {
            const bool last = (t == nt - 2);
            const char* a1 = cA + (size_t)(t + 1) * kstep;
            const char* a2 = last ? nA : cA + (size_t)(t + 2) * kstep; const char* b2 = last ? nB : cB + (size_t)(t + 2) * kstep;
            const char* a3 = a2 + kstep; const char* b3 = b2 + kstep;
            if (last && has_next) S.a_ready(nxt);
            PG8_LDB(B0, 0, 0); PG8_SCHED; PG8_LDA(At, 0, 0); PG8_STAGE(PG8_SA(1, 1), a1 + hstep, voffA);
            PG8_WAIT_L(8); PG8_BAR; PG8_WAIT_L(0); PG8_MMA(0, 0, At, B0); PG8_BAR; PG8_SCHED;
            PG8_LDB(B1, 0, 1); PG8_STAGE(PG8_SB(0, 0), b2, voffB);
            PG8_BAR; PG8_WAIT_L(0); PG8_MMA(0, 1, At, B1); PG8_BAR;
            PG8_LDA(At, 0, 1); PG8_STAGE(PG8_SA(0, 0), a2, voffA);
            PG8_BAR; PG8_WAIT_L(0); PG8_MMA(1, 0, At, B0); PG8_BAR; PG8_SCHED;
            PG8_STAGE(PG8_SB(0, 1), b2 + hstep, voffB);
            PG8_WAIT_V(6); PG8_BAR; PG8_MMA(1, 1, At, B1); PG8_BAR;
            PG8_LDB(B0, 1, 0); PG8_SCHED; PG8_LDA(At, 1, 0); PG8_STAGE(PG8_SA(0, 1), a2 + hstep, voffA);
            PG8_WAIT_L(8); PG8_BAR; PG8_WAIT_L(0); PG8_MMA(0, 0, At, B0); PG8_BAR; PG8_SCHED;
            PG8_LDB(B1, 1, 1); PG8_STAGE(PG8_SB(1, 0), b3, voffB);
            PG8_BAR; PG8_WAIT_L(0); PG8_MMA(0, 1, At, B1); PG8_BAR;
            PG8_LDA(At, 1, 1); PG8_STAGE(PG8_SA(1, 0), a3, voffA);
            PG8_BAR; PG8_WAIT_L(0); PG8_MMA(1, 0, At, B0); PG8_BAR; PG8_SCHED;
            PG8_STAGE(PG8_SB(1, 1), b3 + hstep, voffB);
            PG8_WAIT_V(6); PG8_BAR; PG8_MMA(1, 1, At, B1); PG8_BAR;
        }
        if constexpr (!Epi::AFTER_DRAIN) { E(acc, cur, wr, wc, fr, fq); S.done(cur); }
        if (!has_next) break;
#pragma unroll
        for (int a = 0; a < 2; ++a)
#pragma unroll
            for (int b = 0; b < 2; ++b)
#pragma unroll
                for (int m = 0; m < 4; ++m)
#pragma unroll
                    for (int n = 0; n < 2; ++n) acc[a][b][m][n] = (f32x4){0.f, 0.f, 0.f, 0.f};
        cur = nxt; cA = nA; cB = nB; ++ui;
    }
    PG8_WAIT_V(0);
    if (wr == 0) PG8_BAR;
    PG8_BAR;
    if constexpr (Epi::AFTER_DRAIN) { E.fused(acc, cur, wr, wc, fr, fq, lds, wid, lane); S.done(cur); }
#undef PG8_SA
#undef PG8_SB
#undef PG8_STAGE
#undef PG8_LDA
#undef PG8_LDB
#undef PG8_MMA
#undef PG8_WAIT_V
#undef PG8_WAIT_L
#undef PG8_BAR
#undef PG8_SCHED
}
}

__device__ void phase_mod(PP p, float* lds) {
    const int TIDX = otid();
    const int tid = TIDX;
    float* s = lds;
    float* red = lds + 3 * 2048;
    float* MOD = (float*)(p->ws + OFF_MOD);
    for (int i = tid; i < 3 * 2048; i += 512) { const int r = i >> 11, k = i & 2047; const float c = r < 2 ? p->in[I_C][r * 2048 + k] : p->in[I_CCTX][k]; s[i] = c * sigmoidf(c); }
    __syncthreads();
    for (int task = blockIdx.x; task < 192; task += gridDim.x) {
        const int l = task / 96, j0 = (task % 96) * 128, jc = tid & 127, kp = tid >> 7;
        const float* w = p->in[I_WMOD] + (size_t)l * 2048 * 12288 + j0 + jc;
        float a0 = 0.f, a1 = 0.f, a2 = 0.f;
#pragma unroll 8
        for (int k = kp * 512; k < kp * 512 + 512; ++k) { const float wv = w[(size_t)k * 12288]; a0 += s[k] * wv; a1 += s[2048 + k] * wv; a2 += s[4096 + k] * wv; }
        red[(kp * 3 + 0) * 128 + jc] = a0; red[(kp * 3 + 1) * 128 + jc] = a1; red[(kp * 3 + 2) * 128 + jc] = a2;
        __syncthreads();
        if (tid < 384) { const int r = tid >> 7, j = tid & 127;
            const float v = ((red[(0 * 3 + r) * 128 + j] + red[(1 * 3 + r) * 128 + j]) + (red[(2 * 3 + r) * 128 + j] + red[(3 * 3 + r) * 128 + j])) + p->in[I_BMOD][l * 12288 + j0 + j];
            MOD[(size_t)(l * 3 + r) * 12288 + j0 + j] = v; }
        __syncthreads();
    }
    if (blockIdx.x == gridDim.x - 1) {
        float* rc = (float*)(p->ws + OFF_ROPE); float* rs = rc + 2048;
        for (int i = tid; i < 2048; i += 512) { const int pos = i >> 5, j = i & 31; const float fr = powf(10000.0f, -(float)j / 32.0f); const float ang = (float)pos * fr; rc[i] = cosf(ang); rs[i] = sinf(ang); }
    }
}

__device__ void conv_tile(const float* __restrict__ src, int ld_src, int n_valid, int n0, int k0, bf16_t* __restrict__ dst, int ld_dst, float* tile) {
    const int TIDX = otid();
    const int tid = TIDX;
#pragma unroll
    for (int i = 0; i < 2; ++i) { const int kr = (tid >> 4) + i * 32, nc = (tid & 15) * 4; const float* sp = src + (size_t)(k0 + kr) * ld_src + n0 + nc;
        f32x4 v;
        if (n0 + nc + 3 < n_valid) v = *(const f32x4*)sp;
        else { v[0] = (n0 + nc + 0 < n_valid) ? sp[0] : 0.f; v[1] = (n0 + nc + 1 < n_valid) ? sp[1] : 0.f; v[2] = (n0 + nc + 2 < n_valid) ? sp[2] : 0.f; v[3] = (n0 + nc + 3 < n_valid) ? sp[3] : 0.f; }
        float* tp = tile + kr * 65 + nc; tp[0] = v[0]; tp[1] = v[1]; tp[2] = v[2]; tp[3] = v[3]; }
    __syncthreads();
    { const int n = tid >> 3, kc = (tid & 7) * 8; u32x4 o;
#pragma unroll
        for (int j = 0; j < 4; ++j) o[j] = pack2(tile[(kc + 2 * j) * 65 + n], tile[(kc + 2 * j + 1) * 65 + n]);
        *(u32x4*)(dst + (size_t)(n0 + n) * ld_dst + k0 + kc) = o; }
    __syncthreads();
}
__device__ void phase_convert(PP p, int l, float* lds, int vb, int vg, size_t wsh, int t_lo, int t_hi, bool lora) {
    const int TIDX = otid();
    unsigned char* wsw = p->ws + wsh;
    for (int t = t_lo + vb; t < t_hi; t += vg) {
        if (t < 8064) { const int nt = t >> 5, kt = t & 31; conv_tile(p->in[I_WIN] + (size_t)l * 2048 * DIN, DIN, DIN, nt * 64, kt * 64, (bf16_t*)(wsw + OFF_WIN), 2048, lds); }
        else if (t < 9600) { const int tt = t - 8064, br = tt >> 9, r = tt & 511, nt = r >> 4, kt = r & 15;
            conv_tile(p->in[I_WBR] + (size_t)(l * 3 + br) * 1024 * 2048, 2048, 2048, nt * 64, kt * 64, (bf16_t*)(wsw + OFF_WBR) + (size_t)br * 2048 * 1024, 1024, lds); }
        else if (t < 10624) { const int tt = t - 9600, nt = tt >> 5, kt = tt & 31; conv_tile(p->in[I_WOUT] + (size_t)l * 2048 * 2048, 2048, 2048, nt * 64, kt * 64, (bf16_t*)(wsw + OFF_WOUT), 2048, lds); }
        else if (t < 14720) { const int tt = t - 10624, nt = tt >> 5, kt = tt & 31; conv_tile(p->in[I_WFF1] + (size_t)l * 2048 * 8192, 8192, 8192, nt * 64, kt * 64, (bf16_t*)(wsw + OFF_WFF1), 2048, lds); }
        else { const int tt = t - 14720, nt = tt >> 7, kt = tt & 127; conv_tile(p->in[I_WFF2] + (size_t)l * 8192 * 2048, 2048, 2048, nt * 64, kt * 64, (bf16_t*)(wsw + OFF_WFF2), 8192, lds); }
    }
    bf16_t* WL = (bf16_t*)(wsw + OFF_WLORA);
    if (lora) for (int idx = vb * 512 + TIDX; idx < 5120 * 640; idx += vg * 512) {
        const int n = idx / 640, k = idx - n * 640, blk = n >> 10, nn = n & 1023;
        const int k0 = blk < 4 ? blk * 96 : 384, kw = blk < 4 ? 96 : 256;
        float v = 0.f;
        if (k >= k0 && k < k0 + kw) {
            const float* sp = blk < 2 ? p->in[I_RWWUP] + (size_t)(l * 2 + blk) * 96 * 1024 : (blk < 4 ? p->in[I_RWAUP] + (size_t)(l * 2 + blk - 2) * 96 * 1024 : p->in[I_RWGUP] + (size_t)l * 256 * 1024);
            v = sp[(size_t)(k - k0) * 1024 + nn]; }
        WL[idx] = f2bf(v);
    }
}
__device__ void phase_init(PP p, int l) {
    const int TIDX = otid();
    if (blockIdx.x == 0 && TIDX < 8) ((unsigned*)(p->ws + OFF_CTL))[l * 8 + TIDX] = 0u;
}

__device__ __forceinline__ void phase_norm(const float* __restrict__ xlat, const float* __restrict__ xctx, int nrows, const float* __restrict__ g, const float* __restrict__ modl, int ishift, int iscale, bf16_t* __restrict__ H,
                           const float* part = nullptr, const float* pgate = nullptr, float* xl_ctx = nullptr) {
    const int TIDX = otid();
    const int wid = TIDX >> 6, lane = TIDX & 63;
    for (int row = blockIdx.x * 8 + wid; row < nrows; row += gridDim.x * 8) {
        const float* xr = row < NLAT ? xlat + (size_t)row * 2048 : xctx + (size_t)(row - NLAT) * 2048;
        const int mrow = row < NLAT ? (row >> 12) : 2;
        const float* sh = modl + (size_t)mrow * 12288 + ishift * 2048; const float* sc = modl + (size_t)mrow * 12288 + iscale * 2048;
        f32x4 v[8]; float ss = 0.f;
#pragma unroll
        for (int i = 0; i < 8; ++i) v[i] = *(const f32x4*)(xr + (i * 64 + lane) * 4);
        if (part != nullptr && row >= NLAT) {
#pragma unroll
            for (int i = 0; i < 8; ++i) { const int col = (i * 64 + lane) * 4; const float* pp = part + (size_t)(row - NLAT) * 2048 + col;
                f32x4 a = *(const f32x4*)pp;
#pragma unroll
                for (int s_ = 1; s_ < 16; ++s_) a += *(const f32x4*)(pp + (size_t)s_ * 512 * 2048);
                v[i] += *(const f32x4*)(pgate + col) * a;
                *(f32x4*)(xl_ctx + (size_t)(row - NLAT) * 2048 + col) = v[i]; } }
#pragma unroll
        for (int i = 0; i < 8; ++i) ss += v[i][0] * v[i][0] + v[i][1] * v[i][1] + v[i][2] * v[i][2] + v[i][3] * v[i][3];
        ss = wsum(ss);
        const float r = rsqrtf(ss * (1.0f / 2048.0f) + 1e-6f);
#pragma unroll
        for (int i = 0; i < 8; ++i) { const int col = (i * 64 + lane) * 4; const f32x4 gg = *(const f32x4*)(g + col), s1 = *(const f32x4*)(sc + col), s0 = *(const f32x4*)(sh + col);
            float o[4];
#pragma unroll
            for (int j = 0; j < 4; ++j) o[j] = (v[i][j] * r * gg[j]) * (1.0f + s1[j]) + s0[j];
            u32x2 w; w[0] = pack2(o[0], o[1]); w[1] = pack2(o[2], o[3]);
            *(u32x2*)(H + (size_t)row * 2048 + col) = w; }
    }
}
__device__ void phase_final(PP p) {
    const int TIDX = otid();
    const int wid = TIDX >> 6, lane = TIDX & 63;
    const float* XL = (const float*)(p->ws + OFF_XL); const float* g = p->in[I_FING];
    for (int row = blockIdx.x * 8 + wid; row < NLAT; row += gridDim.x * 8) {
        const float* xr = XL + (size_t)row * 2048;
        f32x4 v[8]; float ss = 0.f;
#pragma unroll
        for (int i = 0; i < 8; ++i) { v[i] = *(const f32x4*)(xr + (i * 64 + lane) * 4); ss += v[i][0] * v[i][0] + v[i][1] * v[i][1] + v[i][2] * v[i][2] + v[i][3] * v[i][3]; }
        ss = wsum(ss);
        const float r = rsqrtf(ss * (1.0f / 2048.0f) + 1e-6f);
#pragma unroll
        for (int i = 0; i < 8; ++i) { const int col = (i * 64 + lane) * 4; const f32x4 gg = *(const f32x4*)(g + col);
            f32x4 o; o[0] = v[i][0] * r * gg[0]; o[1] = v[i][1] * r * gg[1]; o[2] = v[i][2] * r * gg[2]; o[3] = v[i][3] * r * gg[3];
            *(f32x4*)(p->out + (size_t)row * 2048 + col) = o; }
    }
}

DEVI void seq_nbrs(int row, bool& hp, bool& hn) {
    if (row < NLAT) { const int t = row & 4095; hp = t > 0; hn = t < 4095; } else { const int m = (row - NLAT) & 255; hp = m > 0; hn = m < 255; }
}
DEVI float shiftf(float c, float pv, float nx, float mu) { return c + mu * (0.5f * (pv + nx) - c); }

__device__ void phase_prep(PP p, int l, bf16_t* ldsT) {
    const int TIDX = otid();
    const bf16_t* P = (const bf16_t*)(p->ws + OFF_P); bf16_t* LA = (bf16_t*)(p->ws + OFF_LA);
    const float* mu = p->in[I_RWMU] + (size_t)l * 3712 + 3072;
    for (int idx = blockIdx.x * 512 + TIDX; idx < NTOK * 80; idx += gridDim.x * 512) {
        const int row = idx / 80, j = (idx - row * 80) * 8;
        bool hp, hn; seq_nbrs(row, hp, hn);
        const bf16_t* pc = P + (size_t)row * NP + RWB + 3072 + j;
        const u32x4 c = *(const u32x4*)pc;
        const u32x4 z = {0u, 0u, 0u, 0u};
        const u32x4 pv = hp ? *(const u32x4*)(pc - NP) : z, nx = hn ? *(const u32x4*)(pc + NP) : z;
        float o[8];
#pragma unroll
        for (int q = 0; q < 4; ++q) { o[2 * q] = shiftf(bflo(c[q]), bflo(pv[q]), bflo(nx[q]), mu[j + 2 * q]); o[2 * q + 1] = shiftf(bfhi(c[q]), bfhi(pv[q]), bfhi(nx[q]), mu[j + 2 * q + 1]); }
        if (j < 192) {
#pragma unroll
            for (int q = 0; q < 8; ++q) o[q] = tanhf(o[q]); }
        else if (j >= 384) {
#pragma unroll
            for (int q = 0; q < 8; ++q) o[q] = sigmoidf(o[q]); }
        u32x4 w; w[0] = pack2(o[0], o[1]); w[1] = pack2(o[2], o[3]); w[2] = pack2(o[4], o[5]); w[3] = pack2(o[6], o[7]);
        *(u32x4*)(LA + (size_t)row * 640 + j) = w;
    }
    bf16_t* VT = (bf16_t*)(p->ws + OFF_VT);
    const int tid = TIDX;
    for (int t = blockIdx.x; t < 136 * 16; t += gridDim.x) {
        const int rt = t >> 4, hd = t & 15, h = hd >> 1, dh = hd & 1;
        const int row0 = rt * 64;
        { const int tl = tid >> 3, dc = (tid & 7) * 8;
            const u32x4 v = *(const u32x4*)(P + (size_t)(row0 + tl) * NP + NAB + 2048 + h * 128 + dh * 64 + dc);
            bf16_t* tp = ldsT + tl * 66 + dc;
#pragma unroll
            for (int q = 0; q < 4; ++q) { tp[2 * q] = (bf16_t)(v[q] & 0xffffu); tp[2 * q + 1] = (bf16_t)(v[q] >> 16); } }
        __syncthreads();
        { const int d = tid >> 3, tc = (tid & 7) * 8;
            int b, pos; if (row0 < NLAT) { b = row0 >> 12; pos = row0 & 4095; } else { b = (row0 - NLAT) >> 8; pos = 4096 + ((row0 - NLAT) & 255); }
            u32x4 o;
#pragma unroll
            for (int q = 0; q < 4; ++q) o[q] = (unsigned)ldsT[(tc + 2 * q) * 66 + d] | ((unsigned)ldsT[(tc + 2 * q + 1) * 66 + d] << 16);
            *(u32x4*)(VT + ((size_t)((b * 8 + h) * 128 + dh * 64 + d)) * 4352 + pos + tc) = o; }
        __syncthreads();
    }
}

DEVI int scan_row(int s, int b, int dir) {
    if (s < 256) { const int m = dir ? 255 - s : s; return NLAT + b * 256 + m; }
    const int t = dir ? 4095 - (s - 256) : s - 256; return b * 4096 + t;
}
__device__ void rwkv_scan(PP p, int l, int task, float* lds) {
    const int TIDX = otid();
    const int chain = task >> 1, half = task & 1;
    const int b = chain >> 5, h = (chain >> 1) & 15, dir = chain & 1, tid = TIDX;
    const bf16_t* P = (const bf16_t*)(p->ws + OFF_P); const bf16_t* LO = (const bf16_t*)(p->ws + OFF_LO);
    float* YO = (float*)(p->ws + OFF_YRWF) + (size_t)dir * NTOK * 1024 + h * 64;
    const int sl = tid >> 5, e2 = (tid & 31) * 2, ch = h * 64 + e2;
    const float* MU = p->in[I_RWMU] + (size_t)l * 3712;
    const float mur0 = MU[ch], mur1 = MU[ch + 1], muk0 = MU[1024 + ch], muk1 = MU[1024 + ch + 1], muv0 = MU[2048 + ch], muv1 = MU[2048 + ch + 1];
    const float w00 = p->in[I_RWW0][(l * 2 + dir) * 1024 + ch], w01 = p->in[I_RWW0][(l * 2 + dir) * 1024 + ch + 1];
    const float a00 = p->in[I_RWA0][(l * 2 + dir) * 1024 + ch], a01 = p->in[I_RWA0][(l * 2 + dir) * 1024 + ch + 1];
    const float kk0 = p->in[I_RWKK][l * 1024 + ch], kk1 = p->in[I_RWKK][l * 1024 + ch + 1], ka0 = p->in[I_RWKA][l * 1024 + ch], ka1 = p->in[I_RWKA][l * 1024 + ch + 1];
    const float rk0 = p->in[I_RWRK][l * 1024 + ch], rk1 = p->in[I_RWRK][l * 1024 + ch + 1];
    float* RK = (float*)(p->ws + OFF_RK); const bool wrk = dir == 0 && half == 0; int srow = 0;
    const int kq = tid & 15, v = half * 32 + (tid >> 4);
    f32x2 S0 = (f32x2){0.f, 0.f}, S1 = (f32x2){0.f, 0.f};
    unsigned rc, rp, rn, kc, kp, kn, vc, vp, vn, wr_, ar_;
    auto issue = [&](int g) {
        const int row = scan_row(g * 16 + sl, b, dir); bool hp, hn; seq_nbrs(row, hp, hn); srow = row;
        const bf16_t* pr = P + (size_t)row * NP + RWB + ch;
        rc = *(const unsigned*)pr; kc = *(const unsigned*)(pr + 1024); vc = *(const unsigned*)(pr + 2048);
        rp = 0u; kp = 0u; vp = 0u; rn = 0u; kn = 0u; vn = 0u;
        if (hp) { rp = *(const unsigned*)(pr - NP); kp = *(const unsigned*)(pr - NP + 1024); vp = *(const unsigned*)(pr - NP + 2048); }
        if (hn) { rn = *(const unsigned*)(pr + NP); kn = *(const unsigned*)(pr + NP + 1024); vn = *(const unsigned*)(pr + NP + 2048); }
        const bf16_t* lo = LO + (size_t)row * 5120 + dir * 1024 + ch;
        wr_ = *(const unsigned*)lo; ar_ = *(const unsigned*)(lo + 2048);
    };
    auto commit = [&](int buf) {
        float* st = lds + buf * 6144 + sl * 384 + e2;
        const float r0 = shiftf(bflo(rc), bflo(rp), bflo(rn), mur0), r1 = shiftf(bfhi(rc), bfhi(rp), bfhi(rn), mur1);
        const float k0 = shiftf(bflo(kc), bflo(kp), bflo(kn), muk0), k1 = shiftf(bfhi(kc), bfhi(kp), bfhi(kn), muk1);
        const float v0 = shiftf(bflo(vc), bflo(vp), bflo(vn), muv0), v1 = shiftf(bfhi(vc), bfhi(vp), bfhi(vn), muv1);
        const float x0 = -(w00 + bflo(wr_)), x1 = -(w01 + bfhi(wr_));
        const float sp0 = x0 > 20.f ? x0 : __logf(1.0f + __expf(x0)), sp1 = x1 > 20.f ? x1 : __logf(1.0f + __expf(x1));
        const float d0 = __expf(-__expf(-sp0 - 0.5f)), d1 = __expf(-__expf(-sp1 - 0.5f));
        const float ar0 = fsigmoid(a00 + bflo(ar_)), ar1 = fsigmoid(a01 + bfhi(ar_));
        const float kd0 = k0 * (1.0f + (ar0 - 1.0f) * ka0), kd1 = k1 * (1.0f + (ar1 - 1.0f) * ka1);
        const float q0 = k0 * kk0, q1 = k1 * kk1;
        float ss = red16(q0 * q0 + q1 * q1);
        ss += __shfl_xor(ss, 16);
        const float inv = frcp(fmaxf(__builtin_amdgcn_sqrtf(ss), 1e-12f));
        const float n0 = q0 * inv, n1 = q1 * inv;
        if (wrk) { float t = red16(r0 * k0 * rk0 + r1 * k1 * rk1); t += __shfl_xor(t, 16); if ((tid & 31) == 0) RK[srow * 16 + h] = t; }
        *(f32x2*)(st + 0) = (f32x2){r0, r1}; *(f32x2*)(st + 64) = (f32x2){d0, d1}; *(f32x2*)(st + 128) = (f32x2){kd0, kd1};
        *(f32x2*)(st + 192) = (f32x2){v0, v1}; *(f32x2*)(st + 256) = (f32x2){-n0, -n1}; *(f32x2*)(st + 320) = (f32x2){n0 * ar0, n1 * ar1};
    };
    __syncthreads();
    issue(0); commit(0);
    __syncthreads();
    constexpr int NG = 4352 / 16;
    for (int g = 0; g < NG; ++g) {
        if (g + 1 < NG) issue(g + 1);
        {
            const float* base = lds + (g & 1) * 6144 + kq * 4;
            float ykeep = 0.f;
            f32x4 nA, nD, nB, nK, nR; float nV;
#define RW_LOAD(i_) do { const float* st_ = base + (i_) * 384; nA = *(const f32x4*)(st_ + 256); nD = *(const f32x4*)(st_ + 64); nB = *(const f32x4*)(st_ + 320); nK = *(const f32x4*)(st_ + 128); nR = *(const f32x4*)(st_); \
                nV = st_[192 - kq * 4 + v]; } while (0)
            RW_LOAD(0);
#pragma unroll
            for (int i = 0; i < 16; ++i) {
                const f32x4 a = nA, d = nD, bb = nB, k = nK, r = nR; const float vv = nV;
                if (i < 15) { RW_LOAD(i + 1); }
                __builtin_amdgcn_sched_barrier(0x77);
                f32x2 pa2 = S0 * (f32x2){a[0], a[1]}; pa2 = S1 * (f32x2){a[2], a[3]} + pa2;
                const f32x2 vvb = (f32x2){vv, vv};
                const f32x2 u0 = S0 * (f32x2){d[0], d[1]} + vvb * (f32x2){k[0], k[1]}, u1 = S1 * (f32x2){d[2], d[3]} + vvb * (f32x2){k[2], k[3]};
                const float pa = red16(pa2[0] + pa2[1]);
                const f32x2 pab = (f32x2){pa, pa};
                S0 = pab * (f32x2){bb[0], bb[1]} + u0; S1 = pab * (f32x2){bb[2], bb[3]} + u1;
                f32x2 y2 = S0 * (f32x2){r[0], r[1]}; y2 = S1 * (f32x2){r[2], r[3]} + y2;
                const float y = red16(y2[0] + y2[1]);
                ykeep = (kq == i) ? y : ykeep;
            }
#undef RW_LOAD
            YO[(size_t)scan_row(g * 16 + kq, b, dir) * 1024 + v] = ykeep;
        }
        if (g + 1 < NG) commit((g + 1) & 1);
        __syncthreads();
    }
}

__device__ void mlstm_scan(PP p, int l, int chain, int g8, float* lds) {
    const int TIDX = otid();
    const int b = chain >> 3, h = (chain >> 1) & 3, dir = chain & 1, tid = TIDX;
    const bf16_t* P = (const bf16_t*)(p->ws + OFF_P);
    const float* RC = (const float*)(p->ws + OFF_ROPE); const float* RS = RC + 2048;
    float* NO = (float*)(p->ws + OFF_MLNUM) + (size_t)dir * NTOK * 4 * 272 + h * 272;
    const int sl = tid >> 5, j = tid & 31;
    const float gbi = p->in[I_MLGB][l * 16 + (dir * 2 + 0) * 4 + h], gbf = p->in[I_MLGB][l * 16 + (dir * 2 + 1) * 4 + h];
    const int rowl = (tid >> 3) & 31, kq = tid & 7, crow = g8 * 32 + rowl, lane = tid & 63;
    f32x2 C[8];
#pragma unroll
    for (int i = 0; i < 8; ++i) C[i] = (f32x2){0.f, 0.f};
    f32x2 nst = (f32x2){0.f, 0.f};
    bf16_t q0, q1, q2, q3, k0, k1, k2, k3, gi, gf; unsigned vv2; float cr, sr, cc, sc;
    auto issue = [&](int g) {
        const int row = scan_row(g * 16 + sl, b, dir);
        const bf16_t* pr = P + (size_t)row * NP;
        const bf16_t* pq = pr + h * 128 + j; const bf16_t* pk = pr + 512 + h * 128 + j;
        q0 = pq[0]; q1 = pq[32]; q2 = pq[64]; q3 = pq[96]; k0 = pk[0]; k1 = pk[32]; k2 = pk[64]; k3 = pk[96];
        vv2 = j < 16 ? *(const unsigned*)(pr + 1024 + h * 256 + g8 * 32 + 2 * j) : 0u;
        gi = pr[3072 + (dir * 2 + 0) * 4 + h]; gf = pr[3072 + (dir * 2 + 1) * 4 + h];
        if (row < NLAT) { const int t = row & 4095, pr_ = t >> 6, pc_ = t & 63; cr = RC[pr_ * 32 + j]; sr = RS[pr_ * 32 + j]; cc = RC[pc_ * 32 + j]; sc = RS[pc_ * 32 + j]; }
        else { cr = 1.f; sr = 0.f; cc = 1.f; sc = 0.f; }
    };
    auto commit = [&](int buf) {
        float* st = lds + buf * 5376 + sl * 336;
        const float scale = 0.08838834764831845f;
        const float a0 = bf2f(q0), a1 = bf2f(q1), a2 = bf2f(q2), a3 = bf2f(q3);
        st[j] = (a0 * cr - a1 * sr) * scale; st[32 + j] = (a0 * sr + a1 * cr) * scale; st[64 + j] = (a2 * cc - a3 * sc) * scale; st[96 + j] = (a2 * sc + a3 * cc) * scale;
        const float c0 = bf2f(k0), c1 = bf2f(k1), c2 = bf2f(k2), c3 = bf2f(k3);
        st[128 + j] = c0 * cr - c1 * sr; st[160 + j] = c0 * sr + c1 * cr; st[192 + j] = c2 * cc - c3 * sc; st[224 + j] = c2 * sc + c3 * cc;
        if (j < 16) { st[256 + 2 * j] = bflo(vv2); st[257 + 2 * j] = bfhi(vv2); }
        if (j == 0) { st[320] = fsigmoid(bf2f(gf) + gbf); st[321] = __expf(bf2f(gi) + gbi); }
    };
    __syncthreads();
    issue(0); commit(0);
    __syncthreads();
    constexpr int NG = 4352 / 16;
    for (int g = 0; g < NG; ++g) {
        if (g + 1 < NG) issue(g + 1);
        const float* base = lds + (g & 1) * 5376;
        if (tid < 256) {
            float nkeep = 0.f, Fc = 1.0f;
            f32x4 nK[4], nQ[4]; float nF, nI, nV0;
#define ML_LOAD(i_) do { const float* st_ = base + (i_) * 336; _Pragma("unroll") for (int c4 = 0; c4 < 4; ++c4) { nK[c4] = *(const f32x4*)(st_ + 128 + c4 * 32 + kq * 4); nQ[c4] = *(const f32x4*)(st_ + c4 * 32 + kq * 4); } \
                nF = st_[320]; nI = st_[321]; nV0 = st_[256 + rowl]; } while (0)
            ML_LOAD(0);
#pragma unroll
            for (int i = 0; i < 16; ++i) {
                f32x4 kk[4], qq[4];
#pragma unroll
                for (int c4 = 0; c4 < 4; ++c4) { kk[c4] = nK[c4]; qq[c4] = nQ[c4]; }
                Fc *= nF;
                const float coef = nI * nV0 * frcp(Fc);
                if (i < 15) { ML_LOAD(i + 1); }
                __builtin_amdgcn_sched_barrier(0x77);
                const f32x2 cf = (f32x2){coef, coef};
                f32x2 num2 = (f32x2){0.f, 0.f}, num3 = (f32x2){0.f, 0.f};
#pragma unroll
                for (int c4 = 0; c4 < 4; ++c4) {
                    const f32x2 KA = (f32x2){kk[c4][0], kk[c4][1]}, KB = (f32x2){kk[c4][2], kk[c4][3]}, QA = (f32x2){qq[c4][0], qq[c4][1]}, QB = (f32x2){qq[c4][2], qq[c4][3]};
                    C[2 * c4] = cf * KA + C[2 * c4]; C[2 * c4 + 1] = cf * KB + C[2 * c4 + 1];
                    num2 = C[2 * c4] * QA + num2; num3 = C[2 * c4 + 1] * QB + num3; }
                num2 += num3;
                const float num = red8(num2[0] + num2[1]) * Fc;
                nkeep = (kq == (i & 7)) ? num : nkeep;
                if ((i & 7) == 7) NO[(size_t)scan_row(g * 16 + (i - 7) + kq, b, dir) * (4 * 272) + crow] = nkeep;
            }
            { const f32x2 fb = (f32x2){Fc, Fc};
#pragma unroll
                for (int x = 0; x < 8; ++x) C[x] = C[x] * fb; }
#undef ML_LOAD
        } else if (g8 == 0 && tid < 320) {
            float nkeep = 0.f;
            f32x2 nk, nq; float nf, ni;
#define MN_LOAD(i_) do { const float* st_ = base + (i_) * 336; nk = *(const f32x2*)(st_ + 128 + 2 * lane); nq = *(const f32x2*)(st_ + 2 * lane); nf = st_[320]; ni = st_[321]; } while (0)
            MN_LOAD(0);
#pragma unroll
            for (int i = 0; i < 16; ++i) {
                const f32x2 kk = nk, qq = nq; const float f = nf, ig = ni;
                if (i < 15) { MN_LOAD(i + 1); }
                __builtin_amdgcn_sched_barrier(0x77);
                nst = (f32x2){f, f} * nst + (f32x2){ig, ig} * kk;
                const f32x2 d2 = nst * qq;
                const float den16 = red16(d2[0] + d2[1]);
                nkeep = ((lane & 15) == i) ? den16 : nkeep;
            }
#undef MN_LOAD
            nkeep += __shfl_xor(nkeep, 16); nkeep += __shfl_xor(nkeep, 32);
            if (lane < 16) NO[(size_t)scan_row(g * 16 + lane, b, dir) * (4 * 272) + 256] = nkeep;
        }
        if (g + 1 < NG) commit((g + 1) & 1);
        __syncthreads();
    }
}

#define MFMA16(a, b, c) __builtin_amdgcn_mfma_f32_16x16x32_bf16(a, b, c, 0, 0, 0)
__device__ void na_wave(PP p, int l, int task) {
    const int TIDX = otid();
    const bf16_t* P = (const bf16_t*)(p->ws + OFF_P); const bf16_t* VT = (const bf16_t*)(p->ws + OFF_VT);
    bf16_t* YN = (bf16_t*)(p->ws + OFF_Y3) + 2ull * NTOK * 1024;
    const int w = TIDX >> 6, lane = TIDX & 63, n16 = lane & 15, g = lane >> 4;
    int b, h, qrow, r = 0, qcol = 0, cs = 0, row_start = 0, c_start = 0; bool lat;
    if (task < 512) { lat = true; b = task >> 8; h = (task >> 5) & 7; const int pair = task & 31; r = pair * 2 + (w >> 2); const int qi = w & 3; qcol = qi * 16 + n16;
        qrow = b * 4096 + r * 64 + qcol; cs = qi == 0 ? 0 : (qi == 1 ? 8 : (qi == 2 ? 24 : 32)); row_start = min(max(r - 4, 0), 56); c_start = min(max(qcol - 8, 0), 48); }
    else { lat = false; const int t2 = task - 512; b = t2 >> 4; h = (t2 >> 1) & 7; const int chunk = t2 & 1; qrow = NLAT + b * 256 + chunk * 128 + w * 16 + n16; }
    bf16x8 qf[4];
#pragma unroll
    for (int c = 0; c < 4; ++c) qf[c] = *(const bf16x8*)(P + (size_t)qrow * NP + NAB + h * 128 + c * 32 + g * 8);
    const float* rpb = p->in[I_RPB] + (size_t)(l * 8 + h) * 15 * 31;
    const bf16_t* vtb = VT + (size_t)((b * 8 + h) * 128) * 4352;
    f32x4 O[8];
#pragma unroll
    for (int i = 0; i < 8; ++i) O[i] = (f32x4){0.f, 0.f, 0.f, 0.f};
    float mrun = -INFINITY, lsum = 0.f;
    const float scale = 0.08838834764831845f;
    for (int pass = lat ? 0 : 2; pass < 4; ++pass) {
        f32x4 S[8];
#pragma unroll
        for (int i = 0; i < 8; ++i) {
            int krowtok;
            if (pass < 2) { const int krow = row_start + pass * 4 + (i >> 1); krowtok = b * 4096 + krow * 64 + cs + (i & 1) * 16 + n16; }
            else krowtok = NLAT + b * 256 + (pass - 2) * 128 + i * 16 + n16;
            const bf16_t* kp = P + (size_t)krowtok * NP + NAB + 1024 + h * 128 + g * 8;
            f32x4 acc = (f32x4){0.f, 0.f, 0.f, 0.f};
#pragma unroll
            for (int c = 0; c < 4; ++c) { const bf16x8 kf = *(const bf16x8*)(kp + c * 32); acc = MFMA16(kf, qf[c], acc); }
            S[i] = acc;
        }
        float mx = -INFINITY;
#pragma unroll
        for (int i = 0; i < 8; ++i) {
            if (pass < 2) { const int krow = row_start + pass * 4 + (i >> 1); const float* rb = rpb + (krow - r + 7) * 31;
#pragma unroll
                for (int jj = 0; jj < 4; ++jj) { const int kc = cs + (i & 1) * 16 + 4 * g + jj; const bool ok = (kc >= c_start) && (kc < c_start + 16);
                    const int co = min(max(kc - qcol, -15), 15) + 15;
                    S[i][jj] = ok ? S[i][jj] * scale + rb[co] : -INFINITY; } }
            else {
#pragma unroll
                for (int jj = 0; jj < 4; ++jj) S[i][jj] *= scale; }
#pragma unroll
            for (int jj = 0; jj < 4; ++jj) mx = fmaxf(mx, S[i][jj]);
        }
        mx = fmaxf(mx, __shfl_xor(mx, 16)); mx = fmaxf(mx, __shfl_xor(mx, 32));
        const float mnew = fmaxf(mrun, mx);
        const float alpha = __expf(mrun - mnew);
        mrun = mnew; lsum *= alpha;
#pragma unroll
        for (int i = 0; i < 8; ++i) { O[i][0] *= alpha; O[i][1] *= alpha; O[i][2] *= alpha; O[i][3] *= alpha; }
        bf16x8 pf[4];
#pragma unroll
        for (int c = 0; c < 4; ++c) {
            float e[8];
#pragma unroll
            for (int jj = 0; jj < 4; ++jj) { e[jj] = __expf(S[2 * c][jj] - mnew); e[4 + jj] = __expf(S[2 * c + 1][jj] - mnew); }
#pragma unroll
            for (int jj = 0; jj < 8; ++jj) lsum += e[jj];
            u32x4 u; u[0] = pack2(e[0], e[1]); u[1] = pack2(e[2], e[3]); u[2] = pack2(e[4], e[5]); u[3] = pack2(e[6], e[7]);
            pf[c] = __builtin_bit_cast(bf16x8, u);
        }
#pragma unroll
        for (int c = 0; c < 4; ++c) {
            int pos0, pos1;
            if (pass < 2) { const int krow = row_start + pass * 4 + c; pos0 = krow * 64 + cs + 4 * g; pos1 = pos0 + 16; }
            else { pos0 = 4096 + (pass - 2) * 128 + c * 32 + 4 * g; pos1 = pos0 + 16; }
#pragma unroll
            for (int dt = 0; dt < 8; ++dt) {
                const bf16_t* vp = vtb + (size_t)(dt * 16 + n16) * 4352;
                const bf16x4 v0 = *(const bf16x4*)(vp + pos0), v1 = *(const bf16x4*)(vp + pos1);
                const bf16x8 vf = __builtin_shufflevector(v0, v1, 0, 1, 2, 3, 4, 5, 6, 7);
                O[dt] = MFMA16(vf, pf[c], O[dt]);
            }
        }
    }
    lsum += __shfl_xor(lsum, 16); lsum += __shfl_xor(lsum, 32);
    const float inv = 1.0f / lsum;
    bf16_t* yo = YN + (size_t)qrow * 1024 + h * 128 + 4 * g;
#pragma unroll
    for (int dt = 0; dt < 8; ++dt) { u32x2 o; o[0] = pack2(O[dt][0] * inv, O[dt][1] * inv); o[1] = pack2(O[dt][2] * inv, O[dt][3] * inv); *(u32x2*)(yo + dt * 16) = o; }
}

__device__ void na_block(PP p, int l, int task, unsigned char* lds) {
    const int TIDX = otid();
    const bf16_t* P = (const bf16_t*)(p->ws + OFF_P); const bf16_t* VT = (const bf16_t*)(p->ws + OFF_VT);
    bf16_t* YN = (bf16_t*)(p->ws + OFF_Y3) + 2ull * NTOK * 1024;
    const int tid = TIDX, w = tid >> 6, lane = tid & 63, n16 = lane & 15, g = lane >> 4, qi = w & 3, kh = w >> 2;
    const int b = task >> 9, h = (task >> 6) & 7, r = task & 63;
    const int qcol = qi * 16 + n16, qrow = b * 4096 + r * 64 + qcol;
    const int cs = qi == 0 ? 0 : (qi == 1 ? 8 : (qi == 2 ? 24 : 32)), row_start = min(max(r - 4, 0), 56), c_start = min(max(qcol - 8, 0), 48);
    unsigned char* KT = lds; unsigned char* VL = lds + 65536;
    bf16x8 qf[4];
#pragma unroll
    for (int c = 0; c < 4; ++c) qf[c] = *(const bf16x8*)(P + (size_t)qrow * NP + NAB + h * 128 + c * 32 + g * 8);
    const float* rpb = p->in[I_RPB] + (size_t)(l * 8 + h) * 15 * 31;
    const bf16_t* vtb = VT + (size_t)((b * 8 + h) * 128) * 4352;
    const bf16_t* kgb = P + NAB + 1024 + h * 128;
    f32x4 O[8];
#pragma unroll
    for (int i = 0; i < 8; ++i) O[i] = (f32x4){0.f, 0.f, 0.f, 0.f};
    float mrun = -INFINITY, lsum = 0.f;
    const float scale = 0.08838834764831845f;
    u32x4 kreg[8], vreg[8];
    auto gload = [&](int pass) {
#pragma unroll
        for (int i = 0; i < 8; ++i) { const int key = i * 32 + (tid >> 4), c16 = tid & 15, s_ = key >> 6, kk = key & 63;
            if (pass < 2) { const int krow = row_start + (s_ < 2 ? 2 * pass + s_ : 2 + 2 * pass + s_);
                kreg[i] = *(const u32x4*)(kgb + (size_t)(b * 4096 + krow * 64 + kk) * NP + c16 * 8); }
            else if (i < 4) { const int m = (s_ == 0 ? 0 : 128) + 64 * (pass - 2) + kk;
                kreg[i] = *(const u32x4*)(kgb + (size_t)(NLAT + b * 256 + m) * NP + c16 * 8); } }
#pragma unroll
        for (int i = 0; i < 8; ++i) { const int d = i * 16 + (tid >> 5), key8 = (tid & 31) * 8, s_ = key8 >> 6, kk = key8 & 63;
            if (pass < 2) { const int krow = row_start + (s_ < 2 ? 2 * pass + s_ : 2 + 2 * pass + s_);
                vreg[i] = *(const u32x4*)(vtb + (size_t)d * 4352 + krow * 64 + kk); }
            else if (key8 < 128) { const int m = (s_ == 0 ? 0 : 128) + 64 * (pass - 2) + kk;
                vreg[i] = *(const u32x4*)(vtb + (size_t)d * 4352 + 4096 + m); } }
    };
    auto lstore = [&](int pass) {
#pragma unroll
        for (int i = 0; i < 8; ++i) { const int key = i * 32 + (tid >> 4), c16 = tid & 15;
            if (pass < 2 || i < 4) *(u32x4*)(KT + key * 256 + ((c16 ^ (key & 15)) * 16)) = kreg[i]; }
#pragma unroll
        for (int i = 0; i < 8; ++i) { const int d = i * 16 + (tid >> 5), kc16 = tid & 31;
            if (pass < 2 || kc16 < 16) *(u32x4*)(VL + d * 512 + ((kc16 ^ (d & 15)) * 16)) = vreg[i]; }
    };
    gload(0);
    for (int pass = 0; pass < 4; ++pass) {
        __syncthreads();
        lstore(pass);
        __syncthreads();
        if (pass < 3) gload(pass + 1);
        f32x4 S[4];
#pragma unroll
        for (int i = 0; i < 4; ++i) {
            const int keyl = pass < 2 ? (kh * 2 + (i >> 1)) * 64 + cs + (i & 1) * 16 + n16 : kh * 64 + i * 16 + n16;
            const unsigned char* kp = KT + keyl * 256;
            f32x4 acc = (f32x4){0.f, 0.f, 0.f, 0.f};
#pragma unroll
            for (int c = 0; c < 4; ++c) { const bf16x8 kf = *(const bf16x8*)(kp + (((c * 4 + g) ^ (keyl & 15)) * 16)); acc = MFMA16(kf, qf[c], acc); }
            S[i] = acc;
        }
        float mx = -INFINITY;
#pragma unroll
        for (int i = 0; i < 4; ++i) {
            if (pass < 2) { const int krow = row_start + kh * 4 + 2 * pass + (i >> 1); const float* rb = rpb + (krow - r + 7) * 31;
#pragma unroll
                for (int jj = 0; jj < 4; ++jj) { const int kc = cs + (i & 1) * 16 + 4 * g + jj; const bool ok = (kc >= c_start) && (kc < c_start + 16);
                    const int co = min(max(kc - qcol, -15), 15) + 15;
                    S[i][jj] = ok ? S[i][jj] * scale + rb[co] : -INFINITY; } }
            else {
#pragma unroll
                for (int jj = 0; jj < 4; ++jj) S[i][jj] *= scale; }
#pragma unroll
            for (int jj = 0; jj < 4; ++jj) mx = fmaxf(mx, S[i][jj]);
        }
        mx = fmaxf(mx, __shfl_xor(mx, 16)); mx = fmaxf(mx, __shfl_xor(mx, 32));
        const float mnew = fmaxf(mrun, mx);
        const float alpha = __expf(mrun - mnew);
        mrun = mnew; lsum *= alpha;
#pragma unroll
        for (int i = 0; i < 8; ++i) { O[i][0] *= alpha; O[i][1] *= alpha; O[i][2] *= alpha; O[i][3] *= alpha; }
#pragma unroll
        for (int c = 0; c < 2; ++c) {
            float e[8];
#pragma unroll
            for (int jj = 0; jj < 4; ++jj) { e[jj] = __expf(S[2 * c][jj] - mnew); e[4 + jj] = __expf(S[2 * c + 1][jj] - mnew); }
#pragma unroll
            for (int jj = 0; jj < 8; ++jj) lsum += e[jj];
            u32x4 u; u[0] = pack2(e[0], e[1]); u[1] = pack2(e[2], e[3]); u[2] = pack2(e[4], e[5]); u[3] = pack2(e[6], e[7]);
            const bf16x8 pf = __builtin_bit_cast(bf16x8, u);
            const int key0 = pass < 2 ? (kh * 2 + c) * 64 + cs + 4 * g : kh * 64 + c * 32 + 4 * g;
            const int kc8a = key0 >> 2, kc8b = kc8a + 4;
#pragma unroll
            for (int dt = 0; dt < 8; ++dt) { const int d = dt * 16 + n16; const unsigned char* vp = VL + d * 512;
                const bf16x4 v0 = *(const bf16x4*)(vp + (((kc8a >> 1) ^ (d & 15)) * 16) + (kc8a & 1) * 8), v1 = *(const bf16x4*)(vp + (((kc8b >> 1) ^ (d & 15)) * 16) + (kc8b & 1) * 8);
                const bf16x8 vf = __builtin_shufflevector(v0, v1, 0, 1, 2, 3, 4, 5, 6, 7);
                O[dt] = MFMA16(vf, pf, O[dt]); }
        }
    }
    lsum += __shfl_xor(lsum, 16); lsum += __shfl_xor(lsum, 32);
    __syncthreads();
    float* cmb = (float*)lds + (size_t)qi * 34 * 64 + lane;
    if (kh == 1) { cmb[0] = mrun; cmb[64] = lsum;
#pragma unroll
        for (int dt = 0; dt < 8; ++dt)
#pragma unroll
            for (int jj = 0; jj < 4; ++jj) cmb[(2 + dt * 4 + jj) * 64] = O[dt][jj]; }
    __syncthreads();
    if (kh == 0) { const float m1 = cmb[0], l1 = cmb[64];
        const float mn = fmaxf(mrun, m1), a0 = __expf(mrun - mn), a1 = __expf(m1 - mn);
        const float inv = 1.0f / (lsum * a0 + l1 * a1);
        bf16_t* yo = YN + (size_t)qrow * 1024 + h * 128 + 4 * g;
#pragma unroll
        for (int dt = 0; dt < 8; ++dt) { float o[4];
#pragma unroll
            for (int jj = 0; jj < 4; ++jj) o[jj] = (O[dt][jj] * a0 + cmb[(2 + dt * 4 + jj) * 64] * a1) * inv;
            u32x2 ov; ov[0] = pack2(o[0], o[1]); ov[1] = pack2(o[2], o[3]); *(u32x2*)(yo + dt * 16) = ov; } }
}

__device__ void phase_mix(PP p, int l, float* lds, int which = 7) {
    const int TIDX = otid();
    for (int t = blockIdx.x; t < 256; t += gridDim.x) {
        if (t < 128) { if (which & 1) rwkv_scan(p, l, t, lds); }
        else if (which & 2) mlstm_scan(p, l, (t - 128) >> 3, (t - 128) & 7, lds);
        __syncthreads();
    }
    unsigned* ctr = (unsigned*)(p->ws + OFF_CTL) + l * 8 + ((which & 8) ? 1 : 0);
    if (!(which & 4)) return;
    int* stask = (int*)lds;
    const int ntask = l == 0 ? 1056 : 1024;
    for (;;) {
        __syncthreads();
        if (TIDX == 0) stask[0] = (int)atomicAdd(ctr, 1u);
        __syncthreads();
        const int t = stask[0];
        if (t >= ntask) break;
        if (t < 1024) na_block(p, l, t, (unsigned char*)lds); else na_wave(p, l, t - 512);
    }
}

__device__ void phase_post(PP p, int l, int nrows) {
    const int TIDX = otid();
    const int wid = TIDX >> 6, lane = TIDX & 63, gw = blockIdx.x * 8 + wid, nw = gridDim.x * 8;
    const bf16_t* P = (const bf16_t*)(p->ws + OFF_P); const bf16_t* LO = (const bf16_t*)(p->ws + OFF_LO);
    bf16_t* YM = (bf16_t*)(p->ws + OFF_Y3); bf16_t* YR = YM + (size_t)NTOK * 1024;
    const float* NUM = (const float*)(p->ws + OFF_MLNUM); const float* YF = (const float*)(p->ws + OFF_YRWF);
    for (int row = gw; row < nrows; row += nw) {
        f32x4 a[4], c[4], ng[4]; float dfr[4], dbr[4]; u32x2 ov[4];
#pragma unroll
        for (int h = 0; h < 4; ++h) {
            const float* nf = NUM + ((size_t)row * 4 + h) * 272; const float* nb = NUM + ((size_t)(NTOK + row) * 4 + h) * 272;
            a[h] = *(const f32x4*)(nf + lane * 4); c[h] = *(const f32x4*)(nb + lane * 4); dfr[h] = nf[256]; dbr[h] = nb[256];
            ov[h] = *(const u32x2*)(P + (size_t)row * NP + 2048 + h * 256 + lane * 4);
            ng[h] = *(const f32x4*)(p->in[I_MLNG] + l * 1024 + h * 256 + lane * 4); }
#pragma unroll
        for (int h = 0; h < 4; ++h) {
            const float df = 1.0f / fmaxf(fabsf(dfr[h]), 1.0f), db = 1.0f / fmaxf(fabsf(dbr[h]), 1.0f);
            float hv[4]; float ss = 0.f;
#pragma unroll
            for (int j = 0; j < 4; ++j) { hv[j] = a[h][j] * df + c[h][j] * db; ss += hv[j] * hv[j]; }
            ss = wsum(ss);
            const float rr = rsqrtf(ss * (1.0f / 256.0f) + 1e-6f);
            const float o0 = hv[0] * rr * ng[h][0] * sigmoidf(bflo(ov[h][0])), o1 = hv[1] * rr * ng[h][1] * sigmoidf(bfhi(ov[h][0]));
            const float o2 = hv[2] * rr * ng[h][2] * sigmoidf(bflo(ov[h][1])), o3 = hv[3] * rr * ng[h][3] * sigmoidf(bfhi(ov[h][1]));
            u32x2 w; w[0] = pack2(o0, o1); w[1] = pack2(o2, o3);
            *(u32x2*)(YM + (size_t)row * 1024 + h * 256 + lane * 4) = w; }
    }
    const float* MU = p->in[I_RWMU] + (size_t)l * 3712;
    for (int it = gw; it < nrows * 2; it += nw) {
        const int row = it >> 1, hq = (it & 1) * 8;
        bool hp, hn; seq_nbrs(row, hp, hn);
        float y0[8], y1[8], gg[8], rkv[8]; bf16_t vc[8], vp[8], vn[8];
#pragma unroll
        for (int u = 0; u < 8; ++u) { const int c = (hq + u) * 64 + lane;
            y0[u] = YF[(size_t)row * 1024 + c]; y1[u] = YF[(size_t)(NTOK + row) * 1024 + c];
            const bf16_t* pr = P + (size_t)row * NP + RWB + 2048 + c;
            vc[u] = pr[0]; vp[u] = hp ? pr[-NP] : (bf16_t)0; vn[u] = hn ? pr[NP] : (bf16_t)0;
            rkv[u] = ((const float*)(p->ws + OFF_RK))[row * 16 + hq + u];
            gg[u] = bf2f(LO[(size_t)row * 5120 + 4096 + c]); }
#pragma unroll
        for (int u = 0; u < 8; ++u) { const int c = (hq + u) * 64 + lane;
            const float y = y0[u] + y1[u];
            const float mean = wsum(y) * (1.0f / 64.0f);
            const float dy = y - mean;
            const float var = wsum(dy * dy) * (1.0f / 64.0f);
            const float yn = dy * rsqrtf(var + 64e-5f);
            const float vv = shiftf(bf2f(vc[u]), bf2f(vp[u]), bf2f(vn[u]), MU[2048 + c]);
            const float bonus = rkv[u] * vv;
            const float o = (yn * p->in[I_RWLNW][l * 1024 + c] + p->in[I_RWLNB][l * 1024 + c] + bonus) * gg[u];
            YR[(size_t)row * 1024 + c] = f2bf(o); }
    }
}


constexpr size_t PART_OFF = 150ull << 20;
#ifndef DUPMASK
#define DUPMASK 0
#endif
#ifndef DUPWHICH
#define DUPWHICH 3
#endif
__global__ void __launch_bounds__(512, 2) fwd_kernel(Params p0) {
    extern __shared__ __attribute__((aligned(16))) unsigned char shm[];
    cg::grid_group grid = cg::this_grid();
    float* ldsf = (float*)shm;
    LAS unsigned char* ldsg = (LAS unsigned char*)shm;
    const int ph_lo = p0.ph_lo, ph_hi = p0.ph_hi;
    auto kseg = __builtin_amdgcn_kernarg_segment_ptr();
    for (int ph = ph_lo; ph < ph_hi; ++ph) {
        if (ph > ph_lo) grid.sync();
        PP p = (PP)kseg; asm volatile("" : "+s"(p));
        unsigned char* ws = p->ws;
        const float* MOD = (const float*)(ws + OFF_MOD);
        float* XL = (float*)(ws + OFF_XL);
        bf16_t* H = (bf16_t*)(ws + OFF_H);
        bf16_t* Pb = (bf16_t*)(ws + OFF_P);
        if (ph == 0) { phase_mod(p, ldsf); __syncthreads(); phase_convert(p, 0, ldsf, (int)blockIdx.x, (int)gridDim.x, 0, 0, 18816, true); continue; }
        if (ph == NPHASE - 1) { phase_final(p); continue; }
        const int l = (ph - 1) / 11, sub = (ph - 1) % 11;
        const int two_wt = p->two_wt;
        const size_t wsh = (l == 1 && two_wt) ? WT_SHIFT : 0;
#if DUPMASK
        for (int rep = 0; rep < (((DUPMASK >> sub) & 1) ? 2 : 1); ++rep) { if (rep) grid.sync();
#endif
        const int Ml = l == 0 ? NTOK : NLAT;
        const float* modl = MOD + (size_t)l * 3 * 12288;
        if (sub == 1 || sub == 3 || sub == 6 || sub == 7 || sub == 9 || sub == 10) {
            const bool ksplit = l == 0 && (sub == 7 || sub == 10) && gridDim.x == 256;
            for (int part = 0; part < (ksplit ? 2 : (sub == 3 ? 3 : 1)); ++part) {
            pg8::Gemm g; pg8::SchedG S; pg8::EpiG E;
            S.mode = 0; S.mo.init(Ml / 256, (int)gridDim.x, (int)blockIdx.x);
            E.kind = 0; E.split = 0; E.O = Pb; E.ldc = NP; E.P = Pb; E.ACC = (float*)(ws + OFF_YRWF);
            E.xin_lat = XL; E.xin_ctx = XL + (size_t)NLAT * 2048; E.XL = XL; E.gate = modl; E.part = nullptr;
            if (sub == 1) { g = pg8::Gemm{H, (const bf16_t*)(ws + wsh + OFF_WIN), NTOK, NP, 2048, 32}; }
            else if (sub == 3) { const int n0 = part * 2048, k0 = part == 0 ? 0 : (part == 1 ? 192 : 384);
                g = pg8::Gemm{(const bf16_t*)(ws + OFF_LA) + k0, (const bf16_t*)(ws + wsh + OFF_WLORA) + (size_t)n0 * 640 + k0, NTOK, part == 2 ? 1024 : 2048, 640, 4}; E.O = (bf16_t*)(ws + OFF_LO) + n0; E.ldc = 5120; }
            else if (sub == 6) { g = pg8::Gemm{(const bf16_t*)(ws + OFF_Y3), (const bf16_t*)(ws + wsh + OFF_WBR), Ml, 2048, 1024, 16}; S.mode = 1; E.kind = 2; E.O = H; }
            else if (sub == 7) { g = pg8::Gemm{H, (const bf16_t*)(ws + wsh + OFF_WOUT), Ml, 2048, 2048, 32}; E.kind = 3; E.gate = modl + 2 * 2048;
                if (l == 0) { E.xin_lat = p->in[I_X]; E.xin_ctx = p->in[I_CTX]; } }
            else if (sub == 9) { g = pg8::Gemm{H, (const bf16_t*)(ws + wsh + OFF_WFF1), Ml, DFF, 2048, 32}; E.kind = 1; E.ldc = DFF; }
            else { g = pg8::Gemm{Pb, (const bf16_t*)(ws + wsh + OFF_WFF2), Ml, 2048, DFF, 128}; E.kind = 3; E.gate = modl + 5 * 2048; }
            if (ksplit) {
                if (part == 0) g.M = NLAT;
                else { const int ks = (int)blockIdx.x & 15; g.nt >>= 4; g.A += (size_t)ks * g.nt * 64; g.Bt += (size_t)ks * g.nt * 64; S.mode = 2; E.split = 1;
                    E.part = (float*)(ws + OFF_P + (sub == 10 ? PART_OFF : 0)) + (size_t)ks * 512 * 2048; }
            }
            S.so.init(g.M, g.N, (int)gridDim.x, (int)blockIdx.x);
            pg8::gemm_phase(ldsg, g, S, E);
            }
            if (two_wt && l == 0 && gridDim.x == 256) {
                if (sub == 1 && blockIdx.x >= 94) phase_convert(p, 1, ldsf, (int)blockIdx.x - 94, 162, WT_SHIFT, 0, 4000, false);
                if (sub == 6 && blockIdx.x >= 16) phase_convert(p, 1, ldsf, (int)blockIdx.x - 16, 240, WT_SHIFT, 4000, 11500, false);
                if (sub == 9 && blockIdx.x >= 64) phase_convert(p, 1, ldsf, (int)blockIdx.x - 64, 192, WT_SHIFT, 11500, 18816, true);
            } else if (two_wt && l == 0 && sub == 10) phase_convert(p, 1, ldsf, (int)blockIdx.x, (int)gridDim.x, WT_SHIFT, 0, 18816, true);
        } else
        switch (sub) {
        case 0: {
            phase_init(p, l);
            if (l == 1 && !two_wt) phase_convert(p, l, ldsf, (int)blockIdx.x, (int)gridDim.x, wsh, 0, 18816, true);
            if (l == 0) phase_norm(p->in[I_X], p->in[I_CTX], NTOK, p->in[I_N1G] + l * 2048, modl, 0, 1, H);
            else if (gridDim.x == 256) phase_norm(XL, XL + (size_t)NLAT * 2048, NTOK, p->in[I_N1G] + l * 2048, modl, 0, 1, H, (const float*)(ws + OFF_P + PART_OFF), MOD + 2 * 12288 + 5 * 2048, XL + (size_t)NLAT * 2048);
            else phase_norm(XL, XL + (size_t)NLAT * 2048, NTOK, p->in[I_N1G] + l * 2048, modl, 0, 1, H);
        } break;
        case 2: phase_prep(p, l, (bf16_t*)shm); break;
#if DUPMASK
        case 4: phase_mix(p, l, ldsf, rep ? DUPWHICH : 7); break;
#else
        case 4: phase_mix(p, l, ldsf); break;
#endif
        case 5: phase_post(p, l, Ml); break;
        case 8: if (l == 0 && gridDim.x == 256) phase_norm(XL, p->in[I_CTX], Ml, p->in[I_N2G] + l * 2048, modl, 3, 4, H, (const float*)(ws + OFF_P), modl + 2 * 12288 + 2 * 2048, XL + (size_t)NLAT * 2048);
                else phase_norm(XL, XL + (size_t)NLAT * 2048, Ml, p->in[I_N2G] + l * 2048, modl, 3, 4, H); break;
        }
#if DUPMASK
        }
#endif
    }
}

extern "C" void kernel_launch(void* const* d_in, const int* in_sizes, int n_in, void* d_out, int out_size, void* d_ws, size_t ws_size, hipStream_t stream) {
    static int grid = 0;
    if (grid == 0) {
        if (n_in != 28 || ws_size < WS_END) { fprintf(stderr, "kernel_launch: need 28 inputs and %zu bytes of workspace (got %d, %zu)\n", (size_t)WS_END, n_in, ws_size); grid = -1; return; }
        if (hipFuncSetAttribute((const void*)fwd_kernel, hipFuncAttributeMaxDynamicSharedMemorySize, LDS_BYTES) != hipSuccess) { fprintf(stderr, "kernel_launch: hipFuncSetAttribute failed\n"); grid = -1; return; }
        int dev = 0, cus = 0, per_cu = 0;
        hipGetDevice(&dev);
        hipDeviceGetAttribute(&cus, hipDeviceAttributeMultiprocessorCount, dev);
        hipOccupancyMaxActiveBlocksPerMultiprocessor(&per_cu, (const void*)fwd_kernel, 512, LDS_BYTES);
        if (per_cu < 1) { fprintf(stderr, "kernel_launch: occupancy query says %d blocks per CU\n", per_cu); per_cu = 1; }
        (void)hipGetLastError();
        grid = cus * 1;
        if (grid > 256) grid = 256;
    }
    if (grid < 0) return;
    Params p{};
    for (int i = 0; i < 28; ++i) p.in[i] = (const float*)d_in[i];
    p.out = (float*)d_out; p.ws = (unsigned char*)d_ws; p.two_wt = (ws_size >= WS_END + WT_BYTES) ? 1 : 0;
#if ONE_LAUNCH
    p.ph_lo = 0; p.ph_hi = NPHASE;
    void* args[] = {&p};
    hipError_t e = hipLaunchCooperativeKernel((const void*)fwd_kernel, dim3(grid), dim3(512), args, LDS_BYTES, stream);
    if (e != hipSuccess) fprintf(stderr, "cooperative launch failed: %s (grid %d)\n", hipGetErrorString(e), grid);
#else
    for (int ph = 0; ph < NPHASE; ++ph) {
        p.ph_lo = ph; p.ph_hi = ph + 1;
        hipLaunchKernelGGL(fwd_kernel, dim3(grid), dim3(512), LDS_BYTES, stream, p);
    }
#endif
}
```

```cpp
#include <hip/hip_runtime.h>
#include <hip/hip_cooperative_groups.h>
#include <cstdio>
namespace cg = cooperative_groups;

#ifndef ONE_LAUNCH
#define ONE_LAUNCH 1
#endif

#define DEVI __device__ __forceinline__
#define LAS __attribute__((address_space(3)))
typedef unsigned short bf16_t;
typedef short bf16x8 __attribute__((ext_vector_type(8)));
typedef short bf16x4 __attribute__((ext_vector_type(4)));
typedef float f32x4 __attribute__((ext_vector_type(4)));
typedef float f32x2 __attribute__((ext_vector_type(2)));
typedef unsigned u32x4 __attribute__((ext_vector_type(4)));
typedef unsigned u32x2 __attribute__((ext_vector_type(2)));

constexpr int D = 2048, NTOK = 8704, NLAT = 8192, NP = 16128, DIN = 16016, DFF = 8192;
constexpr int RWB = 3088, NAB = 6800, GTB = 9872;
constexpr int LDS_BYTES = 131072;
constexpr int NPHASE = 24;

constexpr size_t OFF_CTL = 0;
constexpr size_t OFF_MOD = 4096;
constexpr size_t OFF_ROPE = OFF_MOD + 2ull * 3 * 12288 * 4;
constexpr size_t OFF_WIN = OFF_ROPE + 16384;
constexpr size_t OFF_WBR = OFF_WIN + 16128ull * 2048 * 2;
constexpr size_t OFF_WOUT = OFF_WBR + 3ull * 2048 * 1024 * 2;
constexpr size_t OFF_WFF1 = OFF_WOUT + 2048ull * 2048 * 2;
constexpr size_t OFF_WFF2 = OFF_WFF1 + 8192ull * 2048 * 2;
constexpr size_t OFF_WLORA = OFF_WFF2 + 8192ull * 2048 * 2;
constexpr size_t OFF_XL = OFF_WLORA + 5120ull * 640 * 2;
constexpr size_t OFF_H = OFF_XL + 8704ull * 2048 * 4;
constexpr size_t OFF_P = OFF_H + 8704ull * 2048 * 2;
constexpr size_t OFF_LA = OFF_P + 8704ull * 16128 * 2;
constexpr size_t OFF_LO = OFF_LA + 8704ull * 640 * 2;
constexpr size_t OFF_YRWF = OFF_LO + 8704ull * 5120 * 2;
constexpr size_t OFF_MLNUM = OFF_YRWF + 2ull * 8704 * 1024 * 4;
constexpr size_t OFF_VT = OFF_MLNUM + 2ull * 8704 * 4 * 272 * 4;
constexpr size_t OFF_Y3 = OFF_VT + 2ull * 8 * 128 * 4352 * 2;
constexpr size_t OFF_RK = OFF_Y3 + 3ull * 8704 * 1024 * 2;
constexpr size_t WS_END = OFF_RK + 8704ull * 16 * 4;
constexpr size_t WT_BYTES = OFF_XL - OFF_WIN, WT_SHIFT = WS_END - OFF_WIN;

struct Params {
    const float* in[28];
    float* out;
    unsigned char* ws;
    int ph_lo, ph_hi, two_wt, pad_;
};
typedef const __attribute__((address_space(4))) Params* PP;
enum { I_X = 0, I_C, I_CTX, I_CCTX, I_WMOD, I_BMOD, I_N1G, I_WIN, I_MLGB, I_MLNG, I_RWMU, I_RWW0, I_RWWUP, I_RWA0, I_RWAUP, I_RWGUP,
       I_RWKK, I_RWKA, I_RWRK, I_RWLNW, I_RWLNB, I_RPB, I_WBR, I_WOUT, I_N2G, I_WFF1, I_WFF2, I_FING };

DEVI int otid() { int t; asm volatile("v_mov_b32 %0, %1" : "=v"(t) : "v"((int)threadIdx.x)); return t; }
DEVI float bf2f(bf16_t b) { return __uint_as_float(((unsigned)b) << 16); }
DEVI float bflo(unsigned u) { return __uint_as_float(u << 16); }
DEVI float bfhi(unsigned u) { return __uint_as_float(u & 0xffff0000u); }
DEVI bf16_t f2bf(float f) { unsigned u = __float_as_uint(f); u += 0x7FFFu + ((u >> 16) & 1u); return (bf16_t)(u >> 16); }
DEVI unsigned pack2(float lo, float hi) { return (unsigned)f2bf(lo) | ((unsigned)f2bf(hi) << 16); }
DEVI float sigmoidf(float x) { return __builtin_amdgcn_rcpf(1.0f + __expf(-x)); }
#define DPP_ADD(x, CTRL) ((x) + __int_as_float(__builtin_amdgcn_update_dpp(0, __float_as_int(x), CTRL, 0xF, 0xF, true)))
DEVI float wsum(float x) {
    x = DPP_ADD(x, 0xB1); x = DPP_ADD(x, 0x4E); x = DPP_ADD(x, 0x141); x = DPP_ADD(x, 0x140);
    const int xi = __float_as_int(x);
    return (__int_as_float(__builtin_amdgcn_readlane(xi, 0)) + __int_as_float(__builtin_amdgcn_readlane(xi, 16))) + (__int_as_float(__builtin_amdgcn_readlane(xi, 32)) + __int_as_float(__builtin_amdgcn_readlane(xi, 48)));
}
DEVI float red8(float x) {
    x = DPP_ADD(x, 0xB1);
    x = DPP_ADD(x, 0x4E);
    x = DPP_ADD(x, 0x141);
    return x;
}

DEVI float red16(float x) {
    x = DPP_ADD(x, 0xB1); x = DPP_ADD(x, 0x4E); x = DPP_ADD(x, 0x141); x = DPP_ADD(x, 0x140);
    return x;
}
DEVI float sfma(float a, float b, float c) { float d; asm("v_fma_f32 %0, %1, %2, %3" : "=v"(d) : "v"(a), "v"(b), "v"(c)); return d; }
DEVI float smul(float a, float b) { float d; asm("v_mul_f32 %0, %1, %2" : "=v"(d) : "v"(a), "v"(b)); return d; }
DEVI void fadd_g(float* ptr, float v) { (void)__builtin_amdgcn_global_atomic_fadd_f32((__attribute__((address_space(1))) float*)ptr, v); }
DEVI float frcp(float x) { return __builtin_amdgcn_rcpf(x); }
DEVI float fsigmoid(float x) { return __builtin_amdgcn_rcpf(1.0f + __expf(-x)); }

namespace pg8 {
constexpr int BM = 256, BK = 64, HALF = 128, HTB = HALF * BK * 2, STAGE_BYTES = 8 * HTB, NXCD = 8, WGM = 8;
__host__ __device__ __forceinline__ int lds_byte(int r, int c) { const int st = (r >> 4) * 2 + (c >> 5), rr = r & 15, cc = c & 31, ob = rr * 64 + cc * 2; return st * 1024 + (ob ^ (((ob >> 9) & 1) << 5)); }
__host__ __device__ __forceinline__ void stage_rc(int b, int& R, int& C) { const int st = b / 1024, sb = b % 1024, swz = sb ^ (((sb >> 9) & 1) << 5); R = (st >> 1) * 16 + swz / 64; C = (st & 1) * 32 + (swz % 64) / 2; }
__host__ __device__ __forceinline__ int perm32(int rho) { const int n = rho >> 4, i = rho & 15; return 8 * (i >> 2) + 4 * n + (i & 3); }
struct Unit { int pm, pn; };
struct Gemm { const bf16_t* A; const bf16_t* Bt; int M, N, K, nt; };
struct StaticOrder {
    int nM, nN, nwg, G, c;
    __device__ void init(int M, int N, int G_, int c_) { nM = M / BM; nN = N / BM; nwg = nM * nN; G = G_; c = c_; }
    __device__ bool next(int i, Unit& u) const {
        const long L = (long)i * G + c; if (L >= nwg) return false;
        int wgid = (int)L; { const int q = nwg / NXCD, r = nwg % NXCD, xcd = wgid % NXCD, off = wgid / NXCD; wgid = (xcd < r ? xcd * (q + 1) : r * (q + 1) + (xcd - r) * q) + off; }
        const int nig = WGM * nN, gid = wgid / nig, fm = gid * WGM, gsz = (nM - fm) < WGM ? (nM - fm) : WGM;
        u.pm = fm + ((wgid % nig) % gsz); u.pn = (wgid % nig) / gsz; return true;
    }
    __device__ __forceinline__ void a_ready(const Unit&) const {}
    __device__ __forceinline__ void done(const Unit&) const {}
};
struct MergeOrder {
    int ntiles, G, c;
    __device__ void init(int nM, int G_, int c_) { ntiles = nM * 8; G = G_; c = c_; }
    __device__ bool next(int i, Unit& u) const {
        const int ti = i / 3, br = i - ti * 3; const long L = (long)ti * G + c; if (L >= ntiles) return false;
        const int pm = (int)L >> 3, pn = (int)L & 7; u.pm = br * 34 + pm; u.pn = br * 8 + pn; return true;
    }
    __device__ __forceinline__ void a_ready(const Unit&) const {}
    __device__ __forceinline__ void done(const Unit&) const {}
};
DEVI unsigned cvt_pk_bf16(float lo, float hi) { unsigned r; asm volatile("v_cvt_pk_bf16_f32 %0, %1, %2" : "=v"(r) : "v"(lo), "v"(hi)); return r; }


struct SchedG {
    int mode;
    StaticOrder so; MergeOrder mo;
    __device__ __forceinline__ bool next(int i, Unit& u) const {
        if (mode == 2) { if (i > 0) return false; const int cu = so.c >> 4; u.pm = 32 + (cu >> 3); u.pn = cu & 7; return true; }
        return mode == 0 ? so.next(i, u) : mo.next(i, u); }
    __device__ __forceinline__ void a_ready(const Unit&) const {}
    __device__ __forceinline__ void done(const Unit&) const {}
};
struct EpiG {
    static constexpr bool PERM = true, AFTER_DRAIN = false;
    int kind, split;
    bf16_t* O; int ldc;
    const bf16_t* P; float* ACC;
    const float* xin_lat; const float* xin_ctx; float* XL; const float* gate; float* part;
    __device__ __forceinline__ void operator()(const f32x4 (&acc)[2][2][4][2], const Unit& u, int wr, int wc, int fr, int fq) const {
        if (kind <= 1) {
            const int row0 = u.pm * BM + wr * 64 + fr, col0 = u.pn * BM + wc * 32 + 8 * fq;
#pragma unroll
            for (int ai = 0; ai < 2; ++ai)
#pragma unroll
                for (int m = 0; m < 4; ++m) { bf16_t* rowp = O + (size_t)(row0 + ai * HALF + m * 16) * ldc + col0;
#pragma unroll
                    for (int bj = 0; bj < 2; ++bj) { f32x4 v0 = acc[ai][bj][m][0], v1 = acc[ai][bj][m][1];
                        if (kind == 1) {
#pragma unroll
                            for (int i = 0; i < 4; ++i) { float a = fmaxf(v0[i], 0.f), b = fmaxf(v1[i], 0.f); v0[i] = a * a; v1[i] = b * b; } }
                        u32x4 o; o[0] = cvt_pk_bf16(v0[0], v0[1]); o[1] = cvt_pk_bf16(v0[2], v0[3]); o[2] = cvt_pk_bf16(v1[0], v1[1]); o[3] = cvt_pk_bf16(v1[2], v1[3]);
                        *(u32x4*)(rowp + bj * HALF) = o; } }
        } else if (kind == 2) {
            const int br = u.pn >> 3, pn = u.pn & 7, pm = u.pm - br * 34;
            const int row0 = pm * BM + wr * 64 + fr, col0 = pn * BM + wc * 32 + 8 * fq;
#pragma unroll
            for (int ai = 0; ai < 2; ++ai)
#pragma unroll
                for (int m = 0; m < 4; ++m) { const size_t row = (size_t)(row0 + ai * HALF + m * 16);
#pragma unroll
                    for (int bj = 0; bj < 2; ++bj) { const int col = col0 + bj * HALF;
                        const u32x4 gv = *(const u32x4*)(P + row * NP + GTB + br * 2048 + col);
                        f32x4 v0 = acc[ai][bj][m][0], v1 = acc[ai][bj][m][1];
                        v0[0] *= sigmoidf(bflo(gv[0])); v0[1] *= sigmoidf(bfhi(gv[0])); v0[2] *= sigmoidf(bflo(gv[1])); v0[3] *= sigmoidf(bfhi(gv[1]));
                        v1[0] *= sigmoidf(bflo(gv[2])); v1[1] *= sigmoidf(bfhi(gv[2])); v1[2] *= sigmoidf(bflo(gv[3])); v1[3] *= sigmoidf(bfhi(gv[3]));
                        float* ap = ACC + row * 2048 + col;
                        if (br == 0) { *(f32x4*)ap = v0; *(f32x4*)(ap + 4) = v1; }
                        else { v0 += *(const f32x4*)ap; v1 += *(const f32x4*)(ap + 4);
                            if (br == 1) { *(f32x4*)ap = v0; *(f32x4*)(ap + 4) = v1; }
                            else { u32x4 o; o[0] = cvt_pk_bf16(v0[0], v0[1]); o[1] = cvt_pk_bf16(v0[2], v0[3]); o[2] = cvt_pk_bf16(v1[0], v1[1]); o[3] = cvt_pk_bf16(v1[2], v1[3]);
                                *(u32x4*)(O + row * 2048 + col) = o; } } } }
        } else {
            const int row0 = u.pm * BM + wr * 64 + fr, col0 = u.pn * BM + wc * 32 + 8 * fq;
#pragma unroll
            for (int ai = 0; ai < 2; ++ai)
#pragma unroll
                for (int m = 0; m < 4; ++m) { const int row = row0 + ai * HALF + m * 16;
                    const int mrow = row < NLAT ? (row >> 12) : 2;
                    const float* xr = row < NLAT ? xin_lat + (size_t)row * 2048 : xin_ctx + (size_t)(row - NLAT) * 2048;
                    const float* gr = gate + (size_t)mrow * 12288; float* orow = XL + (size_t)row * 2048;
#pragma unroll
                    for (int bj = 0; bj < 2; ++bj)
#pragma unroll
                        for (int n = 0; n < 2; ++n) { const int col = col0 + bj * HALF + n * 4;
                            const f32x4 g = *(const f32x4*)(gr + col);
                            if (split) *(f32x4*)(part + (size_t)(row - NLAT) * 2048 + col) = acc[ai][bj][m][n];
                            else { const f32x4 x = *(const f32x4*)(xr + col); *(f32x4*)(orow + col) = x + g * acc[ai][bj][m][n]; } } }
        }
    }
};
template <class Epi, class Sched>
__device__ __forceinline__ void gemm_phase(LAS unsigned char* lds, const Gemm g, const Sched& S, const Epi& E) {
    const int tid = otid(), wid = __builtin_amdgcn_readfirstlane(tid >> 6), lane = tid & 63, wr = wid >> 2, wc = wid & 3, fr = lane & 15, fq = lane >> 4;
    const int K = g.K, nt = g.nt;
    unsigned voffA[2], voffB[2];
#pragma unroll
    for (int i = 0; i < 2; ++i) { int R, C; stage_rc(tid * 16 + i * 8192, R, C); const int Rb = Epi::PERM ? ((R & ~31) + perm32(R & 31)) : R;
        voffA[i] = (unsigned)(R * K + C) * 2u; voffB[i] = (unsigned)(Rb * K + C) * 2u; }
    const size_t kstep = (size_t)(BK * 2);
    const size_t hstep = (size_t)HALF * K * 2;
    const size_t tstep = 2 * hstep;
    const unsigned ldsw = (unsigned)wid * 1024u;
    const int aoff = lds_byte(wr * 64 + fr, fq * 8), boff = lds_byte(wc * 32 + fr, fq * 8);
#define PG8_SA(b, h) (((b) * 2 + (h)) * HTB)
#define PG8_SB(b, h) ((4 + (b) * 2 + (h)) * HTB)
#define PG8_STAGE(bufoff, gbase, voff) do { _Pragma("unroll") for (int _i = 0; _i < 2; ++_i) \
        __builtin_amdgcn_global_load_lds((const unsigned*)((const char*)(gbase) + (voff)[_i]), (LAS unsigned*)(lds + (bufoff) + ldsw + _i * 8192), 16, 0, 0); } while (0)
#define PG8_LDA(dst, b, h) do { _Pragma("unroll") for (int m = 0; m < 4; ++m) _Pragma("unroll") for (int k = 0; k < 2; ++k) dst[m][k] = *(const LAS bf16x8*)(lds + PG8_SA(b, h) + aoff + m * 2048 + k * 1024); } while (0)
#define PG8_LDB(dst, b, h) do { _Pragma("unroll") for (int n = 0; n < 2; ++n) _Pragma("unroll") for (int k = 0; k < 2; ++k) dst[n][k] = *(const LAS bf16x8*)(lds + PG8_SB(b, h) + boff + n * 2048 + k * 1024); } while (0)
#define PG8_MMA(ai, bj, At, Bt) do { __builtin_amdgcn_s_setprio(1); _Pragma("unroll") for (int m = 0; m < 4; ++m) _Pragma("unroll") for (int n = 0; n < 2; ++n) _Pragma("unroll") for (int k = 0; k < 2; ++k) \
        acc[ai][bj][m][n] = __builtin_amdgcn_mfma_f32_16x16x32_bf16(Bt[n][k], At[m][k], acc[ai][bj][m][n], 0, 0, 0); __builtin_amdgcn_s_setprio(0); } while (0)
#define PG8_WAIT_V(n) asm volatile("s_waitcnt vmcnt(" #n ")" ::: "memory")
#define PG8_WAIT_L(n) asm volatile("s_waitcnt lgkmcnt(" #n ")" ::: "memory")
#define PG8_BAR __builtin_amdgcn_s_barrier()
#define PG8_SCHED __builtin_amdgcn_sched_barrier(0)
    Unit cur, nxt; int ui = 0;
    if (!S.next(0, cur)) return;
    f32x4 acc[2][2][4][2];
#pragma unroll
    for (int a = 0; a < 2; ++a)
#pragma unroll
        for (int b = 0; b < 2; ++b)
#pragma unroll
            for (int m = 0; m < 4; ++m)
#pragma unroll
                for (int n = 0; n < 2; ++n) acc[a][b][m][n] = (f32x4){0.f, 0.f, 0.f, 0.f};
    bf16x8 At[4][2], B0[2][2], B1[2][2];
    const char* cA = (const char*)g.A + (size_t)cur.pm * tstep; const char* cB = (const char*)g.Bt + (size_t)cur.pn * tstep;
    S.a_ready(cur);
    PG8_STAGE(PG8_SB(0, 0), cB, voffB); PG8_STAGE(PG8_SA(0, 0), cA, voffA); PG8_STAGE(PG8_SB(0, 1), cB + hstep, voffB); PG8_STAGE(PG8_SA(0, 1), cA + hstep, voffA);
    if (wr == 1) PG8_BAR;
    PG8_WAIT_V(4); PG8_BAR;
    PG8_STAGE(PG8_SB(1, 0), cB + kstep, voffB); PG8_STAGE(PG8_SA(1, 0), cA + kstep, voffA); PG8_STAGE(PG8_SB(1, 1), cB + hstep + kstep, voffB);
    PG8_WAIT_V(6); PG8_BAR;
    for (;;) {
        const bool has_next = S.next(ui + 1, nxt);
        const char* nA = has_next ? (const char*)g.A + (size_t)nxt.pm * tstep : cA; const char* nB = has_next ? (const char*)g.Bt + (size_t)nxt.pn * tstep : cB;
        for (int t = 0; t < nt; t += 2) {
            const bool last = (t == nt - 2);
            const char* a1 = cA + (size_t)(t + 1) * kstep;
            const char* a2 = last ? nA : cA + (size_t)(t + 2) * kstep; const char* b2 = last ? nB : cB + (size_t)(t + 2) * kstep;
            const char* a3 = a2 + kstep; const char* b3 = b2 + kstep;
            if (last && has_next) S.a_ready(nxt);
            PG8_LDB(B0, 0, 0); PG8_SCHED; PG8_LDA(At, 0, 0); PG8_STAGE(PG8_SA(1, 1), a1 + hstep, voffA);
            PG8_WAIT_L(8); PG8_BAR; PG8_WAIT_L(0); PG8_MMA(0, 0, At, B0); PG8_BAR; PG8_SCHED;
            PG8_LDB(B1, 0, 1); PG8_STAGE(PG8_SB(0, 0), b2, voffB);
            PG8_BAR; PG8_WAIT_L(0); PG8_MMA(0, 1, At, B1); PG8_BAR;
            PG8_LDA(At, 0, 1); PG8_STAGE(PG8_SA(0, 0), a2, voffA);
            PG8_BAR; PG8_WAIT_L(0); PG8_MMA(1, 0, At, B0); PG8_BAR; PG8_SCHED;
            PG8_STAGE(PG8_SB(0, 1), b2 + hstep, voffB);
            PG8_WAIT_V(6); PG8_BAR; PG8_MMA(1, 1, At, B1); PG8_BAR;
            PG8_LDB(B0, 1, 0); PG8_SCHED; PG8_LDA(At, 1, 0); PG8_STAGE(PG8_SA(0, 1), a2 + hstep, voffA);
            PG8_WAIT_L(8); PG8_BAR; PG8_WAIT_L(0); PG8_MMA(0, 0, At, B0); PG8_BAR; PG8_SCHED;
            PG8_LDB(B1, 1, 1); PG8_STAGE(PG8_SB(1, 0), b3, voffB);
            PG8_BAR; PG8_WAIT_L(0); PG8_MMA(0, 1, At, B1); PG8_BAR;
            PG8_LDA(At, 1, 1); PG8_STAGE(PG8_SA(1, 0), a3, voffA);
            PG8_BAR; PG8_WAIT_L(0); PG8_MMA(1, 0, At, B0); PG8_BAR; PG8_SCHED;
            PG8_STAGE(PG8_SB(1, 1), b3 + hstep, voffB);
            PG8_WAIT_V(6); PG8_BAR; PG8_MMA(1, 1, At, B1); PG8_BAR;
        }
        if constexpr (!Epi::AFTER_DRAIN) { E(acc, cur, wr, wc, fr, fq); S.done(cur); }
        if (!has_next) break;
#pragma unroll
        for (int a = 0; a < 2; ++a)
#pragma unroll
            for (int b = 0; b < 2; ++b)
#pragma unroll
                for (int m = 0; m < 4; ++m)
#pragma unroll
                    for (int n = 0; n < 2; ++n) acc[a][b][m][n] = (f32x4){0.f, 0.f, 0.f, 0.f};
        cur = nxt; cA = nA; cB = nB; ++ui;
    }
    PG8_WAIT_V(0);
    if (wr == 0) PG8_BAR;
    PG8_BAR;
    if constexpr (Epi::AFTER_DRAIN) { E.fused(acc, cur, wr, wc, fr, fq, lds, wid, lane); S.done(cur); }
#undef PG8_SA
#undef PG8_SB
#undef PG8_STAGE
#undef PG8_LDA
#undef PG8_LDB
#undef PG8_MMA
#undef PG8_WAIT_V
#undef PG8_WAIT_L
#undef PG8_BAR
#undef PG8_SCHED
}
}

__device__ void phase_mod(PP p, float* lds) {
    const int TIDX = otid();
    const int tid = TIDX;
    float* s = lds;
    float* red = lds + 3 * 2048;
    float* MOD = (float*)(p->ws + OFF_MOD);
    for (int i = tid; i < 3 * 2048; i += 512) { const int r = i >> 11, k = i & 2047; const float c = r < 2 ? p->in[I_C][r * 2048 + k] : p->in[I_CCTX][k]; s[i] = c * sigmoidf(c); }
    __syncthreads();
    for (int task = blockIdx.x; task < 192; task += gridDim.x) {
        const int l = task / 96, j0 = (task % 96) * 128, jc = tid & 127, kp = tid >> 7;
        const float* w = p->in[I_WMOD] + (size_t)l * 2048 * 12288 + j0 + jc;
        float a0 = 0.f, a1 = 0.f, a2 = 0.f;
#pragma unroll 8
        for (int k = kp * 512; k < kp * 512 + 512; ++k) { const float wv = w[(size_t)k * 12288]; a0 += s[k] * wv; a1 += s[2048 + k] * wv; a2 += s[4096 + k] * wv; }
        red[(kp * 3 + 0) * 128 + jc] = a0; red[(kp * 3 + 1) * 128 + jc] = a1; red[(kp * 3 + 2) * 128 + jc] = a2;
        __syncthreads();
        if (tid < 384) { const int r = tid >> 7, j = tid & 127;
            const float v = ((red[(0 * 3 + r) * 128 + j] + red[(1 * 3 + r) * 128 + j]) + (red[(2 * 3 + r) * 128 + j] + red[(3 * 3 + r) * 128 + j])) + p->in[I_BMOD][l * 12288 + j0 + j];
            MOD[(size_t)(l * 3 + r) * 12288 + j0 + j] = v; }
        __syncthreads();
    }
    if (blockIdx.x == gridDim.x - 1) {
        float* rc = (float*)(p->ws + OFF_ROPE); float* rs = rc + 2048;
        for (int i = tid; i < 2048; i += 512) { const int pos = i >> 5, j = i & 31; const float fr = powf(10000.0f, -(float)j / 32.0f); const float ang = (float)pos * fr; rc[i] = cosf(ang); rs[i] = sinf(ang); }
    }
}

__device__ void conv_tile(const float* __restrict__ src, int ld_src, int n_valid, int n0, int k0, bf16_t* __restrict__ dst, int ld_dst, float* tile) {
    const int TIDX = otid();
    const int tid = TIDX;
#pragma unroll
    for (int i = 0; i < 2; ++i) { const int kr = (tid >> 4) + i * 32, nc = (tid & 15) * 4; const float* sp = src + (size_t)(k0 + kr) * ld_src + n0 + nc;
        f32x4 v;
        if (n0 + nc + 3 < n_valid) v = *(const f32x4*)sp;
        else { v[0] = (n0 + nc + 0 < n_valid) ? sp[0] : 0.f; v[1] = (n0 + nc + 1 < n_valid) ? sp[1] : 0.f; v[2] = (n0 + nc + 2 < n_valid) ? sp[2] : 0.f; v[3] = (n0 + nc + 3 < n_valid) ? sp[3] : 0.f; }
        float* tp = tile + kr * 65 + nc; tp[0] = v[0]; tp[1] = v[1]; tp[2] = v[2]; tp[3] = v[3]; }
    __syncthreads();
    { const int n = tid >> 3, kc = (tid & 7) * 8; u32x4 o;
#pragma unroll
        for (int j = 0; j < 4; ++j) o[j] = pack2(tile[(kc + 2 * j) * 65 + n], tile[(kc + 2 * j + 1) * 65 + n]);
        *(u32x4*)(dst + (size_t)(n0 + n) * ld_dst + k0 + kc) = o; }
    __syncthreads();
}
__device__ void phase_convert(PP p, int l, float* lds, int vb, int vg, size_t wsh, int t_lo, int t_hi, bool lora) {
    const int TIDX = otid();
    unsigned char* wsw = p->ws + wsh;
    for (int t = t_lo + vb; t < t_hi; t += vg) {
        if (t < 8064) { const int nt = t >> 5, kt = t & 31; conv_tile(p->in[I_WIN] + (size_t)l * 2048 * DIN, DIN, DIN, nt * 64, kt * 64, (bf16_t*)(wsw + OFF_WIN), 2048, lds); }
        else if (t < 9600) { const int tt = t - 8064, br = tt >> 9, r = tt & 511, nt = r >> 4, kt = r & 15;
            conv_tile(p->in[I_WBR] + (size_t)(l * 3 + br) * 1024 * 2048, 2048, 2048, nt * 64, kt * 64, (bf16_t*)(wsw + OFF_WBR) + (size_t)br * 2048 * 1024, 1024, lds); }
        else if (t < 10624) { const int tt = t - 9600, nt = tt >> 5, kt = tt & 31; conv_tile(p->in[I_WOUT] + (size_t)l * 2048 * 2048, 2048, 2048, nt * 64, kt * 64, (bf16_t*)(wsw + OFF_WOUT), 2048, lds); }
        else if (t < 14720) { const int tt = t - 10624, nt = tt >> 5, kt = tt & 31; conv_tile(p->in[I_WFF1] + (size_t)l * 2048 * 8192, 8192, 8192, nt * 64, kt * 64, (bf16_t*)(wsw + OFF_WFF1), 2048, lds); }
        else { const int tt = t - 14720, nt = tt >> 7, kt = tt & 127; conv_tile(p->in[I_WFF2] + (size_t)l * 8192 * 2048, 2048, 2048, nt * 64, kt * 64, (bf16_t*)(wsw + OFF_WFF2), 8192, lds); }
    }
    bf16_t* WL = (bf16_t*)(wsw + OFF_WLORA);
    if (lora) for (int idx = vb * 512 + TIDX; idx < 5120 * 640; idx += vg * 512) {
        const int n = idx / 640, k = idx - n * 640, blk = n >> 10, nn = n & 1023;
        const int k0 = blk < 4 ? blk * 96 : 384, kw = blk < 4 ? 96 : 256;
        float v = 0.f;
        if (k >= k0 && k < k0 + kw) {
            const float* sp = blk < 2 ? p->in[I_RWWUP] + (size_t)(l * 2 + blk) * 96 * 1024 : (blk < 4 ? p->in[I_RWAUP] + (size_t)(l * 2 + blk - 2) * 96 * 1024 : p->in[I_RWGUP] + (size_t)l * 256 * 1024);
            v = sp[(size_t)(k - k0) * 1024 + nn]; }
        WL[idx] = f2bf(v);
    }
}
__device__ void phase_init(PP p, int l) {
    const int TIDX = otid();
    if (blockIdx.x == 0 && TIDX < 8) ((unsigned*)(p->ws + OFF_CTL))[l * 8 + TIDX] = 0u;
}

__device__ __forceinline__ void phase_norm(const float* __restrict__ xlat, const float* __restrict__ xctx, int nrows, const float* __restrict__ g, const float* __restrict__ modl, int ishift, int iscale, bf16_t* __restrict__ H,
                           const float* part = nullptr, const float* pgate = nullptr, float* xl_ctx = nullptr) {
    const int TIDX = otid();
    const int wid = TIDX >> 6, lane = TIDX & 63;
    for (int row = blockIdx.x * 8 + wid; row < nrows; row += gridDim.x * 8) {
        const float* xr = row < NLAT ? xlat + (size_t)row * 2048 : xctx + (size_t)(row - NLAT) * 2048;
        const int mrow = row < NLAT ? (row >> 12) : 2;
        const float* sh = modl + (size_t)mrow * 12288 + ishift * 2048; const float* sc = modl + (size_t)mrow * 12288 + iscale * 2048;
        f32x4 v[8]; float ss = 0.f;
#pragma unroll
        for (int i = 0; i < 8; ++i) v[i] = *(const f32x4*)(xr + (i * 64 + lane) * 4);
        if (part != nullptr && row >= NLAT) {
#pragma unroll
            for (int i = 0; i < 8; ++i) { const int col = (i * 64 + lane) * 4; const float* pp = part + (size_t)(row - NLAT) * 2048 + col;
                f32x4 a = *(const f32x4*)pp;
#pragma unroll
                for (int s_ = 1; s_ < 16; ++s_) a += *(const f32x4*)(pp + (size_t)s_ * 512 * 2048);
                v[i] += *(const f32x4*)(pgate + col) * a;
                *(f32x4*)(xl_ctx + (size_t)(row - NLAT) * 2048 + col) = v[i]; } }
#pragma unroll
        for (int i = 0; i < 8; ++i) ss += v[i][0] * v[i][0] + v[i][1] * v[i][1] + v[i][2] * v[i][2] + v[i][3] * v[i][3];
        ss = wsum(ss);
        const float r = rsqrtf(ss * (1.0f / 2048.0f) + 1e-6f);
#pragma unroll
        for (int i = 0; i < 8; ++i) { const int col = (i * 64 + lane) * 4; const f32x4 gg = *(const f32x4*)(g + col), s1 = *(const f32x4*)(sc + col), s0 = *(const f32x4*)(sh + col);
            float o[4];
#pragma unroll
            for (int j = 0; j < 4; ++j) o[j] = (v[i][j] * r * gg[j]) * (1.0f + s1[j]) + s0[j];
            u32x2 w; w[0] = pack2(o[0], o[1]); w[1] = pack2(o[2], o[3]);
            *(u32x2*)(H + (size_t)row * 2048 + col) = w; }
    }
}
__device__ void phase_final(PP p) {
    const int TIDX = otid();
    const int wid = TIDX >> 6, lane = TIDX & 63;
    const float* XL = (const float*)(p->ws + OFF_XL); const float* g = p->in[I_FING];
    for (int row = blockIdx.x * 8 + wid; row < NLAT; row += gridDim.x * 8) {
        const float* xr = XL + (size_t)row * 2048;
        f32x4 v[8]; float ss = 0.f;
#pragma unroll
        for (int i = 0; i < 8; ++i) { v[i] = *(const f32x4*)(xr + (i * 64 + lane) * 4); ss += v[i][0] * v[i][0] + v[i][1] * v[i][1] + v[i][2] * v[i][2] + v[i][3] * v[i][3]; }
        ss = wsum(ss);
        const float r = rsqrtf(ss * (1.0f / 2048.0f) + 1e-6f);
#pragma unroll
        for (int i = 0; i < 8; ++i) { const int col = (i * 64 + lane) * 4; const f32x4 gg = *(const f32x4*)(g + col);
            f32x4 o; o[0] = v[i][0] * r * gg[0]; o[1] = v[i][1] * r * gg[1]; o[2] = v[i][2] * r * gg[2]; o[3] = v[i][3] * r * gg[3];
            *(f32x4*)(p->out + (size_t)row * 2048 + col) = o; }
    }
}

DEVI void seq_nbrs(int row, bool& hp, bool& hn) {
    if (row < NLAT) { const int t = row & 4095; hp = t > 0; hn = t < 4095; } else { const int m = (row - NLAT) & 255; hp = m > 0; hn = m < 255; }
}
DEVI float shiftf(float c, float pv, float nx, float mu) { return c + mu * (0.5f * (pv + nx) - c); }

__device__ void phase_prep(PP p, int l, bf16_t* ldsT) {
    const int TIDX = otid();
    const bf16_t* P = (const bf16_t*)(p->ws + OFF_P); bf16_t* LA = (bf16_t*)(p->ws + OFF_LA);
    const float* mu = p->in[I_RWMU] + (size_t)l * 3712 + 3072;
    for (int idx = blockIdx.x * 512 + TIDX; idx < NTOK * 80; idx += gridDim.x * 512) {
        const int row = idx / 80, j = (idx - row * 80) * 8;
        bool hp, hn; seq_nbrs(row, hp, hn);
        const bf16_t* pc = P + (size_t)row * NP + RWB + 3072 + j;
        const u32x4 c = *(const u32x4*)pc;
        const u32x4 z = {0u, 0u, 0u, 0u};
        const u32x4 pv = hp ? *(const u32x4*)(pc - NP) : z, nx = hn ? *(const u32x4*)(pc + NP) : z;
        float o[8];
#pragma unroll
        for (int q = 0; q < 4; ++q) { o[2 * q] = shiftf(bflo(c[q]), bflo(pv[q]), bflo(nx[q]), mu[j + 2 * q]); o[2 * q + 1] = shiftf(bfhi(c[q]), bfhi(pv[q]), bfhi(nx[q]), mu[j + 2 * q + 1]); }
        if (j < 192) {
#pragma unroll
            for (int q = 0; q < 8; ++q) o[q] = (1.0f - 2.0f * __builtin_amdgcn_rcpf(1.0f + __expf(2.0f * o[q]))); }
        else if (j >= 384) {
#pragma unroll
            for (int q = 0; q < 8; ++q) o[q] = sigmoidf(o[q]); }
        u32x4 w; w[0] = pack2(o[0], o[1]); w[1] = pack2(o[2], o[3]); w[2] = pack2(o[4], o[5]); w[3] = pack2(o[6], o[7]);
        *(u32x4*)(LA + (size_t)row * 640 + j) = w;
    }
    bf16_t* VT = (bf16_t*)(p->ws + OFF_VT);
    const int tid = TIDX;
    for (int t = blockIdx.x; t < 136 * 16; t += gridDim.x) {
        const int rt = t >> 4, hd = t & 15, h = hd >> 1, dh = hd & 1;
        const int row0 = rt * 64;
        { const int tl = tid >> 3, dc = (tid & 7) * 8;
            const u32x4 v = *(const u32x4*)(P + (size_t)(row0 + tl) * NP + NAB + 2048 + h * 128 + dh * 64 + dc);
            bf16_t* tp = ldsT + tl * 66 + dc;
#pragma unroll
            for (int q = 0; q < 4; ++q) { tp[2 * q] = (bf16_t)(v[q] & 0xffffu); tp[2 * q + 1] = (bf16_t)(v[q] >> 16); } }
        __syncthreads();
        { const int d = tid >> 3, tc = (tid & 7) * 8;
            int b, pos; if (row0 < NLAT) { b = row0 >> 12; pos = row0 & 4095; } else { b = (row0 - NLAT) >> 8; pos = 4096 + ((row0 - NLAT) & 255); }
            u32x4 o;
#pragma unroll
            for (int q = 0; q < 4; ++q) o[q] = (unsigned)ldsT[(tc + 2 * q) * 66 + d] | ((unsigned)ldsT[(tc + 2 * q + 1) * 66 + d] << 16);
            *(u32x4*)(VT + ((size_t)((b * 8 + h) * 128 + dh * 64 + d)) * 4352 + pos + tc) = o; }
        __syncthreads();
    }
}

DEVI int scan_row(int s, int b, int dir) {
    if (s < 256) { const int m = dir ? 255 - s : s; return NLAT + b * 256 + m; }
    const int t = dir ? 4095 - (s - 256) : s - 256; return b * 4096 + t;
}
__device__ void rwkv_scan(PP p, int l, int task, float* lds) {
    const int TIDX = otid();
    const int chain = task >> 1, half = task & 1;
    const int b = chain >> 5, h = (chain >> 1) & 15, dir = chain & 1, tid = TIDX;
    const bf16_t* P = (const bf16_t*)(p->ws + OFF_P); const bf16_t* LO = (const bf16_t*)(p->ws + OFF_LO);
    float* YO = (float*)(p->ws + OFF_YRWF) + (size_t)dir * NTOK * 1024 + h * 64;
    const int sl = tid >> 5, e2 = (tid & 31) * 2, ch = h * 64 + e2;
    const float* MU = p->in[I_RWMU] + (size_t)l * 3712;
    const float mur0 = MU[ch], mur1 = MU[ch + 1], muk0 = MU[1024 + ch], muk1 = MU[1024 + ch + 1], muv0 = MU[2048 + ch], muv1 = MU[2048 + ch + 1];
    const float w00 = p->in[I_RWW0][(l * 2 + dir) * 1024 + ch], w01 = p->in[I_RWW0][(l * 2 + dir) * 1024 + ch + 1];
    const float a00 = p->in[I_RWA0][(l * 2 + dir) * 1024 + ch], a01 = p->in[I_RWA0][(l * 2 + dir) * 1024 + ch + 1];
    const float kk0 = p->in[I_RWKK][l * 1024 + ch], kk1 = p->in[I_RWKK][l * 1024 + ch + 1], ka0 = p->in[I_RWKA][l * 1024 + ch], ka1 = p->in[I_RWKA][l * 1024 + ch + 1];
    const float rk0 = p->in[I_RWRK][l * 1024 + ch], rk1 = p->in[I_RWRK][l * 1024 + ch + 1];
    float* RK = (float*)(p->ws + OFF_RK); const bool wrk = dir == 0 && half == 0; int srow = 0;
    const int kq = tid & 15, v = half * 32 + (tid >> 4);
    f32x2 S0 = (f32x2){0.f, 0.f}, S1 = (f32x2){0.f, 0.f};
    unsigned rc, rp, rn, kc, kp, kn, vc, vp, vn, wr_, ar_;
    auto issue = [&](int g) {
        const int row = scan_row(g * 16 + sl, b, dir); bool hp, hn; seq_nbrs(row, hp, hn); srow = row;
        const bf16_t* pr = P + (size_t)row * NP + RWB + ch;
        rc = *(const unsigned*)pr; kc = *(const unsigned*)(pr + 1024); vc = *(const unsigned*)(pr + 2048);
        rp = 0u; kp = 0u; vp = 0u; rn = 0u; kn = 0u; vn = 0u;
        if (hp) { rp = *(const unsigned*)(pr - NP); kp = *(const unsigned*)(pr - NP + 1024); vp = *(const unsigned*)(pr - NP + 2048); }
        if (hn) { rn = *(const unsigned*)(pr + NP); kn = *(const unsigned*)(pr + NP + 1024); vn = *(const unsigned*)(pr + NP + 2048); }
        const bf16_t* lo = LO + (size_t)row * 5120 + dir * 1024 + ch;
        wr_ = *(const unsigned*)lo; ar_ = *(const unsigned*)(lo + 2048);
    };
    auto commit = [&](int buf) {
        float* st = lds + buf * 6144 + sl * 384 + e2;
        const float r0 = shiftf(bflo(rc), bflo(rp), bflo(rn), mur0), r1 = shiftf(bfhi(rc), bfhi(rp), bfhi(rn), mur1);
        const float k0 = shiftf(bflo(kc), bflo(kp), bflo(kn), muk0), k1 = shiftf(bfhi(kc), bfhi(kp), bfhi(kn), muk1);
        const float v0 = shiftf(bflo(vc), bflo(vp), bflo(vn), muv0), v1 = shiftf(bfhi(vc), bfhi(vp), bfhi(vn), muv1);
        const float x0 = -(w00 + bflo(wr_)), x1 = -(w01 + bfhi(wr_));
        const float sp0 = x0 > 20.f ? x0 : __logf(1.0f + __expf(x0)), sp1 = x1 > 20.f ? x1 : __logf(1.0f + __expf(x1));
        const float d0 = __expf(-__expf(-sp0 - 0.5f)), d1 = __expf(-__expf(-sp1 - 0.5f));
        const float ar0 = fsigmoid(a00 + bflo(ar_)), ar1 = fsigmoid(a01 + bfhi(ar_));
        const float kd0 = k0 * (1.0f + (ar0 - 1.0f) * ka0), kd1 = k1 * (1.0f + (ar1 - 1.0f) * ka1);
        const float q0 = k0 * kk0, q1 = k1 * kk1;
        float ss = red16(q0 * q0 + q1 * q1);
        ss += __shfl_xor(ss, 16);
        const float inv = frcp(fmaxf(__builtin_amdgcn_sqrtf(ss), 1e-12f));
        const float n0 = q0 * inv, n1 = q1 * inv;
        if (wrk) { float t = red16(r0 * k0 * rk0 + r1 * k1 * rk1); t += __shfl_xor(t, 16); if ((tid & 31) == 0) RK[srow * 16 + h] = t; }
        *(f32x2*)(st + 0) = (f32x2){r0, r1}; *(f32x2*)(st + 64) = (f32x2){d0, d1}; *(f32x2*)(st + 128) = (f32x2){kd0, kd1};
        *(f32x2*)(st + 192) = (f32x2){v0, v1}; *(f32x2*)(st + 256) = (f32x2){-n0, -n1}; *(f32x2*)(st + 320) = (f32x2){n0 * ar0, n1 * ar1};
    };
    __syncthreads();
    issue(0); commit(0);
    __syncthreads();
    constexpr int NG = 4352 / 16;
    for (int g = 0; g < NG; ++g) {
        if (g + 1 < NG) issue(g + 1);
        {
            const float* base = lds + (g & 1) * 6144 + kq * 4;
            float ykeep = 0.f;
            f32x4 nA, nD, nB, nK, nR; float nV;
#define RW_LOAD(i_) do { const float* st_ = base + (i_) * 384; nA = *(const f32x4*)(st_ + 256); nD = *(const f32x4*)(st_ + 64); nB = *(const f32x4*)(st_ + 320); nK = *(const f32x4*)(st_ + 128); nR = *(const f32x4*)(st_); \
                nV = st_[192 - kq * 4 + v]; } while (0)
            RW_LOAD(0);
#pragma unroll
            for (int i = 0; i < 16; ++i) {
                const f32x4 a = nA, d = nD, bb = nB, k = nK, r = nR; const float vv = nV;
                if (i < 15) { RW_LOAD(i + 1); }
                __builtin_amdgcn_sched_barrier(0x77);
                f32x2 pa2 = S0 * (f32x2){a[0], a[1]}; pa2 = S1 * (f32x2){a[2], a[3]} + pa2;
                const f32x2 vvb = (f32x2){vv, vv};
                const f32x2 u0 = S0 * (f32x2){d[0], d[1]} + vvb * (f32x2){k[0], k[1]}, u1 = S1 * (f32x2){d[2], d[3]} + vvb * (f32x2){k[2], k[3]};
                const float pa = red16(pa2[0] + pa2[1]);
                const f32x2 pab = (f32x2){pa, pa};
                S0 = pab * (f32x2){bb[0], bb[1]} + u0; S1 = pab * (f32x2){bb[2], bb[3]} + u1;
                f32x2 y2 = S0 * (f32x2){r[0], r[1]}; y2 = S1 * (f32x2){r[2], r[3]} + y2;
                const float y = red16(y2[0] + y2[1]);
                ykeep = (kq == i) ? y : ykeep;
            }
#undef RW_LOAD
            YO[(size_t)scan_row(g * 16 + kq, b, dir) * 1024 + v] = ykeep;
        }
        if (g + 1 < NG) commit((g + 1) & 1);
        __syncthreads();
    }
}

__device__ void mlstm_scan(PP p, int l, int chain, int g8, float* lds) {
    const int TIDX = otid();
    const int b = chain >> 3, h = (chain >> 1) & 3, dir = chain & 1, tid = TIDX;
    const bf16_t* P = (const bf16_t*)(p->ws + OFF_P);
    const float* RC = (const float*)(p->ws + OFF_ROPE); const float* RS = RC + 2048;
    float* NO = (float*)(p->ws + OFF_MLNUM) + (size_t)dir * NTOK * 4 * 272 + h * 272;
    const int sl = tid >> 5, j = tid & 31;
    const float gbi = p->in[I_MLGB][l * 16 + (dir * 2 + 0) * 4 + h], gbf = p->in[I_MLGB][l * 16 + (dir * 2 + 1) * 4 + h];
    const int rowl = (tid >> 3) & 31, kq = tid & 7, crow = g8 * 32 + rowl, lane = tid & 63;
    f32x2 C[8];
#pragma unroll
    for (int i = 0; i < 8; ++i) C[i] = (f32x2){0.f, 0.f};
    f32x2 nst = (f32x2){0.f, 0.f};
    bf16_t q0, q1, q2, q3, k0, k1, k2, k3, gi, gf; unsigned vv2; float cr, sr, cc, sc;
    auto issue = [&](int g) {
        const int row = scan_row(g * 16 + sl, b, dir);
        const bf16_t* pr = P + (size_t)row * NP;
        const bf16_t* pq = pr + h * 128 + j; const bf16_t* pk = pr + 512 + h * 128 + j;
        q0 = pq[0]; q1 = pq[32]; q2 = pq[64]; q3 = pq[96]; k0 = pk[0]; k1 = pk[32]; k2 = pk[64]; k3 = pk[96];
        vv2 = j < 16 ? *(const unsigned*)(pr + 1024 + h * 256 + g8 * 32 + 2 * j) : 0u;
        gi = pr[3072 + (dir * 2 + 0) * 4 + h]; gf = pr[3072 + (dir * 2 + 1) * 4 + h];
        if (row < NLAT) { const int t = row & 4095, pr_ = t >> 6, pc_ = t & 63; cr = RC[pr_ * 32 + j]; sr = RS[pr_ * 32 + j]; cc = RC[pc_ * 32 + j]; sc = RS[pc_ * 32 + j]; }
        else { cr = 1.f; sr = 0.f; cc = 1.f; sc = 0.f; }
    };
    auto commit = [&](int buf) {
        float* st = lds + buf * 5376 + sl * 336;
        const float scale = 0.08838834764831845f;
        const float a0 = bf2f(q0), a1 = bf2f(q1), a2 = bf2f(q2), a3 = bf2f(q3);
        st[j] = (a0 * cr - a1 * sr) * scale; st[32 + j] = (a0 * sr + a1 * cr) * scale; st[64 + j] = (a2 * cc - a3 * sc) * scale; st[96 + j] = (a2 * sc + a3 * cc) * scale;
        const float c0 = bf2f(k0), c1 = bf2f(k1), c2 = bf2f(k2), c3 = bf2f(k3);
        st[128 + j] = c0 * cr - c1 * sr; st[160 + j] = c0 * sr + c1 * cr; st[192 + j] = c2 * cc - c3 * sc; st[224 + j] = c2 * sc + c3 * cc;
        if (j < 16) { st[256 + 2 * j] = bflo(vv2); st[257 + 2 * j] = bfhi(vv2); }
        if (j == 0) { st[320] = fsigmoid(bf2f(gf) + gbf); st[321] = __expf(bf2f(gi) + gbi); }
    };
    __syncthreads();
    issue(0); commit(0);
    __syncthreads();
    constexpr int NG = 4352 / 16;
    for (int g = 0; g < NG; ++g) {
        if (g + 1 < NG) issue(g + 1);
        const float* base = lds + (g & 1) * 5376;
        if (tid < 256) {
            float nkeep = 0.f, Fc = 1.0f;
            f32x4 nK[4], nQ[4]; float nF, nI, nV0;
#define ML_LOAD(i_) do { const float* st_ = base + (i_) * 336; _Pragma("unroll") for (int c4 = 0; c4 < 4; ++c4) { nK[c4] = *(const f32x4*)(st_ + 128 + c4 * 32 + kq * 4); nQ[c4] = *(const f32x4*)(st_ + c4 * 32 + kq * 4); } \
                nF = st_[320]; nI = st_[321]; nV0 = st_[256 + rowl]; } while (0)
            ML_LOAD(0);
#pragma unroll
            for (int i = 0; i < 16; ++i) {
                f32x4 kk[4], qq[4];
#pragma unroll
                for (int c4 = 0; c4 < 4; ++c4) { kk[c4] = nK[c4]; qq[c4] = nQ[c4]; }
                Fc *= nF;
                const float coef = nI * nV0 * frcp(Fc);
                if (i < 15) { ML_LOAD(i + 1); }
                __builtin_amdgcn_sched_barrier(0x77);
                const f32x2 cf = (f32x2){coef, coef};
                f32x2 num2 = (f32x2){0.f, 0.f}, num3 = (f32x2){0.f, 0.f};
#pragma unroll
                for (int c4 = 0; c4 < 4; ++c4) {
                    const f32x2 KA = (f32x2){kk[c4][0], kk[c4][1]}, KB = (f32x2){kk[c4][2], kk[c4][3]}, QA = (f32x2){qq[c4][0], qq[c4][1]}, QB = (f32x2){qq[c4][2], qq[c4][3]};
                    C[2 * c4] = cf * KA + C[2 * c4]; C[2 * c4 + 1] = cf * KB + C[2 * c4 + 1];
                    num2 = C[2 * c4] * QA + num2; num3 = C[2 * c4 + 1] * QB + num3; }
                num2 += num3;
                const float num = red8(num2[0] + num2[1]) * Fc;
                nkeep = (kq == (i & 7)) ? num : nkeep;
                if ((i & 7) == 7) NO[(size_t)scan_row(g * 16 + (i - 7) + kq, b, dir) * (4 * 272) + crow] = nkeep;
            }
            { const f32x2 fb = (f32x2){Fc, Fc};
#pragma unroll
                for (int x = 0; x < 8; ++x) C[x] = C[x] * fb; }
#undef ML_LOAD
        } else if (g8 == 0 && tid < 320) {
            float nkeep = 0.f;
            f32x2 nk, nq; float nf, ni;
#define MN_LOAD(i_) do { const float* st_ = base + (i_) * 336; nk = *(const f32x2*)(st_ + 128 + 2 * lane); nq = *(const f32x2*)(st_ + 2 * lane); nf = st_[320]; ni = st_[321]; } while (0)
            MN_LOAD(0);
#pragma unroll
            for (int i = 0; i < 16; ++i) {
                const f32x2 kk = nk, qq = nq; const float f = nf, ig = ni;
                if (i < 15) { MN_LOAD(i + 1); }
                __builtin_amdgcn_sched_barrier(0x77);
                nst = (f32x2){f, f} * nst + (f32x2){ig, ig} * kk;
                const f32x2 d2 = nst * qq;
                const float den16 = red16(d2[0] + d2[1]);
                nkeep = ((lane & 15) == i) ? den16 : nkeep;
            }
#undef MN_LOAD
            nkeep += __shfl_xor(nkeep, 16); nkeep += __shfl_xor(nkeep, 32);
            if (lane < 16) NO[(size_t)scan_row(g * 16 + lane, b, dir) * (4 * 272) + 256] = nkeep;
        }
        if (g + 1 < NG) commit((g + 1) & 1);
        __syncthreads();
    }
}

#define MFMA16(a, b, c) __builtin_amdgcn_mfma_f32_16x16x32_bf16(a, b, c, 0, 0, 0)
__device__ void na_wave(PP p, int l, int task) {
    const int TIDX = otid();
    const bf16_t* P = (const bf16_t*)(p->ws + OFF_P); const bf16_t* VT = (const bf16_t*)(p->ws + OFF_VT);
    bf16_t* YN = (bf16_t*)(p->ws + OFF_Y3) + 2ull * NTOK * 1024;
    const int w = TIDX >> 6, lane = TIDX & 63, n16 = lane & 15, g = lane >> 4;
    int b, h, qrow, r = 0, qcol = 0, cs = 0, row_start = 0, c_start = 0; bool lat;
    if (task < 512) { lat = true; b = task >> 8; h = (task >> 5) & 7; const int pair = task & 31; r = pair * 2 + (w >> 2); const int qi = w & 3; qcol = qi * 16 + n16;
        qrow = b * 4096 + r * 64 + qcol; cs = qi == 0 ? 0 : (qi == 1 ? 8 : (qi == 2 ? 24 : 32)); row_start = min(max(r - 4, 0), 56); c_start = min(max(qcol - 8, 0), 48); }
    else { lat = false; const int t2 = task - 512; b = t2 >> 4; h = (t2 >> 1) & 7; const int chunk = t2 & 1; qrow = NLAT + b * 256 + chunk * 128 + w * 16 + n16; }
    bf16x8 qf[4];
#pragma unroll
    for (int c = 0; c < 4; ++c) qf[c] = *(const bf16x8*)(P + (size_t)qrow * NP + NAB + h * 128 + c * 32 + g * 8);
    const float* rpb = p->in[I_RPB] + (size_t)(l * 8 + h) * 15 * 31;
    const bf16_t* vtb = VT + (size_t)((b * 8 + h) * 128) * 4352;
    f32x4 O[8];
#pragma unroll
    for (int i = 0; i < 8; ++i) O[i] = (f32x4){0.f, 0.f, 0.f, 0.f};
    float mrun = -INFINITY, lsum = 0.f;
    const float scale = 0.08838834764831845f;
    for (int pass = lat ? 0 : 2; pass < 4; ++pass) {
        f32x4 S[8];
#pragma unroll
        for (int i = 0; i < 8; ++i) {
            int krowtok;
            if (pass < 2) { const int krow = row_start + pass * 4 + (i >> 1); krowtok = b * 4096 + krow * 64 + cs + (i & 1) * 16 + n16; }
            else krowtok = NLAT + b * 256 + (pass - 2) * 128 + i * 16 + n16;
            const bf16_t* kp = P + (size_t)krowtok * NP + NAB + 1024 + h * 128 + g * 8;
            f32x4 acc = (f32x4){0.f, 0.f, 0.f, 0.f};
#pragma unroll
            for (int c = 0; c < 4; ++c) { const bf16x8 kf = *(const bf16x8*)(kp + c * 32); acc = MFMA16(kf, qf[c], acc); }
            S[i] = acc;
        }
        float mx = -INFINITY;
#pragma unroll
        for (int i = 0; i < 8; ++i) {
            if (pass < 2) { const int krow = row_start + pass * 4 + (i >> 1); const float* rb = rpb + (krow - r + 7) * 31;
#pragma unroll
                for (int jj = 0; jj < 4; ++jj) { const int kc = cs + (i & 1) * 16 + 4 * g + jj; const bool ok = (kc >= c_start) && (kc < c_start + 16);
                    const int co = min(max(kc - qcol, -15), 15) + 15;
                    S[i][jj] = ok ? S[i][jj] * scale + rb[co] : -INFINITY; } }
            else {
#pragma unroll
                for (int jj = 0; jj < 4; ++jj) S[i][jj] *= scale; }
#pragma unroll
            for (int jj = 0; jj < 4; ++jj) mx = fmaxf(mx, S[i][jj]);
        }
        mx = fmaxf(mx, __shfl_xor(mx, 16)); mx = fmaxf(mx, __shfl_xor(mx, 32));
        const float mnew = fmaxf(mrun, mx);
        const float alpha = __expf(mrun - mnew);
        mrun = mnew; lsum *= alpha;
#pragma unroll
        for (int i = 0; i < 8; ++i) { O[i][0] *= alpha; O[i][1] *= alpha; O[i][2] *= alpha; O[i][3] *= alpha; }
        bf16x8 pf[4];
#pragma unroll
        for (int c = 0; c < 4; ++c) {
            float e[8];
#pragma unroll
            for (int jj = 0; jj < 4; ++jj) { e[jj] = __expf(S[2 * c][jj] - mnew); e[4 + jj] = __expf(S[2 * c + 1][jj] - mnew); }
#pragma unroll
            for (int jj = 0; jj < 8; ++jj) lsum += e[jj];
            u32x4 u; u[0] = pack2(e[0], e[1]); u[1] = pack2(e[2], e[3]); u[2] = pack2(e[4], e[5]); u[3] = pack2(e[6], e[7]);
            pf[c] = __builtin_bit_cast(bf16x8, u);
        }
#pragma unroll
        for (int c = 0; c < 4; ++c) {
            int pos0, pos1;
            if (pass < 2) { const int krow = row_start + pass * 4 + c; pos0 = krow * 64 + cs + 4 * g; pos1 = pos0 + 16; }
            else { pos0 = 4096 + (pass - 2) * 128 + c * 32 + 4 * g; pos1 = pos0 + 16; }
#pragma unroll
            for (int dt = 0; dt < 8; ++dt) {
                const bf16_t* vp = vtb + (size_t)(dt * 16 + n16) * 4352;
                const bf16x4 v0 = *(const bf16x4*)(vp + pos0), v1 = *(const bf16x4*)(vp + pos1);
                const bf16x8 vf = __builtin_shufflevector(v0, v1, 0, 1, 2, 3, 4, 5, 6, 7);
                O[dt] = MFMA16(vf, pf[c], O[dt]);
            }
        }
    }
    lsum += __shfl_xor(lsum, 16); lsum += __shfl_xor(lsum, 32);
    const float inv = 1.0f / lsum;
    bf16_t* yo = YN + (size_t)qrow * 1024 + h * 128 + 4 * g;
#pragma unroll
    for (int dt = 0; dt < 8; ++dt) { u32x2 o; o[0] = pack2(O[dt][0] * inv, O[dt][1] * inv); o[1] = pack2(O[dt][2] * inv, O[dt][3] * inv); *(u32x2*)(yo + dt * 16) = o; }
}

__device__ void na_block(PP p, int l, int task, unsigned char* lds) {
    const int TIDX = otid();
    const bf16_t* P = (const bf16_t*)(p->ws + OFF_P); const bf16_t* VT = (const bf16_t*)(p->ws + OFF_VT);
    bf16_t* YN = (bf16_t*)(p->ws + OFF_Y3) + 2ull * NTOK * 1024;
    const int tid = TIDX, w = tid >> 6, lane = tid & 63, n16 = lane & 15, g = lane >> 4, qi = w & 3, kh = w >> 2;
    const int b = task >> 9, h = (task >> 6) & 7, r = task & 63;
    const int qcol = qi * 16 + n16, qrow = b * 4096 + r * 64 + qcol;
    const int cs = qi == 0 ? 0 : (qi == 1 ? 8 : (qi == 2 ? 24 : 32)), row_start = min(max(r - 4, 0), 56), c_start = min(max(qcol - 8, 0), 48);
    unsigned char* KT = lds; unsigned char* VL = lds + 65536;
    bf16x8 qf[4];
#pragma unroll
    for (int c = 0; c < 4; ++c) qf[c] = *(const bf16x8*)(P + (size_t)qrow * NP + NAB + h * 128 + c * 32 + g * 8);
    const float* rpb = p->in[I_RPB] + (size_t)(l * 8 + h) * 15 * 31;
    const bf16_t* vtb = VT + (size_t)((b * 8 + h) * 128) * 4352;
    const bf16_t* kgb = P + NAB + 1024 + h * 128;
    f32x4 O[8];
#pragma unroll
    for (int i = 0; i < 8; ++i) O[i] = (f32x4){0.f, 0.f, 0.f, 0.f};
    float mrun = -INFINITY, lsum = 0.f;
    const float scale = 0.08838834764831845f;
    u32x4 kreg[8], vreg[8];
    auto gload = [&](int pass) {
#pragma unroll
        for (int i = 0; i < 8; ++i) { const int key = i * 32 + (tid >> 4), c16 = tid & 15, s_ = key >> 6, kk = key & 63;
            if (pass < 2) { const int krow = row_start + (s_ < 2 ? 2 * pass + s_ : 2 + 2 * pass + s_);
                kreg[i] = *(const u32x4*)(kgb + (size_t)(b * 4096 + krow * 64 + kk) * NP + c16 * 8); }
            else if (i < 4) { const int m = (s_ == 0 ? 0 : 128) + 64 * (pass - 2) + kk;
                kreg[i] = *(const u32x4*)(kgb + (size_t)(NLAT + b * 256 + m) * NP + c16 * 8); } }
#pragma unroll
        for (int i = 0; i < 8; ++i) { const int d = i * 16 + (tid >> 5), key8 = (tid & 31) * 8, s_ = key8 >> 6, kk = key8 & 63;
            if (pass < 2) { const int krow = row_start + (s_ < 2 ? 2 * pass + s_ : 2 + 2 * pass + s_);
                vreg[i] = *(const u32x4*)(vtb + (size_t)d * 4352 + krow * 64 + kk); }
            else if (key8 < 128) { const int m = (s_ == 0 ? 0 : 128) + 64 * (pass - 2) + kk;
                vreg[i] = *(const u32x4*)(vtb + (size_t)d * 4352 + 4096 + m); } }
    };
    auto lstore = [&](int pass) {
#pragma unroll
        for (int i = 0; i < 8; ++i) { const int key = i * 32 + (tid >> 4), c16 = tid & 15;
            if (pass < 2 || i < 4) *(u32x4*)(KT + key * 256 + ((c16 ^ (key & 15)) * 16)) = kreg[i]; }
#pragma unroll
        for (int i = 0; i < 8; ++i) { const int d = i * 16 + (tid >> 5), kc16 = tid & 31;
            if (pass < 2 || kc16 < 16) *(u32x4*)(VL + d * 512 + ((kc16 ^ (d & 15)) * 16)) = vreg[i]; }
    };
    gload(0);
    for (int pass = 0; pass < 4; ++pass) {
        __syncthreads();
        lstore(pass);
        __syncthreads();
        if (pass < 3) gload(pass + 1);
        f32x4 S[4];
#pragma unroll
        for (int i = 0; i < 4; ++i) {
            const int keyl = pass < 2 ? (kh * 2 + (i >> 1)) * 64 + cs + (i & 1) * 16 + n16 : kh * 64 + i * 16 + n16;
            const unsigned char* kp = KT + keyl * 256;
            f32x4 acc = (f32x4){0.f, 0.f, 0.f, 0.f};
#pragma unroll
            for (int c = 0; c < 4; ++c) { const bf16x8 kf = *(const bf16x8*)(kp + (((c * 4 + g) ^ (keyl & 15)) * 16)); acc = MFMA16(kf, qf[c], acc); }
            S[i] = acc;
        }
        float mx = -INFINITY;
#pragma unroll
        for (int i = 0; i < 4; ++i) {
            if (pass < 2) { const int krow = row_start + kh * 4 + 2 * pass + (i >> 1); const float* rb = rpb + (krow - r + 7) * 31;
#pragma unroll
                for (int jj = 0; jj < 4; ++jj) { const int kc = cs + (i & 1) * 16 + 4 * g + jj; const bool ok = (kc >= c_start) && (kc < c_start + 16);
                    const int co = min(max(kc - qcol, -15), 15) + 15;
                    S[i][jj] = ok ? S[i][jj] * scale + rb[co] : -INFINITY; } }
            else {
#pragma unroll
                for (int jj = 0; jj < 4; ++jj) S[i][jj] *= scale; }
#pragma unroll
            for (int jj = 0; jj < 4; ++jj) mx = fmaxf(mx, S[i][jj]);
        }
        mx = fmaxf(mx, __shfl_xor(mx, 16)); mx = fmaxf(mx, __shfl_xor(mx, 32));
        const float mnew = fmaxf(mrun, mx);
        const float alpha = __expf(mrun - mnew);
        mrun = mnew; lsum *= alpha;
#pragma unroll
        for (int i = 0; i < 8; ++i) { O[i][0] *= alpha; O[i][1] *= alpha; O[i][2] *= alpha; O[i][3] *= alpha; }
#pragma unroll
        for (int c = 0; c < 2; ++c) {
            float e[8];
#pragma unroll
            for (int jj = 0; jj < 4; ++jj) { e[jj] = __expf(S[2 * c][jj] - mnew); e[4 + jj] = __expf(S[2 * c + 1][jj] - mnew); }
#pragma unroll
            for (int jj = 0; jj < 8; ++jj) lsum += e[jj];
            u32x4 u; u[0] = pack2(e[0], e[1]); u[1] = pack2(e[2], e[3]); u[2] = pack2(e[4], e[5]); u[3] = pack2(e[6], e[7]);
            const bf16x8 pf = __builtin_bit_cast(bf16x8, u);
            const int key0 = pass < 2 ? (kh * 2 + c) * 64 + cs + 4 * g : kh * 64 + c * 32 + 4 * g;
            const int kc8a = key0 >> 2, kc8b = kc8a + 4;
#pragma unroll
            for (int dt = 0; dt < 8; ++dt) { const int d = dt * 16 + n16; const unsigned char* vp = VL + d * 512;
                const bf16x4 v0 = *(const bf16x4*)(vp + (((kc8a >> 1) ^ (d & 15)) * 16) + (kc8a & 1) * 8), v1 = *(const bf16x4*)(vp + (((kc8b >> 1) ^ (d & 15)) * 16) + (kc8b & 1) * 8);
                const bf16x8 vf = __builtin_shufflevector(v0, v1, 0, 1, 2, 3, 4, 5, 6, 7);
                O[dt] = MFMA16(vf, pf, O[dt]); }
        }
    }
    lsum += __shfl_xor(lsum, 16); lsum += __shfl_xor(lsum, 32);
    __syncthreads();
    float* cmb = (float*)lds + (size_t)qi * 34 * 64 + lane;
    if (kh == 1) { cmb[0] = mrun; cmb[64] = lsum;
#pragma unroll
        for (int dt = 0; dt < 8; ++dt)
#pragma unroll
            for (int jj = 0; jj < 4; ++jj) cmb[(2 + dt * 4 + jj) * 64] = O[dt][jj]; }
    __syncthreads();
    if (kh == 0) { const float m1 = cmb[0], l1 = cmb[64];
        const float mn = fmaxf(mrun, m1), a0 = __expf(mrun - mn), a1 = __expf(m1 - mn);
        const float inv = 1.0f / (lsum * a0 + l1 * a1);
        bf16_t* yo = YN + (size_t)qrow * 1024 + h * 128 + 4 * g;
#pragma unroll
        for (int dt = 0; dt < 8; ++dt) { float o[4];
#pragma unroll
            for (int jj = 0; jj < 4; ++jj) o[jj] = (O[dt][jj] * a0 + cmb[(2 + dt * 4 + jj) * 64] * a1) * inv;
            u32x2 ov; ov[0] = pack2(o[0], o[1]); ov[1] = pack2(o[2], o[3]); *(u32x2*)(yo + dt * 16) = ov; } }
}

__device__ void phase_mix(PP p, int l, float* lds, int which = 7) {
    const int TIDX = otid();
    for (int t = blockIdx.x; t < 256; t += gridDim.x) {
        if (t < 128) { if (which & 1) rwkv_scan(p, l, t, lds); }
        else if (which & 2) mlstm_scan(p, l, (t - 128) >> 3, (t - 128) & 7, lds);
        __syncthreads();
    }
    unsigned* ctr = (unsigned*)(p->ws + OFF_CTL) + l * 8 + ((which & 8) ? 1 : 0);
    if (!(which & 4)) return;
    int* stask = (int*)lds;
    const int ntask = l == 0 ? 1056 : 1024;
    for (;;) {
        __syncthreads();
        if (TIDX == 0) stask[0] = (int)atomicAdd(ctr, 1u);
        __syncthreads();
        const int t = stask[0];
        if (t >= ntask) break;
        const int nctx = ntask - 1024;
        if (t >= nctx) na_block(p, l, t - nctx, (unsigned char*)lds); else na_wave(p, l, 512 + t);
    }
}

__device__ void phase_post(PP p, int l, int nrows) {
    const int TIDX = otid();
    const int wid = TIDX >> 6, lane = TIDX & 63, gw = blockIdx.x * 8 + wid, nw = gridDim.x * 8;
    const bf16_t* P = (const bf16_t*)(p->ws + OFF_P); const bf16_t* LO = (const bf16_t*)(p->ws + OFF_LO);
    bf16_t* YM = (bf16_t*)(p->ws + OFF_Y3); bf16_t* YR = YM + (size_t)NTOK * 1024;
    const float* NUM = (const float*)(p->ws + OFF_MLNUM); const float* YF = (const float*)(p->ws + OFF_YRWF);
    for (int row = gw; row < nrows; row += nw) {
        f32x4 a[4], c[4], ng[4]; float dfr[4], dbr[4]; u32x2 ov[4];
#pragma unroll
        for (int h = 0; h < 4; ++h) {
            const float* nf = NUM + ((size_t)row * 4 + h) * 272; const float* nb = NUM + ((size_t)(NTOK + row) * 4 + h) * 272;
            a[h] = *(const f32x4*)(nf + lane * 4); c[h] = *(const f32x4*)(nb + lane * 4); dfr[h] = nf[256]; dbr[h] = nb[256];
            ov[h] = *(const u32x2*)(P + (size_t)row * NP + 2048 + h * 256 + lane * 4);
            ng[h] = *(const f32x4*)(p->in[I_MLNG] + l * 1024 + h * 256 + lane * 4); }
#pragma unroll
        for (int h = 0; h < 4; ++h) {
            const float df = 1.0f / fmaxf(fabsf(dfr[h]), 1.0f), db = 1.0f / fmaxf(fabsf(dbr[h]), 1.0f);
            float hv[4]; float ss = 0.f;
#pragma unroll
            for (int j = 0; j < 4; ++j) { hv[j] = a[h][j] * df + c[h][j] * db; ss += hv[j] * hv[j]; }
            ss = wsum(ss);
            const float rr = rsqrtf(ss * (1.0f / 256.0f) + 1e-6f);
            const float o0 = hv[0] * rr * ng[h][0] * sigmoidf(bflo(ov[h][0])), o1 = hv[1] * rr * ng[h][1] * sigmoidf(bfhi(ov[h][0]));
            const float o2 = hv[2] * rr * ng[h][2] * sigmoidf(bflo(ov[h][1])), o3 = hv[3] * rr * ng[h][3] * sigmoidf(bfhi(ov[h][1]));
            u32x2 w; w[0] = pack2(o0, o1); w[1] = pack2(o2, o3);
            *(u32x2*)(YM + (size_t)row * 1024 + h * 256 + lane * 4) = w; }
    }
    const float* MU = p->in[I_RWMU] + (size_t)l * 3712;
    const float* RKp = (const float*)(p->ws + OFF_RK);
#pragma unroll 2
    for (int it = gw; it < nrows * 4; it += nw) {
        const int row = it >> 2, head = (it & 3) * 4 + (lane >> 4), c = head * 64 + (lane & 15) * 4;
        bool hp, hn; seq_nbrs(row, hp, hn);
        const f32x4 ya = *(const f32x4*)(YF + (size_t)row * 1024 + c), yb = *(const f32x4*)(YF + (size_t)(NTOK + row) * 1024 + c);
        const bf16_t* pr = P + (size_t)row * NP + RWB + 2048 + c;
        const u32x2 z2 = {0u, 0u};
        const u32x2 vc = *(const u32x2*)pr, vp = hp ? *(const u32x2*)(pr - NP) : z2, vn = hn ? *(const u32x2*)(pr + NP) : z2;
        const u32x2 gv = *(const u32x2*)(LO + (size_t)row * 5120 + 4096 + c);
        const float rk = RKp[row * 16 + head];
        const f32x4 mu = *(const f32x4*)(MU + 2048 + c), lw = *(const f32x4*)(p->in[I_RWLNW] + l * 1024 + c), lb = *(const f32x4*)(p->in[I_RWLNB] + l * 1024 + c);
        const f32x4 y = ya + yb;
        const float mean = red16((y[0] + y[1]) + (y[2] + y[3])) * (1.0f / 64.0f);
        const f32x4 dy = y - mean;
        const float var = red16((dy[0] * dy[0] + dy[1] * dy[1]) + (dy[2] * dy[2] + dy[3] * dy[3])) * (1.0f / 64.0f);
        const float rs = rsqrtf(var + 64e-5f);
        const float v0 = shiftf(bflo(vc[0]), bflo(vp[0]), bflo(vn[0]), mu[0]), v1 = shiftf(bfhi(vc[0]), bfhi(vp[0]), bfhi(vn[0]), mu[1]);
        const float v2 = shiftf(bflo(vc[1]), bflo(vp[1]), bflo(vn[1]), mu[2]), v3 = shiftf(bfhi(vc[1]), bfhi(vp[1]), bfhi(vn[1]), mu[3]);
        const float o0 = (dy[0] * rs * lw[0] + lb[0] + rk * v0) * bflo(gv[0]), o1 = (dy[1] * rs * lw[1] + lb[1] + rk * v1) * bfhi(gv[0]);
        const float o2 = (dy[2] * rs * lw[2] + lb[2] + rk * v2) * bflo(gv[1]), o3 = (dy[3] * rs * lw[3] + lb[3] + rk * v3) * bfhi(gv[1]);
        u32x2 w; w[0] = pack2(o0, o1); w[1] = pack2(o2, o3);
        *(u32x2*)(YR + (size_t)row * 1024 + c) = w;
    }
}


constexpr size_t PART_OFF = 150ull << 20;
#ifndef DUPMASK
#define DUPMASK 0
#endif
#ifndef DUPWHICH
#define DUPWHICH 3
#endif
__global__ void __launch_bounds__(512, 2) fwd_kernel(Params p0) {
    extern __shared__ __attribute__((aligned(16))) unsigned char shm[];
    cg::grid_group grid = cg::this_grid();
    float* ldsf = (float*)shm;
    LAS unsigned char* ldsg = (LAS unsigned char*)shm;
    const int ph_lo = p0.ph_lo, ph_hi = p0.ph_hi;
    auto kseg = __builtin_amdgcn_kernarg_segment_ptr();
    for (int ph = ph_lo; ph < ph_hi; ++ph) {
        if (ph > ph_lo) grid.sync();
        PP p = (PP)kseg; asm volatile("" : "+s"(p));
        unsigned char* ws = p->ws;
        const float* MOD = (const float*)(ws + OFF_MOD);
        float* XL = (float*)(ws + OFF_XL);
        bf16_t* H = (bf16_t*)(ws + OFF_H);
        bf16_t* Pb = (bf16_t*)(ws + OFF_P);
        if (ph == 0) { phase_mod(p, ldsf); __syncthreads(); phase_convert(p, 0, ldsf, (int)blockIdx.x, (int)gridDim.x, 0, 0, 18816, true); continue; }
        if (ph == NPHASE - 1) { phase_final(p); continue; }
        const int l = (ph - 1) / 11, sub = (ph - 1) % 11;
        const int two_wt = p->two_wt;
        const size_t wsh = (l == 1 && two_wt) ? WT_SHIFT : 0;
#if DUPMASK
        for (int rep = 0; rep < (((DUPMASK >> sub) & 1) ? 2 : 1); ++rep) { if (rep) grid.sync();
#endif
        const int Ml = l == 0 ? NTOK : NLAT;
        const float* modl = MOD + (size_t)l * 3 * 12288;
        if (sub == 1 || sub == 3 || sub == 6 || sub == 7 || sub == 9 || sub == 10) {
            const bool ksplit = l == 0 && (sub == 7 || sub == 10) && gridDim.x == 256;
            for (int part = 0; part < (ksplit ? 2 : (sub == 3 ? 3 : 1)); ++part) {
            pg8::Gemm g; pg8::SchedG S; pg8::EpiG E;
            S.mode = 0; S.mo.init(Ml / 256, (int)gridDim.x, (int)blockIdx.x);
            E.kind = 0; E.split = 0; E.O = Pb; E.ldc = NP; E.P = Pb; E.ACC = (float*)(ws + OFF_YRWF);
            E.xin_lat = XL; E.xin_ctx = XL + (size_t)NLAT * 2048; E.XL = XL; E.gate = modl; E.part = nullptr;
            if (sub == 1) { g = pg8::Gemm{H, (const bf16_t*)(ws + wsh + OFF_WIN), NTOK, NP, 2048, 32}; }
            else if (sub == 3) { const int n0 = part * 2048, k0 = part == 0 ? 0 : (part == 1 ? 192 : 384);
                g = pg8::Gemm{(const bf16_t*)(ws + OFF_LA) + k0, (const bf16_t*)(ws + wsh + OFF_WLORA) + (size_t)n0 * 640 + k0, NTOK, part == 2 ? 1024 : 2048, 640, 4}; E.O = (bf16_t*)(ws + OFF_LO) + n0; E.ldc = 5120; }
            else if (sub == 6) { g = pg8::Gemm{(const bf16_t*)(ws + OFF_Y3), (const bf16_t*)(ws + wsh + OFF_WBR), Ml, 2048, 1024, 16}; S.mode = 1; E.kind = 2; E.O = H; }
            else if (sub == 7) { g = pg8::Gemm{H, (const bf16_t*)(ws + wsh + OFF_WOUT), Ml, 2048, 2048, 32}; E.kind = 3; E.gate = modl + 2 * 2048;
                if (l == 0) { E.xin_lat = p->in[I_X]; E.xin_ctx = p->in[I_CTX]; } }
            else if (sub == 9) { g = pg8::Gemm{H, (const bf16_t*)(ws + wsh + OFF_WFF1), Ml, DFF, 2048, 32}; E.kind = 1; E.ldc = DFF; }
            else { g = pg8::Gemm{Pb, (const bf16_t*)(ws + wsh + OFF_WFF2), Ml, 2048, DFF, 128}; E.kind = 3; E.gate = modl + 5 * 2048; }
            if (ksplit) {
                if (part == 0) g.M = NLAT;
                else { const int ks = (int)blockIdx.x & 15; g.nt >>= 4; g.A += (size_t)ks * g.nt * 64; g.Bt += (size_t)ks * g.nt * 64; S.mode = 2; E.split = 1;
                    E.part = (float*)(ws + OFF_P + (sub == 10 ? PART_OFF : 0)) + (size_t)ks * 512 * 2048; }
            }
            S.so.init(g.M, g.N, (int)gridDim.x, (int)blockIdx.x);
            pg8::gemm_phase(ldsg, g, S, E);
            }
            if (two_wt && l == 0 && gridDim.x == 256) {
                if (sub == 1 && blockIdx.x >= 94) phase_convert(p, 1, ldsf, (int)blockIdx.x - 94, 162, WT_SHIFT, 0, 4000, false);
                if (sub == 6 && blockIdx.x >= 16) phase_convert(p, 1, ldsf, (int)blockIdx.x - 16, 240, WT_SHIFT, 4000, 11500, false);
                if (sub == 9 && blockIdx.x >= 64) phase_convert(p, 1, ldsf, (int)blockIdx.x - 64, 192, WT_SHIFT, 11500, 18816, true);
            } else if (two_wt && l == 0 && sub == 10) phase_convert(p, 1, ldsf, (int)blockIdx.x, (int)gridDim.x, WT_SHIFT, 0, 18816, true);
        } else
        switch (sub) {
        case 0: {
            phase_init(p, l);
            if (l == 1 && !two_wt) phase_convert(p, l, ldsf, (int)blockIdx.x, (int)gridDim.x, wsh, 0, 18816, true);
            if (l == 0) phase_norm(p->in[I_X], p->in[I_CTX], NTOK, p->in[I_N1G] + l * 2048, modl, 0, 1, H);
            else if (gridDim.x == 256) phase_norm(XL, XL + (size_t)NLAT * 2048, NTOK, p->in[I_N1G] + l * 2048, modl, 0, 1, H, (const float*)(ws + OFF_P + PART_OFF), MOD + 2 * 12288 + 5 * 2048, XL + (size_t)NLAT * 2048);
            else phase_norm(XL, XL + (size_t)NLAT * 2048, NTOK, p->in[I_N1G] + l * 2048, modl, 0, 1, H);
        } break;
        case 2: phase_prep(p, l, (bf16_t*)shm); break;
#if DUPMASK
        case 4: phase_mix(p, l, ldsf, rep ? DUPWHICH : 7); break;
#else
        case 4: phase_mix(p, l, ldsf); break;
#endif
        case 5: phase_post(p, l, Ml); break;
        case 8: if (l == 0 && gridDim.x == 256) phase_norm(XL, p->in[I_CTX], Ml, p->in[I_N2G] + l * 2048, modl, 3, 4, H, (const float*)(ws + OFF_P), modl + 2 * 12288 + 2 * 2048, XL + (size_t)NLAT * 2048);
                else phase_norm(XL, XL + (size_t)NLAT * 2048, Ml, p->in[I_N2G] + l * 2048, modl, 3, 4, H); break;
        }
#if DUPMASK
        }
#endif
    }
}

extern "C" void kernel_launch(void* const* d_in, const int* in_sizes, int n_in, void* d_out, int out_size, void* d_ws, size_t ws_size, hipStream_t stream) {
    static int grid = 0;
    if (grid == 0) {
        if (n_in != 28 || ws_size < WS_END) { fprintf(stderr, "kernel_launch: need 28 inputs and %zu bytes of workspace (got %d, %zu)\n", (size_t)WS_END, n_in, ws_size); grid = -1; return; }
        if (hipFuncSetAttribute((const void*)fwd_kernel, hipFuncAttributeMaxDynamicSharedMemorySize, LDS_BYTES) != hipSuccess) { fprintf(stderr, "kernel_launch: hipFuncSetAttribute failed\n"); grid = -1; return; }
        int dev = 0, cus = 0, per_cu = 0;
        hipGetDevice(&dev);
        hipDeviceGetAttribute(&cus, hipDeviceAttributeMultiprocessorCount, dev);
        hipOccupancyMaxActiveBlocksPerMultiprocessor(&per_cu, (const void*)fwd_kernel, 512, LDS_BYTES);
        if (per_cu < 1) { fprintf(stderr, "kernel_launch: occupancy query says %d blocks per CU\n", per_cu); per_cu = 1; }
        (void)hipGetLastError();
        grid = cus * 1;
        if (grid > 256) grid = 256;
    }
    if (grid < 0) return;
    Params p{};
    for (int i = 0; i < 28; ++i) p.in[i] = (const float*)d_in[i];
    p.out = (float*)d_out; p.ws = (unsigned char*)d_ws; p.two_wt = (ws_size >= WS_END + WT_BYTES) ? 1 : 0;
#if ONE_LAUNCH
    p.ph_lo = 0; p.ph_hi = NPHASE;
    void* args[] = {&p};
    hipError_t e = hipLaunchCooperativeKernel((const void*)fwd_kernel, dim3(grid), dim3(512), args, LDS_BYTES, stream);
    if (e != hipSuccess) fprintf(stderr, "cooperative launch failed: %s (grid %d)\n", hipGetErrorString(e), grid);
#else
    for (int ph = 0; ph < NPHASE; ++ph) {
        p.ph_lo = ph; p.ph_hi = ph + 1;
        hipLaunchKernelGGL(fwd_kernel, dim3(grid), dim3(512), LDS_BYTES, stream, p);
    }
#endif
}
```

```cpp
#include <hip/hip_runtime.h>
#include <hip/hip_cooperative_groups.h>
#include <cstdio>
namespace cg = cooperative_groups;

#ifndef ONE_LAUNCH
#define ONE_LAUNCH 1
#endif

#define DEVI __device__ __forceinline__
#define LAS __attribute__((address_space(3)))
typedef unsigned short bf16_t;
typedef short bf16x8 __attribute__((ext_vector_type(8)));
typedef short bf16x4 __attribute__((ext_vector_type(4)));
typedef float f32x4 __attribute__((ext_vector_type(4)));
typedef float f32x2 __attribute__((ext_vector_type(2)));
typedef unsigned u32x4 __attribute__((ext_vector_type(4)));
typedef unsigned u32x2 __attribute__((ext_vector_type(2)));

constexpr int D = 2048, NTOK = 8704, NLAT = 8192, NP = 16128, DIN = 16016, DFF = 8192;
constexpr int RWB = 3088, NAB = 6800, GTB = 9872;
constexpr int LDS_BYTES = 131072;
constexpr int NPHASE = 24;

constexpr size_t OFF_CTL = 0;
constexpr size_t OFF_MOD = 4096;
constexpr size_t OFF_ROPE = OFF_MOD + 2ull * 3 * 12288 * 4;
constexpr size_t OFF_WIN = OFF_ROPE + 16384;
constexpr size_t OFF_WBR = OFF_WIN + 16128ull * 2048 * 2;
constexpr size_t OFF_WOUT = OFF_WBR + 3ull * 2048 * 1024 * 2;
constexpr size_t OFF_WFF1 = OFF_WOUT + 2048ull * 2048 * 2;
constexpr size_t OFF_WFF2 = OFF_WFF1 + 8192ull * 2048 * 2;
constexpr size_t OFF_WLORA = OFF_WFF2 + 8192ull * 2048 * 2;
constexpr size_t OFF_XL = OFF_WLORA + 5120ull * 640 * 2;
constexpr size_t OFF_H = OFF_XL + 8704ull * 2048 * 4;
constexpr size_t OFF_P = OFF_H + 8704ull * 2048 * 2;
constexpr size_t OFF_LA = OFF_P + 8704ull * 16128 * 2;
constexpr size_t OFF_LO = OFF_LA + 8704ull * 640 * 2;
constexpr size_t OFF_YRWF = OFF_LO + 8704ull * 5120 * 2;
constexpr size_t OFF_MLNUM = OFF_YRWF + 2ull * 8704 * 1024 * 4;
constexpr size_t OFF_VT = OFF_MLNUM + 2ull * 8704 * 4 * 272 * 4;
constexpr size_t OFF_Y3 = OFF_VT + 2ull * 8 * 128 * 4352 * 2;
constexpr size_t OFF_RK = OFF_Y3 + 3ull * 8704 * 1024 * 2;
constexpr size_t WS_END = OFF_RK + 8704ull * 16 * 4;
constexpr size_t WT_BYTES = OFF_XL - OFF_WIN, WT_SHIFT = WS_END - OFF_WIN;

struct Params {
    const float* in[28];
    float* out;
    unsigned char* ws;
    int ph_lo, ph_hi, two_wt, pad_;
};
typedef const __attribute__((address_space(4))) Params* PP;
enum { I_X = 0, I_C, I_CTX, I_CCTX, I_WMOD, I_BMOD, I_N1G, I_WIN, I_MLGB, I_MLNG, I_RWMU, I_RWW0, I_RWWUP, I_RWA0, I_RWAUP, I_RWGUP,
       I_RWKK, I_RWKA, I_RWRK, I_RWLNW, I_RWLNB, I_RPB, I_WBR, I_WOUT, I_N2G, I_WFF1, I_WFF2, I_FING };

DEVI int otid() { int t; asm volatile("v_mov_b32 %0, %1" : "=v"(t) : "v"((int)threadIdx.x)); return t; }
DEVI float bf2f(bf16_t b) { return __uint_as_float(((unsigned)b) << 16); }
DEVI float bflo(unsigned u) { return __uint_as_float(u << 16); }
DEVI float bfhi(unsigned u) { return __uint_as_float(u & 0xffff0000u); }
DEVI bf16_t f2bf(float f) { unsigned u = __float_as_uint(f); u += 0x7FFFu + ((u >> 16) & 1u); return (bf16_t)(u >> 16); }
DEVI unsigned pack2(float lo, float hi) { return (unsigned)f2bf(lo) | ((unsigned)f2bf(hi) << 16); }
DEVI float sigmoidf(float x) { return __builtin_amdgcn_rcpf(1.0f + __expf(-x)); }
#define DPP_ADD(x, CTRL) ((x) + __int_as_float(__builtin_amdgcn_update_dpp(0, __float_as_int(x), CTRL, 0xF, 0xF, true)))
DEVI float wsum(float x) {
    x = DPP_ADD(x, 0xB1); x = DPP_ADD(x, 0x4E); x = DPP_ADD(x, 0x141); x = DPP_ADD(x, 0x140);
    const int xi = __float_as_int(x);
    return (__int_as_float(__builtin_amdgcn_readlane(xi, 0)) + __int_as_float(__builtin_amdgcn_readlane(xi, 16))) + (__int_as_float(__builtin_amdgcn_readlane(xi, 32)) + __int_as_float(__builtin_amdgcn_readlane(xi, 48)));
}
DEVI float red8(float x) {
    x = DPP_ADD(x, 0xB1);
    x = DPP_ADD(x, 0x4E);
    x = DPP_ADD(x, 0x141);
    return x;
}

DEVI float red16(float x) {
    x = DPP_ADD(x, 0xB1); x = DPP_ADD(x, 0x4E); x = DPP_ADD(x, 0x141); x = DPP_ADD(x, 0x140);
    return x;
}
DEVI float sfma(float a, float b, float c) { float d; asm("v_fma_f32 %0, %1, %2, %3" : "=v"(d) : "v"(a), "v"(b), "v"(c)); return d; }
DEVI float smul(float a, float b) { float d; asm("v_mul_f32 %0, %1, %2" : "=v"(d) : "v"(a), "v"(b)); return d; }
DEVI void fadd_g(float* ptr, float v) { (void)__builtin_amdgcn_global_atomic_fadd_f32((__attribute__((address_space(1))) float*)ptr, v); }
DEVI float frcp(float x) { return __builtin_amdgcn_rcpf(x); }
DEVI float fsigmoid(float x) { return __builtin_amdgcn_rcpf(1.0f + __expf(-x)); }

namespace pg8 {
constexpr int BM = 256, BK = 64, HALF = 128, HTB = HALF * BK * 2, STAGE_BYTES = 8 * HTB, NXCD = 8, WGM = 8;
__host__ __device__ __forceinline__ int lds_byte(int r, int c) { const int st = (r >> 4) * 2 + (c >> 5), rr = r & 15, cc = c & 31, ob = rr * 64 + cc * 2; return st * 1024 + (ob ^ (((ob >> 9) & 1) << 5)); }
__host__ __device__ __forceinline__ void stage_rc(int b, int& R, int& C) { const int st = b / 1024, sb = b % 1024, swz = sb ^ (((sb >> 9) & 1) << 5); R = (st >> 1) * 16 + swz / 64; C = (st & 1) * 32 + (swz % 64) / 2; }
__host__ __device__ __forceinline__ int perm32(int rho) { const int n = rho >> 4, i = rho & 15; return 8 * (i >> 2) + 4 * n + (i & 3); }
struct Unit { int pm, pn; };
struct Gemm { const bf16_t* A; const bf16_t* Bt; int M, N, K, nt; };
struct StaticOrder {
    int nM, nN, nwg, G, c;
    __device__ void init(int M, int N, int G_, int c_) { nM = M / BM; nN = N / BM; nwg = nM * nN; G = G_; c = c_; }
    __device__ bool next(int i, Unit& u) const {
        const long L = (long)i * G + c; if (L >= nwg) return false;
        int wgid = (int)L; { const int q = nwg / NXCD, r = nwg % NXCD, xcd = wgid % NXCD, off = wgid / NXCD; wgid = (xcd < r ? xcd * (q + 1) : r * (q + 1) + (xcd - r) * q) + off; }
        const int nig = WGM * nN, gid = wgid / nig, fm = gid * WGM, gsz = (nM - fm) < WGM ? (nM - fm) : WGM;
        u.pm = fm + ((wgid % nig) % gsz); u.pn = (wgid % nig) / gsz; return true;
    }
    __device__ __forceinline__ void a_ready(const Unit&) const {}
    __device__ __forceinline__ void done(const Unit&) const {}
};
struct MergeOrder {
    int ntiles, G, c;
    __device__ void init(int nM, int G_, int c_) { ntiles = nM * 8; G = G_; c = c_; }
    __device__ bool next(int i, Unit& u) const {
        const int ti = i / 3, br = i - ti * 3; const long L = (long)ti * G + c; if (L >= ntiles) return false;
        const int pm = (int)L >> 3, pn = (int)L & 7; u.pm = br * 34 + pm; u.pn = br * 8 + pn; return true;
    }
    __device__ __forceinline__ void a_ready(const Unit&) const {}
    __device__ __forceinline__ void done(const Unit&) const {}
};
DEVI unsigned cvt_pk_bf16(float lo, float hi) { unsigned r; asm volatile("v_cvt_pk_bf16_f32 %0, %1, %2" : "=v"(r) : "v"(lo), "v"(hi)); return r; }


struct SchedG {
    int mode;
    StaticOrder so; MergeOrder mo;
    __device__ __forceinline__ bool next(int i, Unit& u) const {
        if (mode == 2) { if (i > 0) return false; const int cu = so.c >> 4; u.pm = 32 + (cu >> 3); u.pn = cu & 7; return true; }
        return mode == 0 ? so.next(i, u) : mo.next(i, u); }
    __device__ __forceinline__ void a_ready(const Unit&) const {}
    __device__ __forceinline__ void done(const Unit&) const {}
};
struct EpiG {
    static constexpr bool PERM = true, AFTER_DRAIN = false;
    int kind, split;
    bf16_t* O; int ldc;
    const bf16_t* P; float* ACC;
    const float* xin_lat; const float* xin_ctx; float* XL; const float* gate; float* part;
    __device__ __forceinline__ void operator()(const f32x4 (&acc)[2][2][4][2], const Unit& u, int wr, int wc, int fr, int fq) const {
        if (kind <= 1) {
            const int row0 = u.pm * BM + wr * 64 + fr, col0 = u.pn * BM + wc * 32 + 8 * fq;
#pragma unroll
            for (int ai = 0; ai < 2; ++ai)
#pragma unroll
                for (int m = 0; m < 4; ++m) { bf16_t* rowp = O + (size_t)(row0 + ai * HALF + m * 16) * ldc + col0;
#pragma unroll
                    for (int bj = 0; bj < 2; ++bj) { f32x4 v0 = acc[ai][bj][m][0], v1 = acc[ai][bj][m][1];
                        if (kind == 1) {
#pragma unroll
                            for (int i = 0; i < 4; ++i) { float a = fmaxf(v0[i], 0.f), b = fmaxf(v1[i], 0.f); v0[i] = a * a; v1[i] = b * b; } }
                        u32x4 o; o[0] = cvt_pk_bf16(v0[0], v0[1]); o[1] = cvt_pk_bf16(v0[2], v0[3]); o[2] = cvt_pk_bf16(v1[0], v1[1]); o[3] = cvt_pk_bf16(v1[2], v1[3]);
                        *(u32x4*)(rowp + bj * HALF) = o; } }
        } else if (kind == 2) {
            const int br = u.pn >> 3, pn = u.pn & 7, pm = u.pm - br * 34;
            const int row0 = pm * BM + wr * 64 + fr, col0 = pn * BM + wc * 32 + 8 * fq;
#pragma unroll
            for (int ai = 0; ai < 2; ++ai)
#pragma unroll
                for (int m = 0; m < 4; ++m) { const size_t row = (size_t)(row0 + ai * HALF + m * 16);
#pragma unroll
                    for (int bj = 0; bj < 2; ++bj) { const int col = col0 + bj * HALF;
                        const u32x4 gv = *(const u32x4*)(P + row * NP + GTB + br * 2048 + col);
                        f32x4 v0 = acc[ai][bj][m][0], v1 = acc[ai][bj][m][1];
                        v0[0] *= sigmoidf(bflo(gv[0])); v0[1] *= sigmoidf(bfhi(gv[0])); v0[2] *= sigmoidf(bflo(gv[1])); v0[3] *= sigmoidf(bfhi(gv[1]));
                        v1[0] *= sigmoidf(bflo(gv[2])); v1[1] *= sigmoidf(bfhi(gv[2])); v1[2] *= sigmoidf(bflo(gv[3])); v1[3] *= sigmoidf(bfhi(gv[3]));
                        float* ap = ACC + row * 2048 + col;
                        if (br == 0) { *(f32x4*)ap = v0; *(f32x4*)(ap + 4) = v1; }
                        else { v0 += *(const f32x4*)ap; v1 += *(const f32x4*)(ap + 4);
                            if (br == 1) { *(f32x4*)ap = v0; *(f32x4*)(ap + 4) = v1; }
                            else { u32x4 o; o[0] = cvt_pk_bf16(v0[0], v0[1]); o[1] = cvt_pk_bf16(v0[2], v0[3]); o[2] = cvt_pk_bf16(v1[0], v1[1]); o[3] = cvt_pk_bf16(v1[2], v1[3]);
                                *(u32x4*)(O + row * 2048 + col) = o; } } } }
        } else {
            const int row0 = u.pm * BM + wr * 64 + fr, col0 = u.pn * BM + wc * 32 + 8 * fq;
#pragma unroll
            for (int ai = 0; ai < 2; ++ai)
#pragma unroll
                for (int m = 0; m < 4; ++m) { const int row = row0 + ai * HALF + m * 16;
                    const int mrow = row < NLAT ? (row >> 12) : 2;
                    const float* xr = row < NLAT ? xin_lat + (size_t)row * 2048 : xin_ctx + (size_t)(row - NLAT) * 2048;
                    const float* gr = gate + (size_t)mrow * 12288; float* orow = XL + (size_t)row * 2048;
#pragma unroll
                    for (int bj = 0; bj < 2; ++bj)
#pragma unroll
                        for (int n = 0; n < 2; ++n) { const int col = col0 + bj * HALF + n * 4;
                            const f32x4 g = *(const f32x4*)(gr + col);
                            if (split) *(f32x4*)(part + (size_t)(row - NLAT) * 2048 + col) = acc[ai][bj][m][n];
                            else { const f32x4 x = *(const f32x4*)(xr + col); *(f32x4*)(orow + col) = x + g * acc[ai][bj][m][n]; } } }
        }
    }
};
template <class Epi, class Sched>
__device__ __forceinline__ void gemm_phase(LAS unsigned char* lds, const Gemm g, const Sched& S, const Epi& E) {
    const int tid = otid(), wid = __builtin_amdgcn_readfirstlane(tid >> 6), lane = tid & 63, wr = wid >> 2, wc = wid & 3, fr = lane & 15, fq = lane >> 4;
    const int K = g.K, nt = g.nt;
    unsigned voffA[2], voffB[2];
#pragma unroll
    for (int i = 0; i < 2; ++i) { int R, C; stage_rc(tid * 16 + i * 8192, R, C); const int Rb = Epi::PERM ? ((R & ~31) + perm32(R & 31)) : R;
        voffA[i] = (unsigned)(R * K + C) * 2u; voffB[i] = (unsigned)(Rb * K + C) * 2u; }
    const size_t kstep = (size_t)(BK * 2);
    const size_t hstep = (size_t)HALF * K * 2;
    const size_t tstep = 2 * hstep;
    const unsigned ldsw = (unsigned)wid * 1024u;
    const int aoff = lds_byte(wr * 64 + fr, fq * 8), boff = lds_byte(wc * 32 + fr, fq * 8);
#define PG8_SA(b, h) (((b) * 2 + (h)) * HTB)
#define PG8_SB(b, h) ((4 + (b) * 2 + (h)) * HTB)
#define PG8_STAGE(bufoff, gbase, voff) do { _Pragma("unroll") for (int _i = 0; _i < 2; ++_i) \
        __builtin_amdgcn_global_load_lds((const unsigned*)((const char*)(gbase) + (voff)[_i]), (LAS unsigned*)(lds + (bufoff) + ldsw + _i * 8192), 16, 0, 0); } while (0)
#define PG8_LDA(dst, b, h) do { _Pragma("unroll") for (int m = 0; m < 4; ++m) _Pragma("unroll") for (int k = 0; k < 2; ++k) dst[m][k] = *(const LAS bf16x8*)(lds + PG8_SA(b, h) + aoff + m * 2048 + k * 1024); } while (0)
#define PG8_LDB(dst, b, h) do { _Pragma("unroll") for (int n = 0; n < 2; ++n) _Pragma("unroll") for (int k = 0; k < 2; ++k) dst[n][k] = *(const LAS bf16x8*)(lds + PG8_SB(b, h) + boff + n * 2048 + k * 1024); } while (0)
#define PG8_MMA(ai, bj, At, Bt) do { __builtin_amdgcn_s_setprio(1); _Pragma("unroll") for (int m = 0; m < 4; ++m) _Pragma("unroll") for (int n = 0; n < 2; ++n) _Pragma("unroll") for (int k = 0; k < 2; ++k) \
        acc[ai][bj][m][n] = __builtin_amdgcn_mfma_f32_16x16x32_bf16(Bt[n][k], At[m][k], acc[ai][bj][m][n], 0, 0, 0); __builtin_amdgcn_s_setprio(0); } while (0)
#define PG8_WAIT_V(n) asm volatile("s_waitcnt vmcnt(" #n ")" ::: "memory")
#define PG8_WAIT_L(n) asm volatile("s_waitcnt lgkmcnt(" #n ")" ::: "memory")
#define PG8_BAR __builtin_amdgcn_s_barrier()
#define PG8_SCHED __builtin_amdgcn_sched_barrier(0)
    Unit cur, nxt; int ui = 0;
    if (!S.next(0, cur)) return;
    f32x4 acc[2][2][4][2];
#pragma unroll
    for (int a = 0; a < 2; ++a)
#pragma unroll
        for (int b = 0; b < 2; ++b)
#pragma unroll
            for (int m = 0; m < 4; ++m)
#pragma unroll
                for (int n = 0; n < 2; ++n) acc[a][b][m][n] = (f32x4){0.f, 0.f, 0.f, 0.f};
    bf16x8 At[4][2], B0[2][2], B1[2][2];
    const char* cA = (const char*)g.A + (size_t)cur.pm * tstep; const char* cB = (const char*)g.Bt + (size_t)cur.pn * tstep;
    S.a_ready(cur);
    PG8_STAGE(PG8_SB(0, 0), cB, voffB); PG8_STAGE(PG8_SA(0, 0), cA, voffA); PG8_STAGE(PG8_SB(0, 1), cB + hstep, voffB); PG8_STAGE(PG8_SA(0, 1), cA + hstep, voffA);
    if (wr == 1) PG8_BAR;
    PG8_WAIT_V(4); PG8_BAR;
    PG8_STAGE(PG8_SB(1, 0), cB + kstep, voffB); PG8_STAGE(PG8_SA(1, 0), cA + kstep, voffA); PG8_STAGE(PG8_SB(1, 1), cB + hstep + kstep, voffB);
    PG8_WAIT_V(6); PG8_BAR;
    for (;;) {
        const bool has_next = S.next(ui + 1, nxt);
        const char* nA = has_next ? (const char*)g.A + (size_t)nxt.pm * tstep : cA; const char* nB = has_next ? (const char*)g.Bt + (size_t)nxt.pn * tstep : cB;
        for (int t = 0; t < nt; t += 2) {
            const bool last = (t == nt - 2);
            const char* a1 = cA + (size_t)(t + 1) * kstep;
            const char* a2 = last ? nA : cA + (size_t)(t + 2) * kstep; const char* b2 = last ? nB : cB + (size_t)(t + 2) * kstep;
            const char* a3 = a2 + kstep; const char* b3 = b2 + kstep;
            if (last && has_next) S.a_ready(nxt);
            PG8_LDB(B0, 0, 0); PG8_SCHED; PG8_LDA(At, 0, 0); PG8_STAGE(PG8_SA(1, 1), a1 + hstep, voffA);
            PG8_WAIT_L(8); PG8_BAR; PG8_WAIT_L(0); PG8_MMA(0, 0, At, B0); PG8_BAR; PG8_SCHED;
            PG8_LDB(B1, 0, 1); PG8_STAGE(PG8_SB(0, 0), b2, voffB);
            PG8_BAR; PG8_WAIT_L(0); PG8_MMA(0, 1, At, B1); PG8_BAR;
            PG8_LDA(At, 0, 1); PG8_STAGE(PG8_SA(0, 0), a2, voffA);
            PG8_BAR; PG8_WAIT_L(0); PG8_MMA(1, 0, At, B0); PG8_BAR; PG8_SCHED;
            PG8_STAGE(PG8_SB(0, 1), b2 + hstep, voffB);
            PG8_WAIT_V(6); PG8_BAR; PG8_MMA(1, 1, At, B1); PG8_BAR;
            PG8_LDB(B0, 1, 0); PG8_SCHED; PG8_LDA(At, 1, 0); PG8_STAGE(PG8_SA(0, 1), a2 + hstep, voffA);
            PG8_WAIT_L(8); PG8_BAR; PG8_WAIT_L(0); PG8_MMA(0, 0, At, B0); PG8_BAR; PG8_SCHED;
            PG8_LDB(B1, 1, 1); PG8_STAGE(PG8_SB(1, 0), b3, voffB);
            PG8_BAR; PG8_WAIT_L(0); PG8_MMA(0, 1, At, B1); PG8_BAR;
            PG8_LDA(At, 1, 1); PG8_STAGE(PG8_SA(1, 0), a3, voffA);
            PG8_BAR; PG8_WAIT_L(0); PG8_MMA(1, 0, At, B0); PG8_BAR; PG8_SCHED;
            PG8_STAGE(PG8_SB(1, 1), b3 + hstep, voffB);
            PG8_WAIT_V(6); PG8_BAR; PG8_MMA(1, 1, At, B1); PG8_BAR;
        }
        if constexpr (!Epi::AFTER_DRAIN) { E(acc, cur, wr, wc, fr, fq); S.done(cur); }
        if (!has_next) break;
#pragma unroll
        for (int a = 0; a < 2; ++a)
#pragma unroll
            for (int b = 0; b < 2; ++b)
#pragma unroll
                for (int m = 0; m < 4; ++m)
#pragma unroll
                    for (int n = 0; n < 2; ++n) acc[a][b][m][n] = (f32x4){0.f, 0.f, 0.f, 0.f};
        cur = nxt; cA = nA; cB = nB; ++ui;
    }
    PG8_WAIT_V(0);
    if (wr == 0) PG8_BAR;
    PG8_BAR;
    if constexpr (Epi::AFTER_DRAIN) { E.fused(acc, cur, wr, wc, fr, fq, lds, wid, lane); S.done(cur); }
#undef PG8_SA
#undef PG8_SB
#undef PG8_STAGE
#undef PG8_LDA
#undef PG8_LDB
#undef PG8_MMA
#undef PG8_WAIT_V
#undef PG8_WAIT_L
#undef PG8_BAR
#undef PG8_SCHED
}
}

__device__ void phase_mod(PP p, float* lds) {
    const int TIDX = otid();
    const int tid = TIDX;
    float* s = lds;
    float* red = lds + 3 * 2048;
    float* MOD = (float*)(p->ws + OFF_MOD);
    for (int i = tid; i < 3 * 2048; i += 512) { const int r = i >> 11, k = i & 2047; const float c = r < 2 ? p->in[I_C][r * 2048 + k] : p->in[I_CCTX][k]; s[i] = c * sigmoidf(c); }
    __syncthreads();
    for (int task = blockIdx.x; task < 192; task += gridDim.x) {
        const int l = task / 96, j0 = (task % 96) * 128, jc = tid & 127, kp = tid >> 7;
        const float* w = p->in[I_WMOD] + (size_t)l * 2048 * 12288 + j0 + jc;
        float a0 = 0.f, a1 = 0.f, a2 = 0.f;
#pragma unroll 8
        for (int k = kp * 512; k < kp * 512 + 512; ++k) { const float wv = w[(size_t)k * 12288]; a0 += s[k] * wv; a1 += s[2048 + k] * wv; a2 += s[4096 + k] * wv; }
        red[(kp * 3 + 0) * 128 + jc] = a0; red[(kp * 3 + 1) * 128 + jc] = a1; red[(kp * 3 + 2) * 128 + jc] = a2;
        __syncthreads();
        if (tid < 384) { const int r = tid >> 7, j = tid & 127;
            const float v = ((red[(0 * 3 + r) * 128 + j] + red[(1 * 3 + r) * 128 + j]) + (red[(2 * 3 + r) * 128 + j] + red[(3 * 3 + r) * 128 + j])) + p->in[I_BMOD][l * 12288 + j0 + j];
            MOD[(size_t)(l * 3 + r) * 12288 + j0 + j] = v; }
        __syncthreads();
    }
    if (blockIdx.x == gridDim.x - 1) {
        float* rc = (float*)(p->ws + OFF_ROPE); float* rs = rc + 2048;
        for (int i = tid; i < 2048; i += 512) { const int pos = i >> 5, j = i & 31; const float fr = powf(10000.0f, -(float)j / 32.0f); const float ang = (float)pos * fr; rc[i] = cosf(ang); rs[i] = sinf(ang); }
    }
}

__device__ void conv_tile(const float* __restrict__ src, int ld_src, int n_valid, int n0, int k0, bf16_t* __restrict__ dst, int ld_dst, float* tile) {
    const int TIDX = otid();
    const int tid = TIDX;
#pragma unroll
    for (int i = 0; i < 2; ++i) { const int kr = (tid >> 4) + i * 32, nc = (tid & 15) * 4; const float* sp = src + (size_t)(k0 + kr) * ld_src + n0 + nc;
        f32x4 v;
        if (n0 + nc + 3 < n_valid) v = *(const f32x4*)sp;
        else { v[0] = (n0 + nc + 0 < n_valid) ? sp[0] : 0.f; v[1] = (n0 + nc + 1 < n_valid) ? sp[1] : 0.f; v[2] = (n0 + nc + 2 < n_valid) ? sp[2] : 0.f; v[3] = (n0 + nc + 3 < n_valid) ? sp[3] : 0.f; }
        float* tp = tile + kr * 65 + nc; tp[0] = v[0]; tp[1] = v[1]; tp[2] = v[2]; tp[3] = v[3]; }
    __syncthreads();
    { const int n = tid >> 3, kc = (tid & 7) * 8; u32x4 o;
#pragma unroll
        for (int j = 0; j < 4; ++j) o[j] = pack2(tile[(kc + 2 * j) * 65 + n], tile[(kc + 2 * j + 1) * 65 + n]);
        *(u32x4*)(dst + (size_t)(n0 + n) * ld_dst + k0 + kc) = o; }
    __syncthreads();
}
__device__ void phase_convert(PP p, int l, float* lds, int vb, int vg, size_t wsh, int t_lo, int t_hi, bool lora) {
    const int TIDX = otid();
    unsigned char* wsw = p->ws + wsh;
    for (int t = t_lo + vb; t < t_hi; t += vg) {
        if (t < 8064) { const int nt = t >> 5, kt = t & 31; conv_tile(p->in[I_WIN] + (size_t)l * 2048 * DIN, DIN, DIN, nt * 64, kt * 64, (bf16_t*)(wsw + OFF_WIN), 2048, lds); }
        else if (t < 9600) { const int tt = t - 8064, br = tt >> 9, r = tt & 511, nt = r >> 4, kt = r & 15;
            conv_tile(p->in[I_WBR] + (size_t)(l * 3 + br) * 1024 * 2048, 2048, 2048, nt * 64, kt * 64, (bf16_t*)(wsw + OFF_WBR) + (size_t)br * 2048 * 1024, 1024, lds); }
        else if (t < 10624) { const int tt = t - 9600, nt = tt >> 5, kt = tt & 31; conv_tile(p->in[I_WOUT] + (size_t)l * 2048 * 2048, 2048, 2048, nt * 64, kt * 64, (bf16_t*)(wsw + OFF_WOUT), 2048, lds); }
        else if (t < 14720) { const int tt = t - 10624, nt = tt >> 5, kt = tt & 31; conv_tile(p->in[I_WFF1] + (size_t)l * 2048 * 8192, 8192, 8192, nt * 64, kt * 64, (bf16_t*)(wsw + OFF_WFF1), 2048, lds); }
        else { const int tt = t - 14720, nt = tt >> 7, kt = tt & 127; conv_tile(p->in[I_WFF2] + (size_t)l * 8192 * 2048, 2048, 2048, nt * 64, kt * 64, (bf16_t*)(wsw + OFF_WFF2), 8192, lds); }
    }
    bf16_t* WL = (bf16_t*)(wsw + OFF_WLORA);
    if (lora) for (int idx = vb * 512 + TIDX; idx < 5120 * 640; idx += vg * 512) {
        const int n = idx / 640, k = idx - n * 640, blk = n >> 10, nn = n & 1023;
        const int k0 = blk < 4 ? blk * 96 : 384, kw = blk < 4 ? 96 : 256;
        float v = 0.f;
        if (k >= k0 && k < k0 + kw) {
            const float* sp = blk < 2 ? p->in[I_RWWUP] + (size_t)(l * 2 + blk) * 96 * 1024 : (blk < 4 ? p->in[I_RWAUP] + (size_t)(l * 2 + blk - 2) * 96 * 1024 : p->in[I_RWGUP] + (size_t)l * 256 * 1024);
            v = sp[(size_t)(k - k0) * 1024 + nn]; }
        WL[idx] = f2bf(v);
    }
}
__device__ void phase_init(PP p, int l) {
    const int TIDX = otid();
    if (blockIdx.x == 0 && TIDX < 8) ((unsigned*)(p->ws + OFF_CTL))[l * 8 + TIDX] = 0u;
}

__device__ __forceinline__ void phase_norm(const float* __restrict__ xlat, const float* __restrict__ xctx, int nrows, const float* __restrict__ g, const float* __restrict__ modl, int ishift, int iscale, bf16_t* __restrict__ H,
                           const float* part = nullptr, const float* pgate = nullptr, float* xl_ctx = nullptr) {
    const int TIDX = otid();
    const int wid = TIDX >> 6, lane = TIDX & 63;
    for (int row = blockIdx.x * 8 + wid; row < nrows; row += gridDim.x * 8) {
        const float* xr = row < NLAT ? xlat + (size_t)row * 2048 : xctx + (size_t)(row - NLAT) * 2048;
        const int mrow = row < NLAT ? (row >> 12) : 2;
        const float* sh = modl + (size_t)mrow * 12288 + ishift * 2048; const float* sc = modl + (size_t)mrow * 12288 + iscale * 2048;
        f32x4 v[8]; float ss = 0.f;
#pragma unroll
        for (int i = 0; i < 8; ++i) v[i] = *(const f32x4*)(xr + (i * 64 + lane) * 4);
        if (part != nullptr && row >= NLAT) {
#pragma unroll
            for (int i = 0; i < 8; ++i) { const int col = (i * 64 + lane) * 4; const float* pp = part + (size_t)(row - NLAT) * 2048 + col;
                f32x4 a = *(const f32x4*)pp;
#pragma unroll
                for (int s_ = 1; s_ < 16; ++s_) a += *(const f32x4*)(pp + (size_t)s_ * 512 * 2048);
                v[i] += *(const f32x4*)(pgate + col) * a;
                *(f32x4*)(xl_ctx + (size_t)(row - NLAT) * 2048 + col) = v[i]; } }
#pragma unroll
        for (int i = 0; i < 8; ++i) ss += v[i][0] * v[i][0] + v[i][1] * v[i][1] + v[i][2] * v[i][2] + v[i][3] * v[i][3];
        ss = wsum(ss);
        const float r = rsqrtf(ss * (1.0f / 2048.0f) + 1e-6f);
#pragma unroll
        for (int i = 0; i < 8; ++i) { const int col = (i * 64 + lane) * 4; const f32x4 gg = *(const f32x4*)(g + col), s1 = *(const f32x4*)(sc + col), s0 = *(const f32x4*)(sh + col);
            float o[4];
#pragma unroll
            for (int j = 0; j < 4; ++j) o[j] = (v[i][j] * r * gg[j]) * (1.0f + s1[j]) + s0[j];
            u32x2 w; w[0] = pack2(o[0], o[1]); w[1] = pack2(o[2], o[3]);
            *(u32x2*)(H + (size_t)row * 2048 + col) = w; }
    }
}
__device__ void phase_final(PP p) {
    const int TIDX = otid();
    const int wid = TIDX >> 6, lane = TIDX & 63;
    const float* XL = (const float*)(p->ws + OFF_XL); const float* g = p->in[I_FING];
    for (int row = blockIdx.x * 8 + wid; row < NLAT; row += gridDim.x * 8) {
        const float* xr = XL + (size_t)row * 2048;
        f32x4 v[8]; float ss = 0.f;
#pragma unroll
        for (int i = 0; i < 8; ++i) { v[i] = *(const f32x4*)(xr + (i * 64 + lane) * 4); ss += v[i][0] * v[i][0] + v[i][1] * v[i][1] + v[i][2] * v[i][2] + v[i][3] * v[i][3]; }
        ss = wsum(ss);
        const float r = rsqrtf(ss * (1.0f / 2048.0f) + 1e-6f);
#pragma unroll
        for (int i = 0; i < 8; ++i) { const int col = (i * 64 + lane) * 4; const f32x4 gg = *(const f32x4*)(g + col);
            f32x4 o; o[0] = v[i][0] * r * gg[0]; o[1] = v[i][1] * r * gg[1]; o[2] = v[i][2] * r * gg[2]; o[3] = v[i][3] * r * gg[3];
            *(f32x4*)(p->out + (size_t)row * 2048 + col) = o; }
    }
}

DEVI void seq_nbrs(int row, bool& hp, bool& hn) {
    if (row < NLAT) { const int t = row & 4095; hp = t > 0; hn = t < 4095; } else { const int m = (row - NLAT) & 255; hp = m > 0; hn = m < 255; }
}
DEVI float shiftf(float c, float pv, float nx, float mu) { return c + mu * (0.5f * (pv + nx) - c); }

__device__ void phase_prep(PP p, int l, bf16_t* ldsT) {
    const int TIDX = otid();
    const bf16_t* P = (const bf16_t*)(p->ws + OFF_P); bf16_t* LA = (bf16_t*)(p->ws + OFF_LA);
    const float* mu = p->in[I_RWMU] + (size_t)l * 3712 + 3072;
    for (int idx = blockIdx.x * 512 + TIDX; idx < NTOK * 80; idx += gridDim.x * 512) {
        const int row = idx / 80, j = (idx - row * 80) * 8;
        bool hp, hn; seq_nbrs(row, hp, hn);
        const bf16_t* pc = P + (size_t)row * NP + RWB + 3072 + j;
        const u32x4 c = *(const u32x4*)pc;
        const u32x4 z = {0u, 0u, 0u, 0u};
        const u32x4 pv = hp ? *(const u32x4*)(pc - NP) : z, nx = hn ? *(const u32x4*)(pc + NP) : z;
        float o[8];
#pragma unroll
        for (int q = 0; q < 4; ++q) { o[2 * q] = shiftf(bflo(c[q]), bflo(pv[q]), bflo(nx[q]), mu[j + 2 * q]); o[2 * q + 1] = shiftf(bfhi(c[q]), bfhi(pv[q]), bfhi(nx[q]), mu[j + 2 * q + 1]); }
        if (j < 192) {
#pragma unroll
            for (int q = 0; q < 8; ++q) o[q] = (1.0f - 2.0f * __builtin_amdgcn_rcpf(1.0f + __expf(2.0f * o[q]))); }
        else if (j >= 384) {
#pragma unroll
            for (int q = 0; q < 8; ++q) o[q] = sigmoidf(o[q]); }
        u32x4 w; w[0] = pack2(o[0], o[1]); w[1] = pack2(o[2], o[3]); w[2] = pack2(o[4], o[5]); w[3] = pack2(o[6], o[7]);
        *(u32x4*)(LA + (size_t)row * 640 + j) = w;
    }
    bf16_t* VT = (bf16_t*)(p->ws + OFF_VT);
    const int tid = TIDX;
    for (int t = blockIdx.x; t < 136 * 16; t += gridDim.x) {
        const int rt = t >> 4, hd = t & 15, h = hd >> 1, dh = hd & 1;
        const int row0 = rt * 64;
        { const int tl = tid >> 3, dc = (tid & 7) * 8;
            const u32x4 v = *(const u32x4*)(P + (size_t)(row0 + tl) * NP + NAB + 2048 + h * 128 + dh * 64 + dc);
            bf16_t* tp = ldsT + tl * 66 + dc;
#pragma unroll
            for (int q = 0; q < 4; ++q) { tp[2 * q] = (bf16_t)(v[q] & 0xffffu); tp[2 * q + 1] = (bf16_t)(v[q] >> 16); } }
        __syncthreads();
        { const int d = tid >> 3, tc = (tid & 7) * 8;
            int b, pos; if (row0 < NLAT) { b = row0 >> 12; pos = row0 & 4095; } else { b = (row0 - NLAT) >> 8; pos = 4096 + ((row0 - NLAT) & 255); }
            u32x4 o;
#pragma unroll
            for (int q = 0; q < 4; ++q) o[q] = (unsigned)ldsT[(tc + 2 * q) * 66 + d] | ((unsigned)ldsT[(tc + 2 * q + 1) * 66 + d] << 16);
            *(u32x4*)(VT + ((size_t)((b * 8 + h) * 128 + dh * 64 + d)) * 4352 + pos + tc) = o; }
        __syncthreads();
    }
}

DEVI int scan_row(int s, int b, int dir) {
    if (s < 256) { const int m = dir ? 255 - s : s; return NLAT + b * 256 + m; }
    const int t = dir ? 4095 - (s - 256) : s - 256; return b * 4096 + t;
}
__device__ void rwkv_scan(PP p, int l, int task, float* lds) {
    const int TIDX = otid();
    const int chain = task >> 1, half = task & 1;
    const int b = chain >> 5, h = (chain >> 1) & 15, dir = chain & 1, tid = TIDX;
    const bf16_t* P = (const bf16_t*)(p->ws + OFF_P); const bf16_t* LO = (const bf16_t*)(p->ws + OFF_LO);
    float* YO = (float*)(p->ws + OFF_YRWF) + (size_t)dir * NTOK * 1024 + h * 64;
    const int sl = tid >> 5, e2 = (tid & 31) * 2, ch = h * 64 + e2;
    const float* MU = p->in[I_RWMU] + (size_t)l * 3712;
    const float mur0 = MU[ch], mur1 = MU[ch + 1], muk0 = MU[1024 + ch], muk1 = MU[1024 + ch + 1], muv0 = MU[2048 + ch], muv1 = MU[2048 + ch + 1];
    const float w00 = p->in[I_RWW0][(l * 2 + dir) * 1024 + ch], w01 = p->in[I_RWW0][(l * 2 + dir) * 1024 + ch + 1];
    const float a00 = p->in[I_RWA0][(l * 2 + dir) * 1024 + ch], a01 = p->in[I_RWA0][(l * 2 + dir) * 1024 + ch + 1];
    const float kk0 = p->in[I_RWKK][l * 1024 + ch], kk1 = p->in[I_RWKK][l * 1024 + ch + 1], ka0 = p->in[I_RWKA][l * 1024 + ch], ka1 = p->in[I_RWKA][l * 1024 + ch + 1];
    const float rk0 = p->in[I_RWRK][l * 1024 + ch], rk1 = p->in[I_RWRK][l * 1024 + ch + 1];
    float* RK = (float*)(p->ws + OFF_RK); const bool wrk = dir == 0 && half == 0; int srow = 0;
    const int kq = tid & 15, v = half * 32 + (tid >> 4);
    f32x2 S0 = (f32x2){0.f, 0.f}, S1 = (f32x2){0.f, 0.f};
    unsigned rc, rp, rn, kc, kp, kn, vc, vp, vn, wr_, ar_;
    auto issue = [&](int g) {
        const int row = scan_row(g * 16 + sl, b, dir); bool hp, hn; seq_nbrs(row, hp, hn); srow = row;
        const bf16_t* pr = P + (size_t)row * NP + RWB + ch;
        rc = *(const unsigned*)pr; kc = *(const unsigned*)(pr + 1024); vc = *(const unsigned*)(pr + 2048);
        rp = 0u; kp = 0u; vp = 0u; rn = 0u; kn = 0u; vn = 0u;
        if (hp) { rp = *(const unsigned*)(pr - NP); kp = *(const unsigned*)(pr - NP + 1024); vp = *(const unsigned*)(pr - NP + 2048); }
        if (hn) { rn = *(const unsigned*)(pr + NP); kn = *(const unsigned*)(pr + NP + 1024); vn = *(const unsigned*)(pr + NP + 2048); }
        const bf16_t* lo = LO + (size_t)row * 5120 + dir * 1024 + ch;
        wr_ = *(const unsigned*)lo; ar_ = *(const unsigned*)(lo + 2048);
    };
    auto commit = [&](int buf) {
        float* st = lds + buf * 6144 + sl * 384 + e2;
        const float r0 = shiftf(bflo(rc), bflo(rp), bflo(rn), mur0), r1 = shiftf(bfhi(rc), bfhi(rp), bfhi(rn), mur1);
        const float k0 = shiftf(bflo(kc), bflo(kp), bflo(kn), muk0), k1 = shiftf(bfhi(kc), bfhi(kp), bfhi(kn), muk1);
        const float v0 = shiftf(bflo(vc), bflo(vp), bflo(vn), muv0), v1 = shiftf(bfhi(vc), bfhi(vp), bfhi(vn), muv1);
        const float x0 = -(w00 + bflo(wr_)), x1 = -(w01 + bfhi(wr_));
        const float sp0 = x0 > 20.f ? x0 : __logf(1.0f + __expf(x0)), sp1 = x1 > 20.f ? x1 : __logf(1.0f + __expf(x1));
        const float d0 = __expf(-__expf(-sp0 - 0.5f)), d1 = __expf(-__expf(-sp1 - 0.5f));
        const float ar0 = fsigmoid(a00 + bflo(ar_)), ar1 = fsigmoid(a01 + bfhi(ar_));
        const float kd0 = k0 * (1.0f + (ar0 - 1.0f) * ka0), kd1 = k1 * (1.0f + (ar1 - 1.0f) * ka1);
        const float q0 = k0 * kk0, q1 = k1 * kk1;
        float ss = red16(q0 * q0 + q1 * q1);
        ss += __shfl_xor(ss, 16);
        const float inv = frcp(fmaxf(__builtin_amdgcn_sqrtf(ss), 1e-12f));
        const float n0 = q0 * inv, n1 = q1 * inv;
        if (wrk) { float t = red16(r0 * k0 * rk0 + r1 * k1 * rk1); t += __shfl_xor(t, 16); if ((tid & 31) == 0) RK[srow * 16 + h] = t; }
        *(f32x2*)(st + 0) = (f32x2){r0, r1}; *(f32x2*)(st + 64) = (f32x2){d0, d1}; *(f32x2*)(st + 128) = (f32x2){kd0, kd1};
        *(f32x2*)(st + 192) = (f32x2){v0, v1}; *(f32x2*)(st + 256) = (f32x2){-n0, -n1}; *(f32x2*)(st + 320) = (f32x2){n0 * ar0, n1 * ar1};
    };
    __syncthreads();
    issue(0); commit(0);
    __syncthreads();
    constexpr int NG = 4352 / 16;
    for (int g = 0; g < NG; ++g) {
        if (g + 1 < NG) issue(g + 1);
        {
            const float* base = lds + (g & 1) * 6144 + kq * 4;
            float ykeep = 0.f;
            f32x4 nA, nD, nB, nK, nR; float nV;
#define RW_LOAD(i_) do { const float* st_ = base + (i_) * 384; nA = *(const f32x4*)(st_ + 256); nD = *(const f32x4*)(st_ + 64); nB = *(const f32x4*)(st_ + 320); nK = *(const f32x4*)(st_ + 128); nR = *(const f32x4*)(st_); \
                nV = st_[192 - kq * 4 + v]; } while (0)
            RW_LOAD(0);
#pragma unroll
            for (int i = 0; i < 16; ++i) {
                const f32x4 a = nA, d = nD, bb = nB, k = nK, r = nR; const float vv = nV;
                if (i < 15) { RW_LOAD(i + 1); }
                __builtin_amdgcn_sched_barrier(0x77);
                f32x2 pa2 = S0 * (f32x2){a[0], a[1]}; pa2 = S1 * (f32x2){a[2], a[3]} + pa2;
                const f32x2 vvb = (f32x2){vv, vv};
                const f32x2 u0 = S0 * (f32x2){d[0], d[1]} + vvb * (f32x2){k[0], k[1]}, u1 = S1 * (f32x2){d[2], d[3]} + vvb * (f32x2){k[2], k[3]};
                const float pa = red16(pa2[0] + pa2[1]);
                const f32x2 pab = (f32x2){pa, pa};
                S0 = pab * (f32x2){bb[0], bb[1]} + u0; S1 = pab * (f32x2){bb[2], bb[3]} + u1;
                f32x2 y2 = S0 * (f32x2){r[0], r[1]}; y2 = S1 * (f32x2){r[2], r[3]} + y2;
                const float y = red16(y2[0] + y2[1]);
                ykeep = (kq == i) ? y : ykeep;
            }
#undef RW_LOAD
            YO[(size_t)scan_row(g * 16 + kq, b, dir) * 1024 + v] = ykeep;
        }
        if (g + 1 < NG) commit((g + 1) & 1);
        __syncthreads();
    }
}

__device__ void mlstm_scan(PP p, int l, int chain, int g8, float* lds) {
    const int TIDX = otid();
    const int b = chain >> 3, h = (chain >> 1) & 3, dir = chain & 1, tid = TIDX;
    const bf16_t* P = (const bf16_t*)(p->ws + OFF_P);
    const float* RC = (const float*)(p->ws + OFF_ROPE); const float* RS = RC + 2048;
    float* NO = (float*)(p->ws + OFF_MLNUM) + (size_t)dir * NTOK * 4 * 272 + h * 272;
    const int sl = tid >> 5, j = tid & 31;
    const float gbi = p->in[I_MLGB][l * 16 + (dir * 2 + 0) * 4 + h], gbf = p->in[I_MLGB][l * 16 + (dir * 2 + 1) * 4 + h];
    const int rowl = (tid >> 3) & 31, kq = tid & 7, crow = g8 * 32 + rowl, lane = tid & 63;
    f32x2 C[8];
#pragma unroll
    for (int i = 0; i < 8; ++i) C[i] = (f32x2){0.f, 0.f};
    f32x2 nst = (f32x2){0.f, 0.f};
    bf16_t q0, q1, q2, q3, k0, k1, k2, k3, gi, gf; unsigned vv2; float cr, sr, cc, sc;
    auto issue = [&](int g) {
        const int row = scan_row(g * 16 + sl, b, dir);
        const bf16_t* pr = P + (size_t)row * NP;
        const bf16_t* pq = pr + h * 128 + j; const bf16_t* pk = pr + 512 + h * 128 + j;
        q0 = pq[0]; q1 = pq[32]; q2 = pq[64]; q3 = pq[96]; k0 = pk[0]; k1 = pk[32]; k2 = pk[64]; k3 = pk[96];
        vv2 = j < 16 ? *(const unsigned*)(pr + 1024 + h * 256 + g8 * 32 + 2 * j) : 0u;
        gi = pr[3072 + (dir * 2 + 0) * 4 + h]; gf = pr[3072 + (dir * 2 + 1) * 4 + h];
        if (row < NLAT) { const int t = row & 4095, pr_ = t >> 6, pc_ = t & 63; cr = RC[pr_ * 32 + j]; sr = RS[pr_ * 32 + j]; cc = RC[pc_ * 32 + j]; sc = RS[pc_ * 32 + j]; }
        else { cr = 1.f; sr = 0.f; cc = 1.f; sc = 0.f; }
    };
    auto commit = [&](int buf) {
        float* st = lds + buf * 5376 + sl * 336;
        const float scale = 0.08838834764831845f;
        const float a0 = bf2f(q0), a1 = bf2f(q1), a2 = bf2f(q2), a3 = bf2f(q3);
        st[j] = (a0 * cr - a1 * sr) * scale; st[32 + j] = (a0 * sr + a1 * cr) * scale; st[64 + j] = (a2 * cc - a3 * sc) * scale; st[96 + j] = (a2 * sc + a3 * cc) * scale;
        const float c0 = bf2f(k0), c1 = bf2f(k1), c2 = bf2f(k2), c3 = bf2f(k3);
        st[128 + j] = c0 * cr - c1 * sr; st[160 + j] = c0 * sr + c1 * cr; st[192 + j] = c2 * cc - c3 * sc; st[224 + j] = c2 * sc + c3 * cc;
        if (j < 16) { st[256 + 2 * j] = bflo(vv2); st[257 + 2 * j] = bfhi(vv2); }
        if (j == 0) { st[320] = fsigmoid(bf2f(gf) + gbf); st[321] = __expf(bf2f(gi) + gbi); }
    };
    __syncthreads();
    issue(0); commit(0);
    __syncthreads();
    constexpr int NG = 4352 / 16;
    for (int g = 0; g < NG; ++g) {
        if (g + 1 < NG) issue(g + 1);
        const float* base = lds + (g & 1) * 5376;
        if (tid < 256) {
            float nkeep = 0.f, Fc = 1.0f;
            f32x4 nK[4], nQ[4]; float nF, nI, nV0;
#define ML_LOAD(i_) do { const float* st_ = base + (i_) * 336; _Pragma("unroll") for (int c4 = 0; c4 < 4; ++c4) { nK[c4] = *(const f32x4*)(st_ + 128 + c4 * 32 + kq * 4); nQ[c4] = *(const f32x4*)(st_ + c4 * 32 + kq * 4); } \
                nF = st_[320]; nI = st_[321]; nV0 = st_[256 + rowl]; } while (0)
            ML_LOAD(0);
#pragma unroll
            for (int i = 0; i < 16; ++i) {
                f32x4 kk[4], qq[4];
#pragma unroll
                for (int c4 = 0; c4 < 4; ++c4) { kk[c4] = nK[c4]; qq[c4] = nQ[c4]; }
                if (Fc < 1e-18f) {
                    const f32x2 fb = (f32x2){Fc, Fc};
#pragma unroll
                    for (int x = 0; x < 8; ++x) C[x] = C[x] * fb;
                    Fc = 1.0f; }
                Fc *= nF;
                const float coef = nI * nV0 * frcp(Fc);
                if (i < 15) { ML_LOAD(i + 1); }
                __builtin_amdgcn_sched_barrier(0x77);
                const f32x2 cf = (f32x2){coef, coef};
                f32x2 num2 = (f32x2){0.f, 0.f}, num3 = (f32x2){0.f, 0.f};
#pragma unroll
                for (int c4 = 0; c4 < 4; ++c4) {
                    const f32x2 KA = (f32x2){kk[c4][0], kk[c4][1]}, KB = (f32x2){kk[c4][2], kk[c4][3]}, QA = (f32x2){qq[c4][0], qq[c4][1]}, QB = (f32x2){qq[c4][2], qq[c4][3]};
                    C[2 * c4] = cf * KA + C[2 * c4]; C[2 * c4 + 1] = cf * KB + C[2 * c4 + 1];
                    num2 = C[2 * c4] * QA + num2; num3 = C[2 * c4 + 1] * QB + num3; }
                num2 += num3;
                const float num = red8(num2[0] + num2[1]) * Fc;
                nkeep = (kq == (i & 7)) ? num : nkeep;
                if ((i & 7) == 7) NO[(size_t)scan_row(g * 16 + (i - 7) + kq, b, dir) * (4 * 272) + crow] = nkeep;
            }
            { const f32x2 fb = (f32x2){Fc, Fc};
#pragma unroll
                for (int x = 0; x < 8; ++x) C[x] = C[x] * fb; }
#undef ML_LOAD
        } else if (g8 == 0 && tid < 320) {
            float nkeep = 0.f;
            f32x2 nk, nq; float nf, ni;
#define MN_LOAD(i_) do { const float* st_ = base + (i_) * 336; nk = *(const f32x2*)(st_ + 128 + 2 * lane); nq = *(const f32x2*)(st_ + 2 * lane); nf = st_[320]; ni = st_[321]; } while (0)
            MN_LOAD(0);
#pragma unroll
            for (int i = 0; i < 16; ++i) {
                const f32x2 kk = nk, qq = nq; const float f = nf, ig = ni;
                if (i < 15) { MN_LOAD(i + 1); }
                __builtin_amdgcn_sched_barrier(0x77);
                nst = (f32x2){f, f} * nst + (f32x2){ig, ig} * kk;
                const f32x2 d2 = nst * qq;
                const float den16 = red16(d2[0] + d2[1]);
                nkeep = ((lane & 15) == i) ? den16 : nkeep;
            }
#undef MN_LOAD
            nkeep += __shfl_xor(nkeep, 16); nkeep += __shfl_xor(nkeep, 32);
            if (lane < 16) NO[(size_t)scan_row(g * 16 + lane, b, dir) * (4 * 272) + 256] = nkeep;
        }
        if (g + 1 < NG) commit((g + 1) & 1);
        __syncthreads();
    }
}

#define MFMA16(a, b, c) __builtin_amdgcn_mfma_f32_16x16x32_bf16(a, b, c, 0, 0, 0)
__device__ void na_wave(PP p, int l, int task) {
    const int TIDX = otid();
    const bf16_t* P = (const bf16_t*)(p->ws + OFF_P); const bf16_t* VT = (const bf16_t*)(p->ws + OFF_VT);
    bf16_t* YN = (bf16_t*)(p->ws + OFF_Y3) + 2ull * NTOK * 1024;
    const int w = TIDX >> 6, lane = TIDX & 63, n16 = lane & 15, g = lane >> 4;
    int b, h, qrow, r = 0, qcol = 0, cs = 0, row_start = 0, c_start = 0; bool lat;
    if (task < 512) { lat = true; b = task >> 8; h = (task >> 5) & 7; const int pair = task & 31; r = pair * 2 + (w >> 2); const int qi = w & 3; qcol = qi * 16 + n16;
        qrow = b * 4096 + r * 64 + qcol; cs = qi == 0 ? 0 : (qi == 1 ? 8 : (qi == 2 ? 24 : 32)); row_start = min(max(r - 4, 0), 56); c_start = min(max(qcol - 8, 0), 48); }
    else { lat = false; const int t2 = task - 512; b = t2 >> 4; h = (t2 >> 1) & 7; const int chunk = t2 & 1; qrow = NLAT + b * 256 + chunk * 128 + w * 16 + n16; }
    bf16x8 qf[4];
#pragma unroll
    for (int c = 0; c < 4; ++c) qf[c] = *(const bf16x8*)(P + (size_t)qrow * NP + NAB + h * 128 + c * 32 + g * 8);
    const float* rpb = p->in[I_RPB] + (size_t)(l * 8 + h) * 15 * 31;
    const bf16_t* vtb = VT + (size_t)((b * 8 + h) * 128) * 4352;
    f32x4 O[8];
#pragma unroll
    for (int i = 0; i < 8; ++i) O[i] = (f32x4){0.f, 0.f, 0.f, 0.f};
    float mrun = -INFINITY, lsum = 0.f;
    const float scale = 0.08838834764831845f;
    for (int pass = lat ? 0 : 2; pass < 4; ++pass) {
        f32x4 S[8];
#pragma unroll
        for (int i = 0; i < 8; ++i) {
            int krowtok;
            if (pass < 2) { const int krow = row_start + pass * 4 + (i >> 1); krowtok = b * 4096 + krow * 64 + cs + (i & 1) * 16 + n16; }
            else krowtok = NLAT + b * 256 + (pass - 2) * 128 + i * 16 + n16;
            const bf16_t* kp = P + (size_t)krowtok * NP + NAB + 1024 + h * 128 + g * 8;
            f32x4 acc = (f32x4){0.f, 0.f, 0.f, 0.f};
#pragma unroll
            for (int c = 0; c < 4; ++c) { const bf16x8 kf = *(const bf16x8*)(kp + c * 32); acc = MFMA16(kf, qf[c], acc); }
            S[i] = acc;
        }
        float mx = -INFINITY;
#pragma unroll
        for (int i = 0; i < 8; ++i) {
            if (pass < 2) { const int krow = row_start + pass * 4 + (i >> 1); const float* rb = rpb + (krow - r + 7) * 31;
#pragma unroll
                for (int jj = 0; jj < 4; ++jj) { const int kc = cs + (i & 1) * 16 + 4 * g + jj; const bool ok = (kc >= c_start) && (kc < c_start + 16);
                    const int co = min(max(kc - qcol, -15), 15) + 15;
                    S[i][jj] = ok ? S[i][jj] * scale + rb[co] : -INFINITY; } }
            else {
#pragma unroll
                for (int jj = 0; jj < 4; ++jj) S[i][jj] *= scale; }
#pragma unroll
            for (int jj = 0; jj < 4; ++jj) mx = fmaxf(mx, S[i][jj]);
        }
        mx = fmaxf(mx, __shfl_xor(mx, 16)); mx = fmaxf(mx, __shfl_xor(mx, 32));
        const float mnew = fmaxf(mrun, mx);
        const float alpha = __expf(mrun - mnew);
        mrun = mnew; lsum *= alpha;
#pragma unroll
        for (int i = 0; i < 8; ++i) { O[i][0] *= alpha; O[i][1] *= alpha; O[i][2] *= alpha; O[i][3] *= alpha; }
        bf16x8 pf[4];
#pragma unroll
        for (int c = 0; c < 4; ++c) {
            float e[8];
#pragma unroll
            for (int jj = 0; jj < 4; ++jj) { e[jj] = __expf(S[2 * c][jj] - mnew); e[4 + jj] = __expf(S[2 * c + 1][jj] - mnew); }
#pragma unroll
            for (int jj = 0; jj < 8; ++jj) lsum += e[jj];
            u32x4 u; u[0] = pack2(e[0], e[1]); u[1] = pack2(e[2], e[3]); u[2] = pack2(e[4], e[5]); u[3] = pack2(e[6], e[7]);
            pf[c] = __builtin_bit_cast(bf16x8, u);
        }
#pragma unroll
        for (int c = 0; c < 4; ++c) {
            int pos0, pos1;
            if (pass < 2) { const int krow = row_start + pass * 4 + c; pos0 = krow * 64 + cs + 4 * g; pos1 = pos0 + 16; }
            else { pos0 = 4096 + (pass - 2) * 128 + c * 32 + 4 * g; pos1 = pos0 + 16; }
#pragma unroll
            for (int dt = 0; dt < 8; ++dt) {
                const bf16_t* vp = vtb + (size_t)(dt * 16 + n16) * 4352;
                const bf16x4 v0 = *(const bf16x4*)(vp + pos0), v1 = *(const bf16x4*)(vp + pos1);
                const bf16x8 vf = __builtin_shufflevector(v0, v1, 0, 1, 2, 3, 4, 5, 6, 7);
                O[dt] = MFMA16(vf, pf[c], O[dt]);
            }
        }
    }
    lsum += __shfl_xor(lsum, 16); lsum += __shfl_xor(lsum, 32);
    const float inv = 1.0f / lsum;
    bf16_t* yo = YN + (size_t)qrow * 1024 + h * 128 + 4 * g;
#pragma unroll
    for (int dt = 0; dt < 8; ++dt) { u32x2 o; o[0] = pack2(O[dt][0] * inv, O[dt][1] * inv); o[1] = pack2(O[dt][2] * inv, O[dt][3] * inv); *(u32x2*)(yo + dt * 16) = o; }
}

__device__ void na_block(PP p, int l, int task, unsigned char* lds) {
    const int TIDX = otid();
    const bf16_t* P = (const bf16_t*)(p->ws + OFF_P); const bf16_t* VT = (const bf16_t*)(p->ws + OFF_VT);
    bf16_t* YN = (bf16_t*)(p->ws + OFF_Y3) + 2ull * NTOK * 1024;
    const int tid = TIDX, w = tid >> 6, lane = tid & 63, n16 = lane & 15, g = lane >> 4, qi = w & 3, kh = w >> 2;
    const int b = task >> 9, h = (task >> 6) & 7, r = task & 63;
    const int qcol = qi * 16 + n16, qrow = b * 4096 + r * 64 + qcol;
    const int cs = qi == 0 ? 0 : (qi == 1 ? 8 : (qi == 2 ? 24 : 32)), row_start = min(max(r - 4, 0), 56), c_start = min(max(qcol - 8, 0), 48);
    unsigned char* KT = lds; unsigned char* VL = lds + 65536;
    bf16x8 qf[4];
#pragma unroll
    for (int c = 0; c < 4; ++c) qf[c] = *(const bf16x8*)(P + (size_t)qrow * NP + NAB + h * 128 + c * 32 + g * 8);
    const float* rpb = p->in[I_RPB] + (size_t)(l * 8 + h) * 15 * 31;
    const bf16_t* vtb = VT + (size_t)((b * 8 + h) * 128) * 4352;
    const bf16_t* kgb = P + NAB + 1024 + h * 128;
    f32x4 O[8];
#pragma unroll
    for (int i = 0; i < 8; ++i) O[i] = (f32x4){0.f, 0.f, 0.f, 0.f};
    float mrun = -INFINITY, lsum = 0.f;
    const float scale = 0.08838834764831845f;
    u32x4 kreg[8], vreg[8];
    auto gload = [&](int pass) {
#pragma unroll
        for (int i = 0; i < 8; ++i) { const int key = i * 32 + (tid >> 4), c16 = tid & 15, s_ = key >> 6, kk = key & 63;
            if (pass < 2) { const int krow = row_start + (s_ < 2 ? 2 * pass + s_ : 2 + 2 * pass + s_);
                kreg[i] = *(const u32x4*)(kgb + (size_t)(b * 4096 + krow * 64 + kk) * NP + c16 * 8); }
            else if (i < 4) { const int m = (s_ == 0 ? 0 : 128) + 64 * (pass - 2) + kk;
                kreg[i] = *(const u32x4*)(kgb + (size_t)(NLAT + b * 256 + m) * NP + c16 * 8); } }
#pragma unroll
        for (int i = 0; i < 8; ++i) { const int d = i * 16 + (tid >> 5), key8 = (tid & 31) * 8, s_ = key8 >> 6, kk = key8 & 63;
            if (pass < 2) { const int krow = row_start + (s_ < 2 ? 2 * pass + s_ : 2 + 2 * pass + s_);
                vreg[i] = *(const u32x4*)(vtb + (size_t)d * 4352 + krow * 64 + kk); }
            else if (key8 < 128) { const int m = (s_ == 0 ? 0 : 128) + 64 * (pass - 2) + kk;
                vreg[i] = *(const u32x4*)(vtb + (size_t)d * 4352 + 4096 + m); } }
    };
    auto lstore = [&](int pass) {
#pragma unroll
        for (int i = 0; i < 8; ++i) { const int key = i * 32 + (tid >> 4), c16 = tid & 15;
            if (pass < 2 || i < 4) *(u32x4*)(KT + key * 256 + ((c16 ^ (key & 15)) * 16)) = kreg[i]; }
#pragma unroll
        for (int i = 0; i < 8; ++i) { const int d = i * 16 + (tid >> 5), kc16 = tid & 31;
            if (pass < 2 || kc16 < 16) *(u32x4*)(VL + d * 512 + ((kc16 ^ (d & 15)) * 16)) = vreg[i]; }
    };
    gload(0);
    for (int pass = 0; pass < 4; ++pass) {
        __syncthreads();
        lstore(pass);
        __syncthreads();
        if (pass < 3) gload(pass + 1);
        f32x4 S[4];
#pragma unroll
        for (int i = 0; i < 4; ++i) {
            const int keyl = pass < 2 ? (kh * 2 + (i >> 1)) * 64 + cs + (i & 1) * 16 + n16 : kh * 64 + i * 16 + n16;
            const unsigned char* kp = KT + keyl * 256;
            f32x4 acc = (f32x4){0.f, 0.f, 0.f, 0.f};
#pragma unroll
            for (int c = 0; c < 4; ++c) { const bf16x8 kf = *(const bf16x8*)(kp + (((c * 4 + g) ^ (keyl & 15)) * 16)); acc = MFMA16(kf, qf[c], acc); }
            S[i] = acc;
        }
        float mx = -INFINITY;
#pragma unroll
        for (int i = 0; i < 4; ++i) {
            if (pass < 2) { const int krow = row_start + kh * 4 + 2 * pass + (i >> 1); const float* rb = rpb + (krow - r + 7) * 31;
#pragma unroll
                for (int jj = 0; jj < 4; ++jj) { const int kc = cs + (i & 1) * 16 + 4 * g + jj; const bool ok = (kc >= c_start) && (kc < c_start + 16);
                    const int co = min(max(kc - qcol, -15), 15) + 15;
                    S[i][jj] = ok ? S[i][jj] * scale + rb[co] : -INFINITY; } }
            else {
#pragma unroll
                for (int jj = 0; jj < 4; ++jj) S[i][jj] *= scale; }
#pragma unroll
            for (int jj = 0; jj < 4; ++jj) mx = fmaxf(mx, S[i][jj]);
        }
        mx = fmaxf(mx, __shfl_xor(mx, 16)); mx = fmaxf(mx, __shfl_xor(mx, 32));
        const float mnew = fmaxf(mrun, mx);
        const float alpha = __expf(mrun - mnew);
        mrun = mnew; lsum *= alpha;
#pragma unroll
        for (int i = 0; i < 8; ++i) { O[i][0] *= alpha; O[i][1] *= alpha; O[i][2] *= alpha; O[i][3] *= alpha; }
#pragma unroll
        for (int c = 0; c < 2; ++c) {
            float e[8];
#pragma unroll
            for (int jj = 0; jj < 4; ++jj) { e[jj] = __expf(S[2 * c][jj] - mnew); e[4 + jj] = __expf(S[2 * c + 1][jj] - mnew); }
#pragma unroll
            for (int jj = 0; jj < 8; ++jj) lsum += e[jj];
            u32x4 u; u[0] = pack2(e[0], e[1]); u[1] = pack2(e[2], e[3]); u[2] = pack2(e[4], e[5]); u[3] = pack2(e[6], e[7]);
            const bf16x8 pf = __builtin_bit_cast(bf16x8, u);
            const int key0 = pass < 2 ? (kh * 2 + c) * 64 + cs + 4 * g : kh * 64 + c * 32 + 4 * g;
            const int kc8a = key0 >> 2, kc8b = kc8a + 4;
#pragma unroll
            for (int dt = 0; dt < 8; ++dt) { const int d = dt * 16 + n16; const unsigned char* vp = VL + d * 512;
                const bf16x4 v0 = *(const bf16x4*)(vp + (((kc8a >> 1) ^ (d & 15)) * 16) + (kc8a & 1) * 8), v1 = *(const bf16x4*)(vp + (((kc8b >> 1) ^ (d & 15)) * 16) + (kc8b & 1) * 8);
                const bf16x8 vf = __builtin_shufflevector(v0, v1, 0, 1, 2, 3, 4, 5, 6, 7);
                O[dt] = MFMA16(vf, pf, O[dt]); }
        }
    }
    lsum += __shfl_xor(lsum, 16); lsum += __shfl_xor(lsum, 32);
    __syncthreads();
    float* cmb = (float*)lds + (size_t)qi * 34 * 64 + lane;
    if (kh == 1) { cmb[0] = mrun; cmb[64] = lsum;
#pragma unroll
        for (int dt = 0; dt < 8; ++dt)
#pragma unroll
            for (int jj = 0; jj < 4; ++jj) cmb[(2 + dt * 4 + jj) * 64] = O[dt][jj]; }
    __syncthreads();
    if (kh == 0) { const float m1 = cmb[0], l1 = cmb[64];
        const float mn = fmaxf(mrun, m1), a0 = __expf(mrun - mn), a1 = __expf(m1 - mn);
        const float inv = 1.0f / (lsum * a0 + l1 * a1);
        bf16_t* yo = YN + (size_t)qrow * 1024 + h * 128 + 4 * g;
#pragma unroll
        for (int dt = 0; dt < 8; ++dt) { float o[4];
#pragma unroll
            for (int jj = 0; jj < 4; ++jj) o[jj] = (O[dt][jj] * a0 + cmb[(2 + dt * 4 + jj) * 64] * a1) * inv;
            u32x2 ov; ov[0] = pack2(o[0], o[1]); ov[1] = pack2(o[2], o[3]); *(u32x2*)(yo + dt * 16) = ov; } }
}

__device__ void phase_mix(PP p, int l, float* lds, int which = 7) {
    const int TIDX = otid();
    for (int t = blockIdx.x; t < 256; t += gridDim.x) {
        if (t < 128) { if (which & 1) rwkv_scan(p, l, t, lds); }
        else if (which & 2) mlstm_scan(p, l, (t - 128) >> 3, (t - 128) & 7, lds);
        __syncthreads();
    }
    unsigned* ctr = (unsigned*)(p->ws + OFF_CTL) + l * 8 + ((which & 8) ? 1 : 0);
    if (!(which & 4)) return;
    int* stask = (int*)lds;
    const int ntask = l == 0 ? 1056 : 1024;
    for (;;) {
        __syncthreads();
        if (TIDX == 0) stask[0] = (int)atomicAdd(ctr, 1u);
        __syncthreads();
        const int t = stask[0];
        if (t >= ntask) break;
        const int nctx = ntask - 1024;
        if (t >= nctx) na_block(p, l, t - nctx, (unsigned char*)lds); else na_wave(p, l, 512 + t);
    }
}

__device__ void phase_post(PP p, int l, int nrows) {
    const int TIDX = otid();
    const int wid = TIDX >> 6, lane = TIDX & 63, gw = blockIdx.x * 8 + wid, nw = gridDim.x * 8;
    const bf16_t* P = (const bf16_t*)(p->ws + OFF_P); const bf16_t* LO = (const bf16_t*)(p->ws + OFF_LO);
    bf16_t* YM = (bf16_t*)(p->ws + OFF_Y3); bf16_t* YR = YM + (size_t)NTOK * 1024;
    const float* NUM = (const float*)(p->ws + OFF_MLNUM); const float* YF = (const float*)(p->ws + OFF_YRWF);
    for (int row = gw; row < nrows; row += nw) {
        f32x4 a[4], c[4], ng[4]; float dfr[4], dbr[4]; u32x2 ov[4];
#pragma unroll
        for (int h = 0; h < 4; ++h) {
            const float* nf = NUM + ((size_t)row * 4 + h) * 272; const float* nb = NUM + ((size_t)(NTOK + row) * 4 + h) * 272;
            a[h] = *(const f32x4*)(nf + lane * 4); c[h] = *(const f32x4*)(nb + lane * 4); dfr[h] = nf[256]; dbr[h] = nb[256];
            ov[h] = *(const u32x2*)(P + (size_t)row * NP + 2048 + h * 256 + lane * 4);
            ng[h] = *(const f32x4*)(p->in[I_MLNG] + l * 1024 + h * 256 + lane * 4); }
#pragma unroll
        for (int h = 0; h < 4; ++h) {
            const float df = 1.0f / fmaxf(fabsf(dfr[h]), 1.0f), db = 1.0f / fmaxf(fabsf(dbr[h]), 1.0f);
            float hv[4]; float ss = 0.f;
#pragma unroll
            for (int j = 0; j < 4; ++j) { hv[j] = a[h][j] * df + c[h][j] * db; ss += hv[j] * hv[j]; }
            ss = wsum(ss);
            const float rr = rsqrtf(ss * (1.0f / 256.0f) + 1e-6f);
            const float o0 = hv[0] * rr * ng[h][0] * sigmoidf(bflo(ov[h][0])), o1 = hv[1] * rr * ng[h][1] * sigmoidf(bfhi(ov[h][0]));
            const float o2 = hv[2] * rr * ng[h][2] * sigmoidf(bflo(ov[h][1])), o3 = hv[3] * rr * ng[h][3] * sigmoidf(bfhi(ov[h][1]));
            u32x2 w; w[0] = pack2(o0, o1); w[1] = pack2(o2, o3);
            *(u32x2*)(YM + (size_t)row * 1024 + h * 256 + lane * 4) = w; }
    }
    const float* MU = p->in[I_RWMU] + (size_t)l * 3712;
    const float* RKp = (const float*)(p->ws + OFF_RK);
#pragma unroll 2
    for (int it = gw; it < nrows * 4; it += nw) {
        const int row = it >> 2, head = (it & 3) * 4 + (lane >> 4), c = head * 64 + (lane & 15) * 4;
        bool hp, hn; seq_nbrs(row, hp, hn);
        const f32x4 ya = *(const f32x4*)(YF + (size_t)row * 1024 + c), yb = *(const f32x4*)(YF + (size_t)(NTOK + row) * 1024 + c);
        const bf16_t* pr = P + (size_t)row * NP + RWB + 2048 + c;
        const u32x2 z2 = {0u, 0u};
        const u32x2 vc = *(const u32x2*)pr, vp = hp ? *(const u32x2*)(pr - NP) : z2, vn = hn ? *(const u32x2*)(pr + NP) : z2;
        const u32x2 gv = *(const u32x2*)(LO + (size_t)row * 5120 + 4096 + c);
        const float rk = RKp[row * 16 + head];
        const f32x4 mu = *(const f32x4*)(MU + 2048 + c), lw = *(const f32x4*)(p->in[I_RWLNW] + l * 1024 + c), lb = *(const f32x4*)(p->in[I_RWLNB] + l * 1024 + c);
        const f32x4 y = ya + yb;
        const float mean = red16((y[0] + y[1]) + (y[2] + y[3])) * (1.0f / 64.0f);
        const f32x4 dy = y - mean;
        const float var = red16((dy[0] * dy[0] + dy[1] * dy[1]) + (dy[2] * dy[2] + dy[3] * dy[3])) * (1.0f / 64.0f);
        const float rs = rsqrtf(var + 64e-5f);
        const float v0 = shiftf(bflo(vc[0]), bflo(vp[0]), bflo(vn[0]), mu[0]), v1 = shiftf(bfhi(vc[0]), bfhi(vp[0]), bfhi(vn[0]), mu[1]);
        const float v2 = shiftf(bflo(vc[1]), bflo(vp[1]), bflo(vn[1]), mu[2]), v3 = shiftf(bfhi(vc[1]), bfhi(vp[1]), bfhi(vn[1]), mu[3]);
        const float o0 = (dy[0] * rs * lw[0] + lb[0] + rk * v0) * bflo(gv[0]), o1 = (dy[1] * rs * lw[1] + lb[1] + rk * v1) * bfhi(gv[0]);
        const float o2 = (dy[2] * rs * lw[2] + lb[2] + rk * v2) * bflo(gv[1]), o3 = (dy[3] * rs * lw[3] + lb[3] + rk * v3) * bfhi(gv[1]);
        u32x2 w; w[0] = pack2(o0, o1); w[1] = pack2(o2, o3);
        *(u32x2*)(YR + (size_t)row * 1024 + c) = w;
    }
}


constexpr size_t PART_OFF = 150ull << 20;
#ifndef DUPMASK
#define DUPMASK 0
#endif
#ifndef DUPWHICH
#define DUPWHICH 3
#endif
__global__ void __launch_bounds__(512, 2) fwd_kernel(Params p0) {
    extern __shared__ __attribute__((aligned(16))) unsigned char shm[];
    cg::grid_group grid = cg::this_grid();
    float* ldsf = (float*)shm;
    LAS unsigned char* ldsg = (LAS unsigned char*)shm;
    const int ph_lo = p0.ph_lo, ph_hi = p0.ph_hi;
    auto kseg = __builtin_amdgcn_kernarg_segment_ptr();
    for (int ph = ph_lo; ph < ph_hi; ++ph) {
        if (ph > ph_lo) grid.sync();
        PP p = (PP)kseg; asm volatile("" : "+s"(p));
        unsigned char* ws = p->ws;
        const float* MOD = (const float*)(ws + OFF_MOD);
        float* XL = (float*)(ws + OFF_XL);
        bf16_t* H = (bf16_t*)(ws + OFF_H);
        bf16_t* Pb = (bf16_t*)(ws + OFF_P);
        if (ph == 0) { phase_mod(p, ldsf); __syncthreads(); phase_convert(p, 0, ldsf, (int)blockIdx.x, (int)gridDim.x, 0, 0, 18816, true); continue; }
        if (ph == NPHASE - 1) { phase_final(p); continue; }
        const int l = (ph - 1) / 11, sub = (ph - 1) % 11;
        const int two_wt = p->two_wt;
        const size_t wsh = (l == 1 && two_wt) ? WT_SHIFT : 0;
#if DUPMASK
        for (int rep = 0; rep < (((DUPMASK >> sub) & 1) ? 2 : 1); ++rep) { if (rep) grid.sync();
#endif
        const int Ml = l == 0 ? NTOK : NLAT;
        const float* modl = MOD + (size_t)l * 3 * 12288;
        if (sub == 1 || sub == 3 || sub == 6 || sub == 7 || sub == 9 || sub == 10) {
            const bool ksplit = l == 0 && (sub == 7 || sub == 10) && gridDim.x == 256;
            for (int part = 0; part < (ksplit ? 2 : (sub == 3 ? 3 : 1)); ++part) {
            pg8::Gemm g; pg8::SchedG S; pg8::EpiG E;
            S.mode = 0; S.mo.init(Ml / 256, (int)gridDim.x, (int)blockIdx.x);
            E.kind = 0; E.split = 0; E.O = Pb; E.ldc = NP; E.P = Pb; E.ACC = (float*)(ws + OFF_YRWF);
            E.xin_lat = XL; E.xin_ctx = XL + (size_t)NLAT * 2048; E.XL = XL; E.gate = modl; E.part = nullptr;
            if (sub == 1) { g = pg8::Gemm{H, (const bf16_t*)(ws + wsh + OFF_WIN), NTOK, NP, 2048, 32}; }
            else if (sub == 3) { const int n0 = part * 2048, k0 = part == 0 ? 0 : (part == 1 ? 192 : 384);
                g = pg8::Gemm{(const bf16_t*)(ws + OFF_LA) + k0, (const bf16_t*)(ws + wsh + OFF_WLORA) + (size_t)n0 * 640 + k0, NTOK, part == 2 ? 1024 : 2048, 640, 4}; E.O = (bf16_t*)(ws + OFF_LO) + n0; E.ldc = 5120; }
            else if (sub == 6) { g = pg8::Gemm{(const bf16_t*)(ws + OFF_Y3), (const bf16_t*)(ws + wsh + OFF_WBR), Ml, 2048, 1024, 16}; S.mode = 1; E.kind = 2; E.O = H; }
            else if (sub == 7) { g = pg8::Gemm{H, (const bf16_t*)(ws + wsh + OFF_WOUT), Ml, 2048, 2048, 32}; E.kind = 3; E.gate = modl + 2 * 2048;
                if (l == 0) { E.xin_lat = p->in[I_X]; E.xin_ctx = p->in[I_CTX]; } }
            else if (sub == 9) { g = pg8::Gemm{H, (const bf16_t*)(ws + wsh + OFF_WFF1), Ml, DFF, 2048, 32}; E.kind = 1; E.ldc = DFF; }
            else { g = pg8::Gemm{Pb, (const bf16_t*)(ws + wsh + OFF_WFF2), Ml, 2048, DFF, 128}; E.kind = 3; E.gate = modl + 5 * 2048; }
            if (ksplit) {
                if (part == 0) g.M = NLAT;
                else { const int ks = (int)blockIdx.x & 15; g.nt >>= 4; g.A += (size_t)ks * g.nt * 64; g.Bt += (size_t)ks * g.nt * 64; S.mode = 2; E.split = 1;
                    E.part = (float*)(ws + OFF_P + (sub == 10 ? PART_OFF : 0)) + (size_t)ks * 512 * 2048; }
            }
            S.so.init(g.M, g.N, (int)gridDim.x, (int)blockIdx.x);
            pg8::gemm_phase(ldsg, g, S, E);
            }
            if (two_wt && l == 0 && gridDim.x == 256) {
                if (sub == 1 && blockIdx.x >= 94) phase_convert(p, 1, ldsf, (int)blockIdx.x - 94, 162, WT_SHIFT, 0, 4000, false);
                if (sub == 6 && blockIdx.x >= 16) phase_convert(p, 1, ldsf, (int)blockIdx.x - 16, 240, WT_SHIFT, 4000, 11500, false);
                if (sub == 9 && blockIdx.x >= 64) phase_convert(p, 1, ldsf, (int)blockIdx.x - 64, 192, WT_SHIFT, 11500, 18816, true);
            } else if (two_wt && l == 0 && sub == 10) phase_convert(p, 1, ldsf, (int)blockIdx.x, (int)gridDim.x, WT_SHIFT, 0, 18816, true);
        } else
        switch (sub) {
        case 0: {
            phase_init(p, l);
            if (l == 1 && !two_wt) phase_convert(p, l, ldsf, (int)blockIdx.x, (int)gridDim.x, wsh, 0, 18816, true);
            if (l == 0) phase_norm(p->in[I_X], p->in[I_CTX], NTOK, p->in[I_N1G] + l * 2048, modl, 0, 1, H);
            else if (gridDim.x == 256) phase_norm(XL, XL + (size_t)NLAT * 2048, NTOK, p->in[I_N1G] + l * 2048, modl, 0, 1, H, (const float*)(ws + OFF_P + PART_OFF), MOD + 2 * 12288 + 5 * 2048, XL + (size_t)NLAT * 2048);
            else phase_norm(XL, XL + (size_t)NLAT * 2048, NTOK, p->in[I_N1G] + l * 2048, modl, 0, 1, H);
        } break;
        case 2: phase_prep(p, l, (bf16_t*)shm); break;
#if DUPMASK
        case 4: phase_mix(p, l, ldsf, rep ? DUPWHICH : 7); break;
#else
        case 4: phase_mix(p, l, ldsf); break;
#endif
        case 5: phase_post(p, l, Ml); break;
        case 8: if (l == 0 && gridDim.x == 256) phase_norm(XL, p->in[I_CTX], Ml, p->in[I_N2G] + l * 2048, modl, 3, 4, H, (const float*)(ws + OFF_P), modl + 2 * 12288 + 2 * 2048, XL + (size_t)NLAT * 2048);
                else phase_norm(XL, XL + (size_t)NLAT * 2048, Ml, p->in[I_N2G] + l * 2048, modl, 3, 4, H); break;
        }
#if DUPMASK
        }
#endif
    }
}

extern "C" void kernel_launch(void* const* d_in, const int* in_sizes, int n_in, void* d_out, int out_size, void* d_ws, size_t ws_size, hipStream_t stream) {
    static int grid = 0;
    if (grid == 0) {
        if (n_in != 28 || ws_size < WS_END) { fprintf(stderr, "kernel_launch: need 28 inputs and %zu bytes of workspace (got %d, %zu)\n", (size_t)WS_END, n_in, ws_size); grid = -1; return; }
        if (hipFuncSetAttribute((const void*)fwd_kernel, hipFuncAttributeMaxDynamicSharedMemorySize, LDS_BYTES) != hipSuccess) { fprintf(stderr, "kernel_launch: hipFuncSetAttribute failed\n"); grid = -1; return; }
        int dev = 0, cus = 0, per_cu = 0;
        hipGetDevice(&dev);
        hipDeviceGetAttribute(&cus, hipDeviceAttributeMultiprocessorCount, dev);
        hipOccupancyMaxActiveBlocksPerMultiprocessor(&per_cu, (const void*)fwd_kernel, 512, LDS_BYTES);
        if (per_cu < 1) { fprintf(stderr, "kernel_launch: occupancy query says %d blocks per CU\n", per_cu); per_cu = 1; }
        (void)hipGetLastError();
        grid = cus * 1;
        if (grid > 256) grid = 256;
    }
    if (grid < 0) return;
    Params p{};
    for (int i = 0; i < 28; ++i) p.in[i] = (const float*)d_in[i];
    p.out = (float*)d_out; p.ws = (unsigned char*)d_ws; p.two_wt = (ws_size >= WS_END + WT_BYTES) ? 1 : 0;
#if ONE_LAUNCH
    p.ph_lo = 0; p.ph_hi = NPHASE;
    void* args[] = {&p};
    hipError_t e = hipLaunchCooperativeKernel((const void*)fwd_kernel, dim3(grid), dim3(512), args, LDS_BYTES, stream);
    if (e != hipSuccess) fprintf(stderr, "cooperative launch failed: %s (grid %d)\n", hipGetErrorString(e), grid);
#else
    for (int ph = 0; ph < NPHASE; ++ph) {
        p.ph_lo = ph; p.ph_hi = ph + 1;
        hipLaunchKernelGGL(fwd_kernel, dim3(grid), dim3(512), LDS_BYTES, stream, p);
    }
#endif
}
```

```cpp
#include <hip/hip_runtime.h>
#include <hip/hip_cooperative_groups.h>
#include <cstdio>
namespace cg = cooperative_groups;

#ifndef ONE_LAUNCH
#define ONE_LAUNCH 1
#endif

#define DEVI __device__ __forceinline__
#define LAS __attribute__((address_space(3)))
typedef unsigned short bf16_t;
typedef short bf16x8 __attribute__((ext_vector_type(8)));
typedef short bf16x4 __attribute__((ext_vector_type(4)));
typedef float f32x4 __attribute__((ext_vector_type(4)));
typedef float f32x2 __attribute__((ext_vector_type(2)));
typedef unsigned u32x4 __attribute__((ext_vector_type(4)));
typedef unsigned u32x2 __attribute__((ext_vector_type(2)));

constexpr int D = 2048, NTOK = 8704, NLAT = 8192, NP = 16128, DIN = 16016, DFF = 8192;
constexpr int RWB = 3088, NAB = 6800, GTB = 9872;
constexpr int LDS_BYTES = 131072;
constexpr int NPHASE = 24;

constexpr size_t OFF_CTL = 0;
constexpr size_t OFF_MOD = 4096;
constexpr size_t OFF_ROPE = OFF_MOD + 2ull * 3 * 12288 * 4;
constexpr size_t OFF_WIN = OFF_ROPE + 16384;
constexpr size_t OFF_WBR = OFF_WIN + 16128ull * 2048 * 2;
constexpr size_t OFF_WOUT = OFF_WBR + 3ull * 2048 * 1024 * 2;
constexpr size_t OFF_WFF1 = OFF_WOUT + 2048ull * 2048 * 2;
constexpr size_t OFF_WFF2 = OFF_WFF1 + 8192ull * 2048 * 2;
constexpr size_t OFF_WLORA = OFF_WFF2 + 8192ull * 2048 * 2;
constexpr size_t OFF_XL = OFF_WLORA + 5120ull * 640 * 2;
constexpr size_t OFF_H = OFF_XL + 8704ull * 2048 * 4;
constexpr size_t OFF_P = OFF_H + 8704ull * 2048 * 2;
constexpr size_t OFF_LA = OFF_P + 8704ull * 16128 * 2;
constexpr size_t OFF_LO = OFF_LA + 8704ull * 640 * 2;
constexpr size_t OFF_YRWF = OFF_LO + 8704ull * 5120 * 2;
constexpr size_t OFF_MLNUM = OFF_YRWF + 2ull * 8704 * 1024 * 4;
constexpr size_t OFF_VT = OFF_MLNUM + 2ull * 8704 * 4 * 272 * 4;
constexpr size_t OFF_Y3 = OFF_VT + 2ull * 8 * 128 * 4352 * 2;
constexpr size_t OFF_RK = OFF_Y3 + 3ull * 8704 * 1024 * 2;
constexpr size_t OFF_BAR = OFF_RK + 8704ull * 16 * 4;
constexpr size_t WS_END = OFF_BAR + 16384;
constexpr size_t WT_BYTES = OFF_XL - OFF_WIN, WT_SHIFT = WS_END - OFF_WIN;

struct Params {
    const float* in[28];
    float* out;
    unsigned char* ws;
    int ph_lo, ph_hi, two_wt, pad_;
};
typedef const __attribute__((address_space(4))) Params* PP;
enum { I_X = 0, I_C, I_CTX, I_CCTX, I_WMOD, I_BMOD, I_N1G, I_WIN, I_MLGB, I_MLNG, I_RWMU, I_RWW0, I_RWWUP, I_RWA0, I_RWAUP, I_RWGUP,
       I_RWKK, I_RWKA, I_RWRK, I_RWLNW, I_RWLNB, I_RPB, I_WBR, I_WOUT, I_N2G, I_WFF1, I_WFF2, I_FING };

DEVI int otid() { int t; asm volatile("v_mov_b32 %0, %1" : "=v"(t) : "v"((int)threadIdx.x)); return t; }
DEVI float bf2f(bf16_t b) { return __uint_as_float(((unsigned)b) << 16); }
DEVI float bflo(unsigned u) { return __uint_as_float(u << 16); }
DEVI float bfhi(unsigned u) { return __uint_as_float(u & 0xffff0000u); }
DEVI bf16_t f2bf(float f) { unsigned u = __float_as_uint(f); u += 0x7FFFu + ((u >> 16) & 1u); return (bf16_t)(u >> 16); }
DEVI unsigned pack2(float lo, float hi) { return (unsigned)f2bf(lo) | ((unsigned)f2bf(hi) << 16); }
DEVI float sigmoidf(float x) { return __builtin_amdgcn_rcpf(1.0f + __expf(-x)); }
#define DPP_ADD(x, CTRL) ((x) + __int_as_float(__builtin_amdgcn_update_dpp(0, __float_as_int(x), CTRL, 0xF, 0xF, true)))
DEVI float wsum(float x) {
    x = DPP_ADD(x, 0xB1); x = DPP_ADD(x, 0x4E); x = DPP_ADD(x, 0x141); x = DPP_ADD(x, 0x140);
    const int xi = __float_as_int(x);
    return (__int_as_float(__builtin_amdgcn_readlane(xi, 0)) + __int_as_float(__builtin_amdgcn_readlane(xi, 16))) + (__int_as_float(__builtin_amdgcn_readlane(xi, 32)) + __int_as_float(__builtin_amdgcn_readlane(xi, 48)));
}
DEVI float red8(float x) {
    x = DPP_ADD(x, 0xB1);
    x = DPP_ADD(x, 0x4E);
    x = DPP_ADD(x, 0x141);
    return x;
}

DEVI float red16(float x) {
    x = DPP_ADD(x, 0xB1); x = DPP_ADD(x, 0x4E); x = DPP_ADD(x, 0x141); x = DPP_ADD(x, 0x140);
    return x;
}
DEVI float sfma(float a, float b, float c) { float d; asm("v_fma_f32 %0, %1, %2, %3" : "=v"(d) : "v"(a), "v"(b), "v"(c)); return d; }
DEVI float smul(float a, float b) { float d; asm("v_mul_f32 %0, %1, %2" : "=v"(d) : "v"(a), "v"(b)); return d; }
DEVI void fadd_g(float* ptr, float v) { (void)__builtin_amdgcn_global_atomic_fadd_f32((__attribute__((address_space(1))) float*)ptr, v); }
DEVI float frcp(float x) { return __builtin_amdgcn_rcpf(x); }
DEVI float fsigmoid(float x) { return __builtin_amdgcn_rcpf(1.0f + __expf(-x)); }

#define XB_TMO      128
#define XB_XCNT(j)  (256  + 64 * (j))
#define XB_XSUB(j)  (1280 + 64 * (j))
#define XB_XGEN(j)  (2304 + 64 * (j))
#define XB_TOP      3328
#define XB_TOPGEN   3392
#define XCD_BAR_WORDS 3456
#define XB_SPIN_CAP (1u << 18)

__device__ __forceinline__ unsigned xb_ld(unsigned* p)              { return __hip_atomic_load(p, __ATOMIC_RELAXED, __HIP_MEMORY_SCOPE_AGENT); }
__device__ __forceinline__ unsigned xb_add(unsigned* p, unsigned v) { return __hip_atomic_fetch_add(p, v, __ATOMIC_RELAXED, __HIP_MEMORY_SCOPE_AGENT); }
__device__ __forceinline__ unsigned xb_xcc_id() { return (unsigned)__builtin_amdgcn_s_getreg((3 << 11) | 20) & 0xFu; }
#define XB_SPIN(cond, bar) do { unsigned _sp = 0; while (cond) { __builtin_amdgcn_s_sleep(1); \
    if ((++_sp & 255u) == 0u) { if (xb_ld(&(bar)[XB_TMO])) break; if (_sp > XB_SPIN_CAP) { atomicAdd(&(bar)[XB_TMO], 1u); break; } } } } while (0)

struct XcdBarrier {
    unsigned* bar; unsigned x;
    volatile LAS unsigned* st;
};

__device__ __forceinline__ XcdBarrier xcd_barrier_post(unsigned* bar, volatile LAS unsigned* st) {
    XcdBarrier b; b.bar = bar; b.x = xb_xcc_id(); b.st = st;
    if (threadIdx.x == 0) (void)xb_add(&bar[XB_XCNT(b.x)], 1u);
    return b;
}
__device__ __forceinline__ void xcd_barrier_complete(unsigned* bar, unsigned x, unsigned& nloc, unsigned& nx) {
    const unsigned G = gridDim.x * gridDim.y * gridDim.z;
    unsigned sum, cnt, mine, sp = 0u;
    for (;;) {
        sum = 0u; cnt = 0u; mine = 0u;
#pragma unroll
        for (unsigned j = 0; j < 16; ++j) { const unsigned c = xb_ld(&bar[XB_XCNT(j)]); sum += c; cnt += (c > 0u) ? 1u : 0u; mine = (j == x) ? c : mine; }
        if (sum == G) break;
        __builtin_amdgcn_s_sleep(1);
        if ((++sp & 255u) == 0u) { if (xb_ld(&bar[XB_TMO])) break; if (sp > XB_SPIN_CAP) { atomicAdd(&bar[XB_TMO], 1u); break; } }
    }
    nloc = mine > 0u ? mine : 1u; nx = cnt > 0u ? cnt : 1u;
}

__device__ __forceinline__ void xcd_barrier(const XcdBarrier& b) {
    asm volatile("s_waitcnt vmcnt(0)" ::: "memory");
    __syncthreads();
    if (threadIdx.x == 0) {
        unsigned* bar = b.bar;
        __builtin_amdgcn_s_waitcnt(0);
        unsigned nloc = b.st[0], nx = b.st[1];
        if (nloc == 0u) { xcd_barrier_complete(bar, b.x, nloc, nx); b.st[0] = nloc; b.st[1] = nx; }
        const unsigned old = xb_add(&bar[XB_XSUB(b.x)], 1u);
        const unsigned gen = old / nloc;
        if (old + 1u == (gen + 1u) * nloc) {
            __builtin_amdgcn_fence(__ATOMIC_RELEASE, "agent");
            asm volatile("s_waitcnt vmcnt(0)" ::: "memory");
            const unsigned og = xb_add(&bar[XB_TOP], 1u);
            const unsigned tg = og / nx;
            if (og + 1u == (tg + 1u) * nx) xb_add(&bar[XB_TOPGEN], 1u);
            else XB_SPIN(xb_ld(&bar[XB_TOPGEN]) == tg, bar);
            __builtin_amdgcn_fence(__ATOMIC_ACQUIRE, "agent");
            xb_add(&bar[XB_XGEN(b.x)], 1u);
            asm volatile("s_waitcnt vmcnt(0)" ::: "memory");
        } else {
            XB_SPIN(xb_ld(&bar[XB_XGEN(b.x)]) == gen, bar);
            __builtin_amdgcn_fence(__ATOMIC_ACQUIRE, "agent");
            asm volatile("s_waitcnt vmcnt(0)" ::: "memory");
        }
    }
    __syncthreads();
}


namespace pg8 {
constexpr int BM = 256, BK = 64, HALF = 128, HTB = HALF * BK * 2, STAGE_BYTES = 8 * HTB, NXCD = 8, WGM = 8;
__host__ __device__ __forceinline__ int lds_byte(int r, int c) { const int st = (r >> 4) * 2 + (c >> 5), rr = r & 15, cc = c & 31, ob = rr * 64 + cc * 2; return st * 1024 + (ob ^ (((ob >> 9) & 1) << 5)); }
__host__ __device__ __forceinline__ void stage_rc(int b, int& R, int& C) { const int st = b / 1024, sb = b % 1024, swz = sb ^ (((sb >> 9) & 1) << 5); R = (st >> 1) * 16 + swz / 64; C = (st & 1) * 32 + (swz % 64) / 2; }
__host__ __device__ __forceinline__ int perm32(int rho) { const int n = rho >> 4, i = rho & 15; return 8 * (i >> 2) + 4 * n + (i & 3); }
struct Unit { int pm, pn; };
struct Gemm { const bf16_t* A; const bf16_t* Bt; int M, N, K, nt; };
struct StaticOrder {
    int nM, nN, nwg, G, c;
    __device__ void init(int M, int N, int G_, int c_) { nM = M / BM; nN = N / BM; nwg = nM * nN; G = G_; c = c_; }
    __device__ bool next(int i, Unit& u) const {
        const long L = (long)i * G + c; if (L >= nwg) return false;
        int wgid = (int)L; { const int q = nwg / NXCD, r = nwg % NXCD, xcd = wgid % NXCD, off = wgid / NXCD; wgid = (xcd < r ? xcd * (q + 1) : r * (q + 1) + (xcd - r) * q) + off; }
        const int nig = WGM * nN, gid = wgid / nig, fm = gid * WGM, gsz = (nM - fm) < WGM ? (nM - fm) : WGM;
        u.pm = fm + ((wgid % nig) % gsz); u.pn = (wgid % nig) / gsz; return true;
    }
    __device__ __forceinline__ void a_ready(const Unit&) const {}
    __device__ __forceinline__ void done(const Unit&) const {}
};
struct MergeOrder {
    int ntiles, G, c;
    __device__ void init(int nM, int G_, int c_) { ntiles = nM * 8; G = G_; c = c_; }
    __device__ bool next(int i, Unit& u) const {
        const int ti = i / 3, br = i - ti * 3; const long L = (long)ti * G + c; if (L >= ntiles) return false;
        const int pm = (int)L >> 3, pn = (int)L & 7; u.pm = br * 34 + pm; u.pn = br * 8 + pn; return true;
    }
    __device__ __forceinline__ void a_ready(const Unit&) const {}
    __device__ __forceinline__ void done(const Unit&) const {}
};
DEVI unsigned cvt_pk_bf16(float lo, float hi) { unsigned r; asm volatile("v_cvt_pk_bf16_f32 %0, %1, %2" : "=v"(r) : "v"(lo), "v"(hi)); return r; }


struct SchedG {
    int mode;
    StaticOrder so; MergeOrder mo;
    __device__ __forceinline__ bool next(int i, Unit& u) const {
        if (mode == 2) { if (i > 0) return false; const int cu = so.c >> 4; u.pm = 32 + (cu >> 3); u.pn = cu & 7; return true; }
        return mode == 0 ? so.next(i, u) : mo.next(i, u); }
    __device__ __forceinline__ void a_ready(const Unit&) const {}
    __device__ __forceinline__ void done(const Unit&) const {}
};
struct EpiG {
    static constexpr bool PERM = true, AFTER_DRAIN = false;
    int kind, split;
    bf16_t* O; int ldc;
    const bf16_t* P; float* ACC;
    const float* xin_lat; const float* xin_ctx; float* XL; const float* gate; float* part;
    __device__ __forceinline__ void operator()(const f32x4 (&acc)[2][2][4][2], const Unit& u, int wr, int wc, int fr, int fq) const {
        if (kind <= 1) {
            const int row0 = u.pm * BM + wr * 64 + fr, col0 = u.pn * BM + wc * 32 + 8 * fq;
#pragma unroll
            for (int ai = 0; ai < 2; ++ai)
#pragma unroll
                for (int m = 0; m < 4; ++m) { bf16_t* rowp = O + (size_t)(row0 + ai * HALF + m * 16) * ldc + col0;
#pragma unroll
                    for (int bj = 0; bj < 2; ++bj) { f32x4 v0 = acc[ai][bj][m][0], v1 = acc[ai][bj][m][1];
                        if (kind == 1) {
#pragma unroll
                            for (int i = 0; i < 4; ++i) { float a = fmaxf(v0[i], 0.f), b = fmaxf(v1[i], 0.f); v0[i] = a * a; v1[i] = b * b; } }
                        u32x4 o; o[0] = cvt_pk_bf16(v0[0], v0[1]); o[1] = cvt_pk_bf16(v0[2], v0[3]); o[2] = cvt_pk_bf16(v1[0], v1[1]); o[3] = cvt_pk_bf16(v1[2], v1[3]);
                        *(u32x4*)(rowp + bj * HALF) = o; } }
        } else if (kind == 2) {
            const int br = u.pn >> 3, pn = u.pn & 7, pm = u.pm - br * 34;
            const int row0 = pm * BM + wr * 64 + fr, col0 = pn * BM + wc * 32 + 8 * fq;
#pragma unroll
            for (int ai = 0; ai < 2; ++ai)
#pragma unroll
                for (int m = 0; m < 4; ++m) { const size_t row = (size_t)(row0 + ai * HALF + m * 16);
#pragma unroll
                    for (int bj = 0; bj < 2; ++bj) { const int col = col0 + bj * HALF;
                        const u32x4 gv = *(const u32x4*)(P + row * NP + GTB + br * 2048 + col);
                        f32x4 v0 = acc[ai][bj][m][0], v1 = acc[ai][bj][m][1];
                        v0[0] *= sigmoidf(bflo(gv[0])); v0[1] *= sigmoidf(bfhi(gv[0])); v0[2] *= sigmoidf(bflo(gv[1])); v0[3] *= sigmoidf(bfhi(gv[1]));
                        v1[0] *= sigmoidf(bflo(gv[2])); v1[1] *= sigmoidf(bfhi(gv[2])); v1[2] *= sigmoidf(bflo(gv[3])); v1[3] *= sigmoidf(bfhi(gv[3]));
                        float* ap = ACC + row * 2048 + col;
                        if (br == 0) { *(f32x4*)ap = v0; *(f32x4*)(ap + 4) = v1; }
                        else { v0 += *(const f32x4*)ap; v1 += *(const f32x4*)(ap + 4);
                            if (br == 1) { *(f32x4*)ap = v0; *(f32x4*)(ap + 4) = v1; }
                            else { u32x4 o; o[0] = cvt_pk_bf16(v0[0], v0[1]); o[1] = cvt_pk_bf16(v0[2], v0[3]); o[2] = cvt_pk_bf16(v1[0], v1[1]); o[3] = cvt_pk_bf16(v1[2], v1[3]);
                                *(u32x4*)(O + row * 2048 + col) = o; } } } }
        } else {
            const int row0 = u.pm * BM + wr * 64 + fr, col0 = u.pn * BM + wc * 32 + 8 * fq;
#pragma unroll
            for (int ai = 0; ai < 2; ++ai)
#pragma unroll
                for (int m = 0; m < 4; ++m) { const int row = row0 + ai * HALF + m * 16;
                    const int mrow = row < NLAT ? (row >> 12) : 2;
                    const float* xr = row < NLAT ? xin_lat + (size_t)row * 2048 : xin_ctx + (size_t)(row - NLAT) * 2048;
                    const float* gr = gate + (size_t)mrow * 12288; float* orow = XL + (size_t)row * 2048;
#pragma unroll
                    for (int bj = 0; bj < 2; ++bj)
#pragma unroll
                        for (int n = 0; n < 2; ++n) { const int col = col0 + bj * HALF + n * 4;
                            const f32x4 g = *(const f32x4*)(gr + col);
                            if (split) *(f32x4*)(part + (size_t)(row - NLAT) * 2048 + col) = acc[ai][bj][m][n];
                            else { const f32x4 x = *(const f32x4*)(xr + col); *(f32x4*)(orow + col) = x + g * acc[ai][bj][m][n]; } } }
        }
    }
};
template <class Epi, class Sched>
__device__ __forceinline__ void gemm_phase(LAS unsigned char* lds, const Gemm g, const Sched& S, const Epi& E) {
    const int tid = otid(), wid = __builtin_amdgcn_readfirstlane(tid >> 6), lane = tid & 63, wr = wid >> 2, wc = wid & 3, fr = lane & 15, fq = lane >> 4;
    const int K = g.K, nt = g.nt;
    unsigned voffA[2], voffB[2];
#pragma unroll
    for (int i = 0; i < 2; ++i) { int R, C; stage_rc(tid * 16 + i * 8192, R, C); const int Rb = Epi::PERM ? ((R & ~31) + perm32(R & 31)) : R;
        voffA[i] = (unsigned)(R * K + C) * 2u; voffB[i] = (unsigned)(Rb * K + C) * 2u; }
    const size_t kstep = (size_t)(BK * 2);
    const size_t hstep = (size_t)HALF * K * 2;
    const size_t tstep = 2 * hstep;
    const unsigned ldsw = (unsigned)wid * 1024u;
    const int aoff = lds_byte(wr * 64 + fr, fq * 8), boff = lds_byte(wc * 32 + fr, fq * 8);
#define PG8_SA(b, h) (((b) * 2 + (h)) * HTB)
#define PG8_SB(b, h) ((4 + (b) * 2 + (h)) * HTB)
#define PG8_STAGE(bufoff, gbase, voff) do { _Pragma("unroll") for (int _i = 0; _i < 2; ++_i) \
        __builtin_amdgcn_global_load_lds((const unsigned*)((const char*)(gbase) + (voff)[_i]), (LAS unsigned*)(lds + (bufoff) + ldsw + _i * 8192), 16, 0, 0); } while (0)
#define PG8_LDA(dst, b, h) do { _Pragma("unroll") for (int m = 0; m < 4; ++m) _Pragma("unroll") for (int k = 0; k < 2; ++k) dst[m][k] = *(const LAS bf16x8*)(lds + PG8_SA(b, h) + aoff + m * 2048 + k * 1024); } while (0)
#define PG8_LDB(dst, b, h) do { _Pragma("unroll") for (int n = 0; n < 2; ++n) _Pragma("unroll") for (int k = 0; k < 2; ++k) dst[n][k] = *(const LAS bf16x8*)(lds + PG8_SB(b, h) + boff + n * 2048 + k * 1024); } while (0)
#define PG8_MMA(ai, bj, At, Bt) do { __builtin_amdgcn_s_setprio(1); _Pragma("unroll") for (int m = 0; m < 4; ++m) _Pragma("unroll") for (int n = 0; n < 2; ++n) _Pragma("unroll") for (int k = 0; k < 2; ++k) \
        acc[ai][bj][m][n] = __builtin_amdgcn_mfma_f32_16x16x32_bf16(Bt[n][k], At[m][k], acc[ai][bj][m][n], 0, 0, 0); __builtin_amdgcn_s_setprio(0); } while (0)
#define PG8_WAIT_V(n) asm volatile("s_waitcnt vmcnt(" #n ")" ::: "memory")
#define PG8_WAIT_L(n) asm volatile("s_waitcnt lgkmcnt(" #n ")" ::: "memory")
#define PG8_BAR __builtin_amdgcn_s_barrier()
#define PG8_SCHED __builtin_amdgcn_sched_barrier(0)
    Unit cur, nxt; int ui = 0;
    if (!S.next(0, cur)) return;
    f32x4 acc[2][2][4][2];
#pragma unroll
    for (int a = 0; a < 2; ++a)
#pragma unroll
        for (int b = 0; b < 2; ++b)
#pragma unroll
            for (int m = 0; m < 4; ++m)
#pragma unroll
                for (int n = 0; n < 2; ++n) acc[a][b][m][n] = (f32x4){0.f, 0.f, 0.f, 0.f};
    bf16x8 At[4][2], B0[2][2], B1[2][2];
    const char* cA = (const char*)g.A + (size_t)cur.pm * tstep; const char* cB = (const char*)g.Bt + (size_t)cur.pn * tstep;
    S.a_ready(cur);
    PG8_STAGE(PG8_SB(0, 0), cB, voffB); PG8_STAGE(PG8_SA(0, 0), cA, voffA); PG8_STAGE(PG8_SB(0, 1), cB + hstep, voffB); PG8_STAGE(PG8_SA(0, 1), cA + hstep, voffA);
    if (wr == 1) PG8_BAR;
    PG8_WAIT_V(4); PG8_BAR;
    PG8_STAGE(PG8_SB(1, 0), cB + kstep, voffB); PG8_STAGE(PG8_SA(1, 0), cA + kstep, voffA); PG8_STAGE(PG8_SB(1, 1), cB + hstep + kstep, voffB);
    PG8_WAIT_V(6); PG8_BAR;
    for (;;) {
        const bool has_next = S.next(ui + 1, nxt);
        const char* nA = has_next ? (const char*)g.A + (size_t)nxt.pm * tstep : cA; const char* nB = has_next ? (const char*)g.Bt + (size_t)nxt.pn * tstep : cB;
        for (int t = 0; t < nt; t += 2) {
            const bool last = (t == nt - 2);
            const char* a1 = cA + (size_t)(t + 1) * kstep;
            const char* a2 = last ? nA : cA + (size_t)(t + 2) * kstep; const char* b2 = last ? nB : cB + (size_t)(t + 2) * kstep;
            const char* a3 = a2 + kstep; const char* b3 = b2 + kstep;
            if (last && has_next) S.a_ready(nxt);
            PG8_LDB(B0, 0, 0); PG8_SCHED; PG8_LDA(At, 0, 0); PG8_STAGE(PG8_SA(1, 1), a1 + hstep, voffA);
            PG8_WAIT_L(8); PG8_BAR; PG8_WAIT_L(0); PG8_MMA(0, 0, At, B0); PG8_BAR; PG8_SCHED;
            PG8_LDB(B1, 0, 1); PG8_STAGE(PG8_SB(0, 0), b2, voffB);
            PG8_BAR; PG8_WAIT_L(0); PG8_MMA(0, 1, At, B1); PG8_BAR;
            PG8_LDA(At, 0, 1); PG8_STAGE(PG8_SA(0, 0), a2, voffA);
            PG8_BAR; PG8_WAIT_L(0); PG8_MMA(1, 0, At, B0); PG8_BAR; PG8_SCHED;
            PG8_STAGE(PG8_SB(0, 1), b2 + hstep, voffB);
            PG8_WAIT_V(6); PG8_BAR; PG8_MMA(1, 1, At, B1); PG8_BAR;
            PG8_LDB(B0, 1, 0); PG8_SCHED; PG8_LDA(At, 1, 0); PG8_STAGE(PG8_SA(0, 1), a2 + hstep, voffA);
            PG8_WAIT_L(8); PG8_BAR; PG8_WAIT_L(0); PG8_MMA(0, 0, At, B0); PG8_BAR; PG8_SCHED;
            PG8_LDB(B1, 1, 1); PG8_STAGE(PG8_SB(1, 0), b3, voffB);
            PG8_BAR; PG8_WAIT_L(0); PG8_MMA(0, 1, At, B1); PG8_BAR;
            PG8_LDA(At, 1, 1); PG8_STAGE(PG8_SA(1, 0), a3, voffA);
            PG8_BAR; PG8_WAIT_L(0); PG8_MMA(1, 0, At, B0); PG8_BAR; PG8_SCHED;
            PG8_STAGE(PG8_SB(1, 1), b3 + hstep, voffB);
            PG8_WAIT_V(6); PG8_BAR; PG8_MMA(1, 1, At, B1); PG8_BAR;
        }
        if constexpr (!Epi::AFTER_DRAIN) { E(acc, cur, wr, wc, fr, fq); S.done(cur); }
        if (!has_next) break;
#pragma unroll
        for (int a = 0; a < 2; ++a)
#pragma unroll
            for (int b = 0; b < 2; ++b)
#pragma unroll
                for (int m = 0; m < 4; ++m)
#pragma unroll
                    for (int n = 0; n < 2; ++n) acc[a][b][m][n] = (f32x4){0.f, 0.f, 0.f, 0.f};
        cur = nxt; cA = nA; cB = nB; ++ui;
    }
    PG8_WAIT_V(0);
    if (wr == 0) PG8_BAR;
    PG8_BAR;
    if constexpr (Epi::AFTER_DRAIN) { E.fused(acc, cur, wr, wc, fr, fq, lds, wid, lane); S.done(cur); }
#undef PG8_SA
#undef PG8_SB
#undef PG8_STAGE
#undef PG8_LDA
#undef PG8_LDB
#undef PG8_MMA
#undef PG8_WAIT_V
#undef PG8_WAIT_L
#undef PG8_BAR
#undef PG8_SCHED
}
}

__device__ void phase_mod(PP p, float* lds) {
    const int TIDX = otid();
    const int tid = TIDX;
    float* s = lds;
    float* red = lds + 3 * 2048;
    float* MOD = (float*)(p->ws + OFF_MOD);
    for (int i = tid; i < 3 * 2048; i += 512) { const int r = i >> 11, k = i & 2047; const float c = r < 2 ? p->in[I_C][r * 2048 + k] : p->in[I_CCTX][k]; s[i] = c * sigmoidf(c); }
    __syncthreads();
    for (int task = blockIdx.x; task < 192; task += gridDim.x) {
        const int l = task / 96, j0 = (task % 96) * 128, jc = tid & 127, kp = tid >> 7;
        const float* w = p->in[I_WMOD] + (size_t)l * 2048 * 12288 + j0 + jc;
        float a0 = 0.f, a1 = 0.f, a2 = 0.f;
#pragma unroll 8
        for (int k = kp * 512; k < kp * 512 + 512; ++k) { const float wv = w[(size_t)k * 12288]; a0 += s[k] * wv; a1 += s[2048 + k] * wv; a2 += s[4096 + k] * wv; }
        red[(kp * 3 + 0) * 128 + jc] = a0; red[(kp * 3 + 1) * 128 + jc] = a1; red[(kp * 3 + 2) * 128 + jc] = a2;
        __syncthreads();
        if (tid < 384) { const int r = tid >> 7, j = tid & 127;
            const float v = ((red[(0 * 3 + r) * 128 + j] + red[(1 * 3 + r) * 128 + j]) + (red[(2 * 3 + r) * 128 + j] + red[(3 * 3 + r) * 128 + j])) + p->in[I_BMOD][l * 12288 + j0 + j];
            MOD[(size_t)(l * 3 + r) * 12288 + j0 + j] = v; }
        __syncthreads();
    }
    if (blockIdx.x == gridDim.x - 1) {
        float* rc = (float*)(p->ws + OFF_ROPE); float* rs = rc + 2048;
        for (int i = tid; i < 2048; i += 512) { const int pos = i >> 5, j = i & 31; const float fr = powf(10000.0f, -(float)j / 32.0f); const float ang = (float)pos * fr; rc[i] = cosf(ang); rs[i] = sinf(ang); }
    }
}

__device__ void conv_tile(const float* __restrict__ src, int ld_src, int n_valid, int n0, int k0, bf16_t* __restrict__ dst, int ld_dst, float* tile) {
    const int TIDX = otid();
    const int tid = TIDX;
#pragma unroll
    for (int i = 0; i < 2; ++i) { const int kr = (tid >> 4) + i * 32, nc = (tid & 15) * 4; const float* sp = src + (size_t)(k0 + kr) * ld_src + n0 + nc;
        f32x4 v;
        if (n0 + nc + 3 < n_valid) v = *(const f32x4*)sp;
        else { v[0] = (n0 + nc + 0 < n_valid) ? sp[0] : 0.f; v[1] = (n0 + nc + 1 < n_valid) ? sp[1] : 0.f; v[2] = (n0 + nc + 2 < n_valid) ? sp[2] : 0.f; v[3] = (n0 + nc + 3 < n_valid) ? sp[3] : 0.f; }
        float* tp = tile + kr * 65 + nc; tp[0] = v[0]; tp[1] = v[1]; tp[2] = v[2]; tp[3] = v[3]; }
    __syncthreads();
    { const int n = tid >> 3, kc = (tid & 7) * 8; u32x4 o;
#pragma unroll
        for (int j = 0; j < 4; ++j) o[j] = pack2(tile[(kc + 2 * j) * 65 + n], tile[(kc + 2 * j + 1) * 65 + n]);
        *(u32x4*)(dst + (size_t)(n0 + n) * ld_dst + k0 + kc) = o; }
    __syncthreads();
}
__device__ void phase_convert(PP p, int l, float* lds, int vb, int vg, size_t wsh, int t_lo, int t_hi, bool lora) {
    const int TIDX = otid();
    unsigned char* wsw = p->ws + wsh;
    for (int t = t_lo + vb; t < t_hi; t += vg) {
        if (t < 8064) { const int nt = t >> 5, kt = t & 31; conv_tile(p->in[I_WIN] + (size_t)l * 2048 * DIN, DIN, DIN, nt * 64, kt * 64, (bf16_t*)(wsw + OFF_WIN), 2048, lds); }
        else if (t < 9600) { const int tt = t - 8064, br = tt >> 9, r = tt & 511, nt = r >> 4, kt = r & 15;
            conv_tile(p->in[I_WBR] + (size_t)(l * 3 + br) * 1024 * 2048, 2048, 2048, nt * 64, kt * 64, (bf16_t*)(wsw + OFF_WBR) + (size_t)br * 2048 * 1024, 1024, lds); }
        else if (t < 10624) { const int tt = t - 9600, nt = tt >> 5, kt = tt & 31; conv_tile(p->in[I_WOUT] + (size_t)l * 2048 * 2048, 2048, 2048, nt * 64, kt * 64, (bf16_t*)(wsw + OFF_WOUT), 2048, lds); }
        else if (t < 14720) { const int tt = t - 10624, nt = tt >> 5, kt = tt & 31; conv_tile(p->in[I_WFF1] + (size_t)l * 2048 * 8192, 8192, 8192, nt * 64, kt * 64, (bf16_t*)(wsw + OFF_WFF1), 2048, lds); }
        else { const int tt = t - 14720, nt = tt >> 7, kt = tt & 127; conv_tile(p->in[I_WFF2] + (size_t)l * 8192 * 2048, 2048, 2048, nt * 64, kt * 64, (bf16_t*)(wsw + OFF_WFF2), 8192, lds); }
    }
    bf16_t* WL = (bf16_t*)(wsw + OFF_WLORA);
    if (lora) for (int idx = vb * 512 + TIDX; idx < 5120 * 640; idx += vg * 512) {
        const int n = idx / 640, k = idx - n * 640, blk = n >> 10, nn = n & 1023;
        const int k0 = blk < 4 ? blk * 96 : 384, kw = blk < 4 ? 96 : 256;
        float v = 0.f;
        if (k >= k0 && k < k0 + kw) {
            const float* sp = blk < 2 ? p->in[I_RWWUP] + (size_t)(l * 2 + blk) * 96 * 1024 : (blk < 4 ? p->in[I_RWAUP] + (size_t)(l * 2 + blk - 2) * 96 * 1024 : p->in[I_RWGUP] + (size_t)l * 256 * 1024);
            v = sp[(size_t)(k - k0) * 1024 + nn]; }
        WL[idx] = f2bf(v);
    }
}
__device__ void phase_init(PP p, int l) {
    const int TIDX = otid();
    if (blockIdx.x == 0 && TIDX < 8) ((unsigned*)(p->ws + OFF_CTL))[l * 8 + TIDX] = 0u;
}

__device__ __forceinline__ void phase_norm(const float* __restrict__ xlat, const float* __restrict__ xctx, int nrows, const float* __restrict__ g, const float* __restrict__ modl, int ishift, int iscale, bf16_t* __restrict__ H,
                           const float* part = nullptr, const float* pgate = nullptr, float* xl_ctx = nullptr) {
    const int TIDX = otid();
    const int wid = TIDX >> 6, lane = TIDX & 63;
    for (int row = blockIdx.x * 8 + wid; row < nrows; row += gridDim.x * 8) {
        const float* xr = row < NLAT ? xlat + (size_t)row * 2048 : xctx + (size_t)(row - NLAT) * 2048;
        const int mrow = row < NLAT ? (row >> 12) : 2;
        const float* sh = modl + (size_t)mrow * 12288 + ishift * 2048; const float* sc = modl + (size_t)mrow * 12288 + iscale * 2048;
        f32x4 v[8]; float ss = 0.f;
#pragma unroll
        for (int i = 0; i < 8; ++i) v[i] = *(const f32x4*)(xr + (i * 64 + lane) * 4);
        if (part != nullptr && row >= NLAT) {
#pragma unroll
            for (int i = 0; i < 8; ++i) { const int col = (i * 64 + lane) * 4; const float* pp = part + (size_t)(row - NLAT) * 2048 + col;
                f32x4 a = *(const f32x4*)pp;
#pragma unroll
                for (int s_ = 1; s_ < 16; ++s_) a += *(const f32x4*)(pp + (size_t)s_ * 512 * 2048);
                v[i] += *(const f32x4*)(pgate + col) * a;
                *(f32x4*)(xl_ctx + (size_t)(row - NLAT) * 2048 + col) = v[i]; } }
#pragma unroll
        for (int i = 0; i < 8; ++i) ss += v[i][0] * v[i][0] + v[i][1] * v[i][1] + v[i][2] * v[i][2] + v[i][3] * v[i][3];
        ss = wsum(ss);
        const float r = rsqrtf(ss * (1.0f / 2048.0f) + 1e-6f);
#pragma unroll
        for (int i = 0; i < 8; ++i) { const int col = (i * 64 + lane) * 4; const f32x4 gg = *(const f32x4*)(g + col), s1 = *(const f32x4*)(sc + col), s0 = *(const f32x4*)(sh + col);
            float o[4];
#pragma unroll
            for (int j = 0; j < 4; ++j) o[j] = (v[i][j] * r * gg[j]) * (1.0f + s1[j]) + s0[j];
            u32x2 w; w[0] = pack2(o[0], o[1]); w[1] = pack2(o[2], o[3]);
            *(u32x2*)(H + (size_t)row * 2048 + col) = w; }
    }
}
__device__ void phase_final(PP p) {
    const int TIDX = otid();
    const int wid = TIDX >> 6, lane = TIDX & 63;
    const float* XL = (const float*)(p->ws + OFF_XL); const float* g = p->in[I_FING];
    for (int row = blockIdx.x * 8 + wid; row < NLAT; row += gridDim.x * 8) {
        const float* xr = XL + (size_t)row * 2048;
        f32x4 v[8]; float ss = 0.f;
#pragma unroll
        for (int i = 0; i < 8; ++i) { v[i] = *(const f32x4*)(xr + (i * 64 + lane) * 4); ss += v[i][0] * v[i][0] + v[i][1] * v[i][1] + v[i][2] * v[i][2] + v[i][3] * v[i][3]; }
        ss = wsum(ss);
        const float r = rsqrtf(ss * (1.0f / 2048.0f) + 1e-6f);
#pragma unroll
        for (int i = 0; i < 8; ++i) { const int col = (i * 64 + lane) * 4; const f32x4 gg = *(const f32x4*)(g + col);
            f32x4 o; o[0] = v[i][0] * r * gg[0]; o[1] = v[i][1] * r * gg[1]; o[2] = v[i][2] * r * gg[2]; o[3] = v[i][3] * r * gg[3];
            *(f32x4*)(p->out + (size_t)row * 2048 + col) = o; }
    }
}

DEVI void seq_nbrs(int row, bool& hp, bool& hn) {
    if (row < NLAT) { const int t = row & 4095; hp = t > 0; hn = t < 4095; } else { const int m = (row - NLAT) & 255; hp = m > 0; hn = m < 255; }
}
DEVI float shiftf(float c, float pv, float nx, float mu) { return c + mu * (0.5f * (pv + nx) - c); }

__device__ void phase_prep(PP p, int l, bf16_t* ldsT) {
    const int TIDX = otid();
    const bf16_t* P = (const bf16_t*)(p->ws + OFF_P); bf16_t* LA = (bf16_t*)(p->ws + OFF_LA);
    const float* mu = p->in[I_RWMU] + (size_t)l * 3712 + 3072;
    for (int idx = blockIdx.x * 512 + TIDX; idx < NTOK * 80; idx += gridDim.x * 512) {
        const int row = idx / 80, j = (idx - row * 80) * 8;
        bool hp, hn; seq_nbrs(row, hp, hn);
        const bf16_t* pc = P + (size_t)row * NP + RWB + 3072 + j;
        const u32x4 c = *(const u32x4*)pc;
        const u32x4 z = {0u, 0u, 0u, 0u};
        const u32x4 pv = hp ? *(const u32x4*)(pc - NP) : z, nx = hn ? *(const u32x4*)(pc + NP) : z;
        float o[8];
#pragma unroll
        for (int q = 0; q < 4; ++q) { o[2 * q] = shiftf(bflo(c[q]), bflo(pv[q]), bflo(nx[q]), mu[j + 2 * q]); o[2 * q + 1] = shiftf(bfhi(c[q]), bfhi(pv[q]), bfhi(nx[q]), mu[j + 2 * q + 1]); }
        if (j < 192) {
#pragma unroll
            for (int q = 0; q < 8; ++q) o[q] = (1.0f - 2.0f * __builtin_amdgcn_rcpf(1.0f + __expf(2.0f * o[q]))); }
        else if (j >= 384) {
#pragma unroll
            for (int q = 0; q < 8; ++q) o[q] = sigmoidf(o[q]); }
        u32x4 w; w[0] = pack2(o[0], o[1]); w[1] = pack2(o[2], o[3]); w[2] = pack2(o[4], o[5]); w[3] = pack2(o[6], o[7]);
        *(u32x4*)(LA + (size_t)row * 640 + j) = w;
    }
    bf16_t* VT = (bf16_t*)(p->ws + OFF_VT);
    const int tid = TIDX;
    for (int t = blockIdx.x; t < 136 * 16; t += gridDim.x) {
        const int rt = t >> 4, hd = t & 15, h = hd >> 1, dh = hd & 1;
        const int row0 = rt * 64;
        { const int tl = tid >> 3, dc = (tid & 7) * 8;
            const u32x4 v = *(const u32x4*)(P + (size_t)(row0 + tl) * NP + NAB + 2048 + h * 128 + dh * 64 + dc);
            bf16_t* tp = ldsT + tl * 66 + dc;
#pragma unroll
            for (int q = 0; q < 4; ++q) { tp[2 * q] = (bf16_t)(v[q] & 0xffffu); tp[2 * q + 1] = (bf16_t)(v[q] >> 16); } }
        __syncthreads();
        { const int d = tid >> 3, tc = (tid & 7) * 8;
            int b, pos; if (row0 < NLAT) { b = row0 >> 12; pos = row0 & 4095; } else { b = (row0 - NLAT) >> 8; pos = 4096 + ((row0 - NLAT) & 255); }
            u32x4 o;
#pragma unroll
            for (int q = 0; q < 4; ++q) o[q] = (unsigned)ldsT[(tc + 2 * q) * 66 + d] | ((unsigned)ldsT[(tc + 2 * q + 1) * 66 + d] << 16);
            *(u32x4*)(VT + ((size_t)((b * 8 + h) * 128 + dh * 64 + d)) * 4352 + pos + tc) = o; }
        __syncthreads();
    }
}

DEVI int scan_row(int s, int b, int dir) {
    if (s < 256) { const int m = dir ? 255 - s : s; return NLAT + b * 256 + m; }
    const int t = dir ? 4095 - (s - 256) : s - 256; return b * 4096 + t;
}
__device__ void rwkv_scan(PP p, int l, int task, float* lds) {
    const int TIDX = otid();
    const int chain = task >> 1, half = task & 1;
    const int b = chain >> 5, h = (chain >> 1) & 15, dir = chain & 1, tid = TIDX;
    const bf16_t* P = (const bf16_t*)(p->ws + OFF_P); const bf16_t* LO = (const bf16_t*)(p->ws + OFF_LO);
    float* YO = (float*)(p->ws + OFF_YRWF) + (size_t)dir * NTOK * 1024 + h * 64;
    const int sl = tid >> 5, e2 = (tid & 31) * 2, ch = h * 64 + e2;
    const float* MU = p->in[I_RWMU] + (size_t)l * 3712;
    const float mur0 = MU[ch], mur1 = MU[ch + 1], muk0 = MU[1024 + ch], muk1 = MU[1024 + ch + 1], muv0 = MU[2048 + ch], muv1 = MU[2048 + ch + 1];
    const float w00 = p->in[I_RWW0][(l * 2 + dir) * 1024 + ch], w01 = p->in[I_RWW0][(l * 2 + dir) * 1024 + ch + 1];
    const float a00 = p->in[I_RWA0][(l * 2 + dir) * 1024 + ch], a01 = p->in[I_RWA0][(l * 2 + dir) * 1024 + ch + 1];
    const float kk0 = p->in[I_RWKK][l * 1024 + ch], kk1 = p->in[I_RWKK][l * 1024 + ch + 1], ka0 = p->in[I_RWKA][l * 1024 + ch], ka1 = p->in[I_RWKA][l * 1024 + ch + 1];
    const float rk0 = p->in[I_RWRK][l * 1024 + ch], rk1 = p->in[I_RWRK][l * 1024 + ch + 1];
    float* RK = (float*)(p->ws + OFF_RK); const bool wrk = dir == 0 && half == 0; int srow = 0;
    const int kq = tid & 15, v = half * 32 + (tid >> 4);
    f32x2 S0 = (f32x2){0.f, 0.f}, S1 = (f32x2){0.f, 0.f};
    unsigned rc, rp, rn, kc, kp, kn, vc, vp, vn, wr_, ar_;
    auto issue = [&](int g) {
        const int row = scan_row(g * 16 + sl, b, dir); bool hp, hn; seq_nbrs(row, hp, hn); srow = row;
        const bf16_t* pr = P + (size_t)row * NP + RWB + ch;
        rc = *(const unsigned*)pr; kc = *(const unsigned*)(pr + 1024); vc = *(const unsigned*)(pr + 2048);
        rp = 0u; kp = 0u; vp = 0u; rn = 0u; kn = 0u; vn = 0u;
        if (hp) { rp = *(const unsigned*)(pr - NP); kp = *(const unsigned*)(pr - NP + 1024); vp = *(const unsigned*)(pr - NP + 2048); }
        if (hn) { rn = *(const unsigned*)(pr + NP); kn = *(const unsigned*)(pr + NP + 1024); vn = *(const unsigned*)(pr + NP + 2048); }
        const bf16_t* lo = LO + (size_t)row * 5120 + dir * 1024 + ch;
        wr_ = *(const unsigned*)lo; ar_ = *(const unsigned*)(lo + 2048);
    };
    auto commit = [&](int buf) {
        float* st = lds + buf * 6144 + sl * 384 + e2;
        const float r0 = shiftf(bflo(rc), bflo(rp), bflo(rn), mur0), r1 = shiftf(bfhi(rc), bfhi(rp), bfhi(rn), mur1);
        const float k0 = shiftf(bflo(kc), bflo(kp), bflo(kn), muk0), k1 = shiftf(bfhi(kc), bfhi(kp), bfhi(kn), muk1);
        const float v0 = shiftf(bflo(vc), bflo(vp), bflo(vn), muv0), v1 = shiftf(bfhi(vc), bfhi(vp), bfhi(vn), muv1);
        const float x0 = -(w00 + bflo(wr_)), x1 = -(w01 + bfhi(wr_));
        const float sp0 = x0 > 20.f ? x0 : __logf(1.0f + __expf(x0)), sp1 = x1 > 20.f ? x1 : __logf(1.0f + __expf(x1));
        const float d0 = __expf(-__expf(-sp0 - 0.5f)), d1 = __expf(-__expf(-sp1 - 0.5f));
        const float ar0 = fsigmoid(a00 + bflo(ar_)), ar1 = fsigmoid(a01 + bfhi(ar_));
        const float kd0 = k0 * (1.0f + (ar0 - 1.0f) * ka0), kd1 = k1 * (1.0f + (ar1 - 1.0f) * ka1);
        const float q0 = k0 * kk0, q1 = k1 * kk1;
        float ss = red16(q0 * q0 + q1 * q1);
        ss += __shfl_xor(ss, 16);
        const float inv = frcp(fmaxf(__builtin_amdgcn_sqrtf(ss), 1e-12f));
        const float n0 = q0 * inv, n1 = q1 * inv;
        if (wrk) { float t = red16(r0 * k0 * rk0 + r1 * k1 * rk1); t += __shfl_xor(t, 16); if ((tid & 31) == 0) RK[srow * 16 + h] = t; }
        *(f32x2*)(st + 0) = (f32x2){r0, r1}; *(f32x2*)(st + 64) = (f32x2){d0, d1}; *(f32x2*)(st + 128) = (f32x2){kd0, kd1};
        *(f32x2*)(st + 192) = (f32x2){v0, v1}; *(f32x2*)(st + 256) = (f32x2){-n0, -n1}; *(f32x2*)(st + 320) = (f32x2){n0 * ar0, n1 * ar1};
    };
    __syncthreads();
    issue(0); commit(0);
    __syncthreads();
    constexpr int NG = 4352 / 16;
    for (int g = 0; g < NG; ++g) {
        if (g + 1 < NG) issue(g + 1);
        {
            const float* base = lds + (g & 1) * 6144 + kq * 4;
            float ykeep = 0.f;
            f32x4 nA, nD, nB, nK, nR; float nV;
#define RW_LOAD(i_) do { const float* st_ = base + (i_) * 384; nA = *(const f32x4*)(st_ + 256); nD = *(const f32x4*)(st_ + 64); nB = *(const f32x4*)(st_ + 320); nK = *(const f32x4*)(st_ + 128); nR = *(const f32x4*)(st_); \
                nV = st_[192 - kq * 4 + v]; } while (0)
            RW_LOAD(0);
#pragma unroll
            for (int i = 0; i < 16; ++i) {
                const f32x4 a = nA, d = nD, bb = nB, k = nK, r = nR; const float vv = nV;
                if (i < 15) { RW_LOAD(i + 1); }
                __builtin_amdgcn_sched_barrier(0x77);
                f32x2 pa2 = S0 * (f32x2){a[0], a[1]}; pa2 = S1 * (f32x2){a[2], a[3]} + pa2;
                const f32x2 vvb = (f32x2){vv, vv};
                const f32x2 u0 = S0 * (f32x2){d[0], d[1]} + vvb * (f32x2){k[0], k[1]}, u1 = S1 * (f32x2){d[2], d[3]} + vvb * (f32x2){k[2], k[3]};
                const float pa = red16(pa2[0] + pa2[1]);
                const f32x2 pab = (f32x2){pa, pa};
                S0 = pab * (f32x2){bb[0], bb[1]} + u0; S1 = pab * (f32x2){bb[2], bb[3]} + u1;
                f32x2 y2 = S0 * (f32x2){r[0], r[1]}; y2 = S1 * (f32x2){r[2], r[3]} + y2;
                const float y = red16(y2[0] + y2[1]);
                ykeep = (kq == i) ? y : ykeep;
            }
#undef RW_LOAD
            YO[(size_t)scan_row(g * 16 + kq, b, dir) * 1024 + v] = ykeep;
        }
        if (g + 1 < NG) commit((g + 1) & 1);
        __syncthreads();
    }
}

__device__ void mlstm_scan(PP p, int l, int chain, int g8, float* lds) {
    const int TIDX = otid();
    const int b = chain >> 3, h = (chain >> 1) & 3, dir = chain & 1, tid = TIDX;
    const bf16_t* P = (const bf16_t*)(p->ws + OFF_P);
    const float* RC = (const float*)(p->ws + OFF_ROPE); const float* RS = RC + 2048;
    float* NO = (float*)(p->ws + OFF_MLNUM) + (size_t)dir * NTOK * 4 * 272 + h * 272;
    const int sl = tid >> 5, j = tid & 31;
    const float gbi = p->in[I_MLGB][l * 16 + (dir * 2 + 0) * 4 + h], gbf = p->in[I_MLGB][l * 16 + (dir * 2 + 1) * 4 + h];
    const int rowl = (tid >> 3) & 31, kq = tid & 7, crow = g8 * 32 + rowl, lane = tid & 63;
    f32x2 C[8];
#pragma unroll
    for (int i = 0; i < 8; ++i) C[i] = (f32x2){0.f, 0.f};
    f32x2 nst = (f32x2){0.f, 0.f};
    bf16_t q0, q1, q2, q3, k0, k1, k2, k3, gi, gf; unsigned vv2; float cr, sr, cc, sc;
    auto issue = [&](int g) {
        const int row = scan_row(g * 16 + sl, b, dir);
        const bf16_t* pr = P + (size_t)row * NP;
        const bf16_t* pq = pr + h * 128 + j; const bf16_t* pk = pr + 512 + h * 128 + j;
        q0 = pq[0]; q1 = pq[32]; q2 = pq[64]; q3 = pq[96]; k0 = pk[0]; k1 = pk[32]; k2 = pk[64]; k3 = pk[96];
        vv2 = j < 16 ? *(const unsigned*)(pr + 1024 + h * 256 + g8 * 32 + 2 * j) : 0u;
        gi = pr[3072 + (dir * 2 + 0) * 4 + h]; gf = pr[3072 + (dir * 2 + 1) * 4 + h];
        if (row < NLAT) { const int t = row & 4095, pr_ = t >> 6, pc_ = t & 63; cr = RC[pr_ * 32 + j]; sr = RS[pr_ * 32 + j]; cc = RC[pc_ * 32 + j]; sc = RS[pc_ * 32 + j]; }
        else { cr = 1.f; sr = 0.f; cc = 1.f; sc = 0.f; }
    };
    auto commit = [&](int buf) {
        float* st = lds + buf * 5376 + sl * 336;
        const float scale = 0.08838834764831845f;
        const float a0 = bf2f(q0), a1 = bf2f(q1), a2 = bf2f(q2), a3 = bf2f(q3);
        st[j] = (a0 * cr - a1 * sr) * scale; st[32 + j] = (a0 * sr + a1 * cr) * scale; st[64 + j] = (a2 * cc - a3 * sc) * scale; st[96 + j] = (a2 * sc + a3 * cc) * scale;
        const float c0 = bf2f(k0), c1 = bf2f(k1), c2 = bf2f(k2), c3 = bf2f(k3);
        st[128 + j] = c0 * cr - c1 * sr; st[160 + j] = c0 * sr + c1 * cr; st[192 + j] = c2 * cc - c3 * sc; st[224 + j] = c2 * sc + c3 * cc;
        if (j < 16) { st[256 + 2 * j] = bflo(vv2); st[257 + 2 * j] = bfhi(vv2); }
        if (j == 0) { st[320] = fsigmoid(bf2f(gf) + gbf); st[321] = __expf(bf2f(gi) + gbi); }
    };
    __syncthreads();
    issue(0); commit(0);
    __syncthreads();
    constexpr int NG = 4352 / 16;
    for (int g = 0; g < NG; ++g) {
        if (g + 1 < NG) issue(g + 1);
        const float* base = lds + (g & 1) * 5376;
        if (tid < 256) {
            float nkeep = 0.f, Fc = 1.0f;
            f32x4 nK[4], nQ[4]; float nF, nI, nV0;
#define ML_LOAD(i_) do { const float* st_ = base + (i_) * 336; _Pragma("unroll") for (int c4 = 0; c4 < 4; ++c4) { nK[c4] = *(const f32x4*)(st_ + 128 + c4 * 32 + kq * 4); nQ[c4] = *(const f32x4*)(st_ + c4 * 32 + kq * 4); } \
                nF = st_[320]; nI = st_[321]; nV0 = st_[256 + rowl]; } while (0)
            ML_LOAD(0);
#pragma unroll
            for (int i = 0; i < 16; ++i) {
                f32x4 kk[4], qq[4];
#pragma unroll
                for (int c4 = 0; c4 < 4; ++c4) { kk[c4] = nK[c4]; qq[c4] = nQ[c4]; }
                if (Fc < 1e-18f) {
                    const f32x2 fb = (f32x2){Fc, Fc};
#pragma unroll
                    for (int x = 0; x < 8; ++x) C[x] = C[x] * fb;
                    Fc = 1.0f; }
                Fc *= nF;
                const float coef = nI * nV0 * frcp(Fc);
                if (i < 15) { ML_LOAD(i + 1); }
                __builtin_amdgcn_sched_barrier(0x77);
                const f32x2 cf = (f32x2){coef, coef};
                f32x2 num2 = (f32x2){0.f, 0.f}, num3 = (f32x2){0.f, 0.f};
#pragma unroll
                for (int c4 = 0; c4 < 4; ++c4) {
                    const f32x2 KA = (f32x2){kk[c4][0], kk[c4][1]}, KB = (f32x2){kk[c4][2], kk[c4][3]}, QA = (f32x2){qq[c4][0], qq[c4][1]}, QB = (f32x2){qq[c4][2], qq[c4][3]};
                    C[2 * c4] = cf * KA + C[2 * c4]; C[2 * c4 + 1] = cf * KB + C[2 * c4 + 1];
                    num2 = C[2 * c4] * QA + num2; num3 = C[2 * c4 + 1] * QB + num3; }
                num2 += num3;
                const float num = red8(num2[0] + num2[1]) * Fc;
                nkeep = (kq == (i & 7)) ? num : nkeep;
                if ((i & 7) == 7) NO[(size_t)scan_row(g * 16 + (i - 7) + kq, b, dir) * (4 * 272) + crow] = nkeep;
            }
            { const f32x2 fb = (f32x2){Fc, Fc};
#pragma unroll
                for (int x = 0; x < 8; ++x) C[x] = C[x] * fb; }
#undef ML_LOAD
        } else if (g8 == 0 && tid < 320) {
            float nkeep = 0.f;
            f32x2 nk, nq; float nf, ni;
#define MN_LOAD(i_) do { const float* st_ = base + (i_) * 336; nk = *(const f32x2*)(st_ + 128 + 2 * lane); nq = *(const f32x2*)(st_ + 2 * lane); nf = st_[320]; ni = st_[321]; } while (0)
            MN_LOAD(0);
#pragma unroll
            for (int i = 0; i < 16; ++i) {
                const f32x2 kk = nk, qq = nq; const float f = nf, ig = ni;
                if (i < 15) { MN_LOAD(i + 1); }
                __builtin_amdgcn_sched_barrier(0x77);
                nst = (f32x2){f, f} * nst + (f32x2){ig, ig} * kk;
                const f32x2 d2 = nst * qq;
                const float den16 = red16(d2[0] + d2[1]);
                nkeep = ((lane & 15) == i) ? den16 : nkeep;
            }
#undef MN_LOAD
            nkeep += __shfl_xor(nkeep, 16); nkeep += __shfl_xor(nkeep, 32);
            if (lane < 16) NO[(size_t)scan_row(g * 16 + lane, b, dir) * (4 * 272) + 256] = nkeep;
        }
        if (g + 1 < NG) commit((g + 1) & 1);
        __syncthreads();
    }
}

#define MFMA16(a, b, c) __builtin_amdgcn_mfma_f32_16x16x32_bf16(a, b, c, 0, 0, 0)
__device__ void na_wave(PP p, int l, int task) {
    const int TIDX = otid();
    const bf16_t* P = (const bf16_t*)(p->ws + OFF_P); const bf16_t* VT = (const bf16_t*)(p->ws + OFF_VT);
    bf16_t* YN = (bf16_t*)(p->ws + OFF_Y3) + 2ull * NTOK * 1024;
    const int w = TIDX >> 6, lane = TIDX & 63, n16 = lane & 15, g = lane >> 4;
    int b, h, qrow, r = 0, qcol = 0, cs = 0, row_start = 0, c_start = 0; bool lat;
    if (task < 512) { lat = true; b = task >> 8; h = (task >> 5) & 7; const int pair = task & 31; r = pair * 2 + (w >> 2); const int qi = w & 3; qcol = qi * 16 + n16;
        qrow = b * 4096 + r * 64 + qcol; cs = qi == 0 ? 0 : (qi == 1 ? 8 : (qi == 2 ? 24 : 32)); row_start = min(max(r - 4, 0), 56); c_start = min(max(qcol - 8, 0), 48); }
    else { lat = false; const int t2 = task - 512; b = t2 >> 4; h = (t2 >> 1) & 7; const int chunk = t2 & 1; qrow = NLAT + b * 256 + chunk * 128 + w * 16 + n16; }
    bf16x8 qf[4];
#pragma unroll
    for (int c = 0; c < 4; ++c) qf[c] = *(const bf16x8*)(P + (size_t)qrow * NP + NAB + h * 128 + c * 32 + g * 8);
    const float* rpb = p->in[I_RPB] + (size_t)(l * 8 + h) * 15 * 31;
    const bf16_t* vtb = VT + (size_t)((b * 8 + h) * 128) * 4352;
    f32x4 O[8];
#pragma unroll
    for (int i = 0; i < 8; ++i) O[i] = (f32x4){0.f, 0.f, 0.f, 0.f};
    float mrun = -INFINITY, lsum = 0.f;
    const float scale = 0.08838834764831845f;
    for (int pass = lat ? 0 : 2; pass < 4; ++pass) {
        f32x4 S[8];
#pragma unroll
        for (int i = 0; i < 8; ++i) {
            int krowtok;
            if (pass < 2) { const int krow = row_start + pass * 4 + (i >> 1); krowtok = b * 4096 + krow * 64 + cs + (i & 1) * 16 + n16; }
            else krowtok = NLAT + b * 256 + (pass - 2) * 128 + i * 16 + n16;
            const bf16_t* kp = P + (size_t)krowtok * NP + NAB + 1024 + h * 128 + g * 8;
            f32x4 acc = (f32x4){0.f, 0.f, 0.f, 0.f};
#pragma unroll
            for (int c = 0; c < 4; ++c) { const bf16x8 kf = *(const bf16x8*)(kp + c * 32); acc = MFMA16(kf, qf[c], acc); }
            S[i] = acc;
        }
        float mx = -INFINITY;
#pragma unroll
        for (int i = 0; i < 8; ++i) {
            if (pass < 2) { const int krow = row_start + pass * 4 + (i >> 1); const float* rb = rpb + (krow - r + 7) * 31;
#pragma unroll
                for (int jj = 0; jj < 4; ++jj) { const int kc = cs + (i & 1) * 16 + 4 * g + jj; const bool ok = (kc >= c_start) && (kc < c_start + 16);
                    const int co = min(max(kc - qcol, -15), 15) + 15;
                    S[i][jj] = ok ? S[i][jj] * scale + rb[co] : -INFINITY; } }
            else {
#pragma unroll
                for (int jj = 0; jj < 4; ++jj) S[i][jj] *= scale; }
#pragma unroll
            for (int jj = 0; jj < 4; ++jj) mx = fmaxf(mx, S[i][jj]);
        }
        mx = fmaxf(mx, __shfl_xor(mx, 16)); mx = fmaxf(mx, __shfl_xor(mx, 32));
        const float mnew = fmaxf(mrun, mx);
        const float alpha = __expf(mrun - mnew);
        mrun = mnew; lsum *= alpha;
#pragma unroll
        for (int i = 0; i < 8; ++i) { O[i][0] *= alpha; O[i][1] *= alpha; O[i][2] *= alpha; O[i][3] *= alpha; }
        bf16x8 pf[4];
#pragma unroll
        for (int c = 0; c < 4; ++c) {
            float e[8];
#pragma unroll
            for (int jj = 0; jj < 4; ++jj) { e[jj] = __expf(S[2 * c][jj] - mnew); e[4 + jj] = __expf(S[2 * c + 1][jj] - mnew); }
#pragma unroll
            for (int jj = 0; jj < 8; ++jj) lsum += e[jj];
            u32x4 u; u[0] = pack2(e[0], e[1]); u[1] = pack2(e[2], e[3]); u[2] = pack2(e[4], e[5]); u[3] = pack2(e[6], e[7]);
            pf[c] = __builtin_bit_cast(bf16x8, u);
        }
#pragma unroll
        for (int c = 0; c < 4; ++c) {
            int pos0, pos1;
            if (pass < 2) { const int krow = row_start + pass * 4 + c; pos0 = krow * 64 + cs + 4 * g; pos1 = pos0 + 16; }
            else { pos0 = 4096 + (pass - 2) * 128 + c * 32 + 4 * g; pos1 = pos0 + 16; }
#pragma unroll
            for (int dt = 0; dt < 8; ++dt) {
                const bf16_t* vp = vtb + (size_t)(dt * 16 + n16) * 4352;
                const bf16x4 v0 = *(const bf16x4*)(vp + pos0), v1 = *(const bf16x4*)(vp + pos1);
                const bf16x8 vf = __builtin_shufflevector(v0, v1, 0, 1, 2, 3, 4, 5, 6, 7);
                O[dt] = MFMA16(vf, pf[c], O[dt]);
            }
        }
    }
    lsum += __shfl_xor(lsum, 16); lsum += __shfl_xor(lsum, 32);
    const float inv = 1.0f / lsum;
    bf16_t* yo = YN + (size_t)qrow * 1024 + h * 128 + 4 * g;
#pragma unroll
    for (int dt = 0; dt < 8; ++dt) { u32x2 o; o[0] = pack2(O[dt][0] * inv, O[dt][1] * inv); o[1] = pack2(O[dt][2] * inv, O[dt][3] * inv); *(u32x2*)(yo + dt * 16) = o; }
}

__device__ void na_block(PP p, int l, int task, unsigned char* lds) {
    const int TIDX = otid();
    const bf16_t* P = (const bf16_t*)(p->ws + OFF_P); const bf16_t* VT = (const bf16_t*)(p->ws + OFF_VT);
    bf16_t* YN = (bf16_t*)(p->ws + OFF_Y3) + 2ull * NTOK * 1024;
    const int tid = TIDX, w = tid >> 6, lane = tid & 63, n16 = lane & 15, g = lane >> 4, qi = w & 3, kh = w >> 2;
    const int b = task >> 9, h = (task >> 6) & 7, r = task & 63;
    const int qcol = qi * 16 + n16, qrow = b * 4096 + r * 64 + qcol;
    const int cs = qi == 0 ? 0 : (qi == 1 ? 8 : (qi == 2 ? 24 : 32)), row_start = min(max(r - 4, 0), 56), c_start = min(max(qcol - 8, 0), 48);
    unsigned char* KT = lds; unsigned char* VL = lds + 65536;
    bf16x8 qf[4];
#pragma unroll
    for (int c = 0; c < 4; ++c) qf[c] = *(const bf16x8*)(P + (size_t)qrow * NP + NAB + h * 128 + c * 32 + g * 8);
    const float* rpb = p->in[I_RPB] + (size_t)(l * 8 + h) * 15 * 31;
    const bf16_t* vtb = VT + (size_t)((b * 8 + h) * 128) * 4352;
    const bf16_t* kgb = P + NAB + 1024 + h * 128;
    f32x4 O[8];
#pragma unroll
    for (int i = 0; i < 8; ++i) O[i] = (f32x4){0.f, 0.f, 0.f, 0.f};
    float mrun = -INFINITY, lsum = 0.f;
    const float scale = 0.08838834764831845f;
    u32x4 kreg[8], vreg[8];
    auto gload = [&](int pass) {
#pragma unroll
        for (int i = 0; i < 8; ++i) { const int key = i * 32 + (tid >> 4), c16 = tid & 15, s_ = key >> 6, kk = key & 63;
            if (pass < 2) { const int krow = row_start + (s_ < 2 ? 2 * pass + s_ : 2 + 2 * pass + s_);
                kreg[i] = *(const u32x4*)(kgb + (size_t)(b * 4096 + krow * 64 + kk) * NP + c16 * 8); }
            else if (i < 4) { const int m = (s_ == 0 ? 0 : 128) + 64 * (pass - 2) + kk;
                kreg[i] = *(const u32x4*)(kgb + (size_t)(NLAT + b * 256 + m) * NP + c16 * 8); } }
#pragma unroll
        for (int i = 0; i < 8; ++i) { const int d = i * 16 + (tid >> 5), key8 = (tid & 31) * 8, s_ = key8 >> 6, kk = key8 & 63;
            if (pass < 2) { const int krow = row_start + (s_ < 2 ? 2 * pass + s_ : 2 + 2 * pass + s_);
                vreg[i] = *(const u32x4*)(vtb + (size_t)d * 4352 + krow * 64 + kk); }
            else if (key8 < 128) { const int m = (s_ == 0 ? 0 : 128) + 64 * (pass - 2) + kk;
                vreg[i] = *(const u32x4*)(vtb + (size_t)d * 4352 + 4096 + m); } }
    };
    auto lstore = [&](int pass) {
#pragma unroll
        for (int i = 0; i < 8; ++i) { const int key = i * 32 + (tid >> 4), c16 = tid & 15;
            if (pass < 2 || i < 4) *(u32x4*)(KT + key * 256 + ((c16 ^ (key & 15)) * 16)) = kreg[i]; }
#pragma unroll
        for (int i = 0; i < 8; ++i) { const int d = i * 16 + (tid >> 5), kc16 = tid & 31;
            if (pass < 2 || kc16 < 16) *(u32x4*)(VL + d * 512 + ((kc16 ^ (d & 15)) * 16)) = vreg[i]; }
    };
    gload(0);
    for (int pass = 0; pass < 4; ++pass) {
        __syncthreads();
        lstore(pass);
        __syncthreads();
        if (pass < 3) gload(pass + 1);
        f32x4 S[4];
#pragma unroll
        for (int i = 0; i < 4; ++i) {
            const int keyl = pass < 2 ? (kh * 2 + (i >> 1)) * 64 + cs + (i & 1) * 16 + n16 : kh * 64 + i * 16 + n16;
            const unsigned char* kp = KT + keyl * 256;
            f32x4 acc = (f32x4){0.f, 0.f, 0.f, 0.f};
#pragma unroll
            for (int c = 0; c < 4; ++c) { const bf16x8 kf = *(const bf16x8*)(kp + (((c * 4 + g) ^ (keyl & 15)) * 16)); acc = MFMA16(kf, qf[c], acc); }
            S[i] = acc;
        }
        float mx = -INFINITY;
#pragma unroll
        for (int i = 0; i < 4; ++i) {
            if (pass < 2) { const int krow = row_start + kh * 4 + 2 * pass + (i >> 1); const float* rb = rpb + (krow - r + 7) * 31;
#pragma unroll
                for (int jj = 0; jj < 4; ++jj) { const int kc = cs + (i & 1) * 16 + 4 * g + jj; const bool ok = (kc >= c_start) && (kc < c_start + 16);
                    const int co = min(max(kc - qcol, -15), 15) + 15;
                    S[i][jj] = ok ? S[i][jj] * scale + rb[co] : -INFINITY; } }
            else {
#pragma unroll
                for (int jj = 0; jj < 4; ++jj) S[i][jj] *= scale; }
#pragma unroll
            for (int jj = 0; jj < 4; ++jj) mx = fmaxf(mx, S[i][jj]);
        }
        mx = fmaxf(mx, __shfl_xor(mx, 16)); mx = fmaxf(mx, __shfl_xor(mx, 32));
        const float mnew = fmaxf(mrun, mx);
        const float alpha = __expf(mrun - mnew);
        mrun = mnew; lsum *= alpha;
#pragma unroll
        for (int i = 0; i < 8; ++i) { O[i][0] *= alpha; O[i][1] *= alpha; O[i][2] *= alpha; O[i][3] *= alpha; }
#pragma unroll
        for (int c = 0; c < 2; ++c) {
            float e[8];
#pragma unroll
            for (int jj = 0; jj < 4; ++jj) { e[jj] = __expf(S[2 * c][jj] - mnew); e[4 + jj] = __expf(S[2 * c + 1][jj] - mnew); }
#pragma unroll
            for (int jj = 0; jj < 8; ++jj) lsum += e[jj];
            u32x4 u; u[0] = pack2(e[0], e[1]); u[1] = pack2(e[2], e[3]); u[2] = pack2(e[4], e[5]); u[3] = pack2(e[6], e[7]);
            const bf16x8 pf = __builtin_bit_cast(bf16x8, u);
            const int key0 = pass < 2 ? (kh * 2 + c) * 64 + cs + 4 * g : kh * 64 + c * 32 + 4 * g;
            const int kc8a = key0 >> 2, kc8b = kc8a + 4;
#pragma unroll
            for (int dt = 0; dt < 8; ++dt) { const int d = dt * 16 + n16; const unsigned char* vp = VL + d * 512;
                const bf16x4 v0 = *(const bf16x4*)(vp + (((kc8a >> 1) ^ (d & 15)) * 16) + (kc8a & 1) * 8), v1 = *(const bf16x4*)(vp + (((kc8b >> 1) ^ (d & 15)) * 16) + (kc8b & 1) * 8);
                const bf16x8 vf = __builtin_shufflevector(v0, v1, 0, 1, 2, 3, 4, 5, 6, 7);
                O[dt] = MFMA16(vf, pf, O[dt]); }
        }
    }
    lsum += __shfl_xor(lsum, 16); lsum += __shfl_xor(lsum, 32);
    __syncthreads();
    float* cmb = (float*)lds + (size_t)qi * 34 * 64 + lane;
    if (kh == 1) { cmb[0] = mrun; cmb[64] = lsum;
#pragma unroll
        for (int dt = 0; dt < 8; ++dt)
#pragma unroll
            for (int jj = 0; jj < 4; ++jj) cmb[(2 + dt * 4 + jj) * 64] = O[dt][jj]; }
    __syncthreads();
    if (kh == 0) { const float m1 = cmb[0], l1 = cmb[64];
        const float mn = fmaxf(mrun, m1), a0 = __expf(mrun - mn), a1 = __expf(m1 - mn);
        const float inv = 1.0f / (lsum * a0 + l1 * a1);
        bf16_t* yo = YN + (size_t)qrow * 1024 + h * 128 + 4 * g;
#pragma unroll
        for (int dt = 0; dt < 8; ++dt) { float o[4];
#pragma unroll
            for (int jj = 0; jj < 4; ++jj) o[jj] = (O[dt][jj] * a0 + cmb[(2 + dt * 4 + jj) * 64] * a1) * inv;
            u32x2 ov; ov[0] = pack2(o[0], o[1]); ov[1] = pack2(o[2], o[3]); *(u32x2*)(yo + dt * 16) = ov; } }
}

__device__ void phase_mix(PP p, int l, float* lds, int which = 7) {
    const int TIDX = otid();
    for (int t = blockIdx.x; t < 256; t += gridDim.x) {
        if (t < 128) { if (which & 1) rwkv_scan(p, l, t, lds); }
        else if (which & 2) mlstm_scan(p, l, (t - 128) >> 3, (t - 128) & 7, lds);
        __syncthreads();
    }
    unsigned* ctr = (unsigned*)(p->ws + OFF_CTL) + l * 8 + ((which & 8) ? 1 : 0);
    if (!(which & 4)) return;
    int* stask = (int*)lds;
    const int ntask = l == 0 ? 1056 : 1024;
    for (;;) {
        __syncthreads();
        if (TIDX == 0) stask[0] = (int)atomicAdd(ctr, 1u);
        __syncthreads();
        const int t = stask[0];
        if (t >= ntask) break;
        const int nctx = ntask - 1024;
        if (t >= nctx) na_block(p, l, t - nctx, (unsigned char*)lds); else na_wave(p, l, 512 + t);
    }
}

__device__ void phase_post(PP p, int l, int nrows) {
    const int TIDX = otid();
    const int wid = TIDX >> 6, lane = TIDX & 63, gw = blockIdx.x * 8 + wid, nw = gridDim.x * 8;
    const bf16_t* P = (const bf16_t*)(p->ws + OFF_P); const bf16_t* LO = (const bf16_t*)(p->ws + OFF_LO);
    bf16_t* YM = (bf16_t*)(p->ws + OFF_Y3); bf16_t* YR = YM + (size_t)NTOK * 1024;
    const float* NUM = (const float*)(p->ws + OFF_MLNUM); const float* YF = (const float*)(p->ws + OFF_YRWF);
    for (int row = gw; row < nrows; row += nw) {
        f32x4 a[4], c[4], ng[4]; float dfr[4], dbr[4]; u32x2 ov[4];
#pragma unroll
        for (int h = 0; h < 4; ++h) {
            const float* nf = NUM + ((size_t)row * 4 + h) * 272; const float* nb = NUM + ((size_t)(NTOK + row) * 4 + h) * 272;
            a[h] = *(const f32x4*)(nf + lane * 4); c[h] = *(const f32x4*)(nb + lane * 4); dfr[h] = nf[256]; dbr[h] = nb[256];
            ov[h] = *(const u32x2*)(P + (size_t)row * NP + 2048 + h * 256 + lane * 4);
            ng[h] = *(const f32x4*)(p->in[I_MLNG] + l * 1024 + h * 256 + lane * 4); }
#pragma unroll
        for (int h = 0; h < 4; ++h) {
            const float df = 1.0f / fmaxf(fabsf(dfr[h]), 1.0f), db = 1.0f / fmaxf(fabsf(dbr[h]), 1.0f);
            float hv[4]; float ss = 0.f;
#pragma unroll
            for (int j = 0; j < 4; ++j) { hv[j] = a[h][j] * df + c[h][j] * db; ss += hv[j] * hv[j]; }
            ss = wsum(ss);
            const float rr = rsqrtf(ss * (1.0f / 256.0f) + 1e-6f);
            const float o0 = hv[0] * rr * ng[h][0] * sigmoidf(bflo(ov[h][0])), o1 = hv[1] * rr * ng[h][1] * sigmoidf(bfhi(ov[h][0]));
            const float o2 = hv[2] * rr * ng[h][2] * sigmoidf(bflo(ov[h][1])), o3 = hv[3] * rr * ng[h][3] * sigmoidf(bfhi(ov[h][1]));
            u32x2 w; w[0] = pack2(o0, o1); w[1] = pack2(o2, o3);
            *(u32x2*)(YM + (size_t)row * 1024 + h * 256 + lane * 4) = w; }
    }
    const float* MU = p->in[I_RWMU] + (size_t)l * 3712;
    const float* RKp = (const float*)(p->ws + OFF_RK);
#pragma unroll 2
    for (int it = gw; it < nrows * 4; it += nw) {
        const int row = it >> 2, head = (it & 3) * 4 + (lane >> 4), c = head * 64 + (lane & 15) * 4;
        bool hp, hn; seq_nbrs(row, hp, hn);
        const f32x4 ya = *(const f32x4*)(YF + (size_t)row * 1024 + c), yb = *(const f32x4*)(YF + (size_t)(NTOK + row) * 1024 + c);
        const bf16_t* pr = P + (size_t)row * NP + RWB + 2048 + c;
        const u32x2 z2 = {0u, 0u};
        const u32x2 vc = *(const u32x2*)pr, vp = hp ? *(const u32x2*)(pr - NP) : z2, vn = hn ? *(const u32x2*)(pr + NP) : z2;
        const u32x2 gv = *(const u32x2*)(LO + (size_t)row * 5120 + 4096 + c);
        const float rk = RKp[row * 16 + head];
        const f32x4 mu = *(const f32x4*)(MU + 2048 + c), lw = *(const f32x4*)(p->in[I_RWLNW] + l * 1024 + c), lb = *(const f32x4*)(p->in[I_RWLNB] + l * 1024 + c);
        const f32x4 y = ya + yb;
        const float mean = red16((y[0] + y[1]) + (y[2] + y[3])) * (1.0f / 64.0f);
        const f32x4 dy = y - mean;
        const float var = red16((dy[0] * dy[0] + dy[1] * dy[1]) + (dy[2] * dy[2] + dy[3] * dy[3])) * (1.0f / 64.0f);
        const float rs = rsqrtf(var + 64e-5f);
        const float v0 = shiftf(bflo(vc[0]), bflo(vp[0]), bflo(vn[0]), mu[0]), v1 = shiftf(bfhi(vc[0]), bfhi(vp[0]), bfhi(vn[0]), mu[1]);
        const float v2 = shiftf(bflo(vc[1]), bflo(vp[1]), bflo(vn[1]), mu[2]), v3 = shiftf(bfhi(vc[1]), bfhi(vp[1]), bfhi(vn[1]), mu[3]);
        const float o0 = (dy[0] * rs * lw[0] + lb[0] + rk * v0) * bflo(gv[0]), o1 = (dy[1] * rs * lw[1] + lb[1] + rk * v1) * bfhi(gv[0]);
        const float o2 = (dy[2] * rs * lw[2] + lb[2] + rk * v2) * bflo(gv[1]), o3 = (dy[3] * rs * lw[3] + lb[3] + rk * v3) * bfhi(gv[1]);
        u32x2 w; w[0] = pack2(o0, o1); w[1] = pack2(o2, o3);
        *(u32x2*)(YR + (size_t)row * 1024 + c) = w;
    }
}


constexpr size_t PART_OFF = 150ull << 20;
#ifndef DUPMASK
#define DUPMASK 0
#endif
#ifndef DUPWHICH
#define DUPWHICH 3
#endif
__global__ void __launch_bounds__(512, 2) fwd_kernel(Params p0) {
    extern __shared__ __attribute__((aligned(16))) unsigned char shm[];
    __shared__ uint4 xb_words;
    cg::grid_group grid = cg::this_grid();
    if (threadIdx.x == 0) xb_words = make_uint4(0u, 0u, 0u, 0u);
    __syncthreads();
    (void)xcd_barrier_post((unsigned*)(p0.ws + OFF_BAR), (volatile LAS unsigned*)&xb_words);
    float* ldsf = (float*)shm;
    LAS unsigned char* ldsg = (LAS unsigned char*)shm;
    const int ph_lo = p0.ph_lo, ph_hi = p0.ph_hi;
    auto kseg = __builtin_amdgcn_kernarg_segment_ptr();
    for (int ph = ph_lo; ph < ph_hi; ++ph) {
        PP p = (PP)kseg; asm volatile("" : "+s"(p));
        if (ph > ph_lo) {
            if (ph == ph_lo + 1) grid.sync();
            else { XcdBarrier xb; xb.bar = (unsigned*)(p->ws + OFF_BAR); xb.x = xb_xcc_id(); xb.st = (volatile LAS unsigned*)&xb_words; xcd_barrier(xb); }
        }
        unsigned char* ws = p->ws;
        const float* MOD = (const float*)(ws + OFF_MOD);
        float* XL = (float*)(ws + OFF_XL);
        bf16_t* H = (bf16_t*)(ws + OFF_H);
        bf16_t* Pb = (bf16_t*)(ws + OFF_P);
        if (ph == 0) { phase_mod(p, ldsf); __syncthreads(); phase_convert(p, 0, ldsf, (int)blockIdx.x, (int)gridDim.x, 0, 0, 18816, true); continue; }
        if (ph == NPHASE - 1) { phase_final(p); continue; }
        const int l = (ph - 1) / 11, sub = (ph - 1) % 11;
        const int two_wt = p->two_wt;
        const size_t wsh = (l == 1 && two_wt) ? WT_SHIFT : 0;
#if DUPMASK
        for (int rep = 0; rep < (((DUPMASK >> sub) & 1) ? 2 : 1); ++rep) { if (rep) grid.sync();
#endif
        const int Ml = l == 0 ? NTOK : NLAT;
        const float* modl = MOD + (size_t)l * 3 * 12288;
        if (sub == 1 || sub == 3 || sub == 6 || sub == 7 || sub == 9 || sub == 10) {
            const bool ksplit = l == 0 && (sub == 7 || sub == 10) && gridDim.x == 256;
            for (int part = 0; part < (ksplit ? 2 : (sub == 3 ? 3 : 1)); ++part) {
            pg8::Gemm g; pg8::SchedG S; pg8::EpiG E;
            S.mode = 0; S.mo.init(Ml / 256, (int)gridDim.x, (int)blockIdx.x);
            E.kind = 0; E.split = 0; E.O = Pb; E.ldc = NP; E.P = Pb; E.ACC = (float*)(ws + OFF_YRWF);
            E.xin_lat = XL; E.xin_ctx = XL + (size_t)NLAT * 2048; E.XL = XL; E.gate = modl; E.part = nullptr;
            if (sub == 1) { g = pg8::Gemm{H, (const bf16_t*)(ws + wsh + OFF_WIN), NTOK, NP, 2048, 32}; }
            else if (sub == 3) { const int n0 = part * 2048, k0 = part == 0 ? 0 : (part == 1 ? 192 : 384);
                g = pg8::Gemm{(const bf16_t*)(ws + OFF_LA) + k0, (const bf16_t*)(ws + wsh + OFF_WLORA) + (size_t)n0 * 640 + k0, NTOK, part == 2 ? 1024 : 2048, 640, 4}; E.O = (bf16_t*)(ws + OFF_LO) + n0; E.ldc = 5120; }
            else if (sub == 6) { g = pg8::Gemm{(const bf16_t*)(ws + OFF_Y3), (const bf16_t*)(ws + wsh + OFF_WBR), Ml, 2048, 1024, 16}; S.mode = 1; E.kind = 2; E.O = H; }
            else if (sub == 7) { g = pg8::Gemm{H, (const bf16_t*)(ws + wsh + OFF_WOUT), Ml, 2048, 2048, 32}; E.kind = 3; E.gate = modl + 2 * 2048;
                if (l == 0) { E.xin_lat = p->in[I_X]; E.xin_ctx = p->in[I_CTX]; } }
            else if (sub == 9) { g = pg8::Gemm{H, (const bf16_t*)(ws + wsh + OFF_WFF1), Ml, DFF, 2048, 32}; E.kind = 1; E.ldc = DFF; }
            else { g = pg8::Gemm{Pb, (const bf16_t*)(ws + wsh + OFF_WFF2), Ml, 2048, DFF, 128}; E.kind = 3; E.gate = modl + 5 * 2048; }
            if (ksplit) {
                if (part == 0) g.M = NLAT;
                else { const int ks = (int)blockIdx.x & 15; g.nt >>= 4; g.A += (size_t)ks * g.nt * 64; g.Bt += (size_t)ks * g.nt * 64; S.mode = 2; E.split = 1;
                    E.part = (float*)(ws + OFF_P + (sub == 10 ? PART_OFF : 0)) + (size_t)ks * 512 * 2048; }
            }
            S.so.init(g.M, g.N, (int)gridDim.x, (int)blockIdx.x);
            pg8::gemm_phase(ldsg, g, S, E);
            }
            if (two_wt && l == 0 && gridDim.x == 256) {
                if (sub == 1 && blockIdx.x >= 94) phase_convert(p, 1, ldsf, (int)blockIdx.x - 94, 162, WT_SHIFT, 0, 4000, false);
                if (sub == 6 && blockIdx.x >= 16) phase_convert(p, 1, ldsf, (int)blockIdx.x - 16, 240, WT_SHIFT, 4000, 11500, false);
                if (sub == 9 && blockIdx.x >= 64) phase_convert(p, 1, ldsf, (int)blockIdx.x - 64, 192, WT_SHIFT, 11500, 18816, true);
            } else if (two_wt && l == 0 && sub == 10) phase_convert(p, 1, ldsf, (int)blockIdx.x, (int)gridDim.x, WT_SHIFT, 0, 18816, true);
        } else
        switch (sub) {
        case 0: {
            phase_init(p, l);
            if (l == 1 && !two_wt) phase_convert(p, l, ldsf, (int)blockIdx.x, (int)gridDim.x, wsh, 0, 18816, true);
            if (l == 0) phase_norm(p->in[I_X], p->in[I_CTX], NTOK, p->in[I_N1G] + l * 2048, modl, 0, 1, H);
            else if (gridDim.x == 256) phase_norm(XL, XL + (size_t)NLAT * 2048, NTOK, p->in[I_N1G] + l * 2048, modl, 0, 1, H, (const float*)(ws + OFF_P + PART_OFF), MOD + 2 * 12288 + 5 * 2048, XL + (size_t)NLAT * 2048);
            else phase_norm(XL, XL + (size_t)NLAT * 2048, NTOK, p->in[I_N1G] + l * 2048, modl, 0, 1, H);
        } break;
        case 2: phase_prep(p, l, (bf16_t*)shm); break;
#if DUPMASK
        case 4: phase_mix(p, l, ldsf, rep ? DUPWHICH : 7); break;
#else
        case 4: phase_mix(p, l, ldsf); break;
#endif
        case 5: phase_post(p, l, Ml); break;
        case 8: if (l == 0 && gridDim.x == 256) phase_norm(XL, p->in[I_CTX], Ml, p->in[I_N2G] + l * 2048, modl, 3, 4, H, (const float*)(ws + OFF_P), modl + 2 * 12288 + 2 * 2048, XL + (size_t)NLAT * 2048);
                else phase_norm(XL, XL + (size_t)NLAT * 2048, Ml, p->in[I_N2G] + l * 2048, modl, 3, 4, H); break;
        }
#if DUPMASK
        }
#endif
    }
}

extern "C" void kernel_launch(void* const* d_in, const int* in_sizes, int n_in, void* d_out, int out_size, void* d_ws, size_t ws_size, hipStream_t stream) {
    static int grid = 0;
    if (grid == 0) {
        if (n_in != 28 || ws_size < WS_END) { fprintf(stderr, "kernel_launch: need 28 inputs and %zu bytes of workspace (got %d, %zu)\n", (size_t)WS_END, n_in, ws_size); grid = -1; return; }
        if (hipFuncSetAttribute((const void*)fwd_kernel, hipFuncAttributeMaxDynamicSharedMemorySize, LDS_BYTES) != hipSuccess) { fprintf(stderr, "kernel_launch: hipFuncSetAttribute failed\n"); grid = -1; return; }
        int dev = 0, cus = 0, per_cu = 0;
        hipGetDevice(&dev);
        hipDeviceGetAttribute(&cus, hipDeviceAttributeMultiprocessorCount, dev);
        hipOccupancyMaxActiveBlocksPerMultiprocessor(&per_cu, (const void*)fwd_kernel, 512, LDS_BYTES);
        if (per_cu < 1) { fprintf(stderr, "kernel_launch: occupancy query says %d blocks per CU\n", per_cu); per_cu = 1; }
        (void)hipGetLastError();
        grid = cus * 1;
        if (grid > 256) grid = 256;
    }
    if (grid < 0) return;
    if (hipMemsetAsync((char*)d_ws + OFF_BAR, 0, XCD_BAR_WORDS * sizeof(unsigned), stream) != hipSuccess) { fprintf(stderr, "kernel_launch: hipMemsetAsync of the barrier words failed\n"); return; }
    Params p{};
    for (int i = 0; i < 28; ++i) p.in[i] = (const float*)d_in[i];
    p.out = (float*)d_out; p.ws = (unsigned char*)d_ws; p.two_wt = (ws_size >= WS_END + WT_BYTES) ? 1 : 0;
#if ONE_LAUNCH
    p.ph_lo = 0; p.ph_hi = NPHASE;
    void* args[] = {&p};
    hipError_t e = hipLaunchCooperativeKernel((const void*)fwd_kernel, dim3(grid), dim3(512), args, LDS_BYTES, stream);
    if (e != hipSuccess) fprintf(stderr, "cooperative launch failed: %s (grid %d)\n", hipGetErrorString(e), grid);
#else
    for (int ph = 0; ph < NPHASE; ++ph) {
        p.ph_lo = ph; p.ph_hi = ph + 1;
        hipLaunchKernelGGL(fwd_kernel, dim3(grid), dim3(512), LDS_BYTES, stream, p);
    }
#endif
}
```

```cpp
#include <hip/hip_runtime.h>
#include <hip/hip_cooperative_groups.h>
#include <cstdio>
namespace cg = cooperative_groups;

#ifndef ONE_LAUNCH
#define ONE_LAUNCH 1
#endif

#define DEVI __device__ __forceinline__
#define LAS __attribute__((address_space(3)))
typedef unsigned short bf16_t;
typedef short bf16x8 __attribute__((ext_vector_type(8)));
typedef short bf16x4 __attribute__((ext_vector_type(4)));
typedef float f32x4 __attribute__((ext_vector_type(4)));
typedef float f32x2 __attribute__((ext_vector_type(2)));
typedef unsigned u32x4 __attribute__((ext_vector_type(4)));
typedef unsigned u32x2 __attribute__((ext_vector_type(2)));

constexpr int D = 2048, NTOK = 8704, NLAT = 8192, NP = 16128, DIN = 16016, DFF = 8192;
constexpr int RWB = 3088, NAB = 6800, GTB = 9872;
constexpr int LDS_BYTES = 131072;
constexpr int NPHASE = 24;

constexpr size_t OFF_CTL = 0;
constexpr size_t OFF_MOD = 4096;
constexpr size_t OFF_ROPE = OFF_MOD + 2ull * 3 * 12288 * 4;
constexpr size_t OFF_WIN = OFF_ROPE + 16384;
constexpr size_t OFF_WBR = OFF_WIN + 16128ull * 2048 * 2;
constexpr size_t OFF_WOUT = OFF_WBR + 3ull * 2048 * 1024 * 2;
constexpr size_t OFF_WFF1 = OFF_WOUT + 2048ull * 2048 * 2;
constexpr size_t OFF_WFF2 = OFF_WFF1 + 8192ull * 2048 * 2;
constexpr size_t OFF_WLORA = OFF_WFF2 + 8192ull * 2048 * 2;
constexpr size_t OFF_XL = OFF_WLORA + 5120ull * 640 * 2;
constexpr size_t OFF_H = OFF_XL + 8704ull * 2048 * 4;
constexpr size_t OFF_P = OFF_H + 8704ull * 2048 * 2;
constexpr size_t OFF_LA = OFF_P + 8704ull * 16128 * 2;
constexpr size_t OFF_LO = OFF_LA + 8704ull * 640 * 2;
constexpr size_t OFF_YRWF = OFF_LO + 8704ull * 5120 * 2;
constexpr size_t OFF_MLNUM = OFF_YRWF + 2ull * 8704 * 1024 * 4;
constexpr size_t OFF_VT = OFF_MLNUM + 2ull * 8704 * 4 * 272 * 4;
constexpr size_t OFF_Y3 = OFF_VT + 2ull * 8 * 128 * 4352 * 2;
constexpr size_t OFF_RK = OFF_Y3 + 3ull * 8704 * 1024 * 2;
constexpr size_t OFF_BAR = OFF_RK + 8704ull * 16 * 4;
constexpr size_t WS_END = OFF_BAR + 16384;
constexpr size_t WT_BYTES = OFF_XL - OFF_WIN, WT_SHIFT = WS_END - OFF_WIN;

struct Params {
    const float* in[28];
    float* out;
    unsigned char* ws;
    int ph_lo, ph_hi, two_wt, pad_;
};
typedef const __attribute__((address_space(4))) Params* PP;
enum { I_X = 0, I_C, I_CTX, I_CCTX, I_WMOD, I_BMOD, I_N1G, I_WIN, I_MLGB, I_MLNG, I_RWMU, I_RWW0, I_RWWUP, I_RWA0, I_RWAUP, I_RWGUP,
       I_RWKK, I_RWKA, I_RWRK, I_RWLNW, I_RWLNB, I_RPB, I_WBR, I_WOUT, I_N2G, I_WFF1, I_WFF2, I_FING };

DEVI int otid() { int t; asm volatile("v_mov_b32 %0, %1" : "=v"(t) : "v"((int)threadIdx.x)); return t; }
DEVI float bf2f(bf16_t b) { return __uint_as_float(((unsigned)b) << 16); }
DEVI float bflo(unsigned u) { return __uint_as_float(u << 16); }
DEVI float bfhi(unsigned u) { return __uint_as_float(u & 0xffff0000u); }
DEVI bf16_t f2bf(float f) { unsigned u = __float_as_uint(f); u += 0x7FFFu + ((u >> 16) & 1u); return (bf16_t)(u >> 16); }
DEVI unsigned pack2(float lo, float hi) { return (unsigned)f2bf(lo) | ((unsigned)f2bf(hi) << 16); }
DEVI float sigmoidf(float x) { return __builtin_amdgcn_rcpf(1.0f + __expf(-x)); }
#define DPP_ADD(x, CTRL) ((x) + __int_as_float(__builtin_amdgcn_update_dpp(0, __float_as_int(x), CTRL, 0xF, 0xF, true)))
DEVI float wsum(float x) {
    x = DPP_ADD(x, 0xB1); x = DPP_ADD(x, 0x4E); x = DPP_ADD(x, 0x141); x = DPP_ADD(x, 0x140);
    const int xi = __float_as_int(x);
    return (__int_as_float(__builtin_amdgcn_readlane(xi, 0)) + __int_as_float(__builtin_amdgcn_readlane(xi, 16))) + (__int_as_float(__builtin_amdgcn_readlane(xi, 32)) + __int_as_float(__builtin_amdgcn_readlane(xi, 48)));
}
DEVI float red8(float x) {
    x = DPP_ADD(x, 0xB1);
    x = DPP_ADD(x, 0x4E);
    x = DPP_ADD(x, 0x141);
    return x;
}

DEVI float red16(float x) {
    x = DPP_ADD(x, 0xB1); x = DPP_ADD(x, 0x4E); x = DPP_ADD(x, 0x141); x = DPP_ADD(x, 0x140);
    return x;
}
DEVI float sfma(float a, float b, float c) { float d; asm("v_fma_f32 %0, %1, %2, %3" : "=v"(d) : "v"(a), "v"(b), "v"(c)); return d; }
DEVI float smul(float a, float b) { float d; asm("v_mul_f32 %0, %1, %2" : "=v"(d) : "v"(a), "v"(b)); return d; }
DEVI void fadd_g(float* ptr, float v) { (void)__builtin_amdgcn_global_atomic_fadd_f32((__attribute__((address_space(1))) float*)ptr, v); }
DEVI float frcp(float x) { return __builtin_amdgcn_rcpf(x); }
DEVI float fsigmoid(float x) { return __builtin_amdgcn_rcpf(1.0f + __expf(-x)); }

#define XB_TMO      128
#define XB_XCNT(j)  (256  + 64 * (j))
#define XB_XSUB(j)  (1280 + 64 * (j))
#define XB_XGEN(j)  (2304 + 64 * (j))
#define XB_TOP      3328
#define XB_TOPGEN   3392
#define XCD_BAR_WORDS 3456
#define XB_SPIN_CAP (1u << 18)

__device__ __forceinline__ unsigned xb_ld(unsigned* p)              { return __hip_atomic_load(p, __ATOMIC_RELAXED, __HIP_MEMORY_SCOPE_AGENT); }
__device__ __forceinline__ unsigned xb_add(unsigned* p, unsigned v) { return __hip_atomic_fetch_add(p, v, __ATOMIC_RELAXED, __HIP_MEMORY_SCOPE_AGENT); }
__device__ __forceinline__ unsigned xb_xcc_id() { return (unsigned)__builtin_amdgcn_s_getreg((3 << 11) | 20) & 0xFu; }
#define XB_SPIN(cond, bar) do { unsigned _sp = 0; while (cond) { __builtin_amdgcn_s_sleep(1); \
    if ((++_sp & 255u) == 0u) { if (xb_ld(&(bar)[XB_TMO])) break; if (_sp > XB_SPIN_CAP) { atomicAdd(&(bar)[XB_TMO], 1u); break; } } } } while (0)

struct XcdBarrier {
    unsigned* bar; unsigned x;
    volatile LAS unsigned* st;
};

__device__ __forceinline__ XcdBarrier xcd_barrier_post(unsigned* bar, volatile LAS unsigned* st) {
    XcdBarrier b; b.bar = bar; b.x = xb_xcc_id(); b.st = st;
    if (threadIdx.x == 0) (void)xb_add(&bar[XB_XCNT(b.x)], 1u);
    return b;
}
__device__ __forceinline__ void xcd_barrier_complete(unsigned* bar, unsigned x, unsigned& nloc, unsigned& nx) {
    const unsigned G = gridDim.x * gridDim.y * gridDim.z;
    unsigned sum, cnt, mine, sp = 0u;
    for (;;) {
        sum = 0u; cnt = 0u; mine = 0u;
#pragma unroll
        for (unsigned j = 0; j < 16; ++j) { const unsigned c = xb_ld(&bar[XB_XCNT(j)]); sum += c; cnt += (c > 0u) ? 1u : 0u; mine = (j == x) ? c : mine; }
        if (sum == G) break;
        __builtin_amdgcn_s_sleep(1);
        if ((++sp & 255u) == 0u) { if (xb_ld(&bar[XB_TMO])) break; if (sp > XB_SPIN_CAP) { atomicAdd(&bar[XB_TMO], 1u); break; } }
    }
    nloc = mine > 0u ? mine : 1u; nx = cnt > 0u ? cnt : 1u;
}

__device__ __forceinline__ void xcd_barrier(const XcdBarrier& b) {
    asm volatile("s_waitcnt vmcnt(0)" ::: "memory");
    __syncthreads();
    if (threadIdx.x == 0) {
        unsigned* bar = b.bar;
        __builtin_amdgcn_s_waitcnt(0);
        unsigned nloc = b.st[0], nx = b.st[1];
        if (nloc == 0u) { xcd_barrier_complete(bar, b.x, nloc, nx); b.st[0] = nloc; b.st[1] = nx; }
        const unsigned old = xb_add(&bar[XB_XSUB(b.x)], 1u);
        const unsigned gen = old / nloc;
        if (old + 1u == (gen + 1u) * nloc) {
            __builtin_amdgcn_fence(__ATOMIC_RELEASE, "agent");
            asm volatile("s_waitcnt vmcnt(0)" ::: "memory");
            const unsigned og = xb_add(&bar[XB_TOP], 1u);
            const unsigned tg = og / nx;
            if (og + 1u == (tg + 1u) * nx) xb_add(&bar[XB_TOPGEN], 1u);
            else XB_SPIN(xb_ld(&bar[XB_TOPGEN]) == tg, bar);
            __builtin_amdgcn_fence(__ATOMIC_ACQUIRE, "agent");
            xb_add(&bar[XB_XGEN(b.x)], 1u);
            asm volatile("s_waitcnt vmcnt(0)" ::: "memory");
        } else {
            XB_SPIN(xb_ld(&bar[XB_XGEN(b.x)]) == gen, bar);
            __builtin_amdgcn_fence(__ATOMIC_ACQUIRE, "agent");
            asm volatile("s_waitcnt vmcnt(0)" ::: "memory");
        }
    }
    __syncthreads();
}


namespace pg8 {
constexpr int BM = 256, BK = 64, HALF = 128, HTB = HALF * BK * 2, STAGE_BYTES = 8 * HTB, NXCD = 8, WGM = 8;
__host__ __device__ __forceinline__ int lds_byte(int r, int c) { const int st = (r >> 4) * 2 + (c >> 5), rr = r & 15, cc = c & 31, ob = rr * 64 + cc * 2; return st * 1024 + (ob ^ (((ob >> 9) & 1) << 5)); }
__host__ __device__ __forceinline__ void stage_rc(int b, int& R, int& C) { const int st = b / 1024, sb = b % 1024, swz = sb ^ (((sb >> 9) & 1) << 5); R = (st >> 1) * 16 + swz / 64; C = (st & 1) * 32 + (swz % 64) / 2; }
__host__ __device__ __forceinline__ int perm32(int rho) { const int n = rho >> 4, i = rho & 15; return 8 * (i >> 2) + 4 * n + (i & 3); }
struct Unit { int pm, pn; };
struct Gemm { const bf16_t* A; const bf16_t* Bt; int M, N, K, nt; };
struct StaticOrder {
    int nM, nN, nwg, G, c;
    __device__ void init(int M, int N, int G_, int c_) { nM = M / BM; nN = N / BM; nwg = nM * nN; G = G_; c = c_; }
    __device__ bool next(int i, Unit& u) const {
        const long L = (long)i * G + c; if (L >= nwg) return false;
        int wgid = (int)L; { const int q = nwg / NXCD, r = nwg % NXCD, xcd = wgid % NXCD, off = wgid / NXCD; wgid = (xcd < r ? xcd * (q + 1) : r * (q + 1) + (xcd - r) * q) + off; }
        const int nig = WGM * nN, gid = wgid / nig, fm = gid * WGM, gsz = (nM - fm) < WGM ? (nM - fm) : WGM;
        u.pm = fm + ((wgid % nig) % gsz); u.pn = (wgid % nig) / gsz; return true;
    }
    __device__ __forceinline__ void a_ready(const Unit&) const {}
    __device__ __forceinline__ void done(const Unit&) const {}
};
struct MergeOrder {
    int ntiles, G, c;
    __device__ void init(int nM, int G_, int c_) { ntiles = nM * 8; G = G_; c = c_; }
    __device__ bool next(int i, Unit& u) const {
        const int ti = i / 3, br = i - ti * 3; const long L = (long)ti * G + c; if (L >= ntiles) return false;
        const int pm = (int)L >> 3, pn = (int)L & 7; u.pm = br * 34 + pm; u.pn = br * 8 + pn; return true;
    }
    __device__ __forceinline__ void a_ready(const Unit&) const {}
    __device__ __forceinline__ void done(const Unit&) const {}
};
DEVI unsigned cvt_pk_bf16(float lo, float hi) { unsigned r; asm volatile("v_cvt_pk_bf16_f32 %0, %1, %2" : "=v"(r) : "v"(lo), "v"(hi)); return r; }


struct SchedG {
    int mode;
    StaticOrder so; MergeOrder mo;
    __device__ __forceinline__ bool next(int i, Unit& u) const {
        if (mode == 2) { if (i > 0) return false; const int cu = so.c >> 4; u.pm = 32 + (cu >> 3); u.pn = cu & 7; return true; }
        return mode == 0 ? so.next(i, u) : mo.next(i, u); }
    __device__ __forceinline__ void a_ready(const Unit&) const {}
    __device__ __forceinline__ void done(const Unit&) const {}
};
struct EpiG {
    static constexpr bool PERM = true, AFTER_DRAIN = false;
    int kind, split;
    bf16_t* O; int ldc;
    const bf16_t* P; float* ACC;
    const float* xin_lat; const float* xin_ctx; float* XL; const float* gate; float* part;
    __device__ __forceinline__ void operator()(const f32x4 (&acc)[2][2][4][2], const Unit& u, int wr, int wc, int fr, int fq) const {
        if (kind <= 1) {
            const int row0 = u.pm * BM + wr * 64 + fr, col0 = u.pn * BM + wc * 32 + 8 * fq;
#pragma unroll
            for (int ai = 0; ai < 2; ++ai)
#pragma unroll
                for (int m = 0; m < 4; ++m) { bf16_t* rowp = O + (size_t)(row0 + ai * HALF + m * 16) * ldc + col0;
#pragma unroll
                    for (int bj = 0; bj < 2; ++bj) { f32x4 v0 = acc[ai][bj][m][0], v1 = acc[ai][bj][m][1];
                        if (kind == 1) {
#pragma unroll
                            for (int i = 0; i < 4; ++i) { float a = fmaxf(v0[i], 0.f), b = fmaxf(v1[i], 0.f); v0[i] = a * a; v1[i] = b * b; } }
                        u32x4 o; o[0] = cvt_pk_bf16(v0[0], v0[1]); o[1] = cvt_pk_bf16(v0[2], v0[3]); o[2] = cvt_pk_bf16(v1[0], v1[1]); o[3] = cvt_pk_bf16(v1[2], v1[3]);
                        *(u32x4*)(rowp + bj * HALF) = o; } }
        } else if (kind == 2) {
            const int br = u.pn >> 3, pn = u.pn & 7, pm = u.pm - br * 34;
            const int row0 = pm * BM + wr * 64 + fr, col0 = pn * BM + wc * 32 + 8 * fq;
#pragma unroll
            for (int ai = 0; ai < 2; ++ai)
#pragma unroll
                for (int m = 0; m < 4; ++m) { const size_t row = (size_t)(row0 + ai * HALF + m * 16);
#pragma unroll
                    for (int bj = 0; bj < 2; ++bj) { const int col = col0 + bj * HALF;
                        const u32x4 gv = *(const u32x4*)(P + row * NP + GTB + br * 2048 + col);
                        f32x4 v0 = acc[ai][bj][m][0], v1 = acc[ai][bj][m][1];
                        v0[0] *= sigmoidf(bflo(gv[0])); v0[1] *= sigmoidf(bfhi(gv[0])); v0[2] *= sigmoidf(bflo(gv[1])); v0[3] *= sigmoidf(bfhi(gv[1]));
                        v1[0] *= sigmoidf(bflo(gv[2])); v1[1] *= sigmoidf(bfhi(gv[2])); v1[2] *= sigmoidf(bflo(gv[3])); v1[3] *= sigmoidf(bfhi(gv[3]));
                        bf16_t* ap = (bf16_t*)ACC + row * 2048 + col;
                        if (br != 0) { const u32x4 pv = *(const u32x4*)ap;
                            v0[0] += bflo(pv[0]); v0[1] += bfhi(pv[0]); v0[2] += bflo(pv[1]); v0[3] += bfhi(pv[1]); v1[0] += bflo(pv[2]); v1[1] += bfhi(pv[2]); v1[2] += bflo(pv[3]); v1[3] += bfhi(pv[3]); }
                        if (br < 2) { u32x4 o; o[0] = cvt_pk_bf16(v0[0], v0[1]); o[1] = cvt_pk_bf16(v0[2], v0[3]); o[2] = cvt_pk_bf16(v1[0], v1[1]); o[3] = cvt_pk_bf16(v1[2], v1[3]); *(u32x4*)ap = o; }
                        else {
                            { u32x4 o; o[0] = cvt_pk_bf16(v0[0], v0[1]); o[1] = cvt_pk_bf16(v0[2], v0[3]); o[2] = cvt_pk_bf16(v1[0], v1[1]); o[3] = cvt_pk_bf16(v1[2], v1[3]);
                                *(u32x4*)(O + row * 2048 + col) = o; } } } }
        } else {
            const int row0 = u.pm * BM + wr * 64 + fr, col0 = u.pn * BM + wc * 32 + 8 * fq;
#pragma unroll
            for (int ai = 0; ai < 2; ++ai)
#pragma unroll
                for (int m = 0; m < 4; ++m) { const int row = row0 + ai * HALF + m * 16;
                    const int mrow = row < NLAT ? (row >> 12) : 2;
                    const float* xr = row < NLAT ? xin_lat + (size_t)row * 2048 : xin_ctx + (size_t)(row - NLAT) * 2048;
                    const float* gr = gate + (size_t)mrow * 12288; float* orow = XL + (size_t)row * 2048;
#pragma unroll
                    for (int bj = 0; bj < 2; ++bj)
#pragma unroll
                        for (int n = 0; n < 2; ++n) { const int col = col0 + bj * HALF + n * 4;
                            const f32x4 g = *(const f32x4*)(gr + col);
                            if (split) *(f32x4*)(part + (size_t)(row - NLAT) * 2048 + col) = acc[ai][bj][m][n];
                            else { const f32x4 x = *(const f32x4*)(xr + col); *(f32x4*)(orow + col) = x + g * acc[ai][bj][m][n]; } } }
        }
    }
};
template <class Epi, class Sched>
__device__ __forceinline__ void gemm_phase(LAS unsigned char* lds, const Gemm g, const Sched& S, const Epi& E) {
    const int tid = otid(), wid = __builtin_amdgcn_readfirstlane(tid >> 6), lane = tid & 63, wr = wid >> 2, wc = wid & 3, fr = lane & 15, fq = lane >> 4;
    const int K = g.K, nt = g.nt;
    unsigned voffA[2], voffB[2];
#pragma unroll
    for (int i = 0; i < 2; ++i) { int R, C; stage_rc(tid * 16 + i * 8192, R, C); const int Rb = Epi::PERM ? ((R & ~31) + perm32(R & 31)) : R;
        voffA[i] = (unsigned)(R * K + C) * 2u; voffB[i] = (unsigned)(Rb * K + C) * 2u; }
    const size_t kstep = (size_t)(BK * 2);
    const size_t hstep = (size_t)HALF * K * 2;
    const size_t tstep = 2 * hstep;
    const unsigned ldsw = (unsigned)wid * 1024u;
    const int aoff = lds_byte(wr * 64 + fr, fq * 8), boff = lds_byte(wc * 32 + fr, fq * 8);
#define PG8_SA(b, h) (((b) * 2 + (h)) * HTB)
#define PG8_SB(b, h) ((4 + (b) * 2 + (h)) * HTB)
#define PG8_STAGE(bufoff, gbase, voff) do { _Pragma("unroll") for (int _i = 0; _i < 2; ++_i) \
        __builtin_amdgcn_global_load_lds((const unsigned*)((const char*)(gbase) + (voff)[_i]), (LAS unsigned*)(lds + (bufoff) + ldsw + _i * 8192), 16, 0, 0); } while (0)
#define PG8_LDA(dst, b, h) do { _Pragma("unroll") for (int m = 0; m < 4; ++m) _Pragma("unroll") for (int k = 0; k < 2; ++k) dst[m][k] = *(const LAS bf16x8*)(lds + PG8_SA(b, h) + aoff + m * 2048 + k * 1024); } while (0)
#define PG8_LDB(dst, b, h) do { _Pragma("unroll") for (int n = 0; n < 2; ++n) _Pragma("unroll") for (int k = 0; k < 2; ++k) dst[n][k] = *(const LAS bf16x8*)(lds + PG8_SB(b, h) + boff + n * 2048 + k * 1024); } while (0)
#define PG8_MMA(ai, bj, At, Bt) do { __builtin_amdgcn_s_setprio(1); _Pragma("unroll") for (int m = 0; m < 4; ++m) _Pragma("unroll") for (int n = 0; n < 2; ++n) _Pragma("unroll") for (int k = 0; k < 2; ++k) \
        acc[ai][bj][m][n] = __builtin_amdgcn_mfma_f32_16x16x32_bf16(Bt[n][k], At[m][k], acc[ai][bj][m][n], 0, 0, 0); __builtin_amdgcn_s_setprio(0); } while (0)
#define PG8_WAIT_V(n) asm volatile("s_waitcnt vmcnt(" #n ")" ::: "memory")
#define PG8_WAIT_L(n) asm volatile("s_waitcnt lgkmcnt(" #n ")" ::: "memory")
#define PG8_BAR __builtin_amdgcn_s_barrier()
#define PG8_SCHED __builtin_amdgcn_sched_barrier(0)
    Unit cur, nxt; int ui = 0;
    if (!S.next(0, cur)) return;
    f32x4 acc[2][2][4][2];
#pragma unroll
    for (int a = 0; a < 2; ++a)
#pragma unroll
        for (int b = 0; b < 2; ++b)
#pragma unroll
            for (int m = 0; m < 4; ++m)
#pragma unroll
                for (int n = 0; n < 2; ++n) acc[a][b][m][n] = (f32x4){0.f, 0.f, 0.f, 0.f};
    bf16x8 At[4][2], B0[2][2], B1[2][2];
    const char* cA = (const char*)g.A + (size_t)cur.pm * tstep; const char* cB = (const char*)g.Bt + (size_t)cur.pn * tstep;
    S.a_ready(cur);
    PG8_STAGE(PG8_SB(0, 0), cB, voffB); PG8_STAGE(PG8_SA(0, 0), cA, voffA); PG8_STAGE(PG8_SB(0, 1), cB + hstep, voffB); PG8_STAGE(PG8_SA(0, 1), cA + hstep, voffA);
    if (wr == 1) PG8_BAR;
    PG8_WAIT_V(4); PG8_BAR;
    PG8_STAGE(PG8_SB(1, 0), cB + kstep, voffB); PG8_STAGE(PG8_SA(1, 0), cA + kstep, voffA); PG8_STAGE(PG8_SB(1, 1), cB + hstep + kstep, voffB);
    PG8_WAIT_V(6); PG8_BAR;
    for (;;) {
        const bool has_next = S.next(ui + 1, nxt);
        const char* nA = has_next ? (const char*)g.A + (size_t)nxt.pm * tstep : cA; const char* nB = has_next ? (const char*)g.Bt + (size_t)nxt.pn * tstep : cB;
        for (int t = 0; t < nt; t += 2) {
            const bool last = (t == nt - 2);
            const char* a1 = cA + (size_t)(t + 1) * kstep;
            const char* a2 = last ? nA : cA + (size_t)(t + 2) * kstep; const char* b2 = last ? nB : cB + (size_t)(t + 2) * kstep;
            const char* a3 = a2 + kstep; const char* b3 = b2 + kstep;
            if (last && has_next) S.a_ready(nxt);
            PG8_LDB(B0, 0, 0); PG8_SCHED; PG8_LDA(At, 0, 0); PG8_STAGE(PG8_SA(1, 1), a1 + hstep, voffA);
            PG8_WAIT_L(8); PG8_BAR; PG8_WAIT_L(0); PG8_MMA(0, 0, At, B0); PG8_BAR; PG8_SCHED;
            PG8_LDB(B1, 0, 1); PG8_STAGE(PG8_SB(0, 0), b2, voffB);
            PG8_BAR; PG8_WAIT_L(0); PG8_MMA(0, 1, At, B1); PG8_BAR;
            PG8_LDA(At, 0, 1); PG8_STAGE(PG8_SA(0, 0), a2, voffA);
            PG8_BAR; PG8_WAIT_L(0); PG8_MMA(1, 0, At, B0); PG8_BAR; PG8_SCHED;
            PG8_STAGE(PG8_SB(0, 1), b2 + hstep, voffB);
            PG8_WAIT_V(6); PG8_BAR; PG8_MMA(1, 1, At, B1); PG8_BAR;
            PG8_LDB(B0, 1, 0); PG8_SCHED; PG8_LDA(At, 1, 0); PG8_STAGE(PG8_SA(0, 1), a2 + hstep, voffA);
            PG8_WAIT_L(8); PG8_BAR; PG8_WAIT_L(0); PG8_MMA(0, 0, At, B0); PG8_BAR; PG8_SCHED;
            PG8_LDB(B1, 1, 1); PG8_STAGE(PG8_SB(1, 0), b3, voffB);
            PG8_BAR; PG8_WAIT_L(0); PG8_MMA(0, 1, At, B1); PG8_BAR;
            PG8_LDA(At, 1, 1); PG8_STAGE(PG8_SA(1, 0), a3, voffA);
            PG8_BAR; PG8_WAIT_L(0); PG8_MMA(1, 0, At, B0); PG8_BAR; PG8_SCHED;
            PG8_STAGE(PG8_SB(1, 1), b3 + hstep, voffB);
            PG8_WAIT_V(6); PG8_BAR; PG8_MMA(1, 1, At, B1); PG8_BAR;
        }
        if constexpr (!Epi::AFTER_DRAIN) { E(acc, cur, wr, wc, fr, fq); S.done(cur); }
        if (!has_next) break;
#pragma unroll
        for (int a = 0; a < 2; ++a)
#pragma unroll
            for (int b = 0; b < 2; ++b)
#pragma unroll
                for (int m = 0; m < 4; ++m)
#pragma unroll
                    for (int n = 0; n < 2; ++n) acc[a][b][m][n] = (f32x4){0.f, 0.f, 0.f, 0.f};
        cur = nxt; cA = nA; cB = nB; ++ui;
    }
    PG8_WAIT_V(0);
    if (wr == 0) PG8_BAR;
    PG8_BAR;
    if constexpr (Epi::AFTER_DRAIN) { E.fused(acc, cur, wr, wc, fr, fq, lds, wid, lane); S.done(cur); }
#undef PG8_SA
#undef PG8_SB
#undef PG8_STAGE
#undef PG8_LDA
#undef PG8_LDB
#undef PG8_MMA
#undef PG8_WAIT_V
#undef PG8_WAIT_L
#undef PG8_BAR
#undef PG8_SCHED
}
}

__device__ void phase_mod(PP p, float* lds) {
    const int TIDX = otid();
    const int tid = TIDX;
    float* s = lds;
    float* red = lds + 3 * 2048;
    float* MOD = (float*)(p->ws + OFF_MOD);
    for (int i = tid; i < 3 * 2048; i += 512) { const int r = i >> 11, k = i & 2047; const float c = r < 2 ? p->in[I_C][r * 2048 + k] : p->in[I_CCTX][k]; s[i] = c * sigmoidf(c); }
    __syncthreads();
    for (int task = blockIdx.x; task < 192; task += gridDim.x) {
        const int l = task / 96, j0 = (task % 96) * 128, jc = tid & 127, kp = tid >> 7;
        const float* w = p->in[I_WMOD] + (size_t)l * 2048 * 12288 + j0 + jc;
        float a0 = 0.f, a1 = 0.f, a2 = 0.f;
#pragma unroll 8
        for (int k = kp * 512; k < kp * 512 + 512; ++k) { const float wv = w[(size_t)k * 12288]; a0 += s[k] * wv; a1 += s[2048 + k] * wv; a2 += s[4096 + k] * wv; }
        red[(kp * 3 + 0) * 128 + jc] = a0; red[(kp * 3 + 1) * 128 + jc] = a1; red[(kp * 3 + 2) * 128 + jc] = a2;
        __syncthreads();
        if (tid < 384) { const int r = tid >> 7, j = tid & 127;
            const float v = ((red[(0 * 3 + r) * 128 + j] + red[(1 * 3 + r) * 128 + j]) + (red[(2 * 3 + r) * 128 + j] + red[(3 * 3 + r) * 128 + j])) + p->in[I_BMOD][l * 12288 + j0 + j];
            MOD[(size_t)(l * 3 + r) * 12288 + j0 + j] = v; }
        __syncthreads();
    }
    if (blockIdx.x == gridDim.x - 1) {
        float* rc = (float*)(p->ws + OFF_ROPE); float* rs = rc + 2048;
        for (int i = tid; i < 2048; i += 512) { const int pos = i >> 5, j = i & 31; const float fr = powf(10000.0f, -(float)j / 32.0f); const float ang = (float)pos * fr; rc[i] = cosf(ang); rs[i] = sinf(ang); }
    }
}

__device__ void conv_tile(const float* __restrict__ src, int ld_src, int n_valid, int n0, int k0, bf16_t* __restrict__ dst, int ld_dst, float* tile) {
    const int TIDX = otid();
    const int tid = TIDX;
#pragma unroll
    for (int i = 0; i < 2; ++i) { const int kr = (tid >> 4) + i * 32, nc = (tid & 15) * 4; const float* sp = src + (size_t)(k0 + kr) * ld_src + n0 + nc;
        f32x4 v;
        if (n0 + nc + 3 < n_valid) v = *(const f32x4*)sp;
        else { v[0] = (n0 + nc + 0 < n_valid) ? sp[0] : 0.f; v[1] = (n0 + nc + 1 < n_valid) ? sp[1] : 0.f; v[2] = (n0 + nc + 2 < n_valid) ? sp[2] : 0.f; v[3] = (n0 + nc + 3 < n_valid) ? sp[3] : 0.f; }
        float* tp = tile + kr * 65 + nc; tp[0] = v[0]; tp[1] = v[1]; tp[2] = v[2]; tp[3] = v[3]; }
    __syncthreads();
    { const int n = tid >> 3, kc = (tid & 7) * 8; u32x4 o;
#pragma unroll
        for (int j = 0; j < 4; ++j) o[j] = pack2(tile[(kc + 2 * j) * 65 + n], tile[(kc + 2 * j + 1) * 65 + n]);
        *(u32x4*)(dst + (size_t)(n0 + n) * ld_dst + k0 + kc) = o; }
    __syncthreads();
}
__device__ void phase_convert(PP p, int l, float* lds, int vb, int vg, size_t wsh, int t_lo, int t_hi, bool lora) {
    const int TIDX = otid();
    unsigned char* wsw = p->ws + wsh;
    for (int t = t_lo + vb; t < t_hi; t += vg) {
        if (t < 8064) { const int nt = t >> 5, kt = t & 31; conv_tile(p->in[I_WIN] + (size_t)l * 2048 * DIN, DIN, DIN, nt * 64, kt * 64, (bf16_t*)(wsw + OFF_WIN), 2048, lds); }
        else if (t < 9600) { const int tt = t - 8064, br = tt >> 9, r = tt & 511, nt = r >> 4, kt = r & 15;
            conv_tile(p->in[I_WBR] + (size_t)(l * 3 + br) * 1024 * 2048, 2048, 2048, nt * 64, kt * 64, (bf16_t*)(wsw + OFF_WBR) + (size_t)br * 2048 * 1024, 1024, lds); }
        else if (t < 10624) { const int tt = t - 9600, nt = tt >> 5, kt = tt & 31; conv_tile(p->in[I_WOUT] + (size_t)l * 2048 * 2048, 2048, 2048, nt * 64, kt * 64, (bf16_t*)(wsw + OFF_WOUT), 2048, lds); }
        else if (t < 14720) { const int tt = t - 10624, nt = tt >> 5, kt = tt & 31; conv_tile(p->in[I_WFF1] + (size_t)l * 2048 * 8192, 8192, 8192, nt * 64, kt * 64, (bf16_t*)(wsw + OFF_WFF1), 2048, lds); }
        else { const int tt = t - 14720, nt = tt >> 7, kt = tt & 127; conv_tile(p->in[I_WFF2] + (size_t)l * 8192 * 2048, 2048, 2048, nt * 64, kt * 64, (bf16_t*)(wsw + OFF_WFF2), 8192, lds); }
    }
    bf16_t* WL = (bf16_t*)(wsw + OFF_WLORA);
    if (lora) for (int idx = vb * 512 + TIDX; idx < 5120 * 640; idx += vg * 512) {
        const int n = idx / 640, k = idx - n * 640, blk = n >> 10, nn = n & 1023;
        const int k0 = blk < 4 ? blk * 96 : 384, kw = blk < 4 ? 96 : 256;
        float v = 0.f;
        if (k >= k0 && k < k0 + kw) {
            const float* sp = blk < 2 ? p->in[I_RWWUP] + (size_t)(l * 2 + blk) * 96 * 1024 : (blk < 4 ? p->in[I_RWAUP] + (size_t)(l * 2 + blk - 2) * 96 * 1024 : p->in[I_RWGUP] + (size_t)l * 256 * 1024);
            v = sp[(size_t)(k - k0) * 1024 + nn]; }
        WL[idx] = f2bf(v);
    }
}
__device__ void phase_init(PP p, int l) {
    const int TIDX = otid();
    if (blockIdx.x == 0 && TIDX < 8) ((unsigned*)(p->ws + OFF_CTL))[l * 8 + TIDX] = 0u;
}

__device__ __forceinline__ void phase_norm(const float* __restrict__ xlat, const float* __restrict__ xctx, int nrows, const float* __restrict__ g, const float* __restrict__ modl, int ishift, int iscale, bf16_t* __restrict__ H,
                           const float* part = nullptr, const float* pgate = nullptr, float* xl_ctx = nullptr) {
    const int TIDX = otid();
    const int wid = TIDX >> 6, lane = TIDX & 63;
    for (int row = blockIdx.x * 8 + wid; row < nrows; row += gridDim.x * 8) {
        const float* xr = row < NLAT ? xlat + (size_t)row * 2048 : xctx + (size_t)(row - NLAT) * 2048;
        const int mrow = row < NLAT ? (row >> 12) : 2;
        const float* sh = modl + (size_t)mrow * 12288 + ishift * 2048; const float* sc = modl + (size_t)mrow * 12288 + iscale * 2048;
        f32x4 v[8]; float ss = 0.f;
#pragma unroll
        for (int i = 0; i < 8; ++i) v[i] = *(const f32x4*)(xr + (i * 64 + lane) * 4);
        if (part != nullptr && row >= NLAT) {
#pragma unroll
            for (int i = 0; i < 8; ++i) { const int col = (i * 64 + lane) * 4; const float* pp = part + (size_t)(row - NLAT) * 2048 + col;
                f32x4 a = *(const f32x4*)pp;
#pragma unroll
                for (int s_ = 1; s_ < 16; ++s_) a += *(const f32x4*)(pp + (size_t)s_ * 512 * 2048);
                v[i] += *(const f32x4*)(pgate + col) * a;
                *(f32x4*)(xl_ctx + (size_t)(row - NLAT) * 2048 + col) = v[i]; } }
#pragma unroll
        for (int i = 0; i < 8; ++i) ss += v[i][0] * v[i][0] + v[i][1] * v[i][1] + v[i][2] * v[i][2] + v[i][3] * v[i][3];
        ss = wsum(ss);
        const float r = rsqrtf(ss * (1.0f / 2048.0f) + 1e-6f);
#pragma unroll
        for (int i = 0; i < 8; ++i) { const int col = (i * 64 + lane) * 4; const f32x4 gg = *(const f32x4*)(g + col), s1 = *(const f32x4*)(sc + col), s0 = *(const f32x4*)(sh + col);
            float o[4];
#pragma unroll
            for (int j = 0; j < 4; ++j) o[j] = (v[i][j] * r * gg[j]) * (1.0f + s1[j]) + s0[j];
            u32x2 w; w[0] = pack2(o[0], o[1]); w[1] = pack2(o[2], o[3]);
            *(u32x2*)(H + (size_t)row * 2048 + col) = w; }
    }
}
__device__ void phase_final(PP p) {
    const int TIDX = otid();
    const int wid = TIDX >> 6, lane = TIDX & 63;
    const float* XL = (const float*)(p->ws + OFF_XL); const float* g = p->in[I_FING];
    for (int row = blockIdx.x * 8 + wid; row < NLAT; row += gridDim.x * 8) {
        const float* xr = XL + (size_t)row * 2048;
        f32x4 v[8]; float ss = 0.f;
#pragma unroll
        for (int i = 0; i < 8; ++i) { v[i] = *(const f32x4*)(xr + (i * 64 + lane) * 4); ss += v[i][0] * v[i][0] + v[i][1] * v[i][1] + v[i][2] * v[i][2] + v[i][3] * v[i][3]; }
        ss = wsum(ss);
        const float r = rsqrtf(ss * (1.0f / 2048.0f) + 1e-6f);
#pragma unroll
        for (int i = 0; i < 8; ++i) { const int col = (i * 64 + lane) * 4; const f32x4 gg = *(const f32x4*)(g + col);
            f32x4 o; o[0] = v[i][0] * r * gg[0]; o[1] = v[i][1] * r * gg[1]; o[2] = v[i][2] * r * gg[2]; o[3] = v[i][3] * r * gg[3];
            *(f32x4*)(p->out + (size_t)row * 2048 + col) = o; }
    }
}

DEVI void seq_nbrs(int row, bool& hp, bool& hn) {
    if (row < NLAT) { const int t = row & 4095; hp = t > 0; hn = t < 4095; } else { const int m = (row - NLAT) & 255; hp = m > 0; hn = m < 255; }
}
DEVI float shiftf(float c, float pv, float nx, float mu) { return c + mu * (0.5f * (pv + nx) - c); }

__device__ void phase_prep(PP p, int l, bf16_t* ldsT) {
    const int TIDX = otid();
    const bf16_t* P = (const bf16_t*)(p->ws + OFF_P); bf16_t* LA = (bf16_t*)(p->ws + OFF_LA);
    const float* mu = p->in[I_RWMU] + (size_t)l * 3712 + 3072;
    for (int idx = blockIdx.x * 512 + TIDX; idx < NTOK * 80; idx += gridDim.x * 512) {
        const int row = idx / 80, j = (idx - row * 80) * 8;
        bool hp, hn; seq_nbrs(row, hp, hn);
        const bf16_t* pc = P + (size_t)row * NP + RWB + 3072 + j;
        const u32x4 c = *(const u32x4*)pc;
        const u32x4 z = {0u, 0u, 0u, 0u};
        const u32x4 pv = hp ? *(const u32x4*)(pc - NP) : z, nx = hn ? *(const u32x4*)(pc + NP) : z;
        float o[8];
#pragma unroll
        for (int q = 0; q < 4; ++q) { o[2 * q] = shiftf(bflo(c[q]), bflo(pv[q]), bflo(nx[q]), mu[j + 2 * q]); o[2 * q + 1] = shiftf(bfhi(c[q]), bfhi(pv[q]), bfhi(nx[q]), mu[j + 2 * q + 1]); }
        if (j < 192) {
#pragma unroll
            for (int q = 0; q < 8; ++q) o[q] = (1.0f - 2.0f * __builtin_amdgcn_rcpf(1.0f + __expf(2.0f * o[q]))); }
        else if (j >= 384) {
#pragma unroll
            for (int q = 0; q < 8; ++q) o[q] = sigmoidf(o[q]); }
        u32x4 w; w[0] = pack2(o[0], o[1]); w[1] = pack2(o[2], o[3]); w[2] = pack2(o[4], o[5]); w[3] = pack2(o[6], o[7]);
        *(u32x4*)(LA + (size_t)row * 640 + j) = w;
    }
    bf16_t* VT = (bf16_t*)(p->ws + OFF_VT);
    const int tid = TIDX;
    for (int t = blockIdx.x; t < 136 * 16; t += gridDim.x) {
        const int rt = t >> 4, hd = t & 15, h = hd >> 1, dh = hd & 1;
        const int row0 = rt * 64;
        { const int tl = tid >> 3, dc = (tid & 7) * 8;
            const u32x4 v = *(const u32x4*)(P + (size_t)(row0 + tl) * NP + NAB + 2048 + h * 128 + dh * 64 + dc);
            bf16_t* tp = ldsT + tl * 66 + dc;
#pragma unroll
            for (int q = 0; q < 4; ++q) { tp[2 * q] = (bf16_t)(v[q] & 0xffffu); tp[2 * q + 1] = (bf16_t)(v[q] >> 16); } }
        __syncthreads();
        { const int d = tid >> 3, tc = (tid & 7) * 8;
            int b, pos; if (row0 < NLAT) { b = row0 >> 12; pos = row0 & 4095; } else { b = (row0 - NLAT) >> 8; pos = 4096 + ((row0 - NLAT) & 255); }
            u32x4 o;
#pragma unroll
            for (int q = 0; q < 4; ++q) o[q] = (unsigned)ldsT[(tc + 2 * q) * 66 + d] | ((unsigned)ldsT[(tc + 2 * q + 1) * 66 + d] << 16);
            *(u32x4*)(VT + ((size_t)((b * 8 + h) * 128 + dh * 64 + d)) * 4352 + pos + tc) = o; }
        __syncthreads();
    }
}

DEVI int scan_row(int s, int b, int dir) {
    if (s < 256) { const int m = dir ? 255 - s : s; return NLAT + b * 256 + m; }
    const int t = dir ? 4095 - (s - 256) : s - 256; return b * 4096 + t;
}
__device__ void rwkv_scan(PP p, int l, int task, float* lds) {
    const int TIDX = otid();
    const int chain = task >> 1, half = task & 1;
    const int b = chain >> 5, h = (chain >> 1) & 15, dir = chain & 1, tid = TIDX;
    const bf16_t* P = (const bf16_t*)(p->ws + OFF_P); const bf16_t* LO = (const bf16_t*)(p->ws + OFF_LO);
    float* YO = (float*)(p->ws + OFF_YRWF) + (size_t)dir * NTOK * 1024 + h * 64;
    const int sl = tid >> 5, e2 = (tid & 31) * 2, ch = h * 64 + e2;
    const float* MU = p->in[I_RWMU] + (size_t)l * 3712;
    const float mur0 = MU[ch], mur1 = MU[ch + 1], muk0 = MU[1024 + ch], muk1 = MU[1024 + ch + 1], muv0 = MU[2048 + ch], muv1 = MU[2048 + ch + 1];
    const float w00 = p->in[I_RWW0][(l * 2 + dir) * 1024 + ch], w01 = p->in[I_RWW0][(l * 2 + dir) * 1024 + ch + 1];
    const float a00 = p->in[I_RWA0][(l * 2 + dir) * 1024 + ch], a01 = p->in[I_RWA0][(l * 2 + dir) * 1024 + ch + 1];
    const float kk0 = p->in[I_RWKK][l * 1024 + ch], kk1 = p->in[I_RWKK][l * 1024 + ch + 1], ka0 = p->in[I_RWKA][l * 1024 + ch], ka1 = p->in[I_RWKA][l * 1024 + ch + 1];
    const float rk0 = p->in[I_RWRK][l * 1024 + ch], rk1 = p->in[I_RWRK][l * 1024 + ch + 1];
    float* RK = (float*)(p->ws + OFF_RK); const bool wrk = dir == 0 && half == 0; int srow = 0;
    const int kq = tid & 15, v = half * 32 + (tid >> 4);
    f32x2 S0 = (f32x2){0.f, 0.f}, S1 = (f32x2){0.f, 0.f};
    unsigned rc, rp, rn, kc, kp, kn, vc, vp, vn, wr_, ar_;
    auto issue = [&](int g) {
        const int row = scan_row(g * 16 + sl, b, dir); bool hp, hn; seq_nbrs(row, hp, hn); srow = row;
        const bf16_t* pr = P + (size_t)row * NP + RWB + ch;
        rc = *(const unsigned*)pr; kc = *(const unsigned*)(pr + 1024); vc = *(const unsigned*)(pr + 2048);
        rp = 0u; kp = 0u; vp = 0u; rn = 0u; kn = 0u; vn = 0u;
        if (hp) { rp = *(const unsigned*)(pr - NP); kp = *(const unsigned*)(pr - NP + 1024); vp = *(const unsigned*)(pr - NP + 2048); }
        if (hn) { rn = *(const unsigned*)(pr + NP); kn = *(const unsigned*)(pr + NP + 1024); vn = *(const unsigned*)(pr + NP + 2048); }
        const bf16_t* lo = LO + (size_t)row * 5120 + dir * 1024 + ch;
        wr_ = *(const unsigned*)lo; ar_ = *(const unsigned*)(lo + 2048);
    };
    auto commit = [&](int buf) {
        float* st = lds + buf * 6144 + sl * 384 + e2;
        const float r0 = shiftf(bflo(rc), bflo(rp), bflo(rn), mur0), r1 = shiftf(bfhi(rc), bfhi(rp), bfhi(rn), mur1);
        const float k0 = shiftf(bflo(kc), bflo(kp), bflo(kn), muk0), k1 = shiftf(bfhi(kc), bfhi(kp), bfhi(kn), muk1);
        const float v0 = shiftf(bflo(vc), bflo(vp), bflo(vn), muv0), v1 = shiftf(bfhi(vc), bfhi(vp), bfhi(vn), muv1);
        const float x0 = -(w00 + bflo(wr_)), x1 = -(w01 + bfhi(wr_));
        const float sp0 = x0 > 20.f ? x0 : __logf(1.0f + __expf(x0)), sp1 = x1 > 20.f ? x1 : __logf(1.0f + __expf(x1));
        const float d0 = __expf(-__expf(-sp0 - 0.5f)), d1 = __expf(-__expf(-sp1 - 0.5f));
        const float ar0 = fsigmoid(a00 + bflo(ar_)), ar1 = fsigmoid(a01 + bfhi(ar_));
        const float kd0 = k0 * (1.0f + (ar0 - 1.0f) * ka0), kd1 = k1 * (1.0f + (ar1 - 1.0f) * ka1);
        const float q0 = k0 * kk0, q1 = k1 * kk1;
        float ss = red16(q0 * q0 + q1 * q1);
        ss += __shfl_xor(ss, 16);
        const float inv = frcp(fmaxf(__builtin_amdgcn_sqrtf(ss), 1e-12f));
        const float n0 = q0 * inv, n1 = q1 * inv;
        if (wrk) { float t = red16(r0 * k0 * rk0 + r1 * k1 * rk1); t += __shfl_xor(t, 16); if ((tid & 31) == 0) RK[srow * 16 + h] = t; }
        *(f32x2*)(st + 0) = (f32x2){r0, r1}; *(f32x2*)(st + 64) = (f32x2){d0, d1}; *(f32x2*)(st + 128) = (f32x2){kd0, kd1};
        *(f32x2*)(st + 192) = (f32x2){v0, v1}; *(f32x2*)(st + 256) = (f32x2){-n0, -n1}; *(f32x2*)(st + 320) = (f32x2){n0 * ar0, n1 * ar1};
    };
    __syncthreads();
    issue(0); commit(0);
    __syncthreads();
    constexpr int NG = 4352 / 16;
    for (int g = 0; g < NG; ++g) {
        if (g + 1 < NG) issue(g + 1);
        {
            const float* base = lds + (g & 1) * 6144 + kq * 4;
            float ykeep = 0.f;
            f32x4 nA, nD, nB, nK, nR; float nV;
#define RW_LOAD(i_) do { const float* st_ = base + (i_) * 384; nA = *(const f32x4*)(st_ + 256); nD = *(const f32x4*)(st_ + 64); nB = *(const f32x4*)(st_ + 320); nK = *(const f32x4*)(st_ + 128); nR = *(const f32x4*)(st_); \
                nV = st_[192 - kq * 4 + v]; } while (0)
            RW_LOAD(0);
#pragma unroll
            for (int i = 0; i < 16; ++i) {
                const f32x4 a = nA, d = nD, bb = nB, k = nK, r = nR; const float vv = nV;
                if (i < 15) { RW_LOAD(i + 1); }
                __builtin_amdgcn_sched_barrier(0x77);
                f32x2 pa2 = S0 * (f32x2){a[0], a[1]}; pa2 = S1 * (f32x2){a[2], a[3]} + pa2;
                const f32x2 vvb = (f32x2){vv, vv};
                const f32x2 u0 = S0 * (f32x2){d[0], d[1]} + vvb * (f32x2){k[0], k[1]}, u1 = S1 * (f32x2){d[2], d[3]} + vvb * (f32x2){k[2], k[3]};
                const float pa = red16(pa2[0] + pa2[1]);
                const f32x2 pab = (f32x2){pa, pa};
                S0 = pab * (f32x2){bb[0], bb[1]} + u0; S1 = pab * (f32x2){bb[2], bb[3]} + u1;
                f32x2 y2 = S0 * (f32x2){r[0], r[1]}; y2 = S1 * (f32x2){r[2], r[3]} + y2;
                const float y = red16(y2[0] + y2[1]);
                ykeep = (kq == i) ? y : ykeep;
            }
#undef RW_LOAD
            YO[(size_t)scan_row(g * 16 + kq, b, dir) * 1024 + v] = ykeep;
        }
        if (g + 1 < NG) commit((g + 1) & 1);
        __syncthreads();
    }
}

__device__ void mlstm_scan(PP p, int l, int chain, int g8, float* lds) {
    const int TIDX = otid();
    const int b = chain >> 3, h = (chain >> 1) & 3, dir = chain & 1, tid = TIDX;
    const bf16_t* P = (const bf16_t*)(p->ws + OFF_P);
    const float* RC = (const float*)(p->ws + OFF_ROPE); const float* RS = RC + 2048;
    float* NO = (float*)(p->ws + OFF_MLNUM) + (size_t)dir * NTOK * 4 * 272 + h * 272;
    const int sl = tid >> 5, j = tid & 31;
    const float gbi = p->in[I_MLGB][l * 16 + (dir * 2 + 0) * 4 + h], gbf = p->in[I_MLGB][l * 16 + (dir * 2 + 1) * 4 + h];
    const int rowl = (tid >> 3) & 31, kq = tid & 7, crow = g8 * 32 + rowl, lane = tid & 63;
    f32x2 C[8];
#pragma unroll
    for (int i = 0; i < 8; ++i) C[i] = (f32x2){0.f, 0.f};
    f32x2 nst = (f32x2){0.f, 0.f};
    bf16_t q0, q1, q2, q3, k0, k1, k2, k3, gi, gf; unsigned vv2; float cr, sr, cc, sc;
    auto issue = [&](int g) {
        const int row = scan_row(g * 16 + sl, b, dir);
        const bf16_t* pr = P + (size_t)row * NP;
        const bf16_t* pq = pr + h * 128 + j; const bf16_t* pk = pr + 512 + h * 128 + j;
        q0 = pq[0]; q1 = pq[32]; q2 = pq[64]; q3 = pq[96]; k0 = pk[0]; k1 = pk[32]; k2 = pk[64]; k3 = pk[96];
        vv2 = j < 16 ? *(const unsigned*)(pr + 1024 + h * 256 + g8 * 32 + 2 * j) : 0u;
        gi = pr[3072 + (dir * 2 + 0) * 4 + h]; gf = pr[3072 + (dir * 2 + 1) * 4 + h];
        if (row < NLAT) { const int t = row & 4095, pr_ = t >> 6, pc_ = t & 63; cr = RC[pr_ * 32 + j]; sr = RS[pr_ * 32 + j]; cc = RC[pc_ * 32 + j]; sc = RS[pc_ * 32 + j]; }
        else { cr = 1.f; sr = 0.f; cc = 1.f; sc = 0.f; }
    };
    auto commit = [&](int buf) {
        float* st = lds + buf * 5376 + sl * 336;
        const float scale = 0.08838834764831845f;
        const float a0 = bf2f(q0), a1 = bf2f(q1), a2 = bf2f(q2), a3 = bf2f(q3);
        st[j] = (a0 * cr - a1 * sr) * scale; st[32 + j] = (a0 * sr + a1 * cr) * scale; st[64 + j] = (a2 * cc - a3 * sc) * scale; st[96 + j] = (a2 * sc + a3 * cc) * scale;
        const float c0 = bf2f(k0), c1 = bf2f(k1), c2 = bf2f(k2), c3 = bf2f(k3);
        st[128 + j] = c0 * cr - c1 * sr; st[160 + j] = c0 * sr + c1 * cr; st[192 + j] = c2 * cc - c3 * sc; st[224 + j] = c2 * sc + c3 * cc;
        if (j < 16) { st[256 + 2 * j] = bflo(vv2); st[257 + 2 * j] = bfhi(vv2); }
        if (j == 0) { st[320] = fsigmoid(bf2f(gf) + gbf); st[321] = __expf(bf2f(gi) + gbi); }
    };
    __syncthreads();
    issue(0); commit(0);
    __syncthreads();
    constexpr int NG = 4352 / 16;
    for (int g = 0; g < NG; ++g) {
        if (g + 1 < NG) issue(g + 1);
        const float* base = lds + (g & 1) * 5376;
        if (tid < 256) {
            float nkeep = 0.f, Fc = 1.0f;
            f32x4 nK[4], nQ[4]; float nF, nI, nV0;
#define ML_LOAD(i_) do { const float* st_ = base + (i_) * 336; _Pragma("unroll") for (int c4 = 0; c4 < 4; ++c4) { nK[c4] = *(const f32x4*)(st_ + 128 + c4 * 32 + kq * 4); nQ[c4] = *(const f32x4*)(st_ + c4 * 32 + kq * 4); } \
                nF = st_[320]; nI = st_[321]; nV0 = st_[256 + rowl]; } while (0)
            ML_LOAD(0);
#pragma unroll
            for (int i = 0; i < 16; ++i) {
                f32x4 kk[4], qq[4];
#pragma unroll
                for (int c4 = 0; c4 < 4; ++c4) { kk[c4] = nK[c4]; qq[c4] = nQ[c4]; }
                if (Fc < 1e-18f) {
                    const f32x2 fb = (f32x2){Fc, Fc};
#pragma unroll
                    for (int x = 0; x < 8; ++x) C[x] = C[x] * fb;
                    Fc = 1.0f; }
                Fc *= nF;
                const float coef = nI * nV0 * frcp(Fc);
                if (i < 15) { ML_LOAD(i + 1); }
                __builtin_amdgcn_sched_barrier(0x77);
                const f32x2 cf = (f32x2){coef, coef};
                f32x2 num2 = (f32x2){0.f, 0.f}, num3 = (f32x2){0.f, 0.f};
#pragma unroll
                for (int c4 = 0; c4 < 4; ++c4) {
                    const f32x2 KA = (f32x2){kk[c4][0], kk[c4][1]}, KB = (f32x2){kk[c4][2], kk[c4][3]}, QA = (f32x2){qq[c4][0], qq[c4][1]}, QB = (f32x2){qq[c4][2], qq[c4][3]};
                    C[2 * c4] = cf * KA + C[2 * c4]; C[2 * c4 + 1] = cf * KB + C[2 * c4 + 1];
                    num2 = C[2 * c4] * QA + num2; num3 = C[2 * c4 + 1] * QB + num3; }
                num2 += num3;
                const float num = red8(num2[0] + num2[1]) * Fc;
                nkeep = (kq == (i & 7)) ? num : nkeep;
                if ((i & 7) == 7) NO[(size_t)scan_row(g * 16 + (i - 7) + kq, b, dir) * (4 * 272) + crow] = nkeep;
            }
            { const f32x2 fb = (f32x2){Fc, Fc};
#pragma unroll
                for (int x = 0; x < 8; ++x) C[x] = C[x] * fb; }
#undef ML_LOAD
        } else if (g8 == 0 && tid < 320) {
            float nkeep = 0.f;
            f32x2 nk, nq; float nf, ni;
#define MN_LOAD(i_) do { const float* st_ = base + (i_) * 336; nk = *(const f32x2*)(st_ + 128 + 2 * lane); nq = *(const f32x2*)(st_ + 2 * lane); nf = st_[320]; ni = st_[321]; } while (0)
            MN_LOAD(0);
#pragma unroll
            for (int i = 0; i < 16; ++i) {
                const f32x2 kk = nk, qq = nq; const float f = nf, ig = ni;
                if (i < 15) { MN_LOAD(i + 1); }
                __builtin_amdgcn_sched_barrier(0x77);
                nst = (f32x2){f, f} * nst + (f32x2){ig, ig} * kk;
                const f32x2 d2 = nst * qq;
                const float den16 = red16(d2[0] + d2[1]);
                nkeep = ((lane & 15) == i) ? den16 : nkeep;
            }
#undef MN_LOAD
            nkeep += __shfl_xor(nkeep, 16); nkeep += __shfl_xor(nkeep, 32);
            if (lane < 16) NO[(size_t)scan_row(g * 16 + lane, b, dir) * (4 * 272) + 256] = nkeep;
        }
        if (g + 1 < NG) commit((g + 1) & 1);
        __syncthreads();
    }
}

#define MFMA16(a, b, c) __builtin_amdgcn_mfma_f32_16x16x32_bf16(a, b, c, 0, 0, 0)
__device__ void na_wave(PP p, int l, int task) {
    const int TIDX = otid();
    const bf16_t* P = (const bf16_t*)(p->ws + OFF_P); const bf16_t* VT = (const bf16_t*)(p->ws + OFF_VT);
    bf16_t* YN = (bf16_t*)(p->ws + OFF_Y3) + 2ull * NTOK * 1024;
    const int w = TIDX >> 6, lane = TIDX & 63, n16 = lane & 15, g = lane >> 4;
    int b, h, qrow, r = 0, qcol = 0, cs = 0, row_start = 0, c_start = 0; bool lat;
    if (task < 512) { lat = true; b = task >> 8; h = (task >> 5) & 7; const int pair = task & 31; r = pair * 2 + (w >> 2); const int qi = w & 3; qcol = qi * 16 + n16;
        qrow = b * 4096 + r * 64 + qcol; cs = qi == 0 ? 0 : (qi == 1 ? 8 : (qi == 2 ? 24 : 32)); row_start = min(max(r - 4, 0), 56); c_start = min(max(qcol - 8, 0), 48); }
    else { lat = false; const int t2 = task - 512; b = t2 >> 4; h = (t2 >> 1) & 7; const int chunk = t2 & 1; qrow = NLAT + b * 256 + chunk * 128 + w * 16 + n16; }
    bf16x8 qf[4];
#pragma unroll
    for (int c = 0; c < 4; ++c) qf[c] = *(const bf16x8*)(P + (size_t)qrow * NP + NAB + h * 128 + c * 32 + g * 8);
    const float* rpb = p->in[I_RPB] + (size_t)(l * 8 + h) * 15 * 31;
    const bf16_t* vtb = VT + (size_t)((b * 8 + h) * 128) * 4352;
    f32x4 O[8];
#pragma unroll
    for (int i = 0; i < 8; ++i) O[i] = (f32x4){0.f, 0.f, 0.f, 0.f};
    float mrun = -INFINITY, lsum = 0.f;
    const float scale = 0.08838834764831845f;
    for (int pass = lat ? 0 : 2; pass < 4; ++pass) {
        f32x4 S[8];
#pragma unroll
        for (int i = 0; i < 8; ++i) {
            int krowtok;
            if (pass < 2) { const int krow = row_start + pass * 4 + (i >> 1); krowtok = b * 4096 + krow * 64 + cs + (i & 1) * 16 + n16; }
            else krowtok = NLAT + b * 256 + (pass - 2) * 128 + i * 16 + n16;
            const bf16_t* kp = P + (size_t)krowtok * NP + NAB + 1024 + h * 128 + g * 8;
            f32x4 acc = (f32x4){0.f, 0.f, 0.f, 0.f};
#pragma unroll
            for (int c = 0; c < 4; ++c) { const bf16x8 kf = *(const bf16x8*)(kp + c * 32); acc = MFMA16(kf, qf[c], acc); }
            S[i] = acc;
        }
        float mx = -INFINITY;
#pragma unroll
        for (int i = 0; i < 8; ++i) {
            if (pass < 2) { const int krow = row_start + pass * 4 + (i >> 1); const float* rb = rpb + (krow - r + 7) * 31;
#pragma unroll
                for (int jj = 0; jj < 4; ++jj) { const int kc = cs + (i & 1) * 16 + 4 * g + jj; const bool ok = (kc >= c_start) && (kc < c_start + 16);
                    const int co = min(max(kc - qcol, -15), 15) + 15;
                    S[i][jj] = ok ? S[i][jj] * scale + rb[co] : -INFINITY; } }
            else {
#pragma unroll
                for (int jj = 0; jj < 4; ++jj) S[i][jj] *= scale; }
#pragma unroll
            for (int jj = 0; jj < 4; ++jj) mx = fmaxf(mx, S[i][jj]);
        }
        mx = fmaxf(mx, __shfl_xor(mx, 16)); mx = fmaxf(mx, __shfl_xor(mx, 32));
        const float mnew = fmaxf(mrun, mx);
        const float alpha = __expf(mrun - mnew);
        mrun = mnew; lsum *= alpha;
#pragma unroll
        for (int i = 0; i < 8; ++i) { O[i][0] *= alpha; O[i][1] *= alpha; O[i][2] *= alpha; O[i][3] *= alpha; }
        bf16x8 pf[4];
#pragma unroll
        for (int c = 0; c < 4; ++c) {
            float e[8];
#pragma unroll
            for (int jj = 0; jj < 4; ++jj) { e[jj] = __expf(S[2 * c][jj] - mnew); e[4 + jj] = __expf(S[2 * c + 1][jj] - mnew); }
#pragma unroll
            for (int jj = 0; jj < 8; ++jj) lsum += e[jj];
            u32x4 u; u[0] = pack2(e[0], e[1]); u[1] = pack2(e[2], e[3]); u[2] = pack2(e[4], e[5]); u[3] = pack2(e[6], e[7]);
            pf[c] = __builtin_bit_cast(bf16x8, u);
        }
#pragma unroll
        for (int c = 0; c < 4; ++c) {
            int pos0, pos1;
            if (pass < 2) { const int krow = row_start + pass * 4 + c; pos0 = krow * 64 + cs + 4 * g; pos1 = pos0 + 16; }
            else { pos0 = 4096 + (pass - 2) * 128 + c * 32 + 4 * g; pos1 = pos0 + 16; }
#pragma unroll
            for (int dt = 0; dt < 8; ++dt) {
                const bf16_t* vp = vtb + (size_t)(dt * 16 + n16) * 4352;
                const bf16x4 v0 = *(const bf16x4*)(vp + pos0), v1 = *(const bf16x4*)(vp + pos1);
                const bf16x8 vf = __builtin_shufflevector(v0, v1, 0, 1, 2, 3, 4, 5, 6, 7);
                O[dt] = MFMA16(vf, pf[c], O[dt]);
            }
        }
    }
    lsum += __shfl_xor(lsum, 16); lsum += __shfl_xor(lsum, 32);
    const float inv = 1.0f / lsum;
    bf16_t* yo = YN + (size_t)qrow * 1024 + h * 128 + 4 * g;
#pragma unroll
    for (int dt = 0; dt < 8; ++dt) { u32x2 o; o[0] = pack2(O[dt][0] * inv, O[dt][1] * inv); o[1] = pack2(O[dt][2] * inv, O[dt][3] * inv); *(u32x2*)(yo + dt * 16) = o; }
}

__device__ void na_block(PP p, int l, int task, unsigned char* lds) {
    const int TIDX = otid();
    const bf16_t* P = (const bf16_t*)(p->ws + OFF_P); const bf16_t* VT = (const bf16_t*)(p->ws + OFF_VT);
    bf16_t* YN = (bf16_t*)(p->ws + OFF_Y3) + 2ull * NTOK * 1024;
    const int tid = TIDX, w = tid >> 6, lane = tid & 63, n16 = lane & 15, g = lane >> 4, qi = w & 3, kh = w >> 2;
    const int b = task >> 9, h = (task >> 6) & 7, r = task & 63;
    const int qcol = qi * 16 + n16, qrow = b * 4096 + r * 64 + qcol;
    const int cs = qi == 0 ? 0 : (qi == 1 ? 8 : (qi == 2 ? 24 : 32)), row_start = min(max(r - 4, 0), 56), c_start = min(max(qcol - 8, 0), 48);
    unsigned char* KT = lds; unsigned char* VL = lds + 65536;
    bf16x8 qf[4];
#pragma unroll
    for (int c = 0; c < 4; ++c) qf[c] = *(const bf16x8*)(P + (size_t)qrow * NP + NAB + h * 128 + c * 32 + g * 8);
    const float* rpb = p->in[I_RPB] + (size_t)(l * 8 + h) * 15 * 31;
    const bf16_t* vtb = VT + (size_t)((b * 8 + h) * 128) * 4352;
    const bf16_t* kgb = P + NAB + 1024 + h * 128;
    f32x4 O[8];
#pragma unroll
    for (int i = 0; i < 8; ++i) O[i] = (f32x4){0.f, 0.f, 0.f, 0.f};
    float mrun = -INFINITY, lsum = 0.f;
    const float scale = 0.08838834764831845f;
    u32x4 kreg[8], vreg[8];
    auto gload = [&](int pass) {
#pragma unroll
        for (int i = 0; i < 8; ++i) { const int key = i * 32 + (tid >> 4), c16 = tid & 15, s_ = key >> 6, kk = key & 63;
            if (pass < 2) { const int krow = row_start + (s_ < 2 ? 2 * pass + s_ : 2 + 2 * pass + s_);
                kreg[i] = *(const u32x4*)(kgb + (size_t)(b * 4096 + krow * 64 + kk) * NP + c16 * 8); }
            else if (i < 4) { const int m = (s_ == 0 ? 0 : 128) + 64 * (pass - 2) + kk;
                kreg[i] = *(const u32x4*)(kgb + (size_t)(NLAT + b * 256 + m) * NP + c16 * 8); } }
#pragma unroll
        for (int i = 0; i < 8; ++i) { const int d = i * 16 + (tid >> 5), key8 = (tid & 31) * 8, s_ = key8 >> 6, kk = key8 & 63;
            if (pass < 2) { const int krow = row_start + (s_ < 2 ? 2 * pass + s_ : 2 + 2 * pass + s_);
                vreg[i] = *(const u32x4*)(vtb + (size_t)d * 4352 + krow * 64 + kk); }
            else if (key8 < 128) { const int m = (s_ == 0 ? 0 : 128) + 64 * (pass - 2) + kk;
                vreg[i] = *(const u32x4*)(vtb + (size_t)d * 4352 + 4096 + m); } }
    };
    auto lstore = [&](int pass) {
#pragma unroll
        for (int i = 0; i < 8; ++i) { const int key = i * 32 + (tid >> 4), c16 = tid & 15;
            if (pass < 2 || i < 4) *(u32x4*)(KT + key * 256 + ((c16 ^ (key & 15)) * 16)) = kreg[i]; }
#pragma unroll
        for (int i = 0; i < 8; ++i) { const int d = i * 16 + (tid >> 5), kc16 = tid & 31;
            if (pass < 2 || kc16 < 16) *(u32x4*)(VL + d * 512 + ((kc16 ^ (d & 15)) * 16)) = vreg[i]; }
    };
    gload(0);
    for (int pass = 0; pass < 4; ++pass) {
        __syncthreads();
        lstore(pass);
        __syncthreads();
        if (pass < 3) gload(pass + 1);
        f32x4 S[4];
#pragma unroll
        for (int i = 0; i < 4; ++i) {
            const int keyl = pass < 2 ? (kh * 2 + (i >> 1)) * 64 + cs + (i & 1) * 16 + n16 : kh * 64 + i * 16 + n16;
            const unsigned char* kp = KT + keyl * 256;
            f32x4 acc = (f32x4){0.f, 0.f, 0.f, 0.f};
#pragma unroll
            for (int c = 0; c < 4; ++c) { const bf16x8 kf = *(const bf16x8*)(kp + (((c * 4 + g) ^ (keyl & 15)) * 16)); acc = MFMA16(kf, qf[c], acc); }
            S[i] = acc;
        }
        float mx = -INFINITY;
#pragma unroll
        for (int i = 0; i < 4; ++i) {
            if (pass < 2) { const int krow = row_start + kh * 4 + 2 * pass + (i >> 1); const float* rb = rpb + (krow - r + 7) * 31;
#pragma unroll
                for (int jj = 0; jj < 4; ++jj) { const int kc = cs + (i & 1) * 16 + 4 * g + jj; const bool ok = (kc >= c_start) && (kc < c_start + 16);
                    const int co = min(max(kc - qcol, -15), 15) + 15;
                    S[i][jj] = ok ? S[i][jj] * scale + rb[co] : -INFINITY; } }
            else {
#pragma unroll
                for (int jj = 0; jj < 4; ++jj) S[i][jj] *= scale; }
#pragma unroll
            for (int jj = 0; jj < 4; ++jj) mx = fmaxf(mx, S[i][jj]);
        }
        mx = fmaxf(mx, __shfl_xor(mx, 16)); mx = fmaxf(mx, __shfl_xor(mx, 32));
        const float mnew = fmaxf(mrun, mx);
        const float alpha = __expf(mrun - mnew);
        mrun = mnew; lsum *= alpha;
#pragma unroll
        for (int i = 0; i < 8; ++i) { O[i][0] *= alpha; O[i][1] *= alpha; O[i][2] *= alpha; O[i][3] *= alpha; }
#pragma unroll
        for (int c = 0; c < 2; ++c) {
            float e[8];
#pragma unroll
            for (int jj = 0; jj < 4; ++jj) { e[jj] = __expf(S[2 * c][jj] - mnew); e[4 + jj] = __expf(S[2 * c + 1][jj] - mnew); }
#pragma unroll
            for (int jj = 0; jj < 8; ++jj) lsum += e[jj];
            u32x4 u; u[0] = pack2(e[0], e[1]); u[1] = pack2(e[2], e[3]); u[2] = pack2(e[4], e[5]); u[3] = pack2(e[6], e[7]);
            const bf16x8 pf = __builtin_bit_cast(bf16x8, u);
            const int key0 = pass < 2 ? (kh * 2 + c) * 64 + cs + 4 * g : kh * 64 + c * 32 + 4 * g;
            const int kc8a = key0 >> 2, kc8b = kc8a + 4;
#pragma unroll
            for (int dt = 0; dt < 8; ++dt) { const int d = dt * 16 + n16; const unsigned char* vp = VL + d * 512;
                const bf16x4 v0 = *(const bf16x4*)(vp + (((kc8a >> 1) ^ (d & 15)) * 16) + (kc8a & 1) * 8), v1 = *(const bf16x4*)(vp + (((kc8b >> 1) ^ (d & 15)) * 16) + (kc8b & 1) * 8);
                const bf16x8 vf = __builtin_shufflevector(v0, v1, 0, 1, 2, 3, 4, 5, 6, 7);
                O[dt] = MFMA16(vf, pf, O[dt]); }
        }
    }
    lsum += __shfl_xor(lsum, 16); lsum += __shfl_xor(lsum, 32);
    __syncthreads();
    float* cmb = (float*)lds + (size_t)qi * 34 * 64 + lane;
    if (kh == 1) { cmb[0] = mrun; cmb[64] = lsum;
#pragma unroll
        for (int dt = 0; dt < 8; ++dt)
#pragma unroll
            for (int jj = 0; jj < 4; ++jj) cmb[(2 + dt * 4 + jj) * 64] = O[dt][jj]; }
    __syncthreads();
    if (kh == 0) { const float m1 = cmb[0], l1 = cmb[64];
        const float mn = fmaxf(mrun, m1), a0 = __expf(mrun - mn), a1 = __expf(m1 - mn);
        const float inv = 1.0f / (lsum * a0 + l1 * a1);
        bf16_t* yo = YN + (size_t)qrow * 1024 + h * 128 + 4 * g;
#pragma unroll
        for (int dt = 0; dt < 8; ++dt) { float o[4];
#pragma unroll
            for (int jj = 0; jj < 4; ++jj) o[jj] = (O[dt][jj] * a0 + cmb[(2 + dt * 4 + jj) * 64] * a1) * inv;
            u32x2 ov; ov[0] = pack2(o[0], o[1]); ov[1] = pack2(o[2], o[3]); *(u32x2*)(yo + dt * 16) = ov; } }
}

__device__ void phase_mix(PP p, int l, float* lds, int which = 7) {
    const int TIDX = otid();
    for (int t = blockIdx.x; t < 256; t += gridDim.x) {
        if (t < 128) { if (which & 1) rwkv_scan(p, l, t, lds); }
        else if (which & 2) mlstm_scan(p, l, (t - 128) >> 3, (t - 128) & 7, lds);
        __syncthreads();
    }
    unsigned* ctr = (unsigned*)(p->ws + OFF_CTL) + l * 8 + ((which & 8) ? 1 : 0);
    if (!(which & 4)) return;
    int* stask = (int*)lds;
    const int ntask = l == 0 ? 1056 : 1024;
    for (;;) {
        __syncthreads();
        if (TIDX == 0) stask[0] = (int)atomicAdd(ctr, 1u);
        __syncthreads();
        const int t = stask[0];
        if (t >= ntask) break;
        const int nctx = ntask - 1024;
        if (t >= nctx) na_block(p, l, t - nctx, (unsigned char*)lds); else na_wave(p, l, 512 + t);
    }
}

__device__ void phase_post(PP p, int l, int nrows) {
    const int TIDX = otid();
    const int wid = TIDX >> 6, lane = TIDX & 63, gw = blockIdx.x * 8 + wid, nw = gridDim.x * 8;
    const bf16_t* P = (const bf16_t*)(p->ws + OFF_P); const bf16_t* LO = (const bf16_t*)(p->ws + OFF_LO);
    bf16_t* YM = (bf16_t*)(p->ws + OFF_Y3); bf16_t* YR = YM + (size_t)NTOK * 1024;
    const float* NUM = (const float*)(p->ws + OFF_MLNUM); const float* YF = (const float*)(p->ws + OFF_YRWF);
    for (int row = gw; row < nrows; row += nw) {
        f32x4 a[4], c[4], ng[4]; float dfr[4], dbr[4]; u32x2 ov[4];
#pragma unroll
        for (int h = 0; h < 4; ++h) {
            const float* nf = NUM + ((size_t)row * 4 + h) * 272; const float* nb = NUM + ((size_t)(NTOK + row) * 4 + h) * 272;
            a[h] = *(const f32x4*)(nf + lane * 4); c[h] = *(const f32x4*)(nb + lane * 4); dfr[h] = nf[256]; dbr[h] = nb[256];
            ov[h] = *(const u32x2*)(P + (size_t)row * NP + 2048 + h * 256 + lane * 4);
            ng[h] = *(const f32x4*)(p->in[I_MLNG] + l * 1024 + h * 256 + lane * 4); }
#pragma unroll
        for (int h = 0; h < 4; ++h) {
            const float df = 1.0f / fmaxf(fabsf(dfr[h]), 1.0f), db = 1.0f / fmaxf(fabsf(dbr[h]), 1.0f);
            float hv[4]; float ss = 0.f;
#pragma unroll
            for (int j = 0; j < 4; ++j) { hv[j] = a[h][j] * df + c[h][j] * db; ss += hv[j] * hv[j]; }
            ss = wsum(ss);
            const float rr = rsqrtf(ss * (1.0f / 256.0f) + 1e-6f);
            const float o0 = hv[0] * rr * ng[h][0] * sigmoidf(bflo(ov[h][0])), o1 = hv[1] * rr * ng[h][1] * sigmoidf(bfhi(ov[h][0]));
            const float o2 = hv[2] * rr * ng[h][2] * sigmoidf(bflo(ov[h][1])), o3 = hv[3] * rr * ng[h][3] * sigmoidf(bfhi(ov[h][1]));
            u32x2 w; w[0] = pack2(o0, o1); w[1] = pack2(o2, o3);
            *(u32x2*)(YM + (size_t)row * 1024 + h * 256 + lane * 4) = w; }
    }
    const float* MU = p->in[I_RWMU] + (size_t)l * 3712;
    const float* RKp = (const float*)(p->ws + OFF_RK);
#pragma unroll 2
    for (int it = gw; it < nrows * 4; it += nw) {
        const int row = it >> 2, head = (it & 3) * 4 + (lane >> 4), c = head * 64 + (lane & 15) * 4;
        bool hp, hn; seq_nbrs(row, hp, hn);
        const f32x4 ya = *(const f32x4*)(YF + (size_t)row * 1024 + c), yb = *(const f32x4*)(YF + (size_t)(NTOK + row) * 1024 + c);
        const bf16_t* pr = P + (size_t)row * NP + RWB + 2048 + c;
        const u32x2 z2 = {0u, 0u};
        const u32x2 vc = *(const u32x2*)pr, vp = hp ? *(const u32x2*)(pr - NP) : z2, vn = hn ? *(const u32x2*)(pr + NP) : z2;
        const u32x2 gv = *(const u32x2*)(LO + (size_t)row * 5120 + 4096 + c);
        const float rk = RKp[row * 16 + head];
        const f32x4 mu = *(const f32x4*)(MU + 2048 + c), lw = *(const f32x4*)(p->in[I_RWLNW] + l * 1024 + c), lb = *(const f32x4*)(p->in[I_RWLNB] + l * 1024 + c);
        const f32x4 y = ya + yb;
        const float mean = red16((y[0] + y[1]) + (y[2] + y[3])) * (1.0f / 64.0f);
        const f32x4 dy = y - mean;
        const float var = red16((dy[0] * dy[0] + dy[1] * dy[1]) + (dy[2] * dy[2] + dy[3] * dy[3])) * (1.0f / 64.0f);
        const float rs = rsqrtf(var + 64e-5f);
        const float v0 = shiftf(bflo(vc[0]), bflo(vp[0]), bflo(vn[0]), mu[0]), v1 = shiftf(bfhi(vc[0]), bfhi(vp[0]), bfhi(vn[0]), mu[1]);
        const float v2 = shiftf(bflo(vc[1]), bflo(vp[1]), bflo(vn[1]), mu[2]), v3 = shiftf(bfhi(vc[1]), bfhi(vp[1]), bfhi(vn[1]), mu[3]);
        const float o0 = (dy[0] * rs * lw[0] + lb[0] + rk * v0) * bflo(gv[0]), o1 = (dy[1] * rs * lw[1] + lb[1] + rk * v1) * bfhi(gv[0]);
        const float o2 = (dy[2] * rs * lw[2] + lb[2] + rk * v2) * bflo(gv[1]), o3 = (dy[3] * rs * lw[3] + lb[3] + rk * v3) * bfhi(gv[1]);
        u32x2 w; w[0] = pack2(o0, o1); w[1] = pack2(o2, o3);
        *(u32x2*)(YR + (size_t)row * 1024 + c) = w;
    }
}


constexpr size_t PART_OFF = 150ull << 20;
#ifndef DUPMASK
#define DUPMASK 0
#endif
#ifndef DUPWHICH
#define DUPWHICH 3
#endif
__global__ void __launch_bounds__(512, 2) fwd_kernel(Params p0) {
    extern __shared__ __attribute__((aligned(16))) unsigned char shm[];
    __shared__ uint4 xb_words;
    cg::grid_group grid = cg::this_grid();
    if (threadIdx.x == 0) xb_words = make_uint4(0u, 0u, 0u, 0u);
    __syncthreads();
    (void)xcd_barrier_post((unsigned*)(p0.ws + OFF_BAR), (volatile LAS unsigned*)&xb_words);
    float* ldsf = (float*)shm;
    LAS unsigned char* ldsg = (LAS unsigned char*)shm;
    const int ph_lo = p0.ph_lo, ph_hi = p0.ph_hi;
    auto kseg = __builtin_amdgcn_kernarg_segment_ptr();
    for (int ph = ph_lo; ph < ph_hi; ++ph) {
        PP p = (PP)kseg; asm volatile("" : "+s"(p));
        if (ph > ph_lo) {
            if (ph_hi > NPHASE) grid.sync();
            else { XcdBarrier xb; xb.bar = (unsigned*)(p->ws + OFF_BAR); xb.x = xb_xcc_id(); xb.st = (volatile LAS unsigned*)&xb_words; xcd_barrier(xb); }
        }
        unsigned char* ws = p->ws;
        const float* MOD = (const float*)(ws + OFF_MOD);
        float* XL = (float*)(ws + OFF_XL);
        bf16_t* H = (bf16_t*)(ws + OFF_H);
        bf16_t* Pb = (bf16_t*)(ws + OFF_P);
        if (ph == 0) { phase_mod(p, ldsf); __syncthreads(); phase_convert(p, 0, ldsf, (int)blockIdx.x, (int)gridDim.x, 0, 0, 18816, true); continue; }
        if (ph == NPHASE - 1) { phase_final(p); continue; }
        const int l = (ph - 1) / 11, sub = (ph - 1) % 11;
        const int two_wt = p->two_wt;
        const size_t wsh = (l == 1 && two_wt) ? WT_SHIFT : 0;
#if DUPMASK
        for (int rep = 0; rep < (((DUPMASK >> sub) & 1) ? 2 : 1); ++rep) { if (rep) grid.sync();
#endif
        const int Ml = l == 0 ? NTOK : NLAT;
        const float* modl = MOD + (size_t)l * 3 * 12288;
        if (sub == 1 || sub == 3 || sub == 6 || sub == 7 || sub == 9 || sub == 10) {
            const bool ksplit = l == 0 && (sub == 7 || sub == 10) && gridDim.x == 256;
            for (int part = 0; part < (ksplit ? 2 : (sub == 3 ? 3 : 1)); ++part) {
            pg8::Gemm g; pg8::SchedG S; pg8::EpiG E;
            S.mode = 0; S.mo.init(Ml / 256, (int)gridDim.x, (int)blockIdx.x);
            E.kind = 0; E.split = 0; E.O = Pb; E.ldc = NP; E.P = Pb; E.ACC = (float*)(ws + OFF_YRWF);
            E.xin_lat = XL; E.xin_ctx = XL + (size_t)NLAT * 2048; E.XL = XL; E.gate = modl; E.part = nullptr;
            if (sub == 1) { g = pg8::Gemm{H, (const bf16_t*)(ws + wsh + OFF_WIN), NTOK, NP, 2048, 32}; }
            else if (sub == 3) { const int n0 = part * 2048, k0 = part == 0 ? 0 : (part == 1 ? 192 : 384);
                g = pg8::Gemm{(const bf16_t*)(ws + OFF_LA) + k0, (const bf16_t*)(ws + wsh + OFF_WLORA) + (size_t)n0 * 640 + k0, NTOK, part == 2 ? 1024 : 2048, 640, 4}; E.O = (bf16_t*)(ws + OFF_LO) + n0; E.ldc = 5120; }
            else if (sub == 6) { g = pg8::Gemm{(const bf16_t*)(ws + OFF_Y3), (const bf16_t*)(ws + wsh + OFF_WBR), Ml, 2048, 1024, 16}; S.mode = 1; E.kind = 2; E.O = H; }
            else if (sub == 7) { g = pg8::Gemm{H, (const bf16_t*)(ws + wsh + OFF_WOUT), Ml, 2048, 2048, 32}; E.kind = 3; E.gate = modl + 2 * 2048;
                if (l == 0) { E.xin_lat = p->in[I_X]; E.xin_ctx = p->in[I_CTX]; } }
            else if (sub == 9) { g = pg8::Gemm{H, (const bf16_t*)(ws + wsh + OFF_WFF1), Ml, DFF, 2048, 32}; E.kind = 1; E.ldc = DFF; }
            else { g = pg8::Gemm{Pb, (const bf16_t*)(ws + wsh + OFF_WFF2), Ml, 2048, DFF, 128}; E.kind = 3; E.gate = modl + 5 * 2048; }
            if (ksplit) {
                if (part == 0) g.M = NLAT;
                else { const int ks = (int)blockIdx.x & 15; g.nt >>= 4; g.A += (size_t)ks * g.nt * 64; g.Bt += (size_t)ks * g.nt * 64; S.mode = 2; E.split = 1;
                    E.part = (float*)(ws + OFF_P + (sub == 10 ? PART_OFF : 0)) + (size_t)ks * 512 * 2048; }
            }
            S.so.init(g.M, g.N, (int)gridDim.x, (int)blockIdx.x);
            pg8::gemm_phase(ldsg, g, S, E);
            }
            if (two_wt && l == 0 && gridDim.x == 256) {
                if (sub == 1 && blockIdx.x >= 94) phase_convert(p, 1, ldsf, (int)blockIdx.x - 94, 162, WT_SHIFT, 0, 4000, false);
                if (sub == 6 && blockIdx.x >= 16) phase_convert(p, 1, ldsf, (int)blockIdx.x - 16, 240, WT_SHIFT, 4000, 11500, false);
                if (sub == 9 && blockIdx.x >= 64) phase_convert(p, 1, ldsf, (int)blockIdx.x - 64, 192, WT_SHIFT, 11500, 18816, true);
            } else if (two_wt && l == 0 && sub == 10) phase_convert(p, 1, ldsf, (int)blockIdx.x, (int)gridDim.x, WT_SHIFT, 0, 18816, true);
        } else
        switch (sub) {
        case 0: {
            phase_init(p, l);
            if (l == 1 && !two_wt) phase_convert(p, l, ldsf, (int)blockIdx.x, (int)gridDim.x, wsh, 0, 18816, true);
            if (l == 0) phase_norm(p->in[I_X], p->in[I_CTX], NTOK, p->in[I_N1G] + l * 2048, modl, 0, 1, H);
            else if (gridDim.x == 256) phase_norm(XL, XL + (size_t)NLAT * 2048, NTOK, p->in[I_N1G] + l * 2048, modl, 0, 1, H, (const float*)(ws + OFF_P + PART_OFF), MOD + 2 * 12288 + 5 * 2048, XL + (size_t)NLAT * 2048);
            else phase_norm(XL, XL + (size_t)NLAT * 2048, NTOK, p->in[I_N1G] + l * 2048, modl, 0, 1, H);
        } break;
        case 2: phase_prep(p, l, (bf16_t*)shm); break;
#if DUPMASK
        case 4: phase_mix(p, l, ldsf, rep ? DUPWHICH : 7); break;
#else
        case 4: phase_mix(p, l, ldsf); break;
#endif
        case 5: phase_post(p, l, Ml); break;
        case 8: if (l == 0 && gridDim.x == 256) phase_norm(XL, p->in[I_CTX], Ml, p->in[I_N2G] + l * 2048, modl, 3, 4, H, (const float*)(ws + OFF_P), modl + 2 * 12288 + 2 * 2048, XL + (size_t)NLAT * 2048);
                else phase_norm(XL, XL + (size_t)NLAT * 2048, Ml, p->in[I_N2G] + l * 2048, modl, 3, 4, H); break;
        }
#if DUPMASK
        }
#endif
    }
}

extern "C" void kernel_launch(void* const* d_in, const int* in_sizes, int n_in, void* d_out, int out_size, void* d_ws, size_t ws_size, hipStream_t stream) {
    static int grid = 0;
    if (grid == 0) {
        if (n_in != 28 || ws_size < WS_END) { fprintf(stderr, "kernel_launch: need 28 inputs and %zu bytes of workspace (got %d, %zu)\n", (size_t)WS_END, n_in, ws_size); grid = -1; return; }
        if (hipFuncSetAttribute((const void*)fwd_kernel, hipFuncAttributeMaxDynamicSharedMemorySize, LDS_BYTES) != hipSuccess) { fprintf(stderr, "kernel_launch: hipFuncSetAttribute failed\n"); grid = -1; return; }
        int dev = 0, cus = 0, per_cu = 0;
        hipGetDevice(&dev);
        hipDeviceGetAttribute(&cus, hipDeviceAttributeMultiprocessorCount, dev);
        hipOccupancyMaxActiveBlocksPerMultiprocessor(&per_cu, (const void*)fwd_kernel, 512, LDS_BYTES);
        if (per_cu < 1) { fprintf(stderr, "kernel_launch: occupancy query says %d blocks per CU\n", per_cu); per_cu = 1; }
        (void)hipGetLastError();
        grid = cus * 1;
        if (grid > 256) grid = 256;
    }
    if (grid < 0) return;
    if (hipMemsetAsync((char*)d_ws + OFF_BAR, 0, XCD_BAR_WORDS * sizeof(unsigned), stream) != hipSuccess) { fprintf(stderr, "kernel_launch: hipMemsetAsync of the barrier words failed\n"); return; }
    Params p{};
    for (int i = 0; i < 28; ++i) p.in[i] = (const float*)d_in[i];
    p.out = (float*)d_out; p.ws = (unsigned char*)d_ws; p.two_wt = (ws_size >= WS_END + WT_BYTES) ? 1 : 0;
#if ONE_LAUNCH
    p.ph_lo = 0; p.ph_hi = NPHASE;
    void* args[] = {&p};
    hipError_t e = hipLaunchCooperativeKernel((const void*)fwd_kernel, dim3(grid), dim3(512), args, LDS_BYTES, stream);
    if (e != hipSuccess) fprintf(stderr, "cooperative launch failed: %s (grid %d)\n", hipGetErrorString(e), grid);
#else
    for (int ph = 0; ph < NPHASE; ++ph) {
        p.ph_lo = ph; p.ph_hi = ph + 1;
        hipLaunchKernelGGL(fwd_kernel, dim3(grid), dim3(512), LDS_BYTES, stream, p);
    }
#endif
}
```
